# Optimizing an MI355X kernel written in HIP

```python
import jax, jax.numpy as jnp
from jax import lax
import numpy as np

D_MODEL = 1024
BATCH = 8
SEQ = 2048
DEPTH = 1

CONV_WIDTH = D_MODEL
CONV_TAPS = 3
POOL_WIDTH = D_MODEL
POOL_WINDOWS = (2, 4, 8, 16)
N_POOL_GROUPS = len(POOL_WINDOWS)
POOL_GROUP = POOL_WIDTH // N_POOL_GROUPS
N_BRANCHES = 2
IN_COLS = 3 * CONV_WIDTH + POOL_WIDTH + N_BRANCHES * D_MODEL
PEER_HEADS = 8
N_KEYS = 128
N_EXPERTS = N_KEYS * N_KEYS
PEER_TOPK = 16
QUERY_DIM = 256
HALF_QUERY = QUERY_DIM // 2
TOKEN_CHUNK = 128
EPS = 1e-6

kernel_name = "hybrid_shortconv_pool_peer_block"


def rmsnorm(x, g):
    xf = x.astype(jnp.float32)
    y = xf * lax.rsqrt(jnp.mean(xf * xf, axis=-1, keepdims=True) + EPS)
    return (y * g.astype(jnp.float32)).astype(x.dtype)


def causal_short_conv(z, w):
    s = z.shape[1]
    zp = jnp.pad(z, ((0, 0), (CONV_TAPS - 1, 0), (0, 0)))
    y = w[0] * zp[:, 0:s]
    for k in range(1, CONV_TAPS):
        y = y + w[k] * zp[:, k:k + s]
    return y


def multiscale_causal_pool(p, w_grp, scale):
    b, s, _ = p.shape
    pf = p.astype(jnp.float32).reshape(b, s, N_POOL_GROUPS, POOL_GROUP)
    cs = jnp.cumsum(pf, axis=1)
    pos = jnp.arange(s)
    outs = []
    for g, win in enumerate(POOL_WINDOWS):
        c = cs[:, :, g]
        lag = jnp.pad(c, ((0, 0), (win, 0), (0, 0)))[:, :s]
        cnt = jnp.minimum(pos + 1, win).astype(jnp.float32)[None, :, None]
        outs.append((c - lag) / cnt - pf[:, :, g])
    pooled = jnp.stack(outs, axis=2).astype(p.dtype)
    mixed = jnp.einsum('bsgc,gcd->bsgd', pooled, w_grp)
    return mixed.reshape(b, s, POOL_WIDTH) * scale


def hybrid_mixer(xn, w_in, conv_w, w_conv_out, pool_w, pool_scale, w_pool_out, w_out):
    proj = xn @ w_in
    c0, c1, c2 = CONV_WIDTH, 2 * CONV_WIDTH, 3 * CONV_WIDTH
    c3 = c2 + POOL_WIDTH
    b_gate = proj[..., :c0]
    c_gate = proj[..., c0:c1]
    h = proj[..., c1:c2]
    p = proj[..., c2:c3]
    g_a = proj[..., c3:c3 + D_MODEL]
    g_b = proj[..., c3 + D_MODEL:]
    y_a = (b_gate * causal_short_conv(c_gate * h, conv_w)) @ w_conv_out
    y_b = multiscale_causal_pool(p, pool_w, pool_scale) @ w_pool_out
    merged = jax.nn.sigmoid(g_a) * y_a + jax.nn.sigmoid(g_b) * y_b
    return merged @ w_out


def peer(xn, w_query, sub_keys, expert_u, expert_v):
    b, s, d = xn.shape
    t = b * s
    xf = xn.reshape(t, d)
    q = (xf @ w_query).reshape(t, PEER_HEADS, 2, HALF_QUERY)
    scores = jnp.einsum('thpk,hpnk->thpn', q, sub_keys).astype(jnp.float32)
    v1, i1 = lax.top_k(scores[:, :, 0], PEER_TOPK)
    v2, i2 = lax.top_k(scores[:, :, 1], PEER_TOPK)
    cand = (v1[..., :, None] + v2[..., None, :]).reshape(t, PEER_HEADS, PEER_TOPK * PEER_TOPK)
    best, pos = lax.top_k(cand, PEER_TOPK)
    e1 = jnp.take_along_axis(i1, pos // PEER_TOPK, axis=-1)
    e2 = jnp.take_along_axis(i2, pos % PEER_TOPK, axis=-1)
    experts = (e1 * N_KEYS + e2).reshape(t, PEER_HEADS * PEER_TOPK)
    gates = jax.nn.softmax(best, axis=-1).reshape(t, PEER_HEADS * PEER_TOPK).astype(xn.dtype)

    def chunk_fn(args):
        xc, ic, gc = args
        u = expert_u[ic]
        a = jax.nn.gelu(jnp.einsum('cd,ced->ce', xc, u), approximate=False) * gc
        v = expert_v[ic]
        return jnp.einsum('ce,ced->cd', a, v)

    n_chunks = t // TOKEN_CHUNK
    out = lax.map(chunk_fn, (xf.reshape(n_chunks, TOKEN_CHUNK, d),
                             experts.reshape(n_chunks, TOKEN_CHUNK, -1),
                             gates.reshape(n_chunks, TOKEN_CHUNK, -1)))
    return out.reshape(b, s, d)


def setup_inputs(seed: int = 0) -> dict:
    key = jax.random.key(seed)
    ks = jax.random.split(key, 18)
    f32 = jnp.float32
    L, D = DEPTH, D_MODEL
    nrm = lambda k, shape, sc: (jax.random.normal(k, shape, f32) * sc)
    return {
        "x": jax.random.normal(ks[0], (BATCH, SEQ, D), f32),
        "norm_mix_g": 1.0 + nrm(ks[1], (L, D), 0.02),
        "w_in": nrm(ks[2], (L, D, IN_COLS), D ** -0.5),
        "conv_w": nrm(ks[3], (L, CONV_TAPS, CONV_WIDTH), CONV_TAPS ** -0.5),
        "w_conv_out": nrm(ks[4], (L, CONV_WIDTH, D), CONV_WIDTH ** -0.5),
        "pool_w": nrm(ks[5], (L, N_POOL_GROUPS, POOL_GROUP, POOL_GROUP), POOL_GROUP ** -0.5),
        "pool_scale": 1.0 + nrm(ks[6], (L, POOL_WIDTH), 0.02),
        "w_pool_out": nrm(ks[7], (L, POOL_WIDTH, D), POOL_WIDTH ** -0.5),
        "w_out": nrm(ks[8], (L, D, D), D ** -0.5),
        "norm_ffn_g": 1.0 + nrm(ks[9], (L, D), 0.02),
        "w_query": nrm(ks[10], (L, D, PEER_HEADS * QUERY_DIM), D ** -0.5),
        "sub_keys": nrm(ks[11], (L, PEER_HEADS, 2, N_KEYS, HALF_QUERY), HALF_QUERY ** -0.5),
        "expert_u": nrm(ks[12], (L, N_EXPERTS, D), D ** -0.5),
        "expert_v": nrm(ks[13], (L, N_EXPERTS, D), 0.5),
        "norm_final_g": 1.0 + nrm(ks[14], (D,), 0.02),
    }


def reference(x, norm_mix_g, w_in, conv_w, w_conv_out, pool_w, pool_scale, w_pool_out,
              w_out, norm_ffn_g, w_query, sub_keys, expert_u, expert_v, norm_final_g):
    h = x
    for l in range(DEPTH):
        xn = rmsnorm(h, norm_mix_g[l])
        h = h + hybrid_mixer(xn, w_in[l], conv_w[l], w_conv_out[l], pool_w[l],
                             pool_scale[l], w_pool_out[l], w_out[l])
        xn = rmsnorm(h, norm_ffn_g[l])
        h = h + peer(xn, w_query[l], sub_keys[l], expert_u[l], expert_v[l])
    return rmsnorm(h, norm_final_g)
```

```cpp
#include <hip/hip_runtime.h>
#include <cstdio>
#include <cstdint>
namespace pg8 {
#define PG8_LAS __attribute__((address_space(3)))
typedef unsigned short bf16_t;
typedef short bf16x8 __attribute__((ext_vector_type(8)));
typedef float f32x4 __attribute__((ext_vector_type(4)));
typedef unsigned u32x4 __attribute__((ext_vector_type(4)));
constexpr int BM = 256, BK = 64, HALF = 128, HTB = HALF * BK * 2  , STAGE_BYTES = 8 * HTB, NXCD = 8, WGM = 8;

__host__ __device__ __forceinline__ int lds_byte(int r, int c) { const int st = (r >> 4) * 2 + (c >> 5), rr = r & 15, cc = c & 31, ob = rr * 64 + cc * 2; return st * 1024 + (ob ^ (((ob >> 9) & 1) << 5)); }
__host__ __device__ __forceinline__ void stage_rc(int b, int& R, int& C) { const int st = b / 1024, sb = b % 1024, swz = sb ^ (((sb >> 9) & 1) << 5); R = (st >> 1) * 16 + swz / 64; C = (st & 1) * 32 + (swz % 64) / 2; }
__host__ __device__ __forceinline__ int perm32(int rho) { const int n = rho >> 4, i = rho & 15; return 8 * (i >> 2) + 4 * n + (i & 3); }

struct Unit { int pm, pn, sel; };
struct Gemm { const bf16_t* A; const bf16_t* Bt; long offA1, offB1; int M, N, K; };

struct StaticOrder {
    int nM, nN, nwg, G, c;
    __host__ __device__ void init(int M, int N, int G_, int c_) { nM = M / BM; nN = N / BM; nwg = nM * nN; G = G_; c = c_; }
    __host__ __device__ __forceinline__ bool next(int i, Unit& u) const {
        const long L = (long)i * G + c; if (L >= nwg) return false;
        int wgid = (int)L; { const int q = nwg / NXCD, r = nwg % NXCD, xcd = wgid % NXCD, off = wgid / NXCD; wgid = (xcd < r ? xcd * (q + 1) : r * (q + 1) + (xcd - r) * q) + off; }
        const int nig = WGM * nN, gid = wgid / nig, fm = gid * WGM, gsz = (nM - fm) < WGM ? (nM - fm) : WGM;
        u.pm = fm + ((wgid % nig) % gsz); u.pn = (wgid % nig) / gsz; u.sel = 0; return true;
    }
    __device__ __forceinline__ void a_ready(const Unit&) const {}
    __device__ __forceinline__ void done(const Unit&) const {}
};


__device__ __forceinline__ unsigned cvt_pk_bf16(float lo, float hi) { unsigned r; asm volatile("v_cvt_pk_bf16_f32 %0, %1, %2" : "=v"(r) : "v"(lo), "v"(hi)); return r; }
__device__ __forceinline__ float sigm(float x) { return __builtin_amdgcn_rcpf(1.0f + __expf(-x)); }
__device__ __forceinline__ float bflo(unsigned w) { return __uint_as_float(w << 16); }
__device__ __forceinline__ float bfhi(unsigned w) { return __uint_as_float(w & 0xffff0000u); }

struct EpiProj {
    static constexpr bool PERM = true, AFTER_DRAIN = false;
    bf16_t* PB; bf16_t* PG;
    __device__ __forceinline__ void operator()(const f32x4 (&acc)[2][2][4][2], const Unit& u, int wr, int wc, int fr, int fq) const {
        const bool gate = u.pn >= 16;
        bf16_t* base = gate ? PG : PB; const int ldc = gate ? 2048 : 4096; const int colt = (gate ? u.pn - 16 : u.pn) * BM;
        const int row0 = u.pm * BM + wr * 64 + fr, col0 = colt + wc * 32 + 8 * fq;
#pragma unroll
        for (int ai = 0; ai < 2; ++ai)
#pragma unroll
            for (int m = 0; m < 4; ++m) { bf16_t* rowp = base + (size_t)(row0 + ai * HALF + m * 16) * ldc + col0;
#pragma unroll
                for (int bj = 0; bj < 2; ++bj) { f32x4 v0 = acc[ai][bj][m][0], v1 = acc[ai][bj][m][1];
                    if (gate) { v0[0] = sigm(v0[0]); v0[1] = sigm(v0[1]); v0[2] = sigm(v0[2]); v0[3] = sigm(v0[3]); v1[0] = sigm(v1[0]); v1[1] = sigm(v1[1]); v1[2] = sigm(v1[2]); v1[3] = sigm(v1[3]); }
                    u32x4 w; w.x = cvt_pk_bf16(v0[0], v0[1]); w.y = cvt_pk_bf16(v0[2], v0[3]); w.z = cvt_pk_bf16(v1[0], v1[1]); w.w = cvt_pk_bf16(v1[2], v1[3]);
                    *(u32x4*)(rowp + bj * HALF) = w; } }
    }
};
struct EpiMerge {
    static constexpr bool PERM = true, AFTER_DRAIN = false;
    const bf16_t* PG; bf16_t* TMP; long mg_off;
    __device__ __forceinline__ void operator()(const f32x4 (&acc)[2][2][4][2], const Unit& u, int wr, int wc, int fr, int fq) const {
        const int row0 = u.pm * BM + wr * 64 + fr, col0 = u.pn * BM + wc * 32 + 8 * fq; const int goff = u.sel ? 1024 : 0;
#pragma unroll
        for (int ai = 0; ai < 2; ++ai)
#pragma unroll
            for (int m = 0; m < 4; ++m) { const size_t row = (size_t)(row0 + ai * HALF + m * 16);
#pragma unroll
                for (int bj = 0; bj < 2; ++bj) { const int col = col0 + bj * HALF;
                    const u32x4 g = *(const u32x4*)(PG + row * 2048 + goff + col);
                    const f32x4 v0 = acc[ai][bj][m][0], v1 = acc[ai][bj][m][1];
                    float o0 = v0[0] * bflo(g.x), o1 = v0[1] * bfhi(g.x), o2 = v0[2] * bflo(g.y), o3 = v0[3] * bfhi(g.y);
                    float o4 = v1[0] * bflo(g.z), o5 = v1[1] * bfhi(g.z), o6 = v1[2] * bflo(g.w), o7 = v1[3] * bfhi(g.w);
                    if (u.sel) { const u32x4 t = *(const u32x4*)(TMP + row * 1024 + col);
                        o0 += bflo(t.x); o1 += bfhi(t.x); o2 += bflo(t.y); o3 += bfhi(t.y); o4 += bflo(t.z); o5 += bfhi(t.z); o6 += bflo(t.w); o7 += bfhi(t.w); }
                    u32x4 w; w.x = cvt_pk_bf16(o0, o1); w.y = cvt_pk_bf16(o2, o3); w.z = cvt_pk_bf16(o4, o5); w.w = cvt_pk_bf16(o6, o7);
                    *(u32x4*)(TMP + (u.sel ? mg_off : 0l) + row * 1024 + col) = w; } }
    }
};
struct EpiRes {
    static constexpr bool PERM = false, AFTER_DRAIN = false;
    const float* X; float* H;
    __device__ __forceinline__ void operator()(const f32x4 (&acc)[2][2][4][2], const Unit& u, int wr, int wc, int fr, int fq) const {
        const int row0 = u.pm * BM + wr * 64 + fr, col0 = u.pn * BM + wc * 32 + 4 * fq;
#pragma unroll
        for (int ai = 0; ai < 2; ++ai)
#pragma unroll
            for (int m = 0; m < 4; ++m) { const size_t off = (size_t)(row0 + ai * HALF + m * 16) * 1024 + col0;
#pragma unroll
                for (int bj = 0; bj < 2; ++bj)
#pragma unroll
                    for (int n = 0; n < 2; ++n) { const f32x4 xv = *(const f32x4*)(X + off + bj * HALF + n * 16); *(f32x4*)(H + off + bj * HALF + n * 16) = xv + acc[ai][bj][m][n]; } }
    }
};
struct EpiF32 {
    static constexpr bool PERM = false, AFTER_DRAIN = false;
    float* C; int ldc;
    __device__ __forceinline__ void operator()(const f32x4 (&acc)[2][2][4][2], const Unit& u, int wr, int wc, int fr, int fq) const {
        const int row0 = u.pm * BM + wr * 64 + fr, col0 = u.pn * BM + wc * 32 + 4 * fq;
#pragma unroll
        for (int ai = 0; ai < 2; ++ai)
#pragma unroll
            for (int m = 0; m < 4; ++m) { float* rowp = C + (size_t)(row0 + ai * HALF + m * 16) * ldc + col0;
#pragma unroll
                for (int bj = 0; bj < 2; ++bj)
#pragma unroll
                    for (int n = 0; n < 2; ++n) *(f32x4*)(rowp + bj * HALF + n * 16) = acc[ai][bj][m][n]; }
    }
};
struct MergeOrder {
    StaticOrder base;
    __device__ __forceinline__ bool next(int i, Unit& u) const { if (!base.next(i >> 1, u)) return false; u.sel = i & 1; return true; }
    __device__ __forceinline__ void a_ready(const Unit&) const {}
    __device__ __forceinline__ void done(const Unit&) const {}
};

template <class Epi, class Sched, bool ALIGN_EPI = false, bool SP2 = false>
__device__ __forceinline__ void gemm_phase(PG8_LAS unsigned char* lds, const Gemm g, const Sched& S, const Epi& E) {
    const int tid = threadIdx.x, wid = __builtin_amdgcn_readfirstlane(tid >> 6), lane = tid & 63, wr = wid >> 2, wc = wid & 3, fr = lane & 15, fq = lane >> 4;
    const int K = g.K, nt = K / BK;
    unsigned voffA[2], voffB[2];
#pragma unroll
    for (int i = 0; i < 2; ++i) { int R, C; stage_rc(tid * 16 + i * 8192, R, C); const int Rb = Epi::PERM ? ((R & ~31) + perm32(R & 31)) : R;
        voffA[i] = (unsigned)(R * K + C) * 2u; voffB[i] = (unsigned)(Rb * K + C) * 2u; }
    const size_t kstep = (size_t)(BK * 2);
    const size_t hstep = (size_t)HALF * K * 2;
    const size_t tstep = 2 * hstep;
    const unsigned ldsw = (unsigned)wid * 1024u;
    const int aoff = lds_byte(wr * 64 + fr, fq * 8), boff = lds_byte(wc * 32 + fr, fq * 8);
#define PG8_SA(b, h) (((b) * 2 + (h)) * HTB)
#define PG8_SB(b, h) ((4 + (b) * 2 + (h)) * HTB)
#define PG8_STAGE(bufoff, gbase, voff) do { _Pragma("unroll") for (int _i = 0; _i < 2; ++_i) \
        __builtin_amdgcn_global_load_lds((const unsigned*)((const char*)(gbase) + (voff)[_i]), (PG8_LAS unsigned*)(lds + (bufoff) + ldsw + _i * 8192), 16, 0, 0); } while (0)
#define PG8_LDA(dst, b, h) do { _Pragma("unroll") for (int m = 0; m < 4; ++m) _Pragma("unroll") for (int k = 0; k < 2; ++k) dst[m][k] = *(const PG8_LAS bf16x8*)(lds + PG8_SA(b, h) + aoff + m * 2048 + k * 1024); } while (0)
#define PG8_LDB(dst, b, h) do { _Pragma("unroll") for (int n = 0; n < 2; ++n) _Pragma("unroll") for (int k = 0; k < 2; ++k) dst[n][k] = *(const PG8_LAS bf16x8*)(lds + PG8_SB(b, h) + boff + n * 2048 + k * 1024); } while (0)
#define PG8_MMA(ai, bj, At, Bt) do { __builtin_amdgcn_s_setprio(1); _Pragma("unroll") for (int m = 0; m < 4; ++m) _Pragma("unroll") for (int n = 0; n < 2; ++n) _Pragma("unroll") for (int k = 0; k < 2; ++k) \
        acc[ai][bj][m][n] = __builtin_amdgcn_mfma_f32_16x16x32_bf16(Bt[n][k], At[m][k], acc[ai][bj][m][n], 0, 0, 0); __builtin_amdgcn_s_setprio(0); } while (0)
#define PG8_WAIT_V(n) asm volatile("s_waitcnt vmcnt(" #n ")" ::: "memory")
#define PG8_WAIT_L(n) asm volatile("s_waitcnt lgkmcnt(" #n ")" ::: "memory")
#define PG8_BAR __builtin_amdgcn_s_barrier()
#define PG8_SCHED __builtin_amdgcn_sched_barrier(0)
    Unit cur, nxt; int ui = 0;
    if (!S.next(0, cur)) return;
    f32x4 acc[2][2][4][2];
#pragma unroll
    for (int a = 0; a < 2; ++a)
#pragma unroll
        for (int b = 0; b < 2; ++b)
#pragma unroll
            for (int m = 0; m < 4; ++m)
#pragma unroll
                for (int n = 0; n < 2; ++n) acc[a][b][m][n] = (f32x4){0.f, 0.f, 0.f, 0.f};
    bf16x8 At[4][2], B0[2][2], B1[2][2];
    const char* cA = (const char*)g.A + (cur.sel ? g.offA1 : 0l) + (size_t)cur.pm * tstep; const char* cB = (const char*)g.Bt + (cur.sel ? g.offB1 : 0l) + (size_t)cur.pn * tstep;
    S.a_ready(cur);
    if constexpr (SP2) {
        PG8_STAGE(PG8_SB(0, 0), cB, voffB); PG8_STAGE(PG8_SB(0, 1), cB + hstep, voffB); PG8_STAGE(PG8_SA(0, 0), cA, voffA); PG8_STAGE(PG8_SA(0, 1), cA + hstep, voffA);
        if (wr == 1) PG8_BAR;
        PG8_WAIT_V(2); PG8_BAR;
        PG8_STAGE(PG8_SB(1, 0), cB + kstep, voffB); PG8_STAGE(PG8_SA(1, 0), cA + kstep, voffA); PG8_STAGE(PG8_SB(1, 1), cB + hstep + kstep, voffB);
        PG8_WAIT_V(6); PG8_BAR;
    } else {
        PG8_STAGE(PG8_SB(0, 0), cB, voffB); PG8_STAGE(PG8_SA(0, 0), cA, voffA); PG8_STAGE(PG8_SB(0, 1), cB + hstep, voffB); PG8_STAGE(PG8_SA(0, 1), cA + hstep, voffA);
        if (wr == 1) PG8_BAR;
        PG8_WAIT_V(4); PG8_BAR;
        PG8_STAGE(PG8_SB(1, 0), cB + kstep, voffB); PG8_STAGE(PG8_SA(1, 0), cA + kstep, voffA); PG8_STAGE(PG8_SB(1, 1), cB + hstep + kstep, voffB);
        PG8_WAIT_V(6); PG8_BAR;
    }
    for (;;) {
        const bool has_next = S.next(ui + 1, nxt);
        const char* nA = has_next ? (const char*)g.A + (nxt.sel ? g.offA1 : 0l) + (size_t)nxt.pm * tstep : cA; const char* nB = has_next ? (const char*)g.Bt + (nxt.sel ? g.offB1 : 0l) + (size_t)nxt.pn * tstep : cB;
        for (int t = 0; t < nt; t += 2) {
            const bool last = (t == nt - 2);
            const char* a1 = cA + (size_t)(t + 1) * kstep;
            const char* a2 = last ? nA : cA + (size_t)(t + 2) * kstep; const char* b2 = last ? nB : cB + (size_t)(t + 2) * kstep;
            const char* a3 = a2 + kstep; const char* b3 = b2 + kstep;
            if (last && has_next) S.a_ready(nxt);
            if constexpr (SP2) {
            PG8_LDB(B0, 0, 0); PG8_LDB(B1, 0, 1); PG8_SCHED; PG8_LDA(At, 0, 0); PG8_STAGE(PG8_SA(1, 1), a1 + hstep, voffA);
            PG8_WAIT_V(8); PG8_WAIT_L(0); PG8_BAR; PG8_MMA(0, 0, At, B0); PG8_MMA(0, 1, At, B1); PG8_BAR; PG8_SCHED;
            PG8_LDA(At, 0, 1); PG8_STAGE(PG8_SB(0, 0), b2, voffB); PG8_STAGE(PG8_SB(0, 1), b2 + hstep, voffB); PG8_STAGE(PG8_SA(0, 0), a2, voffA);
            PG8_WAIT_V(8); PG8_WAIT_L(0); PG8_BAR; PG8_MMA(1, 0, At, B0); PG8_MMA(1, 1, At, B1); PG8_BAR; PG8_SCHED;
            PG8_LDB(B0, 1, 0); PG8_LDB(B1, 1, 1); PG8_SCHED; PG8_LDA(At, 1, 0); PG8_STAGE(PG8_SA(0, 1), a2 + hstep, voffA);
            PG8_WAIT_V(8); PG8_WAIT_L(0); PG8_BAR; PG8_MMA(0, 0, At, B0); PG8_MMA(0, 1, At, B1); PG8_BAR; PG8_SCHED;
            PG8_LDA(At, 1, 1); PG8_STAGE(PG8_SB(1, 0), b3, voffB); PG8_STAGE(PG8_SB(1, 1), b3 + hstep, voffB); PG8_STAGE(PG8_SA(1, 0), a3, voffA);
            PG8_WAIT_V(8); PG8_WAIT_L(0); PG8_BAR; PG8_MMA(1, 0, At, B0); PG8_MMA(1, 1, At, B1); PG8_BAR; PG8_SCHED;
            } else {
            PG8_LDB(B0, 0, 0); PG8_SCHED; PG8_LDA(At, 0, 0); PG8_STAGE(PG8_SA(1, 1), a1 + hstep, voffA);
            PG8_WAIT_L(8); PG8_BAR; PG8_WAIT_L(0); PG8_MMA(0, 0, At, B0); PG8_BAR; PG8_SCHED;
            PG8_LDB(B1, 0, 1); PG8_STAGE(PG8_SB(0, 0), b2, voffB);
            PG8_BAR; PG8_WAIT_L(0); PG8_MMA(0, 1, At, B1); PG8_BAR;
            PG8_LDA(At, 0, 1); PG8_STAGE(PG8_SA(0, 0), a2, voffA);
            PG8_BAR; PG8_WAIT_L(0); PG8_MMA(1, 0, At, B0); PG8_BAR; PG8_SCHED;
            PG8_STAGE(PG8_SB(0, 1), b2 + hstep, voffB);
            PG8_WAIT_V(6); PG8_BAR; PG8_MMA(1, 1, At, B1); PG8_BAR;
            PG8_LDB(B0, 1, 0); PG8_SCHED; PG8_LDA(At, 1, 0); PG8_STAGE(PG8_SA(0, 1), a2 + hstep, voffA);
            PG8_WAIT_L(8); PG8_BAR; PG8_WAIT_L(0); PG8_MMA(0, 0, At, B0); PG8_BAR; PG8_SCHED;
            PG8_LDB(B1, 1, 1); PG8_STAGE(PG8_SB(1, 0), b3, voffB);
            PG8_BAR; PG8_WAIT_L(0); PG8_MMA(0, 1, At, B1); PG8_BAR;
            PG8_LDA(At, 1, 1); PG8_STAGE(PG8_SA(1, 0), a3, voffA);
            PG8_BAR; PG8_WAIT_L(0); PG8_MMA(1, 0, At, B0); PG8_BAR; PG8_SCHED;
            PG8_STAGE(PG8_SB(1, 1), b3 + hstep, voffB);
            PG8_WAIT_V(6); PG8_BAR; PG8_MMA(1, 1, At, B1); PG8_BAR;
            }
        }
        if constexpr (ALIGN_EPI) { if (wr == 0) PG8_BAR; }
        if constexpr (!Epi::AFTER_DRAIN) { E(acc, cur, wr, wc, fr, fq); S.done(cur); }
        if (!has_next) break;
#pragma unroll
        for (int a = 0; a < 2; ++a)
#pragma unroll
            for (int b = 0; b < 2; ++b)
#pragma unroll
                for (int m = 0; m < 4; ++m)
#pragma unroll
                    for (int n = 0; n < 2; ++n) acc[a][b][m][n] = (f32x4){0.f, 0.f, 0.f, 0.f};
        cur = nxt; cA = nA; cB = nB; ++ui;
        if constexpr (ALIGN_EPI) { if (wr == 1) PG8_BAR; }
    }
    PG8_WAIT_V(0);
    if constexpr (!ALIGN_EPI) { if (wr == 0) PG8_BAR; }
    PG8_BAR;
    if constexpr (Epi::AFTER_DRAIN) { E.fused(acc, cur, wr, wc, fr, fq, lds, wid, lane); S.done(cur); }
#undef PG8_SA
#undef PG8_SB
#undef PG8_STAGE
#undef PG8_LDA
#undef PG8_LDB
#undef PG8_MMA
#undef PG8_WAIT_V
#undef PG8_WAIT_L
#undef PG8_BAR
#undef PG8_SCHED
}
}
constexpr int NWAVES = 8;
#ifndef MK_N_LAUNCHES
#define MK_N_LAUNCHES 9
#endif
constexpr int NPHASE = 9;
constexpr int N_LAUNCHES = MK_N_LAUNCHES;
static_assert(N_LAUNCHES == 1 || N_LAUNCHES == NPHASE, "MK_N_LAUNCHES is 1 or NPHASE");

constexpr int T = 16384, SEQ = 2048, D = 1024, NIN = 6144, NSC = 2048, NEXP = 16384, NSEL = 128;
constexpr float EPS = 1e-6f;

constexpr size_t MiB = 1u << 20;
constexpr size_t WS_CTL = 0, CTL_ZERO_BYTES = 64 * 1024;
constexpr size_t WS_WIN = 1 * MiB, WS_WC = 13 * MiB, WS_WPB = 15 * MiB, WS_WOUT = 17 * MiB, WS_WS = 19 * MiB;
constexpr size_t WS_IDX = 1 * MiB, WS_GATE = 9 * MiB;
constexpr size_t WS_XN = 32 * MiB;
constexpr size_t WS_PB = 64 * MiB;
constexpr size_t WS_TMP = 64 * MiB, WS_MG = 96 * MiB;
constexpr size_t WS_SC = 64 * MiB;
constexpr size_t WS_PG = 192 * MiB;
constexpr size_t WS_U16 = 192 * MiB, WS_V16 = 224 * MiB;
constexpr size_t WS_END = 256 * MiB;
constexpr int CW_BAR = 1024;

constexpr int RING_OFF = 0, RING_BYTES = 131072;
constexpr int LDSCTL_OFF = RING_BYTES, MISC_OFF = LDSCTL_OFF + 320;
constexpr int LDS_BYTES = 147456;
#define GAS __attribute__((address_space(1)))
#define LAS __attribute__((address_space(3)))
typedef unsigned short bf16;
typedef unsigned v4u __attribute__((ext_vector_type(4)));
typedef float f32x4 __attribute__((ext_vector_type(4)));
typedef short bf16x8 __attribute__((ext_vector_type(8)));
typedef GAS unsigned gu32;
typedef GAS unsigned long long gu64;
#define RLX_AGENT __ATOMIC_RELAXED, __HIP_MEMORY_SCOPE_AGENT
#define LDS_WAIT() asm volatile("s_waitcnt lgkmcnt(0)" ::: "memory")
#define VM_WAIT() asm volatile("s_waitcnt vmcnt(0)" ::: "memory")
__device__ __forceinline__ unsigned long long rt() { return __builtin_amdgcn_s_memrealtime(); }
__device__ __forceinline__ unsigned f2bf(float f) { unsigned u = __builtin_bit_cast(unsigned, f); return (u + 0x7fffu + ((u >> 16) & 1u)) >> 16; }
__device__ __forceinline__ unsigned pk2(float lo, float hi) { return f2bf(lo) | (f2bf(hi) << 16); }

#define XB_TMO      128
#define XB_XCNT(j)  (256  + 64 * (j))
#define XB_XSUB(j)  (1280 + 64 * (j))
#define XB_XGEN(j)  (2304 + 64 * (j))
#define XB_TOP      3328
#define XB_TOPGEN   3392
#define XCD_BAR_WORDS 3456
#define XB_SPIN_CAP (1u << 18)

__device__ __forceinline__ unsigned xb_ld(unsigned* p)              { return __hip_atomic_load(p, __ATOMIC_RELAXED, __HIP_MEMORY_SCOPE_AGENT); }
__device__ __forceinline__ unsigned xb_add(unsigned* p, unsigned v) { return __hip_atomic_fetch_add(p, v, __ATOMIC_RELAXED, __HIP_MEMORY_SCOPE_AGENT); }
__device__ __forceinline__ unsigned xb_xcc_id() { return (unsigned)__builtin_amdgcn_s_getreg((3 << 11) | 20) & 0xFu; }
#define XB_SPIN(cond, bar) do { unsigned _sp = 0; while (cond) { __builtin_amdgcn_s_sleep(1); \
    if ((++_sp & 255u) == 0u) { if (xb_ld(&(bar)[XB_TMO])) break; if (_sp > XB_SPIN_CAP) { atomicAdd(&(bar)[XB_TMO], 1u); break; } } } } while (0)

struct XcdBarrier {
    unsigned* bar; unsigned x;
    volatile LAS unsigned* st;
};

__device__ __forceinline__ XcdBarrier xcd_barrier_post(unsigned* bar, volatile LAS unsigned* st) {
    XcdBarrier b; b.bar = bar; b.x = xb_xcc_id(); b.st = st;
    if (threadIdx.x == 0) (void)xb_add(&bar[XB_XCNT(b.x)], 1u);
    return b;
}
__device__ __forceinline__ void xcd_barrier_complete(unsigned* bar, unsigned x, unsigned& nloc, unsigned& nx) {
    const unsigned G = gridDim.x * gridDim.y * gridDim.z;
    unsigned sum, cnt, mine, sp = 0u;
    for (;;) {
        sum = 0u; cnt = 0u; mine = 0u;
#pragma unroll
        for (unsigned j = 0; j < 16; ++j) { const unsigned c = xb_ld(&bar[XB_XCNT(j)]); sum += c; cnt += (c > 0u) ? 1u : 0u; mine = (j == x) ? c : mine; }
        if (sum == G) break;
        __builtin_amdgcn_s_sleep(1);
        if ((++sp & 255u) == 0u) { if (xb_ld(&bar[XB_TMO])) break; if (sp > XB_SPIN_CAP) { atomicAdd(&bar[XB_TMO], 1u); break; } }
    }
    nloc = mine > 0u ? mine : 1u; nx = cnt > 0u ? cnt : 1u;
}

__device__ __forceinline__ void xcd_barrier(const XcdBarrier& b) {
    asm volatile("s_waitcnt vmcnt(0)" ::: "memory");
    __syncthreads();
    if (threadIdx.x == 0) {
        unsigned* bar = b.bar;
        __builtin_amdgcn_s_waitcnt(0);
        unsigned nloc = b.st[0], nx = b.st[1];
        if (nloc == 0u) { xcd_barrier_complete(bar, b.x, nloc, nx); b.st[0] = nloc; b.st[1] = nx; }
        const unsigned old = xb_add(&bar[XB_XSUB(b.x)], 1u);
        const unsigned gen = old / nloc;
        if (old + 1u == (gen + 1u) * nloc) {
            __builtin_amdgcn_fence(__ATOMIC_RELEASE, "agent");
            asm volatile("s_waitcnt vmcnt(0)" ::: "memory");
            const unsigned og = xb_add(&bar[XB_TOP], 1u);
            const unsigned tg = og / nx;
            if (og + 1u == (tg + 1u) * nx) xb_add(&bar[XB_TOPGEN], 1u);
            else XB_SPIN(xb_ld(&bar[XB_TOPGEN]) == tg, bar);
            __builtin_amdgcn_fence(__ATOMIC_ACQUIRE, "agent");
            xb_add(&bar[XB_XGEN(b.x)], 1u);
            asm volatile("s_waitcnt vmcnt(0)" ::: "memory");
        } else {
            XB_SPIN(xb_ld(&bar[XB_XGEN(b.x)]) == gen, bar);
            __builtin_amdgcn_fence(__ATOMIC_ACQUIRE, "agent");
            asm volatile("s_waitcnt vmcnt(0)" ::: "memory");
        }
    }
    __syncthreads();
}

struct Frame {
    LAS unsigned char* lds;
    volatile LAS unsigned* MISC;
    int tid, lane, wave;
    int vcu, G;
};
__device__ __forceinline__ float wave_sum(float v) {
#pragma unroll
    for (int o = 1; o < 64; o <<= 1) v += __shfl_xor(v, o);
    return v;
}
__device__ __forceinline__ float bflo(unsigned w) { return __uint_as_float(w << 16); }
__device__ __forceinline__ float bfhi(unsigned w) { return __uint_as_float(w & 0xffff0000u); }
__device__ __forceinline__ void unpack8(const v4u w, float (&f)[8]) { f[0] = bflo(w.x); f[1] = bfhi(w.x); f[2] = bflo(w.y); f[3] = bfhi(w.y); f[4] = bflo(w.z); f[5] = bfhi(w.z); f[6] = bflo(w.w); f[7] = bfhi(w.w); }
__device__ __forceinline__ v4u pack8(const float (&f)[8]) { v4u o; o.x = pk2(f[0], f[1]); o.y = pk2(f[2], f[3]); o.z = pk2(f[4], f[5]); o.w = pk2(f[6], f[7]); return o; }

__device__ __forceinline__ void p0_transpose_item(const float* W, int K, int N, bf16* WT, LAS float* scr, int item, int lane) {
    const int nblk = N / 32, kb = item / nblk, nb = item % nblk, k0 = 64 * kb, n0 = 32 * nb;
#pragma unroll 8
    for (int i = 0; i < 32; ++i) { const int kk = 2 * i + (lane >> 5); scr[kk * 33 + (lane & 31)] = W[(size_t)(k0 + kk) * N + n0 + (lane & 31)]; }
    LDS_WAIT(); asm volatile("" ::: "memory");
    const int c = lane & 7;
#pragma unroll
    for (int j = 0; j < 4; ++j) { const int n = (lane >> 3) + 8 * j; const LAS float* s = scr + (8 * c) * 33 + n;
        v4u o; o.x = pk2(s[0 * 33], s[1 * 33]); o.y = pk2(s[2 * 33], s[3 * 33]); o.z = pk2(s[4 * 33], s[5 * 33]); o.w = pk2(s[6 * 33], s[7 * 33]);
        *(GAS v4u*)(WT + (size_t)(n0 + n) * K + k0 + 8 * c) = o; }
    LDS_WAIT(); asm volatile("" ::: "memory");
}
__device__ __forceinline__ void fold_tile(LAS float* sm, const float* Ap, int sAi, int sAk, const float* As, const float* Bp, int sBj, int K, bf16* Cp, int ldc, int tid) {
    LAS float* sA = sm; LAS float* sB = sm + 32 * 65;
    float acc[8];
#pragma unroll
    for (int q = 0; q < 8; ++q) acc[q] = 0.f;
    const int tj = tid & 63, ti0 = tid >> 6;
    for (int k0 = 0; k0 < K; k0 += 32) {
#pragma unroll
        for (int r = 0; r < 4; ++r) { const int e = tid + 512 * r; int i, k;
            if (sAk == 1) { k = e & 31; i = e >> 5; } else { i = e & 63; k = e >> 6; }
            float a = Ap[(size_t)i * sAi + (size_t)(k0 + k) * sAk]; if (As) a *= As[k0 + k];
            sA[k * 65 + i] = a;
            const int kb = e & 31, jb = e >> 5;
            sB[kb * 65 + jb] = Bp[(size_t)jb * sBj + k0 + kb]; }
        __syncthreads();
#pragma unroll 4
        for (int k = 0; k < 32; ++k) { const float b = sB[k * 65 + tj];
#pragma unroll
            for (int q = 0; q < 8; ++q) acc[q] += sA[k * 65 + ti0 + 8 * q] * b; }
        __syncthreads();
    }
#pragma unroll
    for (int q = 0; q < 8; ++q) Cp[(size_t)(ti0 + 8 * q) * ldc + tj] = (bf16)f2bf(acc[q]);
}
__device__ __forceinline__ void rms_row_to_bf16(int lane, const float* xrow, const float* g, bf16* orow) {
    const GAS f32x4* xr = (const GAS f32x4*)xrow + lane; const GAS f32x4* gr = (const GAS f32x4*)g + lane;
    f32x4 v[4]; float s = 0.f;
#pragma unroll
    for (int j = 0; j < 4; ++j) { v[j] = xr[64 * j]; s += (v[j].x * v[j].x + v[j].y * v[j].y) + (v[j].z * v[j].z + v[j].w * v[j].w); }
    const float rstd = 1.f / sqrtf(wave_sum(s) * (1.f / D) + EPS);
    GAS unsigned long long* o8 = (GAS unsigned long long*)orow + lane;
#pragma unroll
    for (int j = 0; j < 4; ++j) { const f32x4 gg = gr[64 * j];
        o8[64 * j] = (unsigned long long)pk2(v[j].x * rstd * gg.x, v[j].y * rstd * gg.y) | ((unsigned long long)pk2(v[j].z * rstd * gg.z, v[j].w * rstd * gg.w) << 32); }
}
__device__ __forceinline__ void p2_conv_pool(Frame& F, const bf16* PB, const float* conv_w, bf16* AIN, bf16* POOLED) {
    const int gt = F.vcu * (NWAVES * 64) + F.tid, NT = F.G * (NWAVES * 64);
    for (int it = gt; it < (T / 16) * (D / 8); it += NT) {
        const int cv = it & 127, rc = it >> 7, col = cv * 8, t0 = rc * 16, s0 = t0 & (SEQ - 1);
        float w0[8], w1[8], w2[8];
        { const f32x4 a = *(const GAS f32x4*)(conv_w + col), b = *(const GAS f32x4*)(conv_w + col + 4); w0[0] = a.x; w0[1] = a.y; w0[2] = a.z; w0[3] = a.w; w0[4] = b.x; w0[5] = b.y; w0[6] = b.z; w0[7] = b.w; }
        { const f32x4 a = *(const GAS f32x4*)(conv_w + D + col), b = *(const GAS f32x4*)(conv_w + D + col + 4); w1[0] = a.x; w1[1] = a.y; w1[2] = a.z; w1[3] = a.w; w1[4] = b.x; w1[5] = b.y; w1[6] = b.z; w1[7] = b.w; }
        { const f32x4 a = *(const GAS f32x4*)(conv_w + 2 * D + col), b = *(const GAS f32x4*)(conv_w + 2 * D + col + 4); w2[0] = a.x; w2[1] = a.y; w2[2] = a.z; w2[3] = a.w; w2[4] = b.x; w2[5] = b.y; w2[6] = b.z; w2[7] = b.w; }
        float um2[8], um1[8];
#pragma unroll
        for (int i = 0; i < 8; ++i) { um2[i] = 0.f; um1[i] = 0.f; }
        if (s0 != 0) {
            float c[8], h[8];
            unpack8(*(const GAS v4u*)(PB + (size_t)(t0 - 2) * 4096 + 1024 + col), c); unpack8(*(const GAS v4u*)(PB + (size_t)(t0 - 2) * 4096 + 2048 + col), h);
#pragma unroll
            for (int i = 0; i < 8; ++i) um2[i] = c[i] * h[i];
            unpack8(*(const GAS v4u*)(PB + (size_t)(t0 - 1) * 4096 + 1024 + col), c); unpack8(*(const GAS v4u*)(PB + (size_t)(t0 - 1) * 4096 + 2048 + col), h);
#pragma unroll
            for (int i = 0; i < 8; ++i) um1[i] = c[i] * h[i];
        }
        for (int r = 0; r < 16; ++r) {
            const size_t rowb = (size_t)(t0 + r) * 4096;
            float b[8], c[8], h[8], o[8];
            unpack8(*(const GAS v4u*)(PB + rowb + col), b); unpack8(*(const GAS v4u*)(PB + rowb + 1024 + col), c); unpack8(*(const GAS v4u*)(PB + rowb + 2048 + col), h);
#pragma unroll
            for (int i = 0; i < 8; ++i) { const float u = c[i] * h[i]; o[i] = b[i] * (w0[i] * um2[i] + w1[i] * um1[i] + w2[i] * u); um2[i] = um1[i]; um1[i] = u; }
            *(GAS v4u*)(AIN + (size_t)(t0 + r) * D + col) = pack8(o);
        }
        const int win = 2 << (col >> 8);
        for (int r = 0; r < 16; ++r) {
            const int t = t0 + r, s = s0 + r;
            float p0[8], sum[8], o[8];
            unpack8(*(const GAS v4u*)(PB + (size_t)t * 4096 + 3072 + col), p0);
#pragma unroll
            for (int i = 0; i < 8; ++i) sum[i] = p0[i];
            const int nb = (s < win - 1) ? s : (win - 1);
            for (int j = 1; j <= nb; ++j) { float pj[8]; unpack8(*(const GAS v4u*)(PB + (size_t)(t - j) * 4096 + 3072 + col), pj);
#pragma unroll
                for (int i = 0; i < 8; ++i) sum[i] += pj[i]; }
            const float inv = 1.0f / (float)(nb + 1);
#pragma unroll
            for (int i = 0; i < 8; ++i) o[i] = sum[i] * inv - p0[i];
            *(GAS v4u*)(POOLED + (size_t)t * D + col) = pack8(o);
        }
    }
}

__device__ __forceinline__ unsigned fkey(float f) { const unsigned u = __float_as_uint(f); return (u & 0x80000000u) ? ~u : (u | 0x80000000u); }
__device__ __forceinline__ int popc64(unsigned long long m) { return __popcll(m); }
__device__ __forceinline__ void p7_topk(Frame& F, const float* SC, int* IDX, float* GATE) {
    LAS float* scr = (LAS float*)(F.lds + RING_OFF + F.wave * 512);
    LAS int* scri = (LAS int*)scr;
    const int gw = F.vcu * NWAVES + F.wave, NGW = F.G * NWAVES, lane = F.lane;
    const unsigned long long lower = (lane == 0) ? 0ull : (~0ull >> (64 - lane));
    for (int it = gw; it < T * 8; it += NGW) {
        const int t = it >> 3, h = it & 7;
        const float* srow = SC + (size_t)t * NSC + h * 256;
#pragma unroll
        for (int p = 0; p < 2; ++p) {
            const float f0 = srow[p * 128 + lane], f1 = srow[p * 128 + 64 + lane];
            const unsigned k0 = fkey(f0), k1 = fkey(f1);
            unsigned thr = 0u;
            for (int bit = 31; bit >= 0; --bit) { const unsigned cand = thr | (1u << bit);
                const int cnt = popc64(__ballot(k0 >= cand)) + popc64(__ballot(k1 >= cand));
                if (cnt >= 16) thr = cand; }
            const unsigned long long mg0 = __ballot(k0 > thr), mg1 = __ballot(k1 > thr), me0 = __ballot(k0 == thr), me1 = __ballot(k1 == thr);
            const int ng0 = popc64(mg0), ngt = ng0 + popc64(mg1), ne0 = popc64(me0);
            int pos0 = -1, pos1 = -1;
            if (k0 > thr) pos0 = popc64(mg0 & lower); else if (k0 == thr) pos0 = ngt + popc64(me0 & lower);
            if (k1 > thr) pos1 = ng0 + popc64(mg1 & lower); else if (k1 == thr) pos1 = ngt + ne0 + popc64(me1 & lower);
            if (pos0 >= 0 && pos0 < 16) { scr[p * 16 + pos0] = f0; scri[32 + p * 16 + pos0] = lane; }
            if (pos1 >= 0 && pos1 < 16) { scr[p * 16 + pos1] = f1; scri[32 + p * 16 + pos1] = lane + 64; }
        }
        LDS_WAIT(); asm volatile("" ::: "memory");
        const int ci = lane >> 2, cj = (lane & 3) * 4;
        const float v1 = scr[ci];
        float sq[4]; unsigned kq[4];
#pragma unroll
        for (int q = 0; q < 4; ++q) { sq[q] = v1 + scr[16 + cj + q]; kq[q] = fkey(sq[q]); }
        unsigned thr = 0u;
        for (int bit = 31; bit >= 0; --bit) { const unsigned cand = thr | (1u << bit);
            const int cnt = popc64(__ballot(kq[0] >= cand)) + popc64(__ballot(kq[1] >= cand)) + popc64(__ballot(kq[2] >= cand)) + popc64(__ballot(kq[3] >= cand));
            if (cnt >= 16) thr = cand; }
        int ngt = 0;
#pragma unroll
        for (int q = 0; q < 4; ++q) ngt += popc64(__ballot(kq[q] > thr));
        int gbase = 0, ebase = ngt;
        const int e1 = scri[32 + ci];
#pragma unroll
        for (int q = 0; q < 4; ++q) {
            const unsigned long long mg = __ballot(kq[q] > thr), me = __ballot(kq[q] == thr);
            int pos = -1;
            if (kq[q] > thr) pos = gbase + popc64(mg & lower); else if (kq[q] == thr) pos = ebase + popc64(me & lower);
            gbase += popc64(mg); ebase += popc64(me);
            if (pos >= 0 && pos < 16) { scri[64 + pos] = e1 * 128 + scri[48 + cj + q]; scr[80 + pos] = sq[q]; }
        }
        LDS_WAIT(); asm volatile("" ::: "memory");
        if (lane < 16) {
            const float b = scr[80 + lane]; const int e = scri[64 + lane];
            float m = b;
            m = fmaxf(m, __shfl_xor(m, 8)); m = fmaxf(m, __shfl_xor(m, 4)); m = fmaxf(m, __shfl_xor(m, 2)); m = fmaxf(m, __shfl_xor(m, 1));
            const float ex = __expf(b - m);
            float sm = ex; sm += __shfl_xor(sm, 8); sm += __shfl_xor(sm, 4); sm += __shfl_xor(sm, 2); sm += __shfl_xor(sm, 1);
            IDX[(size_t)t * NSEL + h * 16 + lane] = e; GATE[(size_t)t * NSEL + h * 16 + lane] = ex / sm;
        }
        LDS_WAIT(); asm volatile("" ::: "memory");
    }
}
__device__ __forceinline__ float dot16(const float (&x)[16], const v4u a, const v4u b) {
    float s0 = x[0] * bflo(a.x), s1 = x[1] * bfhi(a.x);
    s0 += x[2] * bflo(a.y); s1 += x[3] * bfhi(a.y); s0 += x[4] * bflo(a.z); s1 += x[5] * bfhi(a.z); s0 += x[6] * bflo(a.w); s1 += x[7] * bfhi(a.w);
    s0 += x[8] * bflo(b.x); s1 += x[9] * bfhi(b.x); s0 += x[10] * bflo(b.y); s1 += x[11] * bfhi(b.y); s0 += x[12] * bflo(b.z); s1 += x[13] * bfhi(b.z); s0 += x[14] * bflo(b.w); s1 += x[15] * bfhi(b.w);
    return s0 + s1;
}
__device__ __forceinline__ void axpy16(float (&y)[16], float a, const v4u u, const v4u v) {
    y[0] += a * bflo(u.x); y[1] += a * bfhi(u.x); y[2] += a * bflo(u.y); y[3] += a * bfhi(u.y); y[4] += a * bflo(u.z); y[5] += a * bfhi(u.z); y[6] += a * bflo(u.w); y[7] += a * bfhi(u.w);
    y[8] += a * bflo(v.x); y[9] += a * bfhi(v.x); y[10] += a * bflo(v.y); y[11] += a * bfhi(v.y); y[12] += a * bflo(v.z); y[13] += a * bfhi(v.z); y[14] += a * bflo(v.w); y[15] += a * bfhi(v.w);
}
__device__ __forceinline__ float gelu_erf(float z) { return 0.5f * z * (1.0f + erff(z * 0.70710678118654752f)); }
__device__ __forceinline__ void p8_peer(Frame& F, const bf16* XN2, const bf16* U16, const bf16* V16, const int* IDX, const float* GATE, float* HOUT, const float* gfin) {
    const int gw = F.vcu * NWAVES + F.wave, NGW = F.G * NWAVES, lane = F.lane;
    for (int t = gw; t < T; t += NGW) {
        float x[16];
        { float a[8], b[8]; unpack8(*(const GAS v4u*)(XN2 + (size_t)t * D + 8 * lane), a); unpack8(*(const GAS v4u*)(XN2 + (size_t)t * D + 512 + 8 * lane), b);
#pragma unroll
          for (int i = 0; i < 8; ++i) { x[i] = a[i]; x[8 + i] = b[i]; } }
        const int id0 = IDX[(size_t)t * NSEL + lane], id1 = IDX[(size_t)t * NSEL + 64 + lane];
        const float g0 = GATE[(size_t)t * NSEL + lane], g1 = GATE[(size_t)t * NSEL + 64 + lane];
        float z0 = 0.f, z1 = 0.f;
        for (int k0 = 0; k0 < NSEL; k0 += 8) {
            const int idv = (k0 < 64) ? id0 : id1;
            v4u ua[8], ub[8];
#pragma unroll
            for (int j = 0; j < 8; ++j) { const int e = __builtin_amdgcn_readlane(idv, (k0 + j) & 63); const bf16* ur = U16 + (size_t)e * D;
                ua[j] = *(const GAS v4u*)(ur + 8 * lane); ub[j] = *(const GAS v4u*)(ur + 512 + 8 * lane); }
#pragma unroll
            for (int j = 0; j < 8; ++j) { const float p = wave_sum(dot16(x, ua[j], ub[j])); const bool mine = (lane == ((k0 + j) & 63));
                if (k0 < 64) z0 = mine ? p : z0; else z1 = mine ? p : z1; }
        }
        const float a0 = gelu_erf(z0) * g0, a1 = gelu_erf(z1) * g1;
        float y[16];
#pragma unroll
        for (int i = 0; i < 16; ++i) y[i] = 0.f;
        for (int k0 = 0; k0 < NSEL; k0 += 8) {
            const int idv = (k0 < 64) ? id0 : id1; const float av = (k0 < 64) ? a0 : a1;
            v4u va[8], vb[8];
#pragma unroll
            for (int j = 0; j < 8; ++j) { const int e = __builtin_amdgcn_readlane(idv, (k0 + j) & 63); const bf16* vr = V16 + (size_t)e * D;
                va[j] = *(const GAS v4u*)(vr + 8 * lane); vb[j] = *(const GAS v4u*)(vr + 512 + 8 * lane); }
#pragma unroll
            for (int j = 0; j < 8; ++j) { const float a = __builtin_bit_cast(float, __builtin_amdgcn_readlane(__builtin_bit_cast(int, av), (k0 + j) & 63)); axpy16(y, a, va[j], vb[j]); }
        }
        float* hr = HOUT + (size_t)t * D;
        const f32x4 h0 = *(const GAS f32x4*)(hr + 8 * lane), h1 = *(const GAS f32x4*)(hr + 8 * lane + 4), h2 = *(const GAS f32x4*)(hr + 512 + 8 * lane), h3 = *(const GAS f32x4*)(hr + 512 + 8 * lane + 4);
        y[0] += h0.x; y[1] += h0.y; y[2] += h0.z; y[3] += h0.w; y[4] += h1.x; y[5] += h1.y; y[6] += h1.z; y[7] += h1.w;
        y[8] += h2.x; y[9] += h2.y; y[10] += h2.z; y[11] += h2.w; y[12] += h3.x; y[13] += h3.y; y[14] += h3.z; y[15] += h3.w;
        float ss = 0.f;
#pragma unroll
        for (int i = 0; i < 16; ++i) ss += y[i] * y[i];
        const float rstd = 1.f / sqrtf(wave_sum(ss) * (1.f / D) + EPS);
        const f32x4 q0 = *(const GAS f32x4*)(gfin + 8 * lane), q1 = *(const GAS f32x4*)(gfin + 8 * lane + 4), q2 = *(const GAS f32x4*)(gfin + 512 + 8 * lane), q3 = *(const GAS f32x4*)(gfin + 512 + 8 * lane + 4);
        *(GAS f32x4*)(hr + 8 * lane) = (f32x4){y[0] * rstd * q0.x, y[1] * rstd * q0.y, y[2] * rstd * q0.z, y[3] * rstd * q0.w};
        *(GAS f32x4*)(hr + 8 * lane + 4) = (f32x4){y[4] * rstd * q1.x, y[5] * rstd * q1.y, y[6] * rstd * q1.z, y[7] * rstd * q1.w};
        *(GAS f32x4*)(hr + 512 + 8 * lane) = (f32x4){y[8] * rstd * q2.x, y[9] * rstd * q2.y, y[10] * rstd * q2.z, y[11] * rstd * q2.w};
        *(GAS f32x4*)(hr + 512 + 8 * lane + 4) = (f32x4){y[12] * rstd * q3.x, y[13] * rstd * q3.y, y[14] * rstd * q3.z, y[15] * rstd * q3.w};
    }
}
__device__ __forceinline__ void cvt_stream(Frame& F, const float* src, bf16* dst, size_t n) {
    const size_t gt = (size_t)F.vcu * (NWAVES * 64) + F.tid, NT = (size_t)F.G * (NWAVES * 64);
    for (size_t i = gt; i < n / 8; i += NT) { const f32x4 a = *(const GAS f32x4*)(src + 8 * i), b = *(const GAS f32x4*)(src + 8 * i + 4);
        v4u o; o.x = pk2(a.x, a.y); o.y = pk2(a.z, a.w); o.z = pk2(b.x, b.y); o.w = pk2(b.z, b.w); *(GAS v4u*)(dst + 8 * i) = o; }
}

struct Args { const float* in[15]; float* out; unsigned char* ws; int ph_lo, ph_hi; };
__global__ void __launch_bounds__(NWAVES * 64, 2) hyb_fwd(Args args) {
    extern __shared__ __attribute__((aligned(16))) unsigned char lds[];
    Frame F;
    F.lds = (LAS unsigned char*)lds;
    F.MISC = (volatile LAS unsigned*)(F.lds + MISC_OFF);
    F.tid = threadIdx.x; F.lane = F.tid & 63; F.wave = __builtin_amdgcn_readfirstlane(F.tid >> 6);
    F.G = gridDim.x; { const int bx = blockIdx.x; F.vcu = (F.G % 8 == 0) ? (bx % 8) * (F.G / 8) + bx / 8 : bx; }
    unsigned char* ws = args.ws;
    gu32* ctl = (gu32*)(ws + WS_CTL);
    const float* x = args.in[0]; const float* g_mix = args.in[1]; const float* w_in = args.in[2]; const float* conv_w = args.in[3]; const float* w_conv_out = args.in[4];
    const float* pool_w = args.in[5]; const float* pool_scale = args.in[6]; const float* w_pool_out = args.in[7]; const float* w_out = args.in[8]; const float* g_ffn = args.in[9];
    const float* w_query = args.in[10]; const float* sub_keys = args.in[11]; const float* expert_u = args.in[12]; const float* expert_v = args.in[13]; const float* g_fin = args.in[14];
    bf16* WIN = (bf16*)(ws + WS_WIN); bf16* WC = (bf16*)(ws + WS_WC); bf16* WPB = (bf16*)(ws + WS_WPB); bf16* WOUT = (bf16*)(ws + WS_WOUT); bf16* WSC = (bf16*)(ws + WS_WS);
    bf16* XN = (bf16*)(ws + WS_XN); bf16* PB = (bf16*)(ws + WS_PB); bf16* PG = (bf16*)(ws + WS_PG); bf16* TMP = (bf16*)(ws + WS_TMP); bf16* MG = (bf16*)(ws + WS_MG);
    float* SC = (float*)(ws + WS_SC); int* IDX = (int*)(ws + WS_IDX); float* GATE = (float*)(ws + WS_GATE); bf16* U16 = (bf16*)(ws + WS_U16); bf16* V16 = (bf16*)(ws + WS_V16);
    bf16* AIN = (bf16*)args.out; bf16* POOLED = (bf16*)args.out + (size_t)T * D; float* H = args.out;

    for (int u = F.tid; u < (LDS_BYTES - LDSCTL_OFF) / 4; u += NWAVES * 64) ((LAS unsigned*)(F.lds + LDSCTL_OFF))[u] = 0u;
    __syncthreads();
    XcdBarrier bar; bar.bar = (unsigned*)(ctl + CW_BAR); bar.x = 0; bar.st = nullptr;
    if (N_LAUNCHES == 1) bar = xcd_barrier_post((unsigned*)(ctl + CW_BAR), F.MISC + 8);
#define GRID_BAR() do { if (N_LAUNCHES == 1) xcd_barrier(bar); } while (0)
    const int lo = args.ph_lo, hi = args.ph_hi;
#define IN(k) (lo <= (k) && (k) < hi)
#define BOTH(k) (IN(k) && IN((k) + 1))
    const int gw = F.vcu * NWAVES + F.wave, NGW = F.G * NWAVES;

    if (IN(0)) {
        LAS float* sm = (LAS float*)(F.lds + RING_OFF);
        for (int it = blockIdx.x; it < 768; it += F.G) {
            if (it < 256) { const int g = it >> 6, i0 = ((it >> 2) & 15) * 64, j0 = (it & 3) * 64;
                fold_tile(sm, w_pool_out + (size_t)g * 256 * D + i0, 1, D, pool_scale + g * 256, pool_w + (size_t)g * 65536 + (size_t)j0 * 256, 256, 256, WPB + (size_t)i0 * D + g * 256 + j0, D, F.tid);
            } else { const int r = it - 256, hp = r >> 5, i0 = ((r >> 4) & 1) * 64, j0 = (r & 15) * 64;
                fold_tile(sm, sub_keys + (size_t)hp * 16384 + (size_t)i0 * 128, 128, 1, nullptr, w_query + (size_t)j0 * NSC + hp * 128, NSC, 128, WSC + (size_t)(hp * 128 + i0) * D + j0, D, F.tid); }
        }
        __syncthreads();
        LAS float* scr = (LAS float*)(F.lds + RING_OFF + F.wave * 16384);
        constexpr int I_IN = (D / 64) * (NIN / 32), I_SQ = (D / 64) * (D / 32);
        for (int it = gw; it < I_IN + 2 * I_SQ; it += NGW) {
            int r = it;
            if (r < I_IN) { p0_transpose_item(w_in, D, NIN, WIN, scr, r, F.lane); continue; } r -= I_IN;
            if (r < I_SQ) { p0_transpose_item(w_conv_out, D, D, WC, scr, r, F.lane); continue; } r -= I_SQ;
            p0_transpose_item(w_out, D, D, WOUT, scr, r, F.lane);
        }
        for (int m = gw; m < T; m += NGW) rms_row_to_bf16(F.lane, x + (size_t)m * D, g_mix, XN + (size_t)m * D);
        if (BOTH(0)) GRID_BAR();
    }
    if (IN(1)) {
        pg8::Gemm g{XN, WIN, 0l, 0l, T, NIN, D}; pg8::StaticOrder S; S.init(T, NIN, F.G, (int)blockIdx.x);
        pg8::EpiProj E{PB, PG};
        pg8::gemm_phase<pg8::EpiProj, pg8::StaticOrder, true, true>(F.lds + RING_OFF, g, S, E);
        if (BOTH(1)) GRID_BAR();
    }
    if (IN(2)) {
        p2_conv_pool(F, PB, conv_w, AIN, POOLED);
        if (BOTH(2)) GRID_BAR();
    }
    if (IN(3)) {
        pg8::Gemm g{AIN, WC, (long)T * D * 2, (long)(WS_WPB - WS_WC), T, D, D}; pg8::MergeOrder S; S.base.init(T, D, F.G, (int)blockIdx.x);
        pg8::EpiMerge E{PG, TMP, (long)((WS_MG - WS_TMP) / 2)};
        pg8::gemm_phase<pg8::EpiMerge, pg8::MergeOrder, true, true>(F.lds + RING_OFF, g, S, E);
        if (BOTH(3)) GRID_BAR();
    }
    if (IN(4)) {
        pg8::Gemm g{MG, WOUT, 0l, 0l, T, D, D}; pg8::StaticOrder S; S.init(T, D, F.G, (int)blockIdx.x);
        pg8::EpiRes E{x, H};
        pg8::gemm_phase<pg8::EpiRes, pg8::StaticOrder, true, true>(F.lds + RING_OFF, g, S, E);
        cvt_stream(F, expert_u, U16, (size_t)NEXP * D);
        cvt_stream(F, expert_v, V16, (size_t)NEXP * D);
        if (BOTH(4)) GRID_BAR();
    }
    if (IN(5)) {
        for (int m = gw; m < T; m += NGW) rms_row_to_bf16(F.lane, H + (size_t)m * D, g_ffn, XN + (size_t)m * D);
        if (BOTH(5)) GRID_BAR();
    }
    if (IN(6)) {
        pg8::Gemm g{XN, WSC, 0l, 0l, T, NSC, D}; pg8::StaticOrder S; S.init(T, NSC, F.G, (int)blockIdx.x);
        pg8::EpiF32 E{SC, NSC};
        pg8::gemm_phase<pg8::EpiF32, pg8::StaticOrder, true, true>(F.lds + RING_OFF, g, S, E);
        if (BOTH(6)) GRID_BAR();
    }
    if (IN(7)) {
        p7_topk(F, SC, IDX, GATE);
        if (BOTH(7)) GRID_BAR();
    }
    if (IN(8)) {
        p8_peer(F, XN, U16, V16, IDX, GATE, H, g_fin);
    }
#undef IN
#undef BOTH
}

extern "C" void kernel_launch(void* const* d_in, const int* in_sizes, int n_in, void* d_out, int out_size, void* d_ws, size_t ws_size, hipStream_t stream) {
    static int grid = 0;
    if (grid == 0) {
        if (n_in != 15 || in_sizes[0] != T * D || out_size != T * D || ws_size < WS_END) { fprintf(stderr, "kernel_launch: shape/workspace mismatch (n_in %d, in0 %d, out %d, ws %zu)\n", n_in, n_in > 0 ? in_sizes[0] : -1, out_size, ws_size); grid = -1; return; }
        int dev = 0, cus = 0, per_cu = 0;
        if (hipGetDevice(&dev) != hipSuccess || hipDeviceGetAttribute(&cus, hipDeviceAttributeMultiprocessorCount, dev) != hipSuccess) { grid = -1; return; }
        if (hipFuncSetAttribute((const void*)hyb_fwd, hipFuncAttributeMaxDynamicSharedMemorySize, LDS_BYTES) != hipSuccess) { fprintf(stderr, "kernel_launch: hipFuncSetAttribute failed\n"); grid = -1; return; }
        if (hipOccupancyMaxActiveBlocksPerMultiprocessor(&per_cu, (const void*)hyb_fwd, NWAVES * 64, LDS_BYTES) != hipSuccess || per_cu < 1)
            fprintf(stderr, "kernel_launch: note: occupancy query reports %d workgroups per CU\n", per_cu);
        (void)hipGetLastError();
        grid = cus;
    }
    if (grid < 0) return;
    if (hipMemsetAsync((char*)d_ws + WS_CTL, 0, CTL_ZERO_BYTES, stream) != hipSuccess) { fprintf(stderr, "kernel_launch: hipMemsetAsync failed\n"); return; }
    Args a{};
    for (int i = 0; i < 15; ++i) a.in[i] = (const float*)d_in[i];
    a.out = (float*)d_out; a.ws = (unsigned char*)d_ws;
    for (int li = 0; li < N_LAUNCHES; ++li) {
        a.ph_lo = (N_LAUNCHES == 1) ? 0 : li; a.ph_hi = (N_LAUNCHES == 1) ? NPHASE : li + 1;
        hipLaunchKernelGGL(hyb_fwd, dim3(grid), dim3(NWAVES * 64), LDS_BYTES, stream, a);
        const hipError_t le = hipPeekAtLastError();
        if (le != hipSuccess) { fprintf(stderr, "kernel_launch: launch %d failed: %s\n", li, hipGetErrorName(le)); break; }
    }
}
```

```cpp
#include <hip/hip_runtime.h>
#include <cstdio>
#include <cstdint>
namespace pg8 {
#define PG8_LAS __attribute__((address_space(3)))
typedef unsigned short bf16_t;
typedef short bf16x8 __attribute__((ext_vector_type(8)));
typedef float f32x4 __attribute__((ext_vector_type(4)));
typedef unsigned u32x4 __attribute__((ext_vector_type(4)));
constexpr int BM = 256, BK = 64, HALF = 128, HTB = HALF * BK * 2  , STAGE_BYTES = 8 * HTB, NXCD = 8, WGM = 8;

__host__ __device__ __forceinline__ int lds_byte(int r, int c) { const int st = (r >> 4) * 2 + (c >> 5), rr = r & 15, cc = c & 31, ob = rr * 64 + cc * 2; return st * 1024 + (ob ^ (((ob >> 9) & 1) << 5)); }
__host__ __device__ __forceinline__ void stage_rc(int b, int& R, int& C) { const int st = b / 1024, sb = b % 1024, swz = sb ^ (((sb >> 9) & 1) << 5); R = (st >> 1) * 16 + swz / 64; C = (st & 1) * 32 + (swz % 64) / 2; }
__host__ __device__ __forceinline__ int perm32(int rho) { const int n = rho >> 4, i = rho & 15; return 8 * (i >> 2) + 4 * n + (i & 3); }

struct Unit { int pm, pn, sel; };
struct Gemm { const bf16_t* A; const bf16_t* Bt; long offA1, offB1; int M, N, K; };

struct StaticOrder {
    int nM, nN, nwg, G, c;
    __host__ __device__ void init(int M, int N, int G_, int c_) { nM = M / BM; nN = N / BM; nwg = nM * nN; G = G_; c = c_; }
    __host__ __device__ __forceinline__ bool next(int i, Unit& u) const {
        const long L = (long)i * G + c; if (L >= nwg) return false;
        int wgid = (int)L; { const int q = nwg / NXCD, r = nwg % NXCD, xcd = wgid % NXCD, off = wgid / NXCD; wgid = (xcd < r ? xcd * (q + 1) : r * (q + 1) + (xcd - r) * q) + off; }
        const int nig = WGM * nN, gid = wgid / nig, fm = gid * WGM, gsz = (nM - fm) < WGM ? (nM - fm) : WGM;
        u.pm = fm + ((wgid % nig) % gsz); u.pn = (wgid % nig) / gsz; u.sel = 0; return true;
    }
    __device__ __forceinline__ void a_ready(const Unit&) const {}
    __device__ __forceinline__ void done(const Unit&) const {}
};


__device__ __forceinline__ unsigned cvt_pk_bf16(float lo, float hi) { unsigned r; asm volatile("v_cvt_pk_bf16_f32 %0, %1, %2" : "=v"(r) : "v"(lo), "v"(hi)); return r; }
__device__ __forceinline__ float sigm(float x) { return __builtin_amdgcn_rcpf(1.0f + __expf(-x)); }
__device__ __forceinline__ float bflo(unsigned w) { return __uint_as_float(w << 16); }
__device__ __forceinline__ float bfhi(unsigned w) { return __uint_as_float(w & 0xffff0000u); }

struct EpiProj {
    static constexpr bool PERM = true, AFTER_DRAIN = false;
    bf16_t* PB; bf16_t* PG;
    __device__ __forceinline__ void operator()(const f32x4 (&acc)[2][2][4][2], const Unit& u, int wr, int wc, int fr, int fq) const {
        const bool gate = u.pn >= 16;
        bf16_t* base = gate ? PG : PB; const int ldc = gate ? 2048 : 4096; const int colt = (gate ? u.pn - 16 : u.pn) * BM;
        const int row0 = u.pm * BM + wr * 64 + fr, col0 = colt + wc * 32 + 8 * fq;
#pragma unroll
        for (int ai = 0; ai < 2; ++ai)
#pragma unroll
            for (int m = 0; m < 4; ++m) { bf16_t* rowp = base + (size_t)(row0 + ai * HALF + m * 16) * ldc + col0;
#pragma unroll
                for (int bj = 0; bj < 2; ++bj) { f32x4 v0 = acc[ai][bj][m][0], v1 = acc[ai][bj][m][1];
                    if (gate) { v0[0] = sigm(v0[0]); v0[1] = sigm(v0[1]); v0[2] = sigm(v0[2]); v0[3] = sigm(v0[3]); v1[0] = sigm(v1[0]); v1[1] = sigm(v1[1]); v1[2] = sigm(v1[2]); v1[3] = sigm(v1[3]); }
                    u32x4 w; w.x = cvt_pk_bf16(v0[0], v0[1]); w.y = cvt_pk_bf16(v0[2], v0[3]); w.z = cvt_pk_bf16(v1[0], v1[1]); w.w = cvt_pk_bf16(v1[2], v1[3]);
                    *(u32x4*)(rowp + bj * HALF) = w; } }
    }
};
struct EpiMerge {
    static constexpr bool PERM = true, AFTER_DRAIN = false;
    const bf16_t* PG; bf16_t* TMP; long mg_off;
    __device__ __forceinline__ void operator()(const f32x4 (&acc)[2][2][4][2], const Unit& u, int wr, int wc, int fr, int fq) const {
        const int row0 = u.pm * BM + wr * 64 + fr, col0 = u.pn * BM + wc * 32 + 8 * fq; const int goff = u.sel ? 1024 : 0;
#pragma unroll
        for (int ai = 0; ai < 2; ++ai)
#pragma unroll
            for (int m = 0; m < 4; ++m) { const size_t row = (size_t)(row0 + ai * HALF + m * 16);
#pragma unroll
                for (int bj = 0; bj < 2; ++bj) { const int col = col0 + bj * HALF;
                    const u32x4 g = *(const u32x4*)(PG + row * 2048 + goff + col);
                    const f32x4 v0 = acc[ai][bj][m][0], v1 = acc[ai][bj][m][1];
                    float o0 = v0[0] * bflo(g.x), o1 = v0[1] * bfhi(g.x), o2 = v0[2] * bflo(g.y), o3 = v0[3] * bfhi(g.y);
                    float o4 = v1[0] * bflo(g.z), o5 = v1[1] * bfhi(g.z), o6 = v1[2] * bflo(g.w), o7 = v1[3] * bfhi(g.w);
                    if (u.sel) { const u32x4 t = *(const u32x4*)(TMP + row * 1024 + col);
                        o0 += bflo(t.x); o1 += bfhi(t.x); o2 += bflo(t.y); o3 += bfhi(t.y); o4 += bflo(t.z); o5 += bfhi(t.z); o6 += bflo(t.w); o7 += bfhi(t.w); }
                    u32x4 w; w.x = cvt_pk_bf16(o0, o1); w.y = cvt_pk_bf16(o2, o3); w.z = cvt_pk_bf16(o4, o5); w.w = cvt_pk_bf16(o6, o7);
                    *(u32x4*)(TMP + (u.sel ? mg_off : 0l) + row * 1024 + col) = w; } }
    }
};
struct EpiRes {
    static constexpr bool PERM = false, AFTER_DRAIN = false;
    const float* X; float* H;
    __device__ __forceinline__ void operator()(const f32x4 (&acc)[2][2][4][2], const Unit& u, int wr, int wc, int fr, int fq) const {
        const int row0 = u.pm * BM + wr * 64 + fr, col0 = u.pn * BM + wc * 32 + 4 * fq;
#pragma unroll
        for (int ai = 0; ai < 2; ++ai)
#pragma unroll
            for (int m = 0; m < 4; ++m) { const size_t off = (size_t)(row0 + ai * HALF + m * 16) * 1024 + col0;
#pragma unroll
                for (int bj = 0; bj < 2; ++bj)
#pragma unroll
                    for (int n = 0; n < 2; ++n) { const f32x4 xv = *(const f32x4*)(X + off + bj * HALF + n * 16); *(f32x4*)(H + off + bj * HALF + n * 16) = xv + acc[ai][bj][m][n]; } }
    }
};
struct EpiF32 {
    static constexpr bool PERM = false, AFTER_DRAIN = false;
    float* C; int ldc;
    __device__ __forceinline__ void operator()(const f32x4 (&acc)[2][2][4][2], const Unit& u, int wr, int wc, int fr, int fq) const {
        const int row0 = u.pm * BM + wr * 64 + fr, col0 = u.pn * BM + wc * 32 + 4 * fq;
#pragma unroll
        for (int ai = 0; ai < 2; ++ai)
#pragma unroll
            for (int m = 0; m < 4; ++m) { float* rowp = C + (size_t)(row0 + ai * HALF + m * 16) * ldc + col0;
#pragma unroll
                for (int bj = 0; bj < 2; ++bj)
#pragma unroll
                    for (int n = 0; n < 2; ++n) *(f32x4*)(rowp + bj * HALF + n * 16) = acc[ai][bj][m][n]; }
    }
};
struct MergeOrder {
    StaticOrder base;
    __device__ __forceinline__ bool next(int i, Unit& u) const { if (!base.next(i >> 1, u)) return false; u.sel = i & 1; return true; }
    __device__ __forceinline__ void a_ready(const Unit&) const {}
    __device__ __forceinline__ void done(const Unit&) const {}
};

template <class Epi, class Sched, bool ALIGN_EPI = false, bool SP2 = false>
__device__ __forceinline__ void gemm_phase(PG8_LAS unsigned char* lds, const Gemm g, const Sched& S, const Epi& E) {
    const int tid = threadIdx.x, wid = __builtin_amdgcn_readfirstlane(tid >> 6), lane = tid & 63, wr = wid >> 2, wc = wid & 3, fr = lane & 15, fq = lane >> 4;
    const int K = g.K, nt = K / BK;
    unsigned voffA[2], voffB[2];
#pragma unroll
    for (int i = 0; i < 2; ++i) { int R, C; stage_rc(tid * 16 + i * 8192, R, C); const int Rb = Epi::PERM ? ((R & ~31) + perm32(R & 31)) : R;
        voffA[i] = (unsigned)(R * K + C) * 2u; voffB[i] = (unsigned)(Rb * K + C) * 2u; }
    const size_t kstep = (size_t)(BK * 2);
    const size_t hstep = (size_t)HALF * K * 2;
    const size_t tstep = 2 * hstep;
    const unsigned ldsw = (unsigned)wid * 1024u;
    const int aoff = lds_byte(wr * 64 + fr, fq * 8), boff = lds_byte(wc * 32 + fr, fq * 8);
#define PG8_SA(b, h) (((b) * 2 + (h)) * HTB)
#define PG8_SB(b, h) ((4 + (b) * 2 + (h)) * HTB)
#define PG8_STAGE(bufoff, gbase, voff) do { _Pragma("unroll") for (int _i = 0; _i < 2; ++_i) \
        __builtin_amdgcn_global_load_lds((const unsigned*)((const char*)(gbase) + (voff)[_i]), (PG8_LAS unsigned*)(lds + (bufoff) + ldsw + _i * 8192), 16, 0, 0); } while (0)
#define PG8_LDA(dst, b, h) do { _Pragma("unroll") for (int m = 0; m < 4; ++m) _Pragma("unroll") for (int k = 0; k < 2; ++k) dst[m][k] = *(const PG8_LAS bf16x8*)(lds + PG8_SA(b, h) + aoff + m * 2048 + k * 1024); } while (0)
#define PG8_LDB(dst, b, h) do { _Pragma("unroll") for (int n = 0; n < 2; ++n) _Pragma("unroll") for (int k = 0; k < 2; ++k) dst[n][k] = *(const PG8_LAS bf16x8*)(lds + PG8_SB(b, h) + boff + n * 2048 + k * 1024); } while (0)
#define PG8_MMA(ai, bj, At, Bt) do { __builtin_amdgcn_s_setprio(1); _Pragma("unroll") for (int m = 0; m < 4; ++m) _Pragma("unroll") for (int n = 0; n < 2; ++n) _Pragma("unroll") for (int k = 0; k < 2; ++k) \
        acc[ai][bj][m][n] = __builtin_amdgcn_mfma_f32_16x16x32_bf16(Bt[n][k], At[m][k], acc[ai][bj][m][n], 0, 0, 0); __builtin_amdgcn_s_setprio(0); } while (0)
#define PG8_WAIT_V(n) asm volatile("s_waitcnt vmcnt(" #n ")" ::: "memory")
#define PG8_WAIT_L(n) asm volatile("s_waitcnt lgkmcnt(" #n ")" ::: "memory")
#define PG8_BAR __builtin_amdgcn_s_barrier()
#define PG8_SCHED __builtin_amdgcn_sched_barrier(0)
    Unit cur, nxt; int ui = 0;
    if (!S.next(0, cur)) return;
    f32x4 acc[2][2][4][2];
#pragma unroll
    for (int a = 0; a < 2; ++a)
#pragma unroll
        for (int b = 0; b < 2; ++b)
#pragma unroll
            for (int m = 0; m < 4; ++m)
#pragma unroll
                for (int n = 0; n < 2; ++n) acc[a][b][m][n] = (f32x4){0.f, 0.f, 0.f, 0.f};
    bf16x8 At[4][2], B0[2][2], B1[2][2];
    const char* cA = (const char*)g.A + (cur.sel ? g.offA1 : 0l) + (size_t)cur.pm * tstep; const char* cB = (const char*)g.Bt + (cur.sel ? g.offB1 : 0l) + (size_t)cur.pn * tstep;
    S.a_ready(cur);
    if constexpr (SP2) {
        PG8_STAGE(PG8_SB(0, 0), cB, voffB); PG8_STAGE(PG8_SB(0, 1), cB + hstep, voffB); PG8_STAGE(PG8_SA(0, 0), cA, voffA); PG8_STAGE(PG8_SA(0, 1), cA + hstep, voffA);
        if (wr == 1) PG8_BAR;
        PG8_WAIT_V(2); PG8_BAR;
        PG8_STAGE(PG8_SB(1, 0), cB + kstep, voffB); PG8_STAGE(PG8_SA(1, 0), cA + kstep, voffA); PG8_STAGE(PG8_SB(1, 1), cB + hstep + kstep, voffB);
        PG8_WAIT_V(6); PG8_BAR;
    } else {
        PG8_STAGE(PG8_SB(0, 0), cB, voffB); PG8_STAGE(PG8_SA(0, 0), cA, voffA); PG8_STAGE(PG8_SB(0, 1), cB + hstep, voffB); PG8_STAGE(PG8_SA(0, 1), cA + hstep, voffA);
        if (wr == 1) PG8_BAR;
        PG8_WAIT_V(4); PG8_BAR;
        PG8_STAGE(PG8_SB(1, 0), cB + kstep, voffB); PG8_STAGE(PG8_SA(1, 0), cA + kstep, voffA); PG8_STAGE(PG8_SB(1, 1), cB + hstep + kstep, voffB);
        PG8_WAIT_V(6); PG8_BAR;
    }
    for (;;) {
        const bool has_next = S.next(ui + 1, nxt);
        const char* nA = has_next ? (const char*)g.A + (nxt.sel ? g.offA1 : 0l) + (size_t)nxt.pm * tstep : cA; const char* nB = has_next ? (const char*)g.Bt + (nxt.sel ? g.offB1 : 0l) + (size_t)nxt.pn * tstep : cB;
        for (int t = 0; t < nt; t += 2) {
            const bool last = (t == nt - 2);
            const char* a1 = cA + (size_t)(t + 1) * kstep;
            const char* a2 = last ? nA : cA + (size_t)(t + 2) * kstep; const char* b2 = last ? nB : cB + (size_t)(t + 2) * kstep;
            const char* a3 = a2 + kstep; const char* b3 = b2 + kstep;
            if (last && has_next) S.a_ready(nxt);
            if constexpr (SP2) {
            PG8_LDB(B0, 0, 0); PG8_LDB(B1, 0, 1); PG8_SCHED; PG8_LDA(At, 0, 0); PG8_STAGE(PG8_SA(1, 1), a1 + hstep, voffA);
            PG8_WAIT_V(8); PG8_WAIT_L(0); PG8_BAR; PG8_MMA(0, 0, At, B0); PG8_MMA(0, 1, At, B1); PG8_BAR; PG8_SCHED;
            PG8_LDA(At, 0, 1); PG8_STAGE(PG8_SB(0, 0), b2, voffB); PG8_STAGE(PG8_SB(0, 1), b2 + hstep, voffB); PG8_STAGE(PG8_SA(0, 0), a2, voffA);
            PG8_WAIT_V(8); PG8_WAIT_L(0); PG8_BAR; PG8_MMA(1, 0, At, B0); PG8_MMA(1, 1, At, B1); PG8_BAR; PG8_SCHED;
            PG8_LDB(B0, 1, 0); PG8_LDB(B1, 1, 1); PG8_SCHED; PG8_LDA(At, 1, 0); PG8_STAGE(PG8_SA(0, 1), a2 + hstep, voffA);
            PG8_WAIT_V(8); PG8_WAIT_L(0); PG8_BAR; PG8_MMA(0, 0, At, B0); PG8_MMA(0, 1, At, B1); PG8_BAR; PG8_SCHED;
            PG8_LDA(At, 1, 1); PG8_STAGE(PG8_SB(1, 0), b3, voffB); PG8_STAGE(PG8_SB(1, 1), b3 + hstep, voffB); PG8_STAGE(PG8_SA(1, 0), a3, voffA);
            PG8_WAIT_V(8); PG8_WAIT_L(0); PG8_BAR; PG8_MMA(1, 0, At, B0); PG8_MMA(1, 1, At, B1); PG8_BAR; PG8_SCHED;
            } else {
            PG8_LDB(B0, 0, 0); PG8_SCHED; PG8_LDA(At, 0, 0); PG8_STAGE(PG8_SA(1, 1), a1 + hstep, voffA);
            PG8_WAIT_L(8); PG8_BAR; PG8_WAIT_L(0); PG8_MMA(0, 0, At, B0); PG8_BAR; PG8_SCHED;
            PG8_LDB(B1, 0, 1); PG8_STAGE(PG8_SB(0, 0), b2, voffB);
            PG8_BAR; PG8_WAIT_L(0); PG8_MMA(0, 1, At, B1); PG8_BAR;
            PG8_LDA(At, 0, 1); PG8_STAGE(PG8_SA(0, 0), a2, voffA);
            PG8_BAR; PG8_WAIT_L(0); PG8_MMA(1, 0, At, B0); PG8_BAR; PG8_SCHED;
            PG8_STAGE(PG8_SB(0, 1), b2 + hstep, voffB);
            PG8_WAIT_V(6); PG8_BAR; PG8_MMA(1, 1, At, B1); PG8_BAR;
            PG8_LDB(B0, 1, 0); PG8_SCHED; PG8_LDA(At, 1, 0); PG8_STAGE(PG8_SA(0, 1), a2 + hstep, voffA);
            PG8_WAIT_L(8); PG8_BAR; PG8_WAIT_L(0); PG8_MMA(0, 0, At, B0); PG8_BAR; PG8_SCHED;
            PG8_LDB(B1, 1, 1); PG8_STAGE(PG8_SB(1, 0), b3, voffB);
            PG8_BAR; PG8_WAIT_L(0); PG8_MMA(0, 1, At, B1); PG8_BAR;
            PG8_LDA(At, 1, 1); PG8_STAGE(PG8_SA(1, 0), a3, voffA);
            PG8_BAR; PG8_WAIT_L(0); PG8_MMA(1, 0, At, B0); PG8_BAR; PG8_SCHED;
            PG8_STAGE(PG8_SB(1, 1), b3 + hstep, voffB);
            PG8_WAIT_V(6); PG8_BAR; PG8_MMA(1, 1, At, B1); PG8_BAR;
            }
        }
        if constexpr (ALIGN_EPI) { if (wr == 0) PG8_BAR; }
        if constexpr (!Epi::AFTER_DRAIN) { E(acc, cur, wr, wc, fr, fq); S.done(cur); }
        if (!has_next) break;
#pragma unroll
        for (int a = 0; a < 2; ++a)
#pragma unroll
            for (int b = 0; b < 2; ++b)
#pragma unroll
                for (int m = 0; m < 4; ++m)
#pragma unroll
                    for (int n = 0; n < 2; ++n) acc[a][b][m][n] = (f32x4){0.f, 0.f, 0.f, 0.f};
        cur = nxt; cA = nA; cB = nB; ++ui;
        if constexpr (ALIGN_EPI) { if (wr == 1) PG8_BAR; }
    }
    PG8_WAIT_V(0);
    if constexpr (!ALIGN_EPI) { if (wr == 0) PG8_BAR; }
    PG8_BAR;
    if constexpr (Epi::AFTER_DRAIN) { E.fused(acc, cur, wr, wc, fr, fq, lds, wid, lane); S.done(cur); }
#undef PG8_SA
#undef PG8_SB
#undef PG8_STAGE
#undef PG8_LDA
#undef PG8_LDB
#undef PG8_MMA
#undef PG8_WAIT_V
#undef PG8_WAIT_L
#undef PG8_BAR
#undef PG8_SCHED
}
}
constexpr int NWAVES = 8;
#ifndef MK_N_LAUNCHES
#define MK_N_LAUNCHES 1
#endif
constexpr int NPHASE = 9;
constexpr int N_LAUNCHES = MK_N_LAUNCHES;
static_assert(N_LAUNCHES == 1 || N_LAUNCHES == NPHASE, "MK_N_LAUNCHES is 1 or NPHASE");

constexpr int T = 16384, SEQ = 2048, D = 1024, NIN = 6144, NSC = 2048, NEXP = 16384, NSEL = 128;
constexpr float EPS = 1e-6f;

constexpr size_t MiB = 1u << 20;
constexpr size_t WS_CTL = 0, CTL_ZERO_BYTES = 64 * 1024;
constexpr size_t WS_WIN = 1 * MiB, WS_WC = 13 * MiB, WS_WPB = 15 * MiB, WS_WOUT = 17 * MiB, WS_WS = 19 * MiB;
constexpr size_t WS_IDX = 1 * MiB, WS_GATE = 9 * MiB;
constexpr size_t WS_XN = 32 * MiB;
constexpr size_t WS_PB = 64 * MiB;
constexpr size_t WS_TMP = 64 * MiB, WS_MG = 96 * MiB;
constexpr size_t WS_SC = 64 * MiB;
constexpr size_t WS_PG = 192 * MiB;
constexpr size_t WS_U16 = 192 * MiB, WS_V16 = 224 * MiB;
constexpr size_t WS_END = 256 * MiB;
constexpr int CW_BAR = 1024;

constexpr int RING_OFF = 0, RING_BYTES = 131072;
constexpr int LDSCTL_OFF = RING_BYTES, MISC_OFF = LDSCTL_OFF + 320;
constexpr int LDS_BYTES = 147456;
#define GAS __attribute__((address_space(1)))
#define LAS __attribute__((address_space(3)))
typedef unsigned short bf16;
typedef unsigned v4u __attribute__((ext_vector_type(4)));
typedef float f32x4 __attribute__((ext_vector_type(4)));
typedef short bf16x8 __attribute__((ext_vector_type(8)));
typedef GAS unsigned gu32;
typedef GAS unsigned long long gu64;
#define RLX_AGENT __ATOMIC_RELAXED, __HIP_MEMORY_SCOPE_AGENT
#define LDS_WAIT() asm volatile("s_waitcnt lgkmcnt(0)" ::: "memory")
#define VM_WAIT() asm volatile("s_waitcnt vmcnt(0)" ::: "memory")
__device__ __forceinline__ unsigned long long rt() { return __builtin_amdgcn_s_memrealtime(); }
__device__ __forceinline__ unsigned f2bf(float f) { unsigned u = __builtin_bit_cast(unsigned, f); return (u + 0x7fffu + ((u >> 16) & 1u)) >> 16; }
__device__ __forceinline__ unsigned pk2(float lo, float hi) { return f2bf(lo) | (f2bf(hi) << 16); }

#define XB_TMO      128
#define XB_XCNT(j)  (256  + 64 * (j))
#define XB_XSUB(j)  (1280 + 64 * (j))
#define XB_XGEN(j)  (2304 + 64 * (j))
#define XB_TOP      3328
#define XB_TOPGEN   3392
#define XCD_BAR_WORDS 3456
#define XB_SPIN_CAP (1u << 18)

__device__ __forceinline__ unsigned xb_ld(unsigned* p)              { return __hip_atomic_load(p, __ATOMIC_RELAXED, __HIP_MEMORY_SCOPE_AGENT); }
__device__ __forceinline__ unsigned xb_add(unsigned* p, unsigned v) { return __hip_atomic_fetch_add(p, v, __ATOMIC_RELAXED, __HIP_MEMORY_SCOPE_AGENT); }
__device__ __forceinline__ unsigned xb_xcc_id() { return (unsigned)__builtin_amdgcn_s_getreg((3 << 11) | 20) & 0xFu; }
#define XB_SPIN(cond, bar) do { unsigned _sp = 0; while (cond) { __builtin_amdgcn_s_sleep(1); \
    if ((++_sp & 255u) == 0u) { if (xb_ld(&(bar)[XB_TMO])) break; if (_sp > XB_SPIN_CAP) { atomicAdd(&(bar)[XB_TMO], 1u); break; } } } } while (0)

struct XcdBarrier {
    unsigned* bar; unsigned x;
    volatile LAS unsigned* st;
};

__device__ __forceinline__ XcdBarrier xcd_barrier_post(unsigned* bar, volatile LAS unsigned* st) {
    XcdBarrier b; b.bar = bar; b.x = xb_xcc_id(); b.st = st;
    if (threadIdx.x == 0) (void)xb_add(&bar[XB_XCNT(b.x)], 1u);
    return b;
}
__device__ __forceinline__ void xcd_barrier_complete(unsigned* bar, unsigned x, unsigned& nloc, unsigned& nx) {
    const unsigned G = gridDim.x * gridDim.y * gridDim.z;
    unsigned sum, cnt, mine, sp = 0u;
    for (;;) {
        sum = 0u; cnt = 0u; mine = 0u;
#pragma unroll
        for (unsigned j = 0; j < 16; ++j) { const unsigned c = xb_ld(&bar[XB_XCNT(j)]); sum += c; cnt += (c > 0u) ? 1u : 0u; mine = (j == x) ? c : mine; }
        if (sum == G) break;
        __builtin_amdgcn_s_sleep(1);
        if ((++sp & 255u) == 0u) { if (xb_ld(&bar[XB_TMO])) break; if (sp > XB_SPIN_CAP) { atomicAdd(&bar[XB_TMO], 1u); break; } }
    }
    nloc = mine > 0u ? mine : 1u; nx = cnt > 0u ? cnt : 1u;
}

__device__ __forceinline__ void xcd_barrier(const XcdBarrier& b) {
    asm volatile("s_waitcnt vmcnt(0)" ::: "memory");
    __syncthreads();
    if (threadIdx.x == 0) {
        unsigned* bar = b.bar;
        __builtin_amdgcn_s_waitcnt(0);
        unsigned nloc = b.st[0], nx = b.st[1];
        if (nloc == 0u) { xcd_barrier_complete(bar, b.x, nloc, nx); b.st[0] = nloc; b.st[1] = nx; }
        const unsigned old = xb_add(&bar[XB_XSUB(b.x)], 1u);
        const unsigned gen = old / nloc;
        if (old + 1u == (gen + 1u) * nloc) {
            __builtin_amdgcn_fence(__ATOMIC_RELEASE, "agent");
            asm volatile("s_waitcnt vmcnt(0)" ::: "memory");
            const unsigned og = xb_add(&bar[XB_TOP], 1u);
            const unsigned tg = og / nx;
            if (og + 1u == (tg + 1u) * nx) xb_add(&bar[XB_TOPGEN], 1u);
            else XB_SPIN(xb_ld(&bar[XB_TOPGEN]) == tg, bar);
            __builtin_amdgcn_fence(__ATOMIC_ACQUIRE, "agent");
            xb_add(&bar[XB_XGEN(b.x)], 1u);
            asm volatile("s_waitcnt vmcnt(0)" ::: "memory");
        } else {
            XB_SPIN(xb_ld(&bar[XB_XGEN(b.x)]) == gen, bar);
            __builtin_amdgcn_fence(__ATOMIC_ACQUIRE, "agent");
            asm volatile("s_waitcnt vmcnt(0)" ::: "memory");
        }
    }
    __syncthreads();
}

struct Frame {
    LAS unsigned char* lds;
    volatile LAS unsigned* MISC;
    int tid, lane, wave;
    int vcu, G;
};
__device__ __forceinline__ float wave_sum(float v) {
#pragma unroll
    for (int o = 1; o < 64; o <<= 1) v += __shfl_xor(v, o);
    return v;
}
__device__ __forceinline__ float bflo(unsigned w) { return __uint_as_float(w << 16); }
__device__ __forceinline__ float bfhi(unsigned w) { return __uint_as_float(w & 0xffff0000u); }
__device__ __forceinline__ void unpack8(const v4u w, float (&f)[8]) { f[0] = bflo(w.x); f[1] = bfhi(w.x); f[2] = bflo(w.y); f[3] = bfhi(w.y); f[4] = bflo(w.z); f[5] = bfhi(w.z); f[6] = bflo(w.w); f[7] = bfhi(w.w); }
__device__ __forceinline__ v4u pack8(const float (&f)[8]) { v4u o; o.x = pk2(f[0], f[1]); o.y = pk2(f[2], f[3]); o.z = pk2(f[4], f[5]); o.w = pk2(f[6], f[7]); return o; }

__device__ __forceinline__ void p0_transpose_item(const float* W, int K, int N, bf16* WT, LAS float* scr, int item, int lane) {
    const int nblk = N / 32, kb = item / nblk, nb = item % nblk, k0 = 64 * kb, n0 = 32 * nb;
#pragma unroll 8
    for (int i = 0; i < 32; ++i) { const int kk = 2 * i + (lane >> 5); scr[kk * 33 + (lane & 31)] = W[(size_t)(k0 + kk) * N + n0 + (lane & 31)]; }
    LDS_WAIT(); asm volatile("" ::: "memory");
    const int c = lane & 7;
#pragma unroll
    for (int j = 0; j < 4; ++j) { const int n = (lane >> 3) + 8 * j; const LAS float* s = scr + (8 * c) * 33 + n;
        v4u o; o.x = pk2(s[0 * 33], s[1 * 33]); o.y = pk2(s[2 * 33], s[3 * 33]); o.z = pk2(s[4 * 33], s[5 * 33]); o.w = pk2(s[6 * 33], s[7 * 33]);
        *(GAS v4u*)(WT + (size_t)(n0 + n) * K + k0 + 8 * c) = o; }
    LDS_WAIT(); asm volatile("" ::: "memory");
}
__device__ __forceinline__ void fold_tile(LAS float* sm, const float* Ap, int sAi, int sAk, const float* As, const float* Bp, int sBj, int K, bf16* Cp, int ldc, int tid) {
    LAS float* sA = sm; LAS float* sB = sm + 32 * 65;
    float acc[8];
#pragma unroll
    for (int q = 0; q < 8; ++q) acc[q] = 0.f;
    const int tj = tid & 63, ti0 = tid >> 6;
    for (int k0 = 0; k0 < K; k0 += 32) {
#pragma unroll
        for (int r = 0; r < 4; ++r) { const int e = tid + 512 * r; int i, k;
            if (sAk == 1) { k = e & 31; i = e >> 5; } else { i = e & 63; k = e >> 6; }
            float a = Ap[(size_t)i * sAi + (size_t)(k0 + k) * sAk]; if (As) a *= As[k0 + k];
            sA[k * 65 + i] = a;
            const int kb = e & 31, jb = e >> 5;
            sB[kb * 65 + jb] = Bp[(size_t)jb * sBj + k0 + kb]; }
        __syncthreads();
#pragma unroll 4
        for (int k = 0; k < 32; ++k) { const float b = sB[k * 65 + tj];
#pragma unroll
            for (int q = 0; q < 8; ++q) acc[q] += sA[k * 65 + ti0 + 8 * q] * b; }
        __syncthreads();
    }
#pragma unroll
    for (int q = 0; q < 8; ++q) Cp[(size_t)(ti0 + 8 * q) * ldc + tj] = (bf16)f2bf(acc[q]);
}
__device__ __forceinline__ void rms_row_to_bf16(int lane, const float* xrow, const float* g, bf16* orow) {
    const GAS f32x4* xr = (const GAS f32x4*)xrow + lane; const GAS f32x4* gr = (const GAS f32x4*)g + lane;
    f32x4 v[4]; float s = 0.f;
#pragma unroll
    for (int j = 0; j < 4; ++j) { v[j] = xr[64 * j]; s += (v[j].x * v[j].x + v[j].y * v[j].y) + (v[j].z * v[j].z + v[j].w * v[j].w); }
    const float rstd = 1.f / sqrtf(wave_sum(s) * (1.f / D) + EPS);
    GAS unsigned long long* o8 = (GAS unsigned long long*)orow + lane;
#pragma unroll
    for (int j = 0; j < 4; ++j) { const f32x4 gg = gr[64 * j];
        o8[64 * j] = (unsigned long long)pk2(v[j].x * rstd * gg.x, v[j].y * rstd * gg.y) | ((unsigned long long)pk2(v[j].z * rstd * gg.z, v[j].w * rstd * gg.w) << 32); }
}
__device__ __forceinline__ void p2_conv_pool(Frame& F, const bf16* PB, const float* conv_w, bf16* AIN, bf16* POOLED) {
    const int gt = F.vcu * (NWAVES * 64) + F.tid, NT = F.G * (NWAVES * 64);
    for (int it = gt; it < (T / 16) * (D / 8); it += NT) {
        const int cv = it & 127, rc = it >> 7, col = cv * 8, t0 = rc * 16, s0 = t0 & (SEQ - 1);
        float w0[8], w1[8], w2[8];
        { const f32x4 a = *(const GAS f32x4*)(conv_w + col), b = *(const GAS f32x4*)(conv_w + col + 4); w0[0] = a.x; w0[1] = a.y; w0[2] = a.z; w0[3] = a.w; w0[4] = b.x; w0[5] = b.y; w0[6] = b.z; w0[7] = b.w; }
        { const f32x4 a = *(const GAS f32x4*)(conv_w + D + col), b = *(const GAS f32x4*)(conv_w + D + col + 4); w1[0] = a.x; w1[1] = a.y; w1[2] = a.z; w1[3] = a.w; w1[4] = b.x; w1[5] = b.y; w1[6] = b.z; w1[7] = b.w; }
        { const f32x4 a = *(const GAS f32x4*)(conv_w + 2 * D + col), b = *(const GAS f32x4*)(conv_w + 2 * D + col + 4); w2[0] = a.x; w2[1] = a.y; w2[2] = a.z; w2[3] = a.w; w2[4] = b.x; w2[5] = b.y; w2[6] = b.z; w2[7] = b.w; }
        float um2[8], um1[8];
#pragma unroll
        for (int i = 0; i < 8; ++i) { um2[i] = 0.f; um1[i] = 0.f; }
        if (s0 != 0) {
            float c[8], h[8];
            unpack8(*(const GAS v4u*)(PB + (size_t)(t0 - 2) * 4096 + 1024 + col), c); unpack8(*(const GAS v4u*)(PB + (size_t)(t0 - 2) * 4096 + 2048 + col), h);
#pragma unroll
            for (int i = 0; i < 8; ++i) um2[i] = c[i] * h[i];
            unpack8(*(const GAS v4u*)(PB + (size_t)(t0 - 1) * 4096 + 1024 + col), c); unpack8(*(const GAS v4u*)(PB + (size_t)(t0 - 1) * 4096 + 2048 + col), h);
#pragma unroll
            for (int i = 0; i < 8; ++i) um1[i] = c[i] * h[i];
        }
        for (int r = 0; r < 16; ++r) {
            const size_t rowb = (size_t)(t0 + r) * 4096;
            float b[8], c[8], h[8], o[8];
            unpack8(*(const GAS v4u*)(PB + rowb + col), b); unpack8(*(const GAS v4u*)(PB + rowb + 1024 + col), c); unpack8(*(const GAS v4u*)(PB + rowb + 2048 + col), h);
#pragma unroll
            for (int i = 0; i < 8; ++i) { const float u = c[i] * h[i]; o[i] = b[i] * (w0[i] * um2[i] + w1[i] * um1[i] + w2[i] * u); um2[i] = um1[i]; um1[i] = u; }
            *(GAS v4u*)(AIN + (size_t)(t0 + r) * D + col) = pack8(o);
        }
        const int win = 2 << (col >> 8);
        for (int r = 0; r < 16; ++r) {
            const int t = t0 + r, s = s0 + r;
            float p0[8], sum[8], o[8];
            unpack8(*(const GAS v4u*)(PB + (size_t)t * 4096 + 3072 + col), p0);
#pragma unroll
            for (int i = 0; i < 8; ++i) sum[i] = p0[i];
            const int nb = (s < win - 1) ? s : (win - 1);
            for (int j = 1; j <= nb; ++j) { float pj[8]; unpack8(*(const GAS v4u*)(PB + (size_t)(t - j) * 4096 + 3072 + col), pj);
#pragma unroll
                for (int i = 0; i < 8; ++i) sum[i] += pj[i]; }
            const float inv = 1.0f / (float)(nb + 1);
#pragma unroll
            for (int i = 0; i < 8; ++i) o[i] = sum[i] * inv - p0[i];
            *(GAS v4u*)(POOLED + (size_t)t * D + col) = pack8(o);
        }
    }
}

__device__ __forceinline__ unsigned fkey(float f) { const unsigned u = __float_as_uint(f); return (u & 0x80000000u) ? ~u : (u | 0x80000000u); }
__device__ __forceinline__ int popc64(unsigned long long m) { return __popcll(m); }
__device__ __forceinline__ void p7_topk(Frame& F, const float* SC, int* IDX, float* GATE) {
    LAS float* scr = (LAS float*)(F.lds + RING_OFF + F.wave * 512);
    LAS int* scri = (LAS int*)scr;
    const int gw = F.vcu * NWAVES + F.wave, NGW = F.G * NWAVES, lane = F.lane;
    const unsigned long long lower = (lane == 0) ? 0ull : (~0ull >> (64 - lane));
    for (int it = gw; it < T * 8; it += NGW) {
        const int t = it >> 3, h = it & 7;
        const float* srow = SC + (size_t)t * NSC + h * 256;
#pragma unroll
        for (int p = 0; p < 2; ++p) {
            const float f0 = srow[p * 128 + lane], f1 = srow[p * 128 + 64 + lane];
            const unsigned k0 = fkey(f0), k1 = fkey(f1);
            unsigned thr = 0u;
            for (int bit = 31; bit >= 0; --bit) { const unsigned cand = thr | (1u << bit);
                const int cnt = popc64(__ballot(k0 >= cand)) + popc64(__ballot(k1 >= cand));
                if (cnt >= 16) thr = cand; }
            const unsigned long long mg0 = __ballot(k0 > thr), mg1 = __ballot(k1 > thr), me0 = __ballot(k0 == thr), me1 = __ballot(k1 == thr);
            const int ng0 = popc64(mg0), ngt = ng0 + popc64(mg1), ne0 = popc64(me0);
            int pos0 = -1, pos1 = -1;
            if (k0 > thr) pos0 = popc64(mg0 & lower); else if (k0 == thr) pos0 = ngt + popc64(me0 & lower);
            if (k1 > thr) pos1 = ng0 + popc64(mg1 & lower); else if (k1 == thr) pos1 = ngt + ne0 + popc64(me1 & lower);
            if (pos0 >= 0 && pos0 < 16) { scr[p * 16 + pos0] = f0; scri[32 + p * 16 + pos0] = lane; }
            if (pos1 >= 0 && pos1 < 16) { scr[p * 16 + pos1] = f1; scri[32 + p * 16 + pos1] = lane + 64; }
        }
        LDS_WAIT(); asm volatile("" ::: "memory");
        const int ci = lane >> 2, cj = (lane & 3) * 4;
        const float v1 = scr[ci];
        float sq[4]; unsigned kq[4];
#pragma unroll
        for (int q = 0; q < 4; ++q) { sq[q] = v1 + scr[16 + cj + q]; kq[q] = fkey(sq[q]); }
        unsigned thr = 0u;
        for (int bit = 31; bit >= 0; --bit) { const unsigned cand = thr | (1u << bit);
            const int cnt = popc64(__ballot(kq[0] >= cand)) + popc64(__ballot(kq[1] >= cand)) + popc64(__ballot(kq[2] >= cand)) + popc64(__ballot(kq[3] >= cand));
            if (cnt >= 16) thr = cand; }
        int ngt = 0;
#pragma unroll
        for (int q = 0; q < 4; ++q) ngt += popc64(__ballot(kq[q] > thr));
        int gbase = 0, ebase = ngt;
        const int e1 = scri[32 + ci];
#pragma unroll
        for (int q = 0; q < 4; ++q) {
            const unsigned long long mg = __ballot(kq[q] > thr), me = __ballot(kq[q] == thr);
            int pos = -1;
            if (kq[q] > thr) pos = gbase + popc64(mg & lower); else if (kq[q] == thr) pos = ebase + popc64(me & lower);
            gbase += popc64(mg); ebase += popc64(me);
            if (pos >= 0 && pos < 16) { scri[64 + pos] = e1 * 128 + scri[48 + cj + q]; scr[80 + pos] = sq[q]; }
        }
        LDS_WAIT(); asm volatile("" ::: "memory");
        if (lane < 16) {
            const float b = scr[80 + lane]; const int e = scri[64 + lane];
            float m = b;
            m = fmaxf(m, __shfl_xor(m, 8)); m = fmaxf(m, __shfl_xor(m, 4)); m = fmaxf(m, __shfl_xor(m, 2)); m = fmaxf(m, __shfl_xor(m, 1));
            const float ex = __expf(b - m);
            float sm = ex; sm += __shfl_xor(sm, 8); sm += __shfl_xor(sm, 4); sm += __shfl_xor(sm, 2); sm += __shfl_xor(sm, 1);
            IDX[(size_t)t * NSEL + h * 16 + lane] = e; GATE[(size_t)t * NSEL + h * 16 + lane] = ex / sm;
        }
        LDS_WAIT(); asm volatile("" ::: "memory");
    }
}
__device__ __forceinline__ float dot16(const float (&x)[16], const v4u a, const v4u b) {
    float s0 = x[0] * bflo(a.x), s1 = x[1] * bfhi(a.x);
    s0 += x[2] * bflo(a.y); s1 += x[3] * bfhi(a.y); s0 += x[4] * bflo(a.z); s1 += x[5] * bfhi(a.z); s0 += x[6] * bflo(a.w); s1 += x[7] * bfhi(a.w);
    s0 += x[8] * bflo(b.x); s1 += x[9] * bfhi(b.x); s0 += x[10] * bflo(b.y); s1 += x[11] * bfhi(b.y); s0 += x[12] * bflo(b.z); s1 += x[13] * bfhi(b.z); s0 += x[14] * bflo(b.w); s1 += x[15] * bfhi(b.w);
    return s0 + s1;
}
__device__ __forceinline__ void axpy16(float (&y)[16], float a, const v4u u, const v4u v) {
    y[0] += a * bflo(u.x); y[1] += a * bfhi(u.x); y[2] += a * bflo(u.y); y[3] += a * bfhi(u.y); y[4] += a * bflo(u.z); y[5] += a * bfhi(u.z); y[6] += a * bflo(u.w); y[7] += a * bfhi(u.w);
    y[8] += a * bflo(v.x); y[9] += a * bfhi(v.x); y[10] += a * bflo(v.y); y[11] += a * bfhi(v.y); y[12] += a * bflo(v.z); y[13] += a * bfhi(v.z); y[14] += a * bflo(v.w); y[15] += a * bfhi(v.w);
}
__device__ __forceinline__ float gelu_erf(float z) { return 0.5f * z * (1.0f + erff(z * 0.70710678118654752f)); }
__device__ __forceinline__ void p8_peer(Frame& F, const bf16* XN2, const bf16* U16, const bf16* V16, const int* IDX, const float* GATE, float* HOUT, const float* gfin) {
    const int gw = F.vcu * NWAVES + F.wave, NGW = F.G * NWAVES, lane = F.lane;
    for (int t = gw; t < T; t += NGW) {
        float x[16];
        { float a[8], b[8]; unpack8(*(const GAS v4u*)(XN2 + (size_t)t * D + 8 * lane), a); unpack8(*(const GAS v4u*)(XN2 + (size_t)t * D + 512 + 8 * lane), b);
#pragma unroll
          for (int i = 0; i < 8; ++i) { x[i] = a[i]; x[8 + i] = b[i]; } }
        const int id0 = IDX[(size_t)t * NSEL + lane], id1 = IDX[(size_t)t * NSEL + 64 + lane];
        const float g0 = GATE[(size_t)t * NSEL + lane], g1 = GATE[(size_t)t * NSEL + 64 + lane];
        float z0 = 0.f, z1 = 0.f;
        for (int k0 = 0; k0 < NSEL; k0 += 8) {
            const int idv = (k0 < 64) ? id0 : id1;
            v4u ua[8], ub[8];
#pragma unroll
            for (int j = 0; j < 8; ++j) { const int e = __builtin_amdgcn_readlane(idv, (k0 + j) & 63); const bf16* ur = U16 + (size_t)e * D;
                ua[j] = *(const GAS v4u*)(ur + 8 * lane); ub[j] = *(const GAS v4u*)(ur + 512 + 8 * lane); }
#pragma unroll
            for (int j = 0; j < 8; ++j) { const float p = wave_sum(dot16(x, ua[j], ub[j])); const bool mine = (lane == ((k0 + j) & 63));
                if (k0 < 64) z0 = mine ? p : z0; else z1 = mine ? p : z1; }
        }
        const float a0 = gelu_erf(z0) * g0, a1 = gelu_erf(z1) * g1;
        float y[16];
#pragma unroll
        for (int i = 0; i < 16; ++i) y[i] = 0.f;
        for (int k0 = 0; k0 < NSEL; k0 += 8) {
            const int idv = (k0 < 64) ? id0 : id1; const float av = (k0 < 64) ? a0 : a1;
            v4u va[8], vb[8];
#pragma unroll
            for (int j = 0; j < 8; ++j) { const int e = __builtin_amdgcn_readlane(idv, (k0 + j) & 63); const bf16* vr = V16 + (size_t)e * D;
                va[j] = *(const GAS v4u*)(vr + 8 * lane); vb[j] = *(const GAS v4u*)(vr + 512 + 8 * lane); }
#pragma unroll
            for (int j = 0; j < 8; ++j) { const float a = __builtin_bit_cast(float, __builtin_amdgcn_readlane(__builtin_bit_cast(int, av), (k0 + j) & 63)); axpy16(y, a, va[j], vb[j]); }
        }
        float* hr = HOUT + (size_t)t * D;
        const f32x4 h0 = *(const GAS f32x4*)(hr + 8 * lane), h1 = *(const GAS f32x4*)(hr + 8 * lane + 4), h2 = *(const GAS f32x4*)(hr + 512 + 8 * lane), h3 = *(const GAS f32x4*)(hr + 512 + 8 * lane + 4);
        y[0] += h0.x; y[1] += h0.y; y[2] += h0.z; y[3] += h0.w; y[4] += h1.x; y[5] += h1.y; y[6] += h1.z; y[7] += h1.w;
        y[8] += h2.x; y[9] += h2.y; y[10] += h2.z; y[11] += h2.w; y[12] += h3.x; y[13] += h3.y; y[14] += h3.z; y[15] += h3.w;
        float ss = 0.f;
#pragma unroll
        for (int i = 0; i < 16; ++i) ss += y[i] * y[i];
        const float rstd = 1.f / sqrtf(wave_sum(ss) * (1.f / D) + EPS);
        const f32x4 q0 = *(const GAS f32x4*)(gfin + 8 * lane), q1 = *(const GAS f32x4*)(gfin + 8 * lane + 4), q2 = *(const GAS f32x4*)(gfin + 512 + 8 * lane), q3 = *(const GAS f32x4*)(gfin + 512 + 8 * lane + 4);
        *(GAS f32x4*)(hr + 8 * lane) = (f32x4){y[0] * rstd * q0.x, y[1] * rstd * q0.y, y[2] * rstd * q0.z, y[3] * rstd * q0.w};
        *(GAS f32x4*)(hr + 8 * lane + 4) = (f32x4){y[4] * rstd * q1.x, y[5] * rstd * q1.y, y[6] * rstd * q1.z, y[7] * rstd * q1.w};
        *(GAS f32x4*)(hr + 512 + 8 * lane) = (f32x4){y[8] * rstd * q2.x, y[9] * rstd * q2.y, y[10] * rstd * q2.z, y[11] * rstd * q2.w};
        *(GAS f32x4*)(hr + 512 + 8 * lane + 4) = (f32x4){y[12] * rstd * q3.x, y[13] * rstd * q3.y, y[14] * rstd * q3.z, y[15] * rstd * q3.w};
    }
}
__device__ __forceinline__ void cvt_stream(Frame& F, const float* src, bf16* dst, size_t n) {
    const size_t gt = (size_t)F.vcu * (NWAVES * 64) + F.tid, NT = (size_t)F.G * (NWAVES * 64);
    for (size_t i = gt; i < n / 8; i += NT) { const f32x4 a = *(const GAS f32x4*)(src + 8 * i), b = *(const GAS f32x4*)(src + 8 * i + 4);
        v4u o; o.x = pk2(a.x, a.y); o.y = pk2(a.z, a.w); o.z = pk2(b.x, b.y); o.w = pk2(b.z, b.w); *(GAS v4u*)(dst + 8 * i) = o; }
}

struct Args { const float* in[15]; float* out; unsigned char* ws; int ph_lo, ph_hi; };
__global__ void __launch_bounds__(NWAVES * 64, 2) hyb_fwd(Args args) {
    extern __shared__ __attribute__((aligned(16))) unsigned char lds[];
    Frame F;
    F.lds = (LAS unsigned char*)lds;
    F.MISC = (volatile LAS unsigned*)(F.lds + MISC_OFF);
    F.tid = threadIdx.x; F.lane = F.tid & 63; F.wave = __builtin_amdgcn_readfirstlane(F.tid >> 6);
    F.G = gridDim.x; { const int bx = blockIdx.x; F.vcu = (F.G % 8 == 0) ? (bx % 8) * (F.G / 8) + bx / 8 : bx; }
    unsigned char* ws = args.ws;
    gu32* ctl = (gu32*)(ws + WS_CTL);
    const float* x = args.in[0]; const float* g_mix = args.in[1]; const float* w_in = args.in[2]; const float* conv_w = args.in[3]; const float* w_conv_out = args.in[4];
    const float* pool_w = args.in[5]; const float* pool_scale = args.in[6]; const float* w_pool_out = args.in[7]; const float* w_out = args.in[8]; const float* g_ffn = args.in[9];
    const float* w_query = args.in[10]; const float* sub_keys = args.in[11]; const float* expert_u = args.in[12]; const float* expert_v = args.in[13]; const float* g_fin = args.in[14];
    bf16* WIN = (bf16*)(ws + WS_WIN); bf16* WC = (bf16*)(ws + WS_WC); bf16* WPB = (bf16*)(ws + WS_WPB); bf16* WOUT = (bf16*)(ws + WS_WOUT); bf16* WSC = (bf16*)(ws + WS_WS);
    bf16* XN = (bf16*)(ws + WS_XN); bf16* PB = (bf16*)(ws + WS_PB); bf16* PG = (bf16*)(ws + WS_PG); bf16* TMP = (bf16*)(ws + WS_TMP); bf16* MG = (bf16*)(ws + WS_MG);
    float* SC = (float*)(ws + WS_SC); int* IDX = (int*)(ws + WS_IDX); float* GATE = (float*)(ws + WS_GATE); bf16* U16 = (bf16*)(ws + WS_U16); bf16* V16 = (bf16*)(ws + WS_V16);
    bf16* AIN = (bf16*)args.out; bf16* POOLED = (bf16*)args.out + (size_t)T * D; float* H = args.out;

    for (int u = F.tid; u < (LDS_BYTES - LDSCTL_OFF) / 4; u += NWAVES * 64) ((LAS unsigned*)(F.lds + LDSCTL_OFF))[u] = 0u;
    __syncthreads();
    XcdBarrier bar; bar.bar = (unsigned*)(ctl + CW_BAR); bar.x = 0; bar.st = nullptr;
    if (N_LAUNCHES == 1) bar = xcd_barrier_post((unsigned*)(ctl + CW_BAR), F.MISC + 8);
#define GRID_BAR() do { if (N_LAUNCHES == 1) xcd_barrier(bar); } while (0)
    const int lo = args.ph_lo, hi = args.ph_hi;
#define IN(k) (lo <= (k) && (k) < hi)
#define BOTH(k) (IN(k) && IN((k) + 1))
    const int gw = F.vcu * NWAVES + F.wave, NGW = F.G * NWAVES;

    if (IN(0)) {
        LAS float* sm = (LAS float*)(F.lds + RING_OFF);
        for (int it = blockIdx.x; it < 768; it += F.G) {
            if (it < 256) { const int g = it >> 6, i0 = ((it >> 2) & 15) * 64, j0 = (it & 3) * 64;
                fold_tile(sm, w_pool_out + (size_t)g * 256 * D + i0, 1, D, pool_scale + g * 256, pool_w + (size_t)g * 65536 + (size_t)j0 * 256, 256, 256, WPB + (size_t)i0 * D + g * 256 + j0, D, F.tid);
            } else { const int r = it - 256, hp = r >> 5, i0 = ((r >> 4) & 1) * 64, j0 = (r & 15) * 64;
                fold_tile(sm, sub_keys + (size_t)hp * 16384 + (size_t)i0 * 128, 128, 1, nullptr, w_query + (size_t)j0 * NSC + hp * 128, NSC, 128, WSC + (size_t)(hp * 128 + i0) * D + j0, D, F.tid); }
        }
        __syncthreads();
        LAS float* scr = (LAS float*)(F.lds + RING_OFF + F.wave * 16384);
        constexpr int I_IN = (D / 64) * (NIN / 32), I_SQ = (D / 64) * (D / 32);
        for (int it = gw; it < I_IN + 2 * I_SQ; it += NGW) {
            int r = it;
            if (r < I_IN) { p0_transpose_item(w_in, D, NIN, WIN, scr, r, F.lane); continue; } r -= I_IN;
            if (r < I_SQ) { p0_transpose_item(w_conv_out, D, D, WC, scr, r, F.lane); continue; } r -= I_SQ;
            p0_transpose_item(w_out, D, D, WOUT, scr, r, F.lane);
        }
        for (int m = gw; m < T; m += NGW) rms_row_to_bf16(F.lane, x + (size_t)m * D, g_mix, XN + (size_t)m * D);
        if (BOTH(0)) GRID_BAR();
    }
    if (IN(1)) {
        pg8::Gemm g{XN, WIN, 0l, 0l, T, NIN, D}; pg8::StaticOrder S; S.init(T, NIN, F.G, (int)blockIdx.x);
        pg8::EpiProj E{PB, PG};
        pg8::gemm_phase<pg8::EpiProj, pg8::StaticOrder, true, true>(F.lds + RING_OFF, g, S, E);
        if (BOTH(1)) GRID_BAR();
    }
    if (IN(2)) {
        p2_conv_pool(F, PB, conv_w, AIN, POOLED);
        if (BOTH(2)) GRID_BAR();
    }
    if (IN(3)) {
        pg8::Gemm g{AIN, WC, (long)T * D * 2, (long)(WS_WPB - WS_WC), T, D, D}; pg8::MergeOrder S; S.base.init(T, D, F.G, (int)blockIdx.x);
        pg8::EpiMerge E{PG, TMP, (long)((WS_MG - WS_TMP) / 2)};
        pg8::gemm_phase<pg8::EpiMerge, pg8::MergeOrder, true, true>(F.lds + RING_OFF, g, S, E);
        if (BOTH(3)) GRID_BAR();
    }
    if (IN(4)) {
        pg8::Gemm g{MG, WOUT, 0l, 0l, T, D, D}; pg8::StaticOrder S; S.init(T, D, F.G, (int)blockIdx.x);
        pg8::EpiRes E{x, H};
        pg8::gemm_phase<pg8::EpiRes, pg8::StaticOrder, true, true>(F.lds + RING_OFF, g, S, E);
        cvt_stream(F, expert_u, U16, (size_t)NEXP * D);
        cvt_stream(F, expert_v, V16, (size_t)NEXP * D);
        if (BOTH(4)) GRID_BAR();
    }
    if (IN(5)) {
        for (int m = gw; m < T; m += NGW) rms_row_to_bf16(F.lane, H + (size_t)m * D, g_ffn, XN + (size_t)m * D);
        if (BOTH(5)) GRID_BAR();
    }
    if (IN(6)) {
        pg8::Gemm g{XN, WSC, 0l, 0l, T, NSC, D}; pg8::StaticOrder S; S.init(T, NSC, F.G, (int)blockIdx.x);
        pg8::EpiF32 E{SC, NSC};
        pg8::gemm_phase<pg8::EpiF32, pg8::StaticOrder, true, true>(F.lds + RING_OFF, g, S, E);
        if (BOTH(6)) GRID_BAR();
    }
    if (IN(7)) {
        p7_topk(F, SC, IDX, GATE);
        if (BOTH(7)) GRID_BAR();
    }
    if (IN(8)) {
        p8_peer(F, XN, U16, V16, IDX, GATE, H, g_fin);
    }
#undef IN
#undef BOTH
}

extern "C" void kernel_launch(void* const* d_in, const int* in_sizes, int n_in, void* d_out, int out_size, void* d_ws, size_t ws_size, hipStream_t stream) {
    static int grid = 0;
    if (grid == 0) {
        if (n_in != 15 || in_sizes[0] != T * D || out_size != T * D || ws_size < WS_END) { fprintf(stderr, "kernel_launch: shape/workspace mismatch (n_in %d, in0 %d, out %d, ws %zu)\n", n_in, n_in > 0 ? in_sizes[0] : -1, out_size, ws_size); grid = -1; return; }
        int dev = 0, cus = 0, per_cu = 0;
        if (hipGetDevice(&dev) != hipSuccess || hipDeviceGetAttribute(&cus, hipDeviceAttributeMultiprocessorCount, dev) != hipSuccess) { grid = -1; return; }
        if (hipFuncSetAttribute((const void*)hyb_fwd, hipFuncAttributeMaxDynamicSharedMemorySize, LDS_BYTES) != hipSuccess) { fprintf(stderr, "kernel_launch: hipFuncSetAttribute failed\n"); grid = -1; return; }
        if (hipOccupancyMaxActiveBlocksPerMultiprocessor(&per_cu, (const void*)hyb_fwd, NWAVES * 64, LDS_BYTES) != hipSuccess || per_cu < 1)
            fprintf(stderr, "kernel_launch: note: occupancy query reports %d workgroups per CU\n", per_cu);
        (void)hipGetLastError();
        grid = cus;
    }
    if (grid < 0) return;
    if (hipMemsetAsync((char*)d_ws + WS_CTL, 0, CTL_ZERO_BYTES, stream) != hipSuccess) { fprintf(stderr, "kernel_launch: hipMemsetAsync failed\n"); return; }
    Args a{};
    for (int i = 0; i < 15; ++i) a.in[i] = (const float*)d_in[i];
    a.out = (float*)d_out; a.ws = (unsigned char*)d_ws;
    for (int li = 0; li < N_LAUNCHES; ++li) {
        a.ph_lo = (N_LAUNCHES == 1) ? 0 : li; a.ph_hi = (N_LAUNCHES == 1) ? NPHASE : li + 1;
        hipLaunchKernelGGL(hyb_fwd, dim3(grid), dim3(NWAVES * 64), LDS_BYTES, stream, a);
        const hipError_t le = hipPeekAtLastError();
        if (le != hipSuccess) { fprintf(stderr, "kernel_launch: launch %d failed: %s\n", li, hipGetErrorName(le)); break; }
    }
}
```

```cpp
#include <hip/hip_runtime.h>
#include <cstdio>
#include <cstdint>
namespace pg8 {
#define PG8_LAS __attribute__((address_space(3)))
typedef unsigned short bf16_t;
typedef short bf16x8 __attribute__((ext_vector_type(8)));
typedef float f32x4 __attribute__((ext_vector_type(4)));
typedef unsigned u32x4 __attribute__((ext_vector_type(4)));
constexpr int BM = 256, BK = 64, HALF = 128, HTB = HALF * BK * 2  , STAGE_BYTES = 8 * HTB, NXCD = 8, WGM = 8;

__host__ __device__ __forceinline__ int lds_byte(int r, int c) { const int st = (r >> 4) * 2 + (c >> 5), rr = r & 15, cc = c & 31, ob = rr * 64 + cc * 2; return st * 1024 + (ob ^ (((ob >> 9) & 1) << 5)); }
__host__ __device__ __forceinline__ void stage_rc(int b, int& R, int& C) { const int st = b / 1024, sb = b % 1024, swz = sb ^ (((sb >> 9) & 1) << 5); R = (st >> 1) * 16 + swz / 64; C = (st & 1) * 32 + (swz % 64) / 2; }
__host__ __device__ __forceinline__ int perm32(int rho) { const int n = rho >> 4, i = rho & 15; return 8 * (i >> 2) + 4 * n + (i & 3); }

struct Unit { int pm, pn, sel; };
struct Gemm { const bf16_t* A; const bf16_t* Bt; long offA1, offB1; int M, N, K; };

struct StaticOrder {
    int nM, nN, nwg, G, c;
    __host__ __device__ void init(int M, int N, int G_, int c_) { nM = M / BM; nN = N / BM; nwg = nM * nN; G = G_; c = c_; }
    __host__ __device__ __forceinline__ bool next(int i, Unit& u) const {
        const long L = (long)i * G + c; if (L >= nwg) return false;
        int wgid = (int)L; { const int q = nwg / NXCD, r = nwg % NXCD, xcd = wgid % NXCD, off = wgid / NXCD; wgid = (xcd < r ? xcd * (q + 1) : r * (q + 1) + (xcd - r) * q) + off; }
        const int nig = WGM * nN, gid = wgid / nig, fm = gid * WGM, gsz = (nM - fm) < WGM ? (nM - fm) : WGM;
        u.pm = fm + ((wgid % nig) % gsz); u.pn = (wgid % nig) / gsz; u.sel = 0; return true;
    }
    __device__ __forceinline__ void a_ready(const Unit&) const {}
    __device__ __forceinline__ void done(const Unit&) const {}
};


__device__ __forceinline__ unsigned cvt_pk_bf16(float lo, float hi) { unsigned r; asm volatile("v_cvt_pk_bf16_f32 %0, %1, %2" : "=v"(r) : "v"(lo), "v"(hi)); return r; }
__device__ __forceinline__ float sigm(float x) { return __builtin_amdgcn_rcpf(1.0f + __expf(-x)); }
__device__ __forceinline__ float bflo(unsigned w) { return __uint_as_float(w << 16); }
__device__ __forceinline__ float bfhi(unsigned w) { return __uint_as_float(w & 0xffff0000u); }

struct EpiProj {
    static constexpr bool PERM = true, AFTER_DRAIN = false;
    bf16_t* PB; bf16_t* PG;
    __device__ __forceinline__ void operator()(const f32x4 (&acc)[2][2][4][2], const Unit& u, int wr, int wc, int fr, int fq) const {
        const bool gate = u.pn >= 16;
        bf16_t* base = gate ? PG : PB; const int ldc = gate ? 2048 : 4096; const int colt = (gate ? u.pn - 16 : u.pn) * BM;
        const int row0 = u.pm * BM + wr * 64 + fr, col0 = colt + wc * 32 + 8 * fq;
#pragma unroll
        for (int ai = 0; ai < 2; ++ai)
#pragma unroll
            for (int m = 0; m < 4; ++m) { bf16_t* rowp = base + (size_t)(row0 + ai * HALF + m * 16) * ldc + col0;
#pragma unroll
                for (int bj = 0; bj < 2; ++bj) { f32x4 v0 = acc[ai][bj][m][0], v1 = acc[ai][bj][m][1];
                    if (gate) { v0[0] = sigm(v0[0]); v0[1] = sigm(v0[1]); v0[2] = sigm(v0[2]); v0[3] = sigm(v0[3]); v1[0] = sigm(v1[0]); v1[1] = sigm(v1[1]); v1[2] = sigm(v1[2]); v1[3] = sigm(v1[3]); }
                    u32x4 w; w.x = cvt_pk_bf16(v0[0], v0[1]); w.y = cvt_pk_bf16(v0[2], v0[3]); w.z = cvt_pk_bf16(v1[0], v1[1]); w.w = cvt_pk_bf16(v1[2], v1[3]);
                    *(u32x4*)(rowp + bj * HALF) = w; } }
    }
};
struct EpiMerge {
    static constexpr bool PERM = true, AFTER_DRAIN = false;
    const bf16_t* PG; bf16_t* TMP; long mg_off;
    __device__ __forceinline__ void operator()(const f32x4 (&acc)[2][2][4][2], const Unit& u, int wr, int wc, int fr, int fq) const {
        const int row0 = u.pm * BM + wr * 64 + fr, col0 = u.pn * BM + wc * 32 + 8 * fq; const int goff = u.sel ? 1024 : 0;
#pragma unroll
        for (int ai = 0; ai < 2; ++ai)
#pragma unroll
            for (int m = 0; m < 4; ++m) { const size_t row = (size_t)(row0 + ai * HALF + m * 16);
#pragma unroll
                for (int bj = 0; bj < 2; ++bj) { const int col = col0 + bj * HALF;
                    const u32x4 g = *(const u32x4*)(PG + row * 2048 + goff + col);
                    const f32x4 v0 = acc[ai][bj][m][0], v1 = acc[ai][bj][m][1];
                    float o0 = v0[0] * bflo(g.x), o1 = v0[1] * bfhi(g.x), o2 = v0[2] * bflo(g.y), o3 = v0[3] * bfhi(g.y);
                    float o4 = v1[0] * bflo(g.z), o5 = v1[1] * bfhi(g.z), o6 = v1[2] * bflo(g.w), o7 = v1[3] * bfhi(g.w);
                    if (u.sel) { const u32x4 t = *(const u32x4*)(TMP + row * 1024 + col);
                        o0 += bflo(t.x); o1 += bfhi(t.x); o2 += bflo(t.y); o3 += bfhi(t.y); o4 += bflo(t.z); o5 += bfhi(t.z); o6 += bflo(t.w); o7 += bfhi(t.w); }
                    u32x4 w; w.x = cvt_pk_bf16(o0, o1); w.y = cvt_pk_bf16(o2, o3); w.z = cvt_pk_bf16(o4, o5); w.w = cvt_pk_bf16(o6, o7);
                    *(u32x4*)(TMP + (u.sel ? mg_off : 0l) + row * 1024 + col) = w; } }
    }
};
struct EpiRes {
    static constexpr bool PERM = false, AFTER_DRAIN = false;
    const float* X; float* H;
    __device__ __forceinline__ void operator()(const f32x4 (&acc)[2][2][4][2], const Unit& u, int wr, int wc, int fr, int fq) const {
        const int row0 = u.pm * BM + wr * 64 + fr, col0 = u.pn * BM + wc * 32 + 4 * fq;
#pragma unroll
        for (int ai = 0; ai < 2; ++ai)
#pragma unroll
            for (int m = 0; m < 4; ++m) { const size_t off = (size_t)(row0 + ai * HALF + m * 16) * 1024 + col0;
#pragma unroll
                for (int bj = 0; bj < 2; ++bj)
#pragma unroll
                    for (int n = 0; n < 2; ++n) { const f32x4 xv = *(const f32x4*)(X + off + bj * HALF + n * 16); *(f32x4*)(H + off + bj * HALF + n * 16) = xv + acc[ai][bj][m][n]; } }
    }
};
struct EpiF32 {
    static constexpr bool PERM = false, AFTER_DRAIN = false;
    float* C; int ldc;
    __device__ __forceinline__ void operator()(const f32x4 (&acc)[2][2][4][2], const Unit& u, int wr, int wc, int fr, int fq) const {
        const int row0 = u.pm * BM + wr * 64 + fr, col0 = u.pn * BM + wc * 32 + 4 * fq;
#pragma unroll
        for (int ai = 0; ai < 2; ++ai)
#pragma unroll
            for (int m = 0; m < 4; ++m) { float* rowp = C + (size_t)(row0 + ai * HALF + m * 16) * ldc + col0;
#pragma unroll
                for (int bj = 0; bj < 2; ++bj)
#pragma unroll
                    for (int n = 0; n < 2; ++n) *(f32x4*)(rowp + bj * HALF + n * 16) = acc[ai][bj][m][n]; }
    }
};
struct MergeOrder {
    StaticOrder base;
    __device__ __forceinline__ bool next(int i, Unit& u) const { if (!base.next(i >> 1, u)) return false; u.sel = i & 1; return true; }
    __device__ __forceinline__ void a_ready(const Unit&) const {}
    __device__ __forceinline__ void done(const Unit&) const {}
};

template <class Epi, class Sched, bool ALIGN_EPI = false, bool SP2 = false>
__device__ __forceinline__ void gemm_phase(PG8_LAS unsigned char* lds, const Gemm g, const Sched& S, const Epi& E) {
    const int tid = threadIdx.x, wid = __builtin_amdgcn_readfirstlane(tid >> 6), lane = tid & 63, wr = wid >> 2, wc = wid & 3, fr = lane & 15, fq = lane >> 4;
    const int K = g.K, nt = K / BK;
    unsigned voffA[2], voffB[2];
#pragma unroll
    for (int i = 0; i < 2; ++i) { int R, C; stage_rc(tid * 16 + i * 8192, R, C); const int Rb = Epi::PERM ? ((R & ~31) + perm32(R & 31)) : R;
        voffA[i] = (unsigned)(R * K + C) * 2u; voffB[i] = (unsigned)(Rb * K + C) * 2u; }
    const size_t kstep = (size_t)(BK * 2);
    const size_t hstep = (size_t)HALF * K * 2;
    const size_t tstep = 2 * hstep;
    const unsigned ldsw = (unsigned)wid * 1024u;
    const int aoff = lds_byte(wr * 64 + fr, fq * 8), boff = lds_byte(wc * 32 + fr, fq * 8);
#define PG8_SA(b, h) (((b) * 2 + (h)) * HTB)
#define PG8_SB(b, h) ((4 + (b) * 2 + (h)) * HTB)
#define PG8_STAGE(bufoff, gbase, voff) do { _Pragma("unroll") for (int _i = 0; _i < 2; ++_i) \
        __builtin_amdgcn_global_load_lds((const unsigned*)((const char*)(gbase) + (voff)[_i]), (PG8_LAS unsigned*)(lds + (bufoff) + ldsw + _i * 8192), 16, 0, 0); } while (0)
#define PG8_LDA(dst, b, h) do { _Pragma("unroll") for (int m = 0; m < 4; ++m) _Pragma("unroll") for (int k = 0; k < 2; ++k) dst[m][k] = *(const PG8_LAS bf16x8*)(lds + PG8_SA(b, h) + aoff + m * 2048 + k * 1024); } while (0)
#define PG8_LDB(dst, b, h) do { _Pragma("unroll") for (int n = 0; n < 2; ++n) _Pragma("unroll") for (int k = 0; k < 2; ++k) dst[n][k] = *(const PG8_LAS bf16x8*)(lds + PG8_SB(b, h) + boff + n * 2048 + k * 1024); } while (0)
#define PG8_MMA(ai, bj, At, Bt) do { __builtin_amdgcn_s_setprio(1); _Pragma("unroll") for (int m = 0; m < 4; ++m) _Pragma("unroll") for (int n = 0; n < 2; ++n) _Pragma("unroll") for (int k = 0; k < 2; ++k) \
        acc[ai][bj][m][n] = __builtin_amdgcn_mfma_f32_16x16x32_bf16(Bt[n][k], At[m][k], acc[ai][bj][m][n], 0, 0, 0); __builtin_amdgcn_s_setprio(0); } while (0)
#define PG8_WAIT_V(n) asm volatile("s_waitcnt vmcnt(" #n ")" ::: "memory")
#define PG8_WAIT_L(n) asm volatile("s_waitcnt lgkmcnt(" #n ")" ::: "memory")
#define PG8_BAR __builtin_amdgcn_s_barrier()
#define PG8_SCHED __builtin_amdgcn_sched_barrier(0)
    Unit cur, nxt; int ui = 0;
    if (!S.next(0, cur)) return;
    f32x4 acc[2][2][4][2];
#pragma unroll
    for (int a = 0; a < 2; ++a)
#pragma unroll
        for (int b = 0; b < 2; ++b)
#pragma unroll
            for (int m = 0; m < 4; ++m)
#pragma unroll
                for (int n = 0; n < 2; ++n) acc[a][b][m][n] = (f32x4){0.f, 0.f, 0.f, 0.f};
    bf16x8 At[4][2], B0[2][2], B1[2][2];
    const char* cA = (const char*)g.A + (cur.sel ? g.offA1 : 0l) + (size_t)cur.pm * tstep; const char* cB = (const char*)g.Bt + (cur.sel ? g.offB1 : 0l) + (size_t)cur.pn * tstep;
    S.a_ready(cur);
    if constexpr (SP2) {
        PG8_STAGE(PG8_SB(0, 0), cB, voffB); PG8_STAGE(PG8_SB(0, 1), cB + hstep, voffB); PG8_STAGE(PG8_SA(0, 0), cA, voffA); PG8_STAGE(PG8_SA(0, 1), cA + hstep, voffA);
        if (wr == 1) PG8_BAR;
        PG8_WAIT_V(2); PG8_BAR;
        PG8_STAGE(PG8_SB(1, 0), cB + kstep, voffB); PG8_STAGE(PG8_SA(1, 0), cA + kstep, voffA); PG8_STAGE(PG8_SB(1, 1), cB + hstep + kstep, voffB);
        PG8_WAIT_V(6); PG8_BAR;
    } else {
        PG8_STAGE(PG8_SB(0, 0), cB, voffB); PG8_STAGE(PG8_SA(0, 0), cA, voffA); PG8_STAGE(PG8_SB(0, 1), cB + hstep, voffB); PG8_STAGE(PG8_SA(0, 1), cA + hstep, voffA);
        if (wr == 1) PG8_BAR;
        PG8_WAIT_V(4); PG8_BAR;
        PG8_STAGE(PG8_SB(1, 0), cB + kstep, voffB); PG8_STAGE(PG8_SA(1, 0), cA + kstep, voffA); PG8_STAGE(PG8_SB(1, 1), cB + hstep + kstep, voffB);
        PG8_WAIT_V(6); PG8_BAR;
    }
    for (;;) {
        const bool has_next = S.next(ui + 1, nxt);
        const char* nA = has_next ? (const char*)g.A + (nxt.sel ? g.offA1 : 0l) + (size_t)nxt.pm * tstep : cA; const char* nB = has_next ? (const char*)g.Bt + (nxt.sel ? g.offB1 : 0l) + (size_t)nxt.pn * tstep : cB;
        for (int t = 0; t < nt; t += 2) {
            const bool last = (t == nt - 2);
            const char* a1 = cA + (size_t)(t + 1) * kstep;
            const char* a2 = last ? nA : cA + (size_t)(t + 2) * kstep; const char* b2 = last ? nB : cB + (size_t)(t + 2) * kstep;
            const char* a3 = a2 + kstep; const char* b3 = b2 + kstep;
            if (last && has_next) S.a_ready(nxt);
            if constexpr (SP2) {
            PG8_LDB(B0, 0, 0); PG8_LDB(B1, 0, 1); PG8_SCHED; PG8_LDA(At, 0, 0); PG8_STAGE(PG8_SA(1, 1), a1 + hstep, voffA);
            PG8_WAIT_V(8); PG8_WAIT_L(0); PG8_BAR; PG8_MMA(0, 0, At, B0); PG8_MMA(0, 1, At, B1); PG8_BAR; PG8_SCHED;
            PG8_LDA(At, 0, 1); PG8_STAGE(PG8_SB(0, 0), b2, voffB); PG8_STAGE(PG8_SB(0, 1), b2 + hstep, voffB); PG8_STAGE(PG8_SA(0, 0), a2, voffA);
            PG8_WAIT_V(8); PG8_WAIT_L(0); PG8_BAR; PG8_MMA(1, 0, At, B0); PG8_MMA(1, 1, At, B1); PG8_BAR; PG8_SCHED;
            PG8_LDB(B0, 1, 0); PG8_LDB(B1, 1, 1); PG8_SCHED; PG8_LDA(At, 1, 0); PG8_STAGE(PG8_SA(0, 1), a2 + hstep, voffA);
            PG8_WAIT_V(8); PG8_WAIT_L(0); PG8_BAR; PG8_MMA(0, 0, At, B0); PG8_MMA(0, 1, At, B1); PG8_BAR; PG8_SCHED;
            PG8_LDA(At, 1, 1); PG8_STAGE(PG8_SB(1, 0), b3, voffB); PG8_STAGE(PG8_SB(1, 1), b3 + hstep, voffB); PG8_STAGE(PG8_SA(1, 0), a3, voffA);
            PG8_WAIT_V(8); PG8_WAIT_L(0); PG8_BAR; PG8_MMA(1, 0, At, B0); PG8_MMA(1, 1, At, B1); PG8_BAR; PG8_SCHED;
            } else {
            PG8_LDB(B0, 0, 0); PG8_SCHED; PG8_LDA(At, 0, 0); PG8_STAGE(PG8_SA(1, 1), a1 + hstep, voffA);
            PG8_WAIT_L(8); PG8_BAR; PG8_WAIT_L(0); PG8_MMA(0, 0, At, B0); PG8_BAR; PG8_SCHED;
            PG8_LDB(B1, 0, 1); PG8_STAGE(PG8_SB(0, 0), b2, voffB);
            PG8_BAR; PG8_WAIT_L(0); PG8_MMA(0, 1, At, B1); PG8_BAR;
            PG8_LDA(At, 0, 1); PG8_STAGE(PG8_SA(0, 0), a2, voffA);
            PG8_BAR; PG8_WAIT_L(0); PG8_MMA(1, 0, At, B0); PG8_BAR; PG8_SCHED;
            PG8_STAGE(PG8_SB(0, 1), b2 + hstep, voffB);
            PG8_WAIT_V(6); PG8_BAR; PG8_MMA(1, 1, At, B1); PG8_BAR;
            PG8_LDB(B0, 1, 0); PG8_SCHED; PG8_LDA(At, 1, 0); PG8_STAGE(PG8_SA(0, 1), a2 + hstep, voffA);
            PG8_WAIT_L(8); PG8_BAR; PG8_WAIT_L(0); PG8_MMA(0, 0, At, B0); PG8_BAR; PG8_SCHED;
            PG8_LDB(B1, 1, 1); PG8_STAGE(PG8_SB(1, 0), b3, voffB);
            PG8_BAR; PG8_WAIT_L(0); PG8_MMA(0, 1, At, B1); PG8_BAR;
            PG8_LDA(At, 1, 1); PG8_STAGE(PG8_SA(1, 0), a3, voffA);
            PG8_BAR; PG8_WAIT_L(0); PG8_MMA(1, 0, At, B0); PG8_BAR; PG8_SCHED;
            PG8_STAGE(PG8_SB(1, 1), b3 + hstep, voffB);
            PG8_WAIT_V(6); PG8_BAR; PG8_MMA(1, 1, At, B1); PG8_BAR;
            }
        }
        if constexpr (ALIGN_EPI) { if (wr == 0) PG8_BAR; }
        if constexpr (!Epi::AFTER_DRAIN) { E(acc, cur, wr, wc, fr, fq); S.done(cur); }
        if (!has_next) break;
#pragma unroll
        for (int a = 0; a < 2; ++a)
#pragma unroll
            for (int b = 0; b < 2; ++b)
#pragma unroll
                for (int m = 0; m < 4; ++m)
#pragma unroll
                    for (int n = 0; n < 2; ++n) acc[a][b][m][n] = (f32x4){0.f, 0.f, 0.f, 0.f};
        cur = nxt; cA = nA; cB = nB; ++ui;
        if constexpr (ALIGN_EPI) { if (wr == 1) PG8_BAR; }
    }
    PG8_WAIT_V(0);
    if constexpr (!ALIGN_EPI) { if (wr == 0) PG8_BAR; }
    PG8_BAR;
    if constexpr (Epi::AFTER_DRAIN) { E.fused(acc, cur, wr, wc, fr, fq, lds, wid, lane); S.done(cur); }
#undef PG8_SA
#undef PG8_SB
#undef PG8_STAGE
#undef PG8_LDA
#undef PG8_LDB
#undef PG8_MMA
#undef PG8_WAIT_V
#undef PG8_WAIT_L
#undef PG8_BAR
#undef PG8_SCHED
}
}
constexpr int NWAVES = 8;
#ifndef MK_N_LAUNCHES
#define MK_N_LAUNCHES 1
#endif
constexpr int NPHASE = 9;
constexpr int N_LAUNCHES = MK_N_LAUNCHES;
static_assert(N_LAUNCHES == 1 || N_LAUNCHES == NPHASE, "MK_N_LAUNCHES is 1 or NPHASE");

constexpr int T = 16384, SEQ = 2048, D = 1024, NIN = 6144, NSC = 2048, NEXP = 16384, NSEL = 128;
constexpr float EPS = 1e-6f;

constexpr size_t MiB = 1u << 20;
constexpr size_t WS_CTL = 0, CTL_ZERO_BYTES = 64 * 1024;
constexpr size_t WS_WIN = 1 * MiB, WS_WC = 13 * MiB, WS_WPB = 15 * MiB, WS_WOUT = 17 * MiB, WS_WS = 19 * MiB;
constexpr size_t WS_IDX = 1 * MiB, WS_GATE = 9 * MiB;
constexpr size_t WS_XN = 32 * MiB;
constexpr size_t WS_PB = 64 * MiB;
constexpr size_t WS_TMP = 64 * MiB, WS_MG = 96 * MiB;
constexpr size_t WS_SC = 64 * MiB;
constexpr size_t WS_PG = 192 * MiB;
constexpr size_t WS_U16 = 192 * MiB, WS_V16 = 224 * MiB;
constexpr size_t WS_END = 256 * MiB;
constexpr int CW_BAR = 1024;

constexpr int RING_OFF = 0, RING_BYTES = 131072;
constexpr int LDSCTL_OFF = RING_BYTES, MISC_OFF = LDSCTL_OFF + 320;
constexpr int LDS_BYTES = 147456;
#define GAS __attribute__((address_space(1)))
#define LAS __attribute__((address_space(3)))
typedef unsigned short bf16;
typedef unsigned v4u __attribute__((ext_vector_type(4)));
typedef float f32x4 __attribute__((ext_vector_type(4)));
typedef short bf16x8 __attribute__((ext_vector_type(8)));
typedef GAS unsigned gu32;
typedef GAS unsigned long long gu64;
#define RLX_AGENT __ATOMIC_RELAXED, __HIP_MEMORY_SCOPE_AGENT
#define LDS_WAIT() asm volatile("s_waitcnt lgkmcnt(0)" ::: "memory")
#define VM_WAIT() asm volatile("s_waitcnt vmcnt(0)" ::: "memory")
__device__ __forceinline__ unsigned long long rt() { return __builtin_amdgcn_s_memrealtime(); }
__device__ __forceinline__ unsigned f2bf(float f) { unsigned u = __builtin_bit_cast(unsigned, f); return (u + 0x7fffu + ((u >> 16) & 1u)) >> 16; }
__device__ __forceinline__ unsigned pk2(float lo, float hi) { return f2bf(lo) | (f2bf(hi) << 16); }

#define XB_TMO      128
#define XB_XCNT(j)  (256  + 64 * (j))
#define XB_XSUB(j)  (1280 + 64 * (j))
#define XB_XGEN(j)  (2304 + 64 * (j))
#define XB_TOP      3328
#define XB_TOPGEN   3392
#define XCD_BAR_WORDS 3456
#define XB_SPIN_CAP (1u << 18)

__device__ __forceinline__ unsigned xb_ld(unsigned* p)              { return __hip_atomic_load(p, __ATOMIC_RELAXED, __HIP_MEMORY_SCOPE_AGENT); }
__device__ __forceinline__ unsigned xb_add(unsigned* p, unsigned v) { return __hip_atomic_fetch_add(p, v, __ATOMIC_RELAXED, __HIP_MEMORY_SCOPE_AGENT); }
__device__ __forceinline__ unsigned xb_xcc_id() { return (unsigned)__builtin_amdgcn_s_getreg((3 << 11) | 20) & 0xFu; }
#define XB_SPIN(cond, bar) do { unsigned _sp = 0; while (cond) { __builtin_amdgcn_s_sleep(1); \
    if ((++_sp & 255u) == 0u) { if (xb_ld(&(bar)[XB_TMO])) break; if (_sp > XB_SPIN_CAP) { atomicAdd(&(bar)[XB_TMO], 1u); break; } } } } while (0)

struct XcdBarrier {
    unsigned* bar; unsigned x;
    volatile LAS unsigned* st;
};

__device__ __forceinline__ XcdBarrier xcd_barrier_post(unsigned* bar, volatile LAS unsigned* st) {
    XcdBarrier b; b.bar = bar; b.x = xb_xcc_id(); b.st = st;
    if (threadIdx.x == 0) (void)xb_add(&bar[XB_XCNT(b.x)], 1u);
    return b;
}
__device__ __forceinline__ void xcd_barrier_complete(unsigned* bar, unsigned x, unsigned& nloc, unsigned& nx) {
    const unsigned G = gridDim.x * gridDim.y * gridDim.z;
    unsigned sum, cnt, mine, sp = 0u;
    for (;;) {
        sum = 0u; cnt = 0u; mine = 0u;
#pragma unroll
        for (unsigned j = 0; j < 16; ++j) { const unsigned c = xb_ld(&bar[XB_XCNT(j)]); sum += c; cnt += (c > 0u) ? 1u : 0u; mine = (j == x) ? c : mine; }
        if (sum == G) break;
        __builtin_amdgcn_s_sleep(1);
        if ((++sp & 255u) == 0u) { if (xb_ld(&bar[XB_TMO])) break; if (sp > XB_SPIN_CAP) { atomicAdd(&bar[XB_TMO], 1u); break; } }
    }
    nloc = mine > 0u ? mine : 1u; nx = cnt > 0u ? cnt : 1u;
}

__device__ __forceinline__ void xcd_barrier(const XcdBarrier& b) {
    asm volatile("s_waitcnt vmcnt(0)" ::: "memory");
    __syncthreads();
    if (threadIdx.x == 0) {
        unsigned* bar = b.bar;
        __builtin_amdgcn_s_waitcnt(0);
        unsigned nloc = b.st[0], nx = b.st[1];
        if (nloc == 0u) { xcd_barrier_complete(bar, b.x, nloc, nx); b.st[0] = nloc; b.st[1] = nx; }
        const unsigned old = xb_add(&bar[XB_XSUB(b.x)], 1u);
        const unsigned gen = old / nloc;
        if (old + 1u == (gen + 1u) * nloc) {
            __builtin_amdgcn_fence(__ATOMIC_RELEASE, "agent");
            asm volatile("s_waitcnt vmcnt(0)" ::: "memory");
            const unsigned og = xb_add(&bar[XB_TOP], 1u);
            const unsigned tg = og / nx;
            if (og + 1u == (tg + 1u) * nx) xb_add(&bar[XB_TOPGEN], 1u);
            else XB_SPIN(xb_ld(&bar[XB_TOPGEN]) == tg, bar);
            __builtin_amdgcn_fence(__ATOMIC_ACQUIRE, "agent");
            xb_add(&bar[XB_XGEN(b.x)], 1u);
            asm volatile("s_waitcnt vmcnt(0)" ::: "memory");
        } else {
            XB_SPIN(xb_ld(&bar[XB_XGEN(b.x)]) == gen, bar);
            __builtin_amdgcn_fence(__ATOMIC_ACQUIRE, "agent");
            asm volatile("s_waitcnt vmcnt(0)" ::: "memory");
        }
    }
    __syncthreads();
}

struct Frame {
    LAS unsigned char* lds;
    volatile LAS unsigned* MISC;
    int tid, lane, wave;
    int vcu, G;
};
__device__ __forceinline__ float wave_sum(float v) {
#pragma unroll
    for (int o = 1; o < 64; o <<= 1) v += __shfl_xor(v, o);
    return v;
}
__device__ __forceinline__ float bflo(unsigned w) { return __uint_as_float(w << 16); }
__device__ __forceinline__ float bfhi(unsigned w) { return __uint_as_float(w & 0xffff0000u); }
__device__ __forceinline__ void unpack8(const v4u w, float (&f)[8]) { f[0] = bflo(w.x); f[1] = bfhi(w.x); f[2] = bflo(w.y); f[3] = bfhi(w.y); f[4] = bflo(w.z); f[5] = bfhi(w.z); f[6] = bflo(w.w); f[7] = bfhi(w.w); }
__device__ __forceinline__ v4u pack8(const float (&f)[8]) { v4u o; o.x = pk2(f[0], f[1]); o.y = pk2(f[2], f[3]); o.z = pk2(f[4], f[5]); o.w = pk2(f[6], f[7]); return o; }

__device__ __forceinline__ void p0_transpose_item(const float* W, int K, int N, bf16* WT, LAS float* scr, int item, int lane) {
    const int nblk = N / 32, kb = item / nblk, nb = item % nblk, k0 = 64 * kb, n0 = 32 * nb;
#pragma unroll 8
    for (int i = 0; i < 32; ++i) { const int kk = 2 * i + (lane >> 5); scr[kk * 33 + (lane & 31)] = W[(size_t)(k0 + kk) * N + n0 + (lane & 31)]; }
    LDS_WAIT(); asm volatile("" ::: "memory");
    const int c = lane & 7;
#pragma unroll
    for (int j = 0; j < 4; ++j) { const int n = (lane >> 3) + 8 * j; const LAS float* s = scr + (8 * c) * 33 + n;
        v4u o; o.x = pk2(s[0 * 33], s[1 * 33]); o.y = pk2(s[2 * 33], s[3 * 33]); o.z = pk2(s[4 * 33], s[5 * 33]); o.w = pk2(s[6 * 33], s[7 * 33]);
        *(GAS v4u*)(WT + (size_t)(n0 + n) * K + k0 + 8 * c) = o; }
    LDS_WAIT(); asm volatile("" ::: "memory");
}
__device__ __forceinline__ void fold_tile(LAS float* sm, const float* Ap, int sAi, int sAk, const float* As, const float* Bp, int sBj, int K, bf16* Cp, int ldc, int tid) {
    LAS float* sA = sm; LAS float* sB = sm + 32 * 65;
    float acc[8];
#pragma unroll
    for (int q = 0; q < 8; ++q) acc[q] = 0.f;
    const int tj = tid & 63, ti0 = tid >> 6;
    for (int k0 = 0; k0 < K; k0 += 32) {
#pragma unroll
        for (int r = 0; r < 4; ++r) { const int e = tid + 512 * r; int i, k;
            if (sAk == 1) { k = e & 31; i = e >> 5; } else { i = e & 63; k = e >> 6; }
            float a = Ap[(size_t)i * sAi + (size_t)(k0 + k) * sAk]; if (As) a *= As[k0 + k];
            sA[k * 65 + i] = a;
            const int kb = e & 31, jb = e >> 5;
            sB[kb * 65 + jb] = Bp[(size_t)jb * sBj + k0 + kb]; }
        __syncthreads();
#pragma unroll 4
        for (int k = 0; k < 32; ++k) { const float b = sB[k * 65 + tj];
#pragma unroll
            for (int q = 0; q < 8; ++q) acc[q] += sA[k * 65 + ti0 + 8 * q] * b; }
        __syncthreads();
    }
#pragma unroll
    for (int q = 0; q < 8; ++q) Cp[(size_t)(ti0 + 8 * q) * ldc + tj] = (bf16)f2bf(acc[q]);
}
__device__ __forceinline__ void rms_row_to_bf16(int lane, const float* xrow, const float* g, bf16* orow) {
    const GAS f32x4* xr = (const GAS f32x4*)xrow + lane; const GAS f32x4* gr = (const GAS f32x4*)g + lane;
    f32x4 v[4]; float s = 0.f;
#pragma unroll
    for (int j = 0; j < 4; ++j) { v[j] = xr[64 * j]; s += (v[j].x * v[j].x + v[j].y * v[j].y) + (v[j].z * v[j].z + v[j].w * v[j].w); }
    const float rstd = 1.f / sqrtf(wave_sum(s) * (1.f / D) + EPS);
    GAS unsigned long long* o8 = (GAS unsigned long long*)orow + lane;
#pragma unroll
    for (int j = 0; j < 4; ++j) { const f32x4 gg = gr[64 * j];
        o8[64 * j] = (unsigned long long)pk2(v[j].x * rstd * gg.x, v[j].y * rstd * gg.y) | ((unsigned long long)pk2(v[j].z * rstd * gg.z, v[j].w * rstd * gg.w) << 32); }
}
__device__ __forceinline__ void p2_conv_pool(Frame& F, const bf16* PB, const float* conv_w, bf16* AIN, bf16* POOLED) {
    const int gt = F.vcu * (NWAVES * 64) + F.tid, NT = F.G * (NWAVES * 64);
    for (int it = gt; it < (T / 16) * (D / 8); it += NT) {
        const int cv = it & 127, rc = it >> 7, col = cv * 8, t0 = rc * 16, s0 = t0 & (SEQ - 1);
        float w0[8], w1[8], w2[8];
        { const f32x4 a = *(const GAS f32x4*)(conv_w + col), b = *(const GAS f32x4*)(conv_w + col + 4); w0[0] = a.x; w0[1] = a.y; w0[2] = a.z; w0[3] = a.w; w0[4] = b.x; w0[5] = b.y; w0[6] = b.z; w0[7] = b.w; }
        { const f32x4 a = *(const GAS f32x4*)(conv_w + D + col), b = *(const GAS f32x4*)(conv_w + D + col + 4); w1[0] = a.x; w1[1] = a.y; w1[2] = a.z; w1[3] = a.w; w1[4] = b.x; w1[5] = b.y; w1[6] = b.z; w1[7] = b.w; }
        { const f32x4 a = *(const GAS f32x4*)(conv_w + 2 * D + col), b = *(const GAS f32x4*)(conv_w + 2 * D + col + 4); w2[0] = a.x; w2[1] = a.y; w2[2] = a.z; w2[3] = a.w; w2[4] = b.x; w2[5] = b.y; w2[6] = b.z; w2[7] = b.w; }
        float um2[8], um1[8];
#pragma unroll
        for (int i = 0; i < 8; ++i) { um2[i] = 0.f; um1[i] = 0.f; }
        if (s0 != 0) {
            float c[8], h[8];
            unpack8(*(const GAS v4u*)(PB + (size_t)(t0 - 2) * 4096 + 1024 + col), c); unpack8(*(const GAS v4u*)(PB + (size_t)(t0 - 2) * 4096 + 2048 + col), h);
#pragma unroll
            for (int i = 0; i < 8; ++i) um2[i] = c[i] * h[i];
            unpack8(*(const GAS v4u*)(PB + (size_t)(t0 - 1) * 4096 + 1024 + col), c); unpack8(*(const GAS v4u*)(PB + (size_t)(t0 - 1) * 4096 + 2048 + col), h);
#pragma unroll
            for (int i = 0; i < 8; ++i) um1[i] = c[i] * h[i];
        }
        for (int r = 0; r < 16; ++r) {
            const size_t rowb = (size_t)(t0 + r) * 4096;
            float b[8], c[8], h[8], o[8];
            unpack8(*(const GAS v4u*)(PB + rowb + col), b); unpack8(*(const GAS v4u*)(PB + rowb + 1024 + col), c); unpack8(*(const GAS v4u*)(PB + rowb + 2048 + col), h);
#pragma unroll
            for (int i = 0; i < 8; ++i) { const float u = c[i] * h[i]; o[i] = b[i] * (w0[i] * um2[i] + w1[i] * um1[i] + w2[i] * u); um2[i] = um1[i]; um1[i] = u; }
            *(GAS v4u*)(AIN + (size_t)(t0 + r) * D + col) = pack8(o);
        }
        const int win = 2 << (col >> 8);
        for (int r = 0; r < 16; ++r) {
            const int t = t0 + r, s = s0 + r;
            float p0[8], sum[8], o[8];
            unpack8(*(const GAS v4u*)(PB + (size_t)t * 4096 + 3072 + col), p0);
#pragma unroll
            for (int i = 0; i < 8; ++i) sum[i] = p0[i];
            const int nb = (s < win - 1) ? s : (win - 1);
            for (int j = 1; j <= nb; ++j) { float pj[8]; unpack8(*(const GAS v4u*)(PB + (size_t)(t - j) * 4096 + 3072 + col), pj);
#pragma unroll
                for (int i = 0; i < 8; ++i) sum[i] += pj[i]; }
            const float inv = 1.0f / (float)(nb + 1);
#pragma unroll
            for (int i = 0; i < 8; ++i) o[i] = sum[i] * inv - p0[i];
            *(GAS v4u*)(POOLED + (size_t)t * D + col) = pack8(o);
        }
    }
}

__device__ __forceinline__ unsigned fkey(float f) { const unsigned u = __float_as_uint(f); return (u & 0x80000000u) ? ~u : (u | 0x80000000u); }
__device__ __forceinline__ int popc64(unsigned long long m) { return __popcll(m); }
__device__ __forceinline__ void p7_topk(Frame& F, const float* SC, int* IDX, float* GATE) {
    LAS float* scr = (LAS float*)(F.lds + RING_OFF + F.wave * 512);
    LAS int* scri = (LAS int*)scr;
    const int gw = F.vcu * NWAVES + F.wave, NGW = F.G * NWAVES, lane = F.lane;
    const unsigned long long lower = (lane == 0) ? 0ull : (~0ull >> (64 - lane));
    for (int it = gw; it < T * 8; it += NGW) {
        const int t = it >> 3, h = it & 7;
        const float* srow = SC + (size_t)t * NSC + h * 256;
#pragma unroll
        for (int p = 0; p < 2; ++p) {
            const float f0 = srow[p * 128 + lane], f1 = srow[p * 128 + 64 + lane];
            const unsigned k0 = fkey(f0), k1 = fkey(f1);
            unsigned thr = 0u;
            for (int bit = 31; bit >= 0; --bit) { const unsigned cand = thr | (1u << bit);
                const int cnt = popc64(__ballot(k0 >= cand)) + popc64(__ballot(k1 >= cand));
                if (cnt >= 16) thr = cand; }
            const unsigned long long mg0 = __ballot(k0 > thr), mg1 = __ballot(k1 > thr), me0 = __ballot(k0 == thr), me1 = __ballot(k1 == thr);
            const int ng0 = popc64(mg0), ngt = ng0 + popc64(mg1), ne0 = popc64(me0);
            int pos0 = -1, pos1 = -1;
            if (k0 > thr) pos0 = popc64(mg0 & lower); else if (k0 == thr) pos0 = ngt + popc64(me0 & lower);
            if (k1 > thr) pos1 = ng0 + popc64(mg1 & lower); else if (k1 == thr) pos1 = ngt + ne0 + popc64(me1 & lower);
            if (pos0 >= 0 && pos0 < 16) { scr[p * 16 + pos0] = f0; scri[32 + p * 16 + pos0] = lane; }
            if (pos1 >= 0 && pos1 < 16) { scr[p * 16 + pos1] = f1; scri[32 + p * 16 + pos1] = lane + 64; }
        }
        LDS_WAIT(); asm volatile("" ::: "memory");
        const int ci = lane >> 2, cj = (lane & 3) * 4;
        const float v1 = scr[ci];
        float sq[4]; unsigned kq[4];
#pragma unroll
        for (int q = 0; q < 4; ++q) { sq[q] = v1 + scr[16 + cj + q]; kq[q] = fkey(sq[q]); }
        unsigned thr = 0u;
        for (int bit = 31; bit >= 0; --bit) { const unsigned cand = thr | (1u << bit);
            const int cnt = popc64(__ballot(kq[0] >= cand)) + popc64(__ballot(kq[1] >= cand)) + popc64(__ballot(kq[2] >= cand)) + popc64(__ballot(kq[3] >= cand));
            if (cnt >= 16) thr = cand; }
        int ngt = 0;
#pragma unroll
        for (int q = 0; q < 4; ++q) ngt += popc64(__ballot(kq[q] > thr));
        int gbase = 0, ebase = ngt;
        const int e1 = scri[32 + ci];
#pragma unroll
        for (int q = 0; q < 4; ++q) {
            const unsigned long long mg = __ballot(kq[q] > thr), me = __ballot(kq[q] == thr);
            int pos = -1;
            if (kq[q] > thr) pos = gbase + popc64(mg & lower); else if (kq[q] == thr) pos = ebase + popc64(me & lower);
            gbase += popc64(mg); ebase += popc64(me);
            if (pos >= 0 && pos < 16) { scri[64 + pos] = e1 * 128 + scri[48 + cj + q]; scr[80 + pos] = sq[q]; }
        }
        LDS_WAIT(); asm volatile("" ::: "memory");
        if (lane < 16) {
            const float b = scr[80 + lane]; const int e = scri[64 + lane];
            float m = b;
            m = fmaxf(m, __shfl_xor(m, 8)); m = fmaxf(m, __shfl_xor(m, 4)); m = fmaxf(m, __shfl_xor(m, 2)); m = fmaxf(m, __shfl_xor(m, 1));
            const float ex = __expf(b - m);
            float sm = ex; sm += __shfl_xor(sm, 8); sm += __shfl_xor(sm, 4); sm += __shfl_xor(sm, 2); sm += __shfl_xor(sm, 1);
            IDX[(size_t)t * NSEL + h * 16 + lane] = e; GATE[(size_t)t * NSEL + h * 16 + lane] = ex / sm;
        }
        LDS_WAIT(); asm volatile("" ::: "memory");
    }
}
typedef int v4i __attribute__((ext_vector_type(4)));
typedef __bf16 bf16x2_t __attribute__((ext_vector_type(2)));
__device__ __forceinline__ float dpp_f(float v, const int ctrl_sel) {
    const int x = __builtin_bit_cast(int, v);
    int r;
    if (ctrl_sel == 0) r = __builtin_amdgcn_update_dpp(0, x, 0xB1, 0xF, 0xF, true);
    else if (ctrl_sel == 1) r = __builtin_amdgcn_update_dpp(0, x, 0x4E, 0xF, 0xF, true);
    else if (ctrl_sel == 2) r = __builtin_amdgcn_update_dpp(0, x, 0x141, 0xF, 0xF, true);
    else r = __builtin_amdgcn_update_dpp(0, x, 0x128, 0xF, 0xF, true);
    return __builtin_bit_cast(float, r);
}
__device__ __forceinline__ float sum8(float v) { v += dpp_f(v, 0); v += dpp_f(v, 1); v += dpp_f(v, 2); return v; }
__device__ __forceinline__ float dot2bf(unsigned a, unsigned b, float acc) { return __builtin_amdgcn_fdot2_f32_bf16(__builtin_bit_cast(bf16x2_t, a), __builtin_bit_cast(bf16x2_t, b), acc, false); }
__device__ __forceinline__ float dot8(const v4u d, const v4u x, float acc) {
    acc = dot2bf(d.x, x.x, acc); acc = dot2bf(d.y, x.y, acc); acc = dot2bf(d.z, x.z, acc); acc = dot2bf(d.w, x.w, acc);
    return acc;
}
__device__ __forceinline__ float gelu_erf(float z) { return 0.5f * z * (1.0f + erff(z * 0.70710678118654752f)); }
__device__ __forceinline__ void p8_issue(v4u (&d)[8], const LAS int* li8, __amdgpu_buffer_rsrc_t rs, int soff, int c16) {
    const v4i e0 = *(const LAS v4i*)li8, e1 = *(const LAS v4i*)(li8 + 4);
    d[0] = __builtin_amdgcn_raw_buffer_load_b128(rs, e0.x * (D * 2) + c16, soff, 0); d[1] = __builtin_amdgcn_raw_buffer_load_b128(rs, e0.y * (D * 2) + c16, soff, 0);
    d[2] = __builtin_amdgcn_raw_buffer_load_b128(rs, e0.z * (D * 2) + c16, soff, 0); d[3] = __builtin_amdgcn_raw_buffer_load_b128(rs, e0.w * (D * 2) + c16, soff, 0);
    d[4] = __builtin_amdgcn_raw_buffer_load_b128(rs, e1.x * (D * 2) + c16, soff, 0); d[5] = __builtin_amdgcn_raw_buffer_load_b128(rs, e1.y * (D * 2) + c16, soff, 0);
    d[6] = __builtin_amdgcn_raw_buffer_load_b128(rs, e1.z * (D * 2) + c16, soff, 0); d[7] = __builtin_amdgcn_raw_buffer_load_b128(rs, e1.w * (D * 2) + c16, soff, 0);
}
__device__ __forceinline__ void p8_compute_u(const v4u (&d)[8], const v4u xs, LAS float* lz8, int c) {
    float p[8];
#pragma unroll
    for (int g = 0; g < 8; ++g) p[g] = sum8(dot8(d[g], xs, 0.f));
    if (c == 0) {
#pragma unroll
        for (int q = 0; q < 2; ++q) { f32x4 z = *(LAS f32x4*)(lz8 + 4 * q); z.x += p[4 * q]; z.y += p[4 * q + 1]; z.z += p[4 * q + 2]; z.w += p[4 * q + 3]; *(LAS f32x4*)(lz8 + 4 * q) = z; }
    }
}
__device__ __forceinline__ void p8_compute_v(const v4u (&d)[8], const LAS float* la8, float (&y)[8]) {
    const f32x4 a0 = *(const LAS f32x4*)la8, a1 = *(const LAS f32x4*)(la8 + 4);
    const float a[8] = {a0.x, a0.y, a0.z, a0.w, a1.x, a1.y, a1.z, a1.w};
#pragma unroll
    for (int g = 0; g < 8; ++g) {
        y[0] += a[g] * bflo(d[g].x); y[1] += a[g] * bfhi(d[g].x); y[2] += a[g] * bflo(d[g].y); y[3] += a[g] * bfhi(d[g].y);
        y[4] += a[g] * bflo(d[g].z); y[5] += a[g] * bfhi(d[g].z); y[6] += a[g] * bflo(d[g].w); y[7] += a[g] * bfhi(d[g].w); }
}
__device__ __forceinline__ void p8_peer(Frame& F, const bf16* XN2, const bf16* U16, const bf16* V16, const int* IDX, const float* GATE, float* HOUT, const float* gfin) {
    LAS int* lidx = (LAS int*)(F.lds + RING_OFF + F.wave * 8704);
    LAS float* lza = (LAS float*)(F.lds + RING_OFF + F.wave * 8704 + 4096);
    LAS float* lss = (LAS float*)(F.lds + RING_OFF + F.wave * 8704 + 8192);
    const int gw = F.vcu * NWAVES + F.wave, NGW = F.G * NWAVES, lane = F.lane, j = lane >> 3, c = lane & 7, c16 = c * 16;
    const __amdgpu_buffer_rsrc_t rsU = __builtin_amdgcn_make_buffer_rsrc((void*)U16, (short)0, NEXP * D * 2, 0x00020000);
    const __amdgpu_buffer_rsrc_t rsV = __builtin_amdgcn_make_buffer_rsrc((void*)V16, (short)0, NEXP * D * 2, 0x00020000);
    for (int grp = gw; grp < T / 8; grp += NGW) {
        const int tb = grp * 8;
#pragma unroll
        for (int i = 0; i < 8; ++i) { lidx[i * 128 + lane] = IDX[(size_t)(tb + i) * NSEL + lane]; lidx[i * 128 + 64 + lane] = IDX[(size_t)(tb + i) * NSEL + 64 + lane]; lza[i * 128 + lane] = 0.f; lza[i * 128 + 64 + lane] = 0.f; }
        if (lane < 8) lss[lane] = 0.f;
        LDS_WAIT(); asm volatile("" ::: "memory");
        {
            v4u dA[8], dB[8], xc, xn;
            p8_issue(dA, lidx + j * 16, rsU, 0, c16); xc = *(const GAS v4u*)(XN2 + (size_t)tb * D + c * 8);
            for (int n = 0; n < 128; ++n) {
                const int s = n >> 3, i = n & 7, n1 = (n + 1) & 127, s1 = n1 >> 3, i1 = n1 & 7;
                xn = *(const GAS v4u*)(XN2 + (size_t)(tb + i1) * D + s1 * 64 + c * 8);
                p8_issue(dB, lidx + i * 128 + j * 16 + 8, rsU, s * 128, c16);
                p8_compute_u(dA, xc, lza + i * 128 + j * 16, c);
                p8_issue(dA, lidx + i1 * 128 + j * 16, rsU, s1 * 128, c16);
                p8_compute_u(dB, xc, lza + i * 128 + j * 16 + 8, c);
                xc = xn;
            }
        }
        LDS_WAIT(); asm volatile("" ::: "memory");
#pragma unroll
        for (int i = 0; i < 8; ++i) {
            const float z0 = lza[i * 128 + lane], z1 = lza[i * 128 + 64 + lane];
            const float g0 = GATE[(size_t)(tb + i) * NSEL + lane], g1 = GATE[(size_t)(tb + i) * NSEL + 64 + lane];
            lza[i * 128 + lane] = gelu_erf(z0) * g0; lza[i * 128 + 64 + lane] = gelu_erf(z1) * g1;
        }
        LDS_WAIT(); asm volatile("" ::: "memory");
        {
            v4u dA[8], dB[8];
            p8_issue(dA, lidx + j * 16, rsV, 0, c16);
            for (int n = 0; n < 128; ++n) {
                const int s = n >> 3, i = n & 7, n1 = (n + 1) & 127, s1 = n1 >> 3, i1 = n1 & 7;
                p8_issue(dB, lidx + i * 128 + j * 16 + 8, rsV, s * 128, c16);
                float* hp = HOUT + (size_t)(tb + i) * D + s * 64 + c * 8;
                f32x4 h0 = {0.f, 0.f, 0.f, 0.f}, h1 = {0.f, 0.f, 0.f, 0.f};
                if (lane < 8) { h0 = *(const GAS f32x4*)hp; h1 = *(const GAS f32x4*)(hp + 4); }
                float y[8];
#pragma unroll
                for (int q = 0; q < 8; ++q) y[q] = 0.f;
                p8_compute_v(dA, lza + i * 128 + j * 16, y);
                p8_issue(dA, lidx + i1 * 128 + j * 16, rsV, s1 * 128, c16);
                p8_compute_v(dB, lza + i * 128 + j * 16 + 8, y);
#pragma unroll
                for (int q = 0; q < 8; ++q) { float v = y[q]; v += dpp_f(v, 3); v += __shfl_xor(v, 16); v += __shfl_xor(v, 32); y[q] = v; }
                if (lane < 8) {
                    const f32x4 o0 = {y[0] + h0.x, y[1] + h0.y, y[2] + h0.z, y[3] + h0.w}, o1 = {y[4] + h1.x, y[5] + h1.y, y[6] + h1.z, y[7] + h1.w};
                    *(GAS f32x4*)hp = o0; *(GAS f32x4*)(hp + 4) = o1;
                    const float q2 = (o0.x * o0.x + o0.y * o0.y) + (o0.z * o0.z + o0.w * o0.w) + (o1.x * o1.x + o1.y * o1.y) + (o1.z * o1.z + o1.w * o1.w);
                    const float tot = sum8(q2);
                    if (lane == 0) lss[i] += tot;
                }
            }
        }
        VM_WAIT(); __builtin_amdgcn_fence(__ATOMIC_ACQUIRE, "agent"); VM_WAIT(); LDS_WAIT(); asm volatile("" ::: "memory");
#pragma unroll
        for (int i = 0; i < 8; ++i) {
            const float rstd = 1.f / sqrtf(lss[i] * (1.f / D) + EPS);
            float* hr = HOUT + (size_t)(tb + i) * D;
#pragma unroll
            for (int q = 0; q < 4; ++q) { const f32x4 yv = *(const GAS f32x4*)(hr + 256 * q + 4 * lane), gg = *(const GAS f32x4*)(gfin + 256 * q + 4 * lane);
                *(GAS f32x4*)(hr + 256 * q + 4 * lane) = (f32x4){yv.x * rstd * gg.x, yv.y * rstd * gg.y, yv.z * rstd * gg.z, yv.w * rstd * gg.w}; }
        }
        LDS_WAIT(); asm volatile("" ::: "memory");
    }
}
__device__ __forceinline__ void cvt_stream(Frame& F, const float* src, bf16* dst, size_t n) {
    const size_t gt = (size_t)F.vcu * (NWAVES * 64) + F.tid, NT = (size_t)F.G * (NWAVES * 64);
    for (size_t i = gt; i < n / 8; i += NT) { const f32x4 a = *(const GAS f32x4*)(src + 8 * i), b = *(const GAS f32x4*)(src + 8 * i + 4);
        v4u o; o.x = pk2(a.x, a.y); o.y = pk2(a.z, a.w); o.z = pk2(b.x, b.y); o.w = pk2(b.z, b.w); *(GAS v4u*)(dst + 8 * i) = o; }
}

struct Args { const float* in[15]; float* out; unsigned char* ws; int ph_lo, ph_hi; };
__global__ void __launch_bounds__(NWAVES * 64, 2) hyb_fwd(Args args) {
    extern __shared__ __attribute__((aligned(16))) unsigned char lds[];
    Frame F;
    F.lds = (LAS unsigned char*)lds;
    F.MISC = (volatile LAS unsigned*)(F.lds + MISC_OFF);
    F.tid = threadIdx.x; F.lane = F.tid & 63; F.wave = __builtin_amdgcn_readfirstlane(F.tid >> 6);
    F.G = gridDim.x; { const int bx = blockIdx.x; F.vcu = (F.G % 8 == 0) ? (bx % 8) * (F.G / 8) + bx / 8 : bx; }
    unsigned char* ws = args.ws;
    gu32* ctl = (gu32*)(ws + WS_CTL);
    const float* x = args.in[0]; const float* g_mix = args.in[1]; const float* w_in = args.in[2]; const float* conv_w = args.in[3]; const float* w_conv_out = args.in[4];
    const float* pool_w = args.in[5]; const float* pool_scale = args.in[6]; const float* w_pool_out = args.in[7]; const float* w_out = args.in[8]; const float* g_ffn = args.in[9];
    const float* w_query = args.in[10]; const float* sub_keys = args.in[11]; const float* expert_u = args.in[12]; const float* expert_v = args.in[13]; const float* g_fin = args.in[14];
    bf16* WIN = (bf16*)(ws + WS_WIN); bf16* WC = (bf16*)(ws + WS_WC); bf16* WPB = (bf16*)(ws + WS_WPB); bf16* WOUT = (bf16*)(ws + WS_WOUT); bf16* WSC = (bf16*)(ws + WS_WS);
    bf16* XN = (bf16*)(ws + WS_XN); bf16* PB = (bf16*)(ws + WS_PB); bf16* PG = (bf16*)(ws + WS_PG); bf16* TMP = (bf16*)(ws + WS_TMP); bf16* MG = (bf16*)(ws + WS_MG);
    float* SC = (float*)(ws + WS_SC); int* IDX = (int*)(ws + WS_IDX); float* GATE = (float*)(ws + WS_GATE); bf16* U16 = (bf16*)(ws + WS_U16); bf16* V16 = (bf16*)(ws + WS_V16);
    bf16* AIN = (bf16*)args.out; bf16* POOLED = (bf16*)args.out + (size_t)T * D; float* H = args.out;

    for (int u = F.tid; u < (LDS_BYTES - LDSCTL_OFF) / 4; u += NWAVES * 64) ((LAS unsigned*)(F.lds + LDSCTL_OFF))[u] = 0u;
    __syncthreads();
    XcdBarrier bar; bar.bar = (unsigned*)(ctl + CW_BAR); bar.x = 0; bar.st = nullptr;
    if (N_LAUNCHES == 1) bar = xcd_barrier_post((unsigned*)(ctl + CW_BAR), F.MISC + 8);
#define GRID_BAR() do { if (N_LAUNCHES == 1) xcd_barrier(bar); } while (0)
    const int lo = args.ph_lo, hi = args.ph_hi;
#define IN(k) (lo <= (k) && (k) < hi)
#define BOTH(k) (IN(k) && IN((k) + 1))
    const int gw = F.vcu * NWAVES + F.wave, NGW = F.G * NWAVES;

    if (IN(0)) {
        LAS float* sm = (LAS float*)(F.lds + RING_OFF);
        for (int it = blockIdx.x; it < 768; it += F.G) {
            if (it < 256) { const int g = it >> 6, i0 = ((it >> 2) & 15) * 64, j0 = (it & 3) * 64;
                fold_tile(sm, w_pool_out + (size_t)g * 256 * D + i0, 1, D, pool_scale + g * 256, pool_w + (size_t)g * 65536 + (size_t)j0 * 256, 256, 256, WPB + (size_t)i0 * D + g * 256 + j0, D, F.tid);
            } else { const int r = it - 256, hp = r >> 5, i0 = ((r >> 4) & 1) * 64, j0 = (r & 15) * 64;
                fold_tile(sm, sub_keys + (size_t)hp * 16384 + (size_t)i0 * 128, 128, 1, nullptr, w_query + (size_t)j0 * NSC + hp * 128, NSC, 128, WSC + (size_t)(hp * 128 + i0) * D + j0, D, F.tid); }
        }
        __syncthreads();
        LAS float* scr = (LAS float*)(F.lds + RING_OFF + F.wave * 16384);
        constexpr int I_IN = (D / 64) * (NIN / 32), I_SQ = (D / 64) * (D / 32);
        for (int it = gw; it < I_IN + 2 * I_SQ; it += NGW) {
            int r = it;
            if (r < I_IN) { p0_transpose_item(w_in, D, NIN, WIN, scr, r, F.lane); continue; } r -= I_IN;
            if (r < I_SQ) { p0_transpose_item(w_conv_out, D, D, WC, scr, r, F.lane); continue; } r -= I_SQ;
            p0_transpose_item(w_out, D, D, WOUT, scr, r, F.lane);
        }
        for (int m = gw; m < T; m += NGW) rms_row_to_bf16(F.lane, x + (size_t)m * D, g_mix, XN + (size_t)m * D);
        if (BOTH(0)) GRID_BAR();
    }
    if (IN(1)) {
        pg8::Gemm g{XN, WIN, 0l, 0l, T, NIN, D}; pg8::StaticOrder S; S.init(T, NIN, F.G, (int)blockIdx.x);
        pg8::EpiProj E{PB, PG};
        pg8::gemm_phase<pg8::EpiProj, pg8::StaticOrder, true, true>(F.lds + RING_OFF, g, S, E);
        if (BOTH(1)) GRID_BAR();
    }
    if (IN(2)) {
        p2_conv_pool(F, PB, conv_w, AIN, POOLED);
        if (BOTH(2)) GRID_BAR();
    }
    if (IN(3)) {
        pg8::Gemm g{AIN, WC, (long)T * D * 2, (long)(WS_WPB - WS_WC), T, D, D}; pg8::MergeOrder S; S.base.init(T, D, F.G, (int)blockIdx.x);
        pg8::EpiMerge E{PG, TMP, (long)((WS_MG - WS_TMP) / 2)};
        pg8::gemm_phase<pg8::EpiMerge, pg8::MergeOrder, true, true>(F.lds + RING_OFF, g, S, E);
        if (BOTH(3)) GRID_BAR();
    }
    if (IN(4)) {
        pg8::Gemm g{MG, WOUT, 0l, 0l, T, D, D}; pg8::StaticOrder S; S.init(T, D, F.G, (int)blockIdx.x);
        pg8::EpiRes E{x, H};
        pg8::gemm_phase<pg8::EpiRes, pg8::StaticOrder, true, true>(F.lds + RING_OFF, g, S, E);
        cvt_stream(F, expert_u, U16, (size_t)NEXP * D);
        cvt_stream(F, expert_v, V16, (size_t)NEXP * D);
        if (BOTH(4)) GRID_BAR();
    }
    if (IN(5)) {
        for (int m = gw; m < T; m += NGW) rms_row_to_bf16(F.lane, H + (size_t)m * D, g_ffn, XN + (size_t)m * D);
        if (BOTH(5)) GRID_BAR();
    }
    if (IN(6)) {
        pg8::Gemm g{XN, WSC, 0l, 0l, T, NSC, D}; pg8::StaticOrder S; S.init(T, NSC, F.G, (int)blockIdx.x);
        pg8::EpiF32 E{SC, NSC};
        pg8::gemm_phase<pg8::EpiF32, pg8::StaticOrder, true, true>(F.lds + RING_OFF, g, S, E);
        if (BOTH(6)) GRID_BAR();
    }
    if (IN(7)) {
        p7_topk(F, SC, IDX, GATE);
        if (BOTH(7)) GRID_BAR();
    }
    if (IN(8)) {
        p8_peer(F, XN, U16, V16, IDX, GATE, H, g_fin);
    }
#undef IN
#undef BOTH
}

extern "C" void kernel_launch(void* const* d_in, const int* in_sizes, int n_in, void* d_out, int out_size, void* d_ws, size_t ws_size, hipStream_t stream) {
    static int grid = 0;
    if (grid == 0) {
        if (n_in != 15 || in_sizes[0] != T * D || out_size != T * D || ws_size < WS_END) { fprintf(stderr, "kernel_launch: shape/workspace mismatch (n_in %d, in0 %d, out %d, ws %zu)\n", n_in, n_in > 0 ? in_sizes[0] : -1, out_size, ws_size); grid = -1; return; }
        int dev = 0, cus = 0, per_cu = 0;
        if (hipGetDevice(&dev) != hipSuccess || hipDeviceGetAttribute(&cus, hipDeviceAttributeMultiprocessorCount, dev) != hipSuccess) { grid = -1; return; }
        if (hipFuncSetAttribute((const void*)hyb_fwd, hipFuncAttributeMaxDynamicSharedMemorySize, LDS_BYTES) != hipSuccess) { fprintf(stderr, "kernel_launch: hipFuncSetAttribute failed\n"); grid = -1; return; }
        if (hipOccupancyMaxActiveBlocksPerMultiprocessor(&per_cu, (const void*)hyb_fwd, NWAVES * 64, LDS_BYTES) != hipSuccess || per_cu < 1)
            fprintf(stderr, "kernel_launch: note: occupancy query reports %d workgroups per CU\n", per_cu);
        (void)hipGetLastError();
        grid = cus;
    }
    if (grid < 0) return;
    if (hipMemsetAsync((char*)d_ws + WS_CTL, 0, CTL_ZERO_BYTES, stream) != hipSuccess) { fprintf(stderr, "kernel_launch: hipMemsetAsync failed\n"); return; }
    Args a{};
    for (int i = 0; i < 15; ++i) a.in[i] = (const float*)d_in[i];
    a.out = (float*)d_out; a.ws = (unsigned char*)d_ws;
    for (int li = 0; li < N_LAUNCHES; ++li) {
        a.ph_lo = (N_LAUNCHES == 1) ? 0 : li; a.ph_hi = (N_LAUNCHES == 1) ? NPHASE : li + 1;
        hipLaunchKernelGGL(hyb_fwd, dim3(grid), dim3(NWAVES * 64), LDS_BYTES, stream, a);
        const hipError_t le = hipPeekAtLastError();
        if (le != hipSuccess) { fprintf(stderr, "kernel_launch: launch %d failed: %s\n", li, hipGetErrorName(le)); break; }
    }
}
```

```cpp
#include <hip/hip_runtime.h>
#include <cstdio>
#include <cstdint>
namespace pg8 {
#define PG8_LAS __attribute__((address_space(3)))
typedef unsigned short bf16_t;
typedef short bf16x8 __attribute__((ext_vector_type(8)));
typedef float f32x4 __attribute__((ext_vector_type(4)));
typedef unsigned u32x4 __attribute__((ext_vector_type(4)));
constexpr int BM = 256, BK = 64, HALF = 128, HTB = HALF * BK * 2  , STAGE_BYTES = 8 * HTB, NXCD = 8, WGM = 8;

__host__ __device__ __forceinline__ int lds_byte(int r, int c) { const int st = (r >> 4) * 2 + (c >> 5), rr = r & 15, cc = c & 31, ob = rr * 64 + cc * 2; return st * 1024 + (ob ^ (((ob >> 9) & 1) << 5)); }
__host__ __device__ __forceinline__ void stage_rc(int b, int& R, int& C) { const int st = b / 1024, sb = b % 1024, swz = sb ^ (((sb >> 9) & 1) << 5); R = (st >> 1) * 16 + swz / 64; C = (st & 1) * 32 + (swz % 64) / 2; }
__host__ __device__ __forceinline__ int perm32(int rho) { const int n = rho >> 4, i = rho & 15; return 8 * (i >> 2) + 4 * n + (i & 3); }

struct Unit { int pm, pn, sel; };
struct Gemm { const bf16_t* A; const bf16_t* Bt; long offA1, offB1; int M, N, K; };

struct StaticOrder {
    int nM, nN, nwg, G, c;
    __host__ __device__ void init(int M, int N, int G_, int c_) { nM = M / BM; nN = N / BM; nwg = nM * nN; G = G_; c = c_; }
    __host__ __device__ __forceinline__ bool next(int i, Unit& u) const {
        const long L = (long)i * G + c; if (L >= nwg) return false;
        int wgid = (int)L; { const int q = nwg / NXCD, r = nwg % NXCD, xcd = wgid % NXCD, off = wgid / NXCD; wgid = (xcd < r ? xcd * (q + 1) : r * (q + 1) + (xcd - r) * q) + off; }
        const int nig = WGM * nN, gid = wgid / nig, fm = gid * WGM, gsz = (nM - fm) < WGM ? (nM - fm) : WGM;
        u.pm = fm + ((wgid % nig) % gsz); u.pn = (wgid % nig) / gsz; u.sel = 0; return true;
    }
    __device__ __forceinline__ void a_ready(const Unit&) const {}
    __device__ __forceinline__ void done(const Unit&) const {}
};


__device__ __forceinline__ unsigned cvt_pk_bf16(float lo, float hi) { unsigned r; asm volatile("v_cvt_pk_bf16_f32 %0, %1, %2" : "=v"(r) : "v"(lo), "v"(hi)); return r; }
__device__ __forceinline__ float sigm(float x) { return __builtin_amdgcn_rcpf(1.0f + __expf(-x)); }
__device__ __forceinline__ float bflo(unsigned w) { return __uint_as_float(w << 16); }
__device__ __forceinline__ float bfhi(unsigned w) { return __uint_as_float(w & 0xffff0000u); }

struct EpiProj {
    static constexpr bool PERM = true, AFTER_DRAIN = false;
    bf16_t* PB; bf16_t* PG;
    __device__ __forceinline__ void operator()(const f32x4 (&acc)[2][2][4][2], const Unit& u, int wr, int wc, int fr, int fq) const {
        const bool gate = u.pn >= 16;
        bf16_t* base = gate ? PG : PB; const int ldc = gate ? 2048 : 4096; const int colt = (gate ? u.pn - 16 : u.pn) * BM;
        const int row0 = u.pm * BM + wr * 64 + fr, col0 = colt + wc * 32 + 8 * fq;
#pragma unroll
        for (int ai = 0; ai < 2; ++ai)
#pragma unroll
            for (int m = 0; m < 4; ++m) { bf16_t* rowp = base + (size_t)(row0 + ai * HALF + m * 16) * ldc + col0;
#pragma unroll
                for (int bj = 0; bj < 2; ++bj) { f32x4 v0 = acc[ai][bj][m][0], v1 = acc[ai][bj][m][1];
                    if (gate) { v0[0] = sigm(v0[0]); v0[1] = sigm(v0[1]); v0[2] = sigm(v0[2]); v0[3] = sigm(v0[3]); v1[0] = sigm(v1[0]); v1[1] = sigm(v1[1]); v1[2] = sigm(v1[2]); v1[3] = sigm(v1[3]); }
                    u32x4 w; w.x = cvt_pk_bf16(v0[0], v0[1]); w.y = cvt_pk_bf16(v0[2], v0[3]); w.z = cvt_pk_bf16(v1[0], v1[1]); w.w = cvt_pk_bf16(v1[2], v1[3]);
                    *(u32x4*)(rowp + bj * HALF) = w; } }
    }
};
struct EpiMerge {
    static constexpr bool PERM = true, AFTER_DRAIN = false;
    const bf16_t* PG; bf16_t* TMP; long mg_off;
    __device__ __forceinline__ void operator()(const f32x4 (&acc)[2][2][4][2], const Unit& u, int wr, int wc, int fr, int fq) const {
        const int row0 = u.pm * BM + wr * 64 + fr, col0 = u.pn * BM + wc * 32 + 8 * fq; const int goff = u.sel ? 1024 : 0;
#pragma unroll
        for (int ai = 0; ai < 2; ++ai)
#pragma unroll
            for (int m = 0; m < 4; ++m) { const size_t row = (size_t)(row0 + ai * HALF + m * 16);
#pragma unroll
                for (int bj = 0; bj < 2; ++bj) { const int col = col0 + bj * HALF;
                    const u32x4 g = *(const u32x4*)(PG + row * 2048 + goff + col);
                    const f32x4 v0 = acc[ai][bj][m][0], v1 = acc[ai][bj][m][1];
                    float o0 = v0[0] * bflo(g.x), o1 = v0[1] * bfhi(g.x), o2 = v0[2] * bflo(g.y), o3 = v0[3] * bfhi(g.y);
                    float o4 = v1[0] * bflo(g.z), o5 = v1[1] * bfhi(g.z), o6 = v1[2] * bflo(g.w), o7 = v1[3] * bfhi(g.w);
                    if (u.sel) { const u32x4 t = *(const u32x4*)(TMP + row * 1024 + col);
                        o0 += bflo(t.x); o1 += bfhi(t.x); o2 += bflo(t.y); o3 += bfhi(t.y); o4 += bflo(t.z); o5 += bfhi(t.z); o6 += bflo(t.w); o7 += bfhi(t.w); }
                    u32x4 w; w.x = cvt_pk_bf16(o0, o1); w.y = cvt_pk_bf16(o2, o3); w.z = cvt_pk_bf16(o4, o5); w.w = cvt_pk_bf16(o6, o7);
                    *(u32x4*)(TMP + (u.sel ? mg_off : 0l) + row * 1024 + col) = w; } }
    }
};
struct EpiRes {
    static constexpr bool PERM = false, AFTER_DRAIN = false;
    const float* X; float* H;
    __device__ __forceinline__ void operator()(const f32x4 (&acc)[2][2][4][2], const Unit& u, int wr, int wc, int fr, int fq) const {
        const int row0 = u.pm * BM + wr * 64 + fr, col0 = u.pn * BM + wc * 32 + 4 * fq;
#pragma unroll
        for (int ai = 0; ai < 2; ++ai)
#pragma unroll
            for (int m = 0; m < 4; ++m) { const size_t off = (size_t)(row0 + ai * HALF + m * 16) * 1024 + col0;
#pragma unroll
                for (int bj = 0; bj < 2; ++bj)
#pragma unroll
                    for (int n = 0; n < 2; ++n) { const f32x4 xv = *(const f32x4*)(X + off + bj * HALF + n * 16); *(f32x4*)(H + off + bj * HALF + n * 16) = xv + acc[ai][bj][m][n]; } }
    }
};
struct EpiF32 {
    static constexpr bool PERM = false, AFTER_DRAIN = false;
    float* C; int ldc;
    __device__ __forceinline__ void operator()(const f32x4 (&acc)[2][2][4][2], const Unit& u, int wr, int wc, int fr, int fq) const {
        const int row0 = u.pm * BM + wr * 64 + fr, col0 = u.pn * BM + wc * 32 + 4 * fq;
#pragma unroll
        for (int ai = 0; ai < 2; ++ai)
#pragma unroll
            for (int m = 0; m < 4; ++m) { float* rowp = C + (size_t)(row0 + ai * HALF + m * 16) * ldc + col0;
#pragma unroll
                for (int bj = 0; bj < 2; ++bj)
#pragma unroll
                    for (int n = 0; n < 2; ++n) *(f32x4*)(rowp + bj * HALF + n * 16) = acc[ai][bj][m][n]; }
    }
};
struct MergeOrder {
    StaticOrder base;
    __device__ __forceinline__ bool next(int i, Unit& u) const { if (!base.next(i >> 1, u)) return false; u.sel = i & 1; return true; }
    __device__ __forceinline__ void a_ready(const Unit&) const {}
    __device__ __forceinline__ void done(const Unit&) const {}
};

template <class Epi, class Sched, bool ALIGN_EPI = false, bool SP2 = false>
__device__ __forceinline__ void gemm_phase(PG8_LAS unsigned char* lds, const Gemm g, const Sched& S, const Epi& E) {
    const int tid = threadIdx.x, wid = __builtin_amdgcn_readfirstlane(tid >> 6), lane = tid & 63, wr = wid >> 2, wc = wid & 3, fr = lane & 15, fq = lane >> 4;
    const int K = g.K, nt = K / BK;
    unsigned voffA[2], voffB[2];
#pragma unroll
    for (int i = 0; i < 2; ++i) { int R, C; stage_rc(tid * 16 + i * 8192, R, C); const int Rb = Epi::PERM ? ((R & ~31) + perm32(R & 31)) : R;
        voffA[i] = (unsigned)(R * K + C) * 2u; voffB[i] = (unsigned)(Rb * K + C) * 2u; }
    const size_t kstep = (size_t)(BK * 2);
    const size_t hstep = (size_t)HALF * K * 2;
    const size_t tstep = 2 * hstep;
    const unsigned ldsw = (unsigned)wid * 1024u;
    const int aoff = lds_byte(wr * 64 + fr, fq * 8), boff = lds_byte(wc * 32 + fr, fq * 8);
#define PG8_SA(b, h) (((b) * 2 + (h)) * HTB)
#define PG8_SB(b, h) ((4 + (b) * 2 + (h)) * HTB)
#define PG8_STAGE(bufoff, gbase, voff) do { _Pragma("unroll") for (int _i = 0; _i < 2; ++_i) \
        __builtin_amdgcn_global_load_lds((const unsigned*)((const char*)(gbase) + (voff)[_i]), (PG8_LAS unsigned*)(lds + (bufoff) + ldsw + _i * 8192), 16, 0, 0); } while (0)
#define PG8_LDA(dst, b, h) do { _Pragma("unroll") for (int m = 0; m < 4; ++m) _Pragma("unroll") for (int k = 0; k < 2; ++k) dst[m][k] = *(const PG8_LAS bf16x8*)(lds + PG8_SA(b, h) + aoff + m * 2048 + k * 1024); } while (0)
#define PG8_LDB(dst, b, h) do { _Pragma("unroll") for (int n = 0; n < 2; ++n) _Pragma("unroll") for (int k = 0; k < 2; ++k) dst[n][k] = *(const PG8_LAS bf16x8*)(lds + PG8_SB(b, h) + boff + n * 2048 + k * 1024); } while (0)
#define PG8_MMA(ai, bj, At, Bt) do { __builtin_amdgcn_s_setprio(1); _Pragma("unroll") for (int m = 0; m < 4; ++m) _Pragma("unroll") for (int n = 0; n < 2; ++n) _Pragma("unroll") for (int k = 0; k < 2; ++k) \
        acc[ai][bj][m][n] = __builtin_amdgcn_mfma_f32_16x16x32_bf16(Bt[n][k], At[m][k], acc[ai][bj][m][n], 0, 0, 0); __builtin_amdgcn_s_setprio(0); } while (0)
#define PG8_WAIT_V(n) asm volatile("s_waitcnt vmcnt(" #n ")" ::: "memory")
#define PG8_WAIT_L(n) asm volatile("s_waitcnt lgkmcnt(" #n ")" ::: "memory")
#define PG8_BAR __builtin_amdgcn_s_barrier()
#define PG8_SCHED __builtin_amdgcn_sched_barrier(0)
    Unit cur, nxt; int ui = 0;
    if (!S.next(0, cur)) return;
    f32x4 acc[2][2][4][2];
#pragma unroll
    for (int a = 0; a < 2; ++a)
#pragma unroll
        for (int b = 0; b < 2; ++b)
#pragma unroll
            for (int m = 0; m < 4; ++m)
#pragma unroll
                for (int n = 0; n < 2; ++n) acc[a][b][m][n] = (f32x4){0.f, 0.f, 0.f, 0.f};
    bf16x8 At[4][2], B0[2][2], B1[2][2];
    const char* cA = (const char*)g.A + (cur.sel ? g.offA1 : 0l) + (size_t)cur.pm * tstep; const char* cB = (const char*)g.Bt + (cur.sel ? g.offB1 : 0l) + (size_t)cur.pn * tstep;
    S.a_ready(cur);
    if constexpr (SP2) {
        PG8_STAGE(PG8_SB(0, 0), cB, voffB); PG8_STAGE(PG8_SB(0, 1), cB + hstep, voffB); PG8_STAGE(PG8_SA(0, 0), cA, voffA); PG8_STAGE(PG8_SA(0, 1), cA + hstep, voffA);
        if (wr == 1) PG8_BAR;
        PG8_WAIT_V(2); PG8_BAR;
        PG8_STAGE(PG8_SB(1, 0), cB + kstep, voffB); PG8_STAGE(PG8_SA(1, 0), cA + kstep, voffA); PG8_STAGE(PG8_SB(1, 1), cB + hstep + kstep, voffB);
        PG8_WAIT_V(6); PG8_BAR;
    } else {
        PG8_STAGE(PG8_SB(0, 0), cB, voffB); PG8_STAGE(PG8_SA(0, 0), cA, voffA); PG8_STAGE(PG8_SB(0, 1), cB + hstep, voffB); PG8_STAGE(PG8_SA(0, 1), cA + hstep, voffA);
        if (wr == 1) PG8_BAR;
        PG8_WAIT_V(4); PG8_BAR;
        PG8_STAGE(PG8_SB(1, 0), cB + kstep, voffB); PG8_STAGE(PG8_SA(1, 0), cA + kstep, voffA); PG8_STAGE(PG8_SB(1, 1), cB + hstep + kstep, voffB);
        PG8_WAIT_V(6); PG8_BAR;
    }
    for (;;) {
        const bool has_next = S.next(ui + 1, nxt);
        const char* nA = has_next ? (const char*)g.A + (nxt.sel ? g.offA1 : 0l) + (size_t)nxt.pm * tstep : cA; const char* nB = has_next ? (const char*)g.Bt + (nxt.sel ? g.offB1 : 0l) + (size_t)nxt.pn * tstep : cB;
        for (int t = 0; t < nt; t += 2) {
            const bool last = (t == nt - 2);
            const char* a1 = cA + (size_t)(t + 1) * kstep;
            const char* a2 = last ? nA : cA + (size_t)(t + 2) * kstep; const char* b2 = last ? nB : cB + (size_t)(t + 2) * kstep;
            const char* a3 = a2 + kstep; const char* b3 = b2 + kstep;
            if (last && has_next) S.a_ready(nxt);
            if constexpr (SP2) {
            PG8_LDB(B0, 0, 0); PG8_LDB(B1, 0, 1); PG8_SCHED; PG8_LDA(At, 0, 0); PG8_STAGE(PG8_SA(1, 1), a1 + hstep, voffA);
            PG8_WAIT_V(8); PG8_WAIT_L(0); PG8_BAR; PG8_MMA(0, 0, At, B0); PG8_MMA(0, 1, At, B1); PG8_BAR; PG8_SCHED;
            PG8_LDA(At, 0, 1); PG8_STAGE(PG8_SB(0, 0), b2, voffB); PG8_STAGE(PG8_SB(0, 1), b2 + hstep, voffB); PG8_STAGE(PG8_SA(0, 0), a2, voffA);
            PG8_WAIT_V(8); PG8_WAIT_L(0); PG8_BAR; PG8_MMA(1, 0, At, B0); PG8_MMA(1, 1, At, B1); PG8_BAR; PG8_SCHED;
            PG8_LDB(B0, 1, 0); PG8_LDB(B1, 1, 1); PG8_SCHED; PG8_LDA(At, 1, 0); PG8_STAGE(PG8_SA(0, 1), a2 + hstep, voffA);
            PG8_WAIT_V(8); PG8_WAIT_L(0); PG8_BAR; PG8_MMA(0, 0, At, B0); PG8_MMA(0, 1, At, B1); PG8_BAR; PG8_SCHED;
            PG8_LDA(At, 1, 1); PG8_STAGE(PG8_SB(1, 0), b3, voffB); PG8_STAGE(PG8_SB(1, 1), b3 + hstep, voffB); PG8_STAGE(PG8_SA(1, 0), a3, voffA);
            PG8_WAIT_V(8); PG8_WAIT_L(0); PG8_BAR; PG8_MMA(1, 0, At, B0); PG8_MMA(1, 1, At, B1); PG8_BAR; PG8_SCHED;
            } else {
            PG8_LDB(B0, 0, 0); PG8_SCHED; PG8_LDA(At, 0, 0); PG8_STAGE(PG8_SA(1, 1), a1 + hstep, voffA);
            PG8_WAIT_L(8); PG8_BAR; PG8_WAIT_L(0); PG8_MMA(0, 0, At, B0); PG8_BAR; PG8_SCHED;
            PG8_LDB(B1, 0, 1); PG8_STAGE(PG8_SB(0, 0), b2, voffB);
            PG8_BAR; PG8_WAIT_L(0); PG8_MMA(0, 1, At, B1); PG8_BAR;
            PG8_LDA(At, 0, 1); PG8_STAGE(PG8_SA(0, 0), a2, voffA);
            PG8_BAR; PG8_WAIT_L(0); PG8_MMA(1, 0, At, B0); PG8_BAR; PG8_SCHED;
            PG8_STAGE(PG8_SB(0, 1), b2 + hstep, voffB);
            PG8_WAIT_V(6); PG8_BAR; PG8_MMA(1, 1, At, B1); PG8_BAR;
            PG8_LDB(B0, 1, 0); PG8_SCHED; PG8_LDA(At, 1, 0); PG8_STAGE(PG8_SA(0, 1), a2 + hstep, voffA);
            PG8_WAIT_L(8); PG8_BAR; PG8_WAIT_L(0); PG8_MMA(0, 0, At, B0); PG8_BAR; PG8_SCHED;
            PG8_LDB(B1, 1, 1); PG8_STAGE(PG8_SB(1, 0), b3, voffB);
            PG8_BAR; PG8_WAIT_L(0); PG8_MMA(0, 1, At, B1); PG8_BAR;
            PG8_LDA(At, 1, 1); PG8_STAGE(PG8_SA(1, 0), a3, voffA);
            PG8_BAR; PG8_WAIT_L(0); PG8_MMA(1, 0, At, B0); PG8_BAR; PG8_SCHED;
            PG8_STAGE(PG8_SB(1, 1), b3 + hstep, voffB);
            PG8_WAIT_V(6); PG8_BAR; PG8_MMA(1, 1, At, B1); PG8_BAR;
            }
        }
        if constexpr (ALIGN_EPI) { if (wr == 0) PG8_BAR; }
        if constexpr (!Epi::AFTER_DRAIN) { E(acc, cur, wr, wc, fr, fq); S.done(cur); }
        if (!has_next) break;
#pragma unroll
        for (int a = 0; a < 2; ++a)
#pragma unroll
            for (int b = 0; b < 2; ++b)
#pragma unroll
                for (int m = 0; m < 4; ++m)
#pragma unroll
                    for (int n = 0; n < 2; ++n) acc[a][b][m][n] = (f32x4){0.f, 0.f, 0.f, 0.f};
        cur = nxt; cA = nA; cB = nB; ++ui;
        if constexpr (ALIGN_EPI) { if (wr == 1) PG8_BAR; }
    }
    PG8_WAIT_V(0);
    if constexpr (!ALIGN_EPI) { if (wr == 0) PG8_BAR; }
    PG8_BAR;
    if constexpr (Epi::AFTER_DRAIN) { E.fused(acc, cur, wr, wc, fr, fq, lds, wid, lane); S.done(cur); }
#undef PG8_SA
#undef PG8_SB
#undef PG8_STAGE
#undef PG8_LDA
#undef PG8_LDB
#undef PG8_MMA
#undef PG8_WAIT_V
#undef PG8_WAIT_L
#undef PG8_BAR
#undef PG8_SCHED
}
}
constexpr int NWAVES = 8;
#ifndef MK_N_LAUNCHES
#define MK_N_LAUNCHES 1
#endif
constexpr int NPHASE = 9;
#ifndef PROBE_DUP
#define PROBE_DUP 0
#endif
#define REPS(k) (1 + ((PROBE_DUP >> (k)) & 1))
constexpr int N_LAUNCHES = MK_N_LAUNCHES;
static_assert(N_LAUNCHES == 1 || N_LAUNCHES == NPHASE, "MK_N_LAUNCHES is 1 or NPHASE");

constexpr int T = 16384, SEQ = 2048, D = 1024, NIN = 6144, NSC = 2048, NEXP = 16384, NSEL = 128;
constexpr float EPS = 1e-6f;

constexpr size_t MiB = 1u << 20;
constexpr size_t WS_CTL = 0, CTL_ZERO_BYTES = 64 * 1024;
constexpr size_t WS_WIN = 1 * MiB, WS_WC = 13 * MiB, WS_WPB = 15 * MiB, WS_WOUT = 17 * MiB, WS_WS = 19 * MiB;
constexpr size_t WS_IDX = 1 * MiB, WS_GATE = 9 * MiB;
constexpr size_t WS_XN = 32 * MiB;
constexpr size_t WS_PB = 64 * MiB;
constexpr size_t WS_TMP = 64 * MiB, WS_MG = 96 * MiB;
constexpr size_t WS_SC = 64 * MiB;
constexpr size_t WS_PG = 192 * MiB;
constexpr size_t WS_U16 = 192 * MiB, WS_V16 = 224 * MiB;
constexpr size_t WS_END = 256 * MiB;
constexpr int CW_BAR = 1024;

constexpr int RING_OFF = 0, RING_BYTES = 131072;
constexpr int LDSCTL_OFF = RING_BYTES, MISC_OFF = LDSCTL_OFF + 320;
constexpr int LDS_BYTES = 147456;
#define GAS __attribute__((address_space(1)))
#define LAS __attribute__((address_space(3)))
typedef unsigned short bf16;
typedef unsigned v4u __attribute__((ext_vector_type(4)));
typedef float f32x4 __attribute__((ext_vector_type(4)));
typedef short bf16x8 __attribute__((ext_vector_type(8)));
typedef GAS unsigned gu32;
typedef GAS unsigned long long gu64;
#define RLX_AGENT __ATOMIC_RELAXED, __HIP_MEMORY_SCOPE_AGENT
#define LDS_WAIT() asm volatile("s_waitcnt lgkmcnt(0)" ::: "memory")
#define VM_WAIT() asm volatile("s_waitcnt vmcnt(0)" ::: "memory")
__device__ __forceinline__ unsigned long long rt() { return __builtin_amdgcn_s_memrealtime(); }
__device__ __forceinline__ unsigned f2bf(float f) { unsigned u = __builtin_bit_cast(unsigned, f); return (u + 0x7fffu + ((u >> 16) & 1u)) >> 16; }
__device__ __forceinline__ unsigned pk2(float lo, float hi) { return f2bf(lo) | (f2bf(hi) << 16); }

#define XB_TMO      128
#define XB_XCNT(j)  (256  + 64 * (j))
#define XB_XSUB(j)  (1280 + 64 * (j))
#define XB_XGEN(j)  (2304 + 64 * (j))
#define XB_TOP      3328
#define XB_TOPGEN   3392
#define XCD_BAR_WORDS 3456
#define XB_SPIN_CAP (1u << 18)

__device__ __forceinline__ unsigned xb_ld(unsigned* p)              { return __hip_atomic_load(p, __ATOMIC_RELAXED, __HIP_MEMORY_SCOPE_AGENT); }
__device__ __forceinline__ unsigned xb_add(unsigned* p, unsigned v) { return __hip_atomic_fetch_add(p, v, __ATOMIC_RELAXED, __HIP_MEMORY_SCOPE_AGENT); }
__device__ __forceinline__ unsigned xb_xcc_id() { return (unsigned)__builtin_amdgcn_s_getreg((3 << 11) | 20) & 0xFu; }
#define XB_SPIN(cond, bar) do { unsigned _sp = 0; while (cond) { __builtin_amdgcn_s_sleep(1); \
    if ((++_sp & 255u) == 0u) { if (xb_ld(&(bar)[XB_TMO])) break; if (_sp > XB_SPIN_CAP) { atomicAdd(&(bar)[XB_TMO], 1u); break; } } } } while (0)

struct XcdBarrier {
    unsigned* bar; unsigned x;
    volatile LAS unsigned* st;
};

__device__ __forceinline__ XcdBarrier xcd_barrier_post(unsigned* bar, volatile LAS unsigned* st) {
    XcdBarrier b; b.bar = bar; b.x = xb_xcc_id(); b.st = st;
    if (threadIdx.x == 0) (void)xb_add(&bar[XB_XCNT(b.x)], 1u);
    return b;
}
__device__ __forceinline__ void xcd_barrier_complete(unsigned* bar, unsigned x, unsigned& nloc, unsigned& nx) {
    const unsigned G = gridDim.x * gridDim.y * gridDim.z;
    unsigned sum, cnt, mine, sp = 0u;
    for (;;) {
        sum = 0u; cnt = 0u; mine = 0u;
#pragma unroll
        for (unsigned j = 0; j < 16; ++j) { const unsigned c = xb_ld(&bar[XB_XCNT(j)]); sum += c; cnt += (c > 0u) ? 1u : 0u; mine = (j == x) ? c : mine; }
        if (sum == G) break;
        __builtin_amdgcn_s_sleep(1);
        if ((++sp & 255u) == 0u) { if (xb_ld(&bar[XB_TMO])) break; if (sp > XB_SPIN_CAP) { atomicAdd(&bar[XB_TMO], 1u); break; } }
    }
    nloc = mine > 0u ? mine : 1u; nx = cnt > 0u ? cnt : 1u;
}

__device__ __forceinline__ void xcd_barrier(const XcdBarrier& b) {
    asm volatile("s_waitcnt vmcnt(0)" ::: "memory");
    __syncthreads();
    if (threadIdx.x == 0) {
        unsigned* bar = b.bar;
        __builtin_amdgcn_s_waitcnt(0);
        unsigned nloc = b.st[0], nx = b.st[1];
        if (nloc == 0u) { xcd_barrier_complete(bar, b.x, nloc, nx); b.st[0] = nloc; b.st[1] = nx; }
        const unsigned old = xb_add(&bar[XB_XSUB(b.x)], 1u);
        const unsigned gen = old / nloc;
        if (old + 1u == (gen + 1u) * nloc) {
            __builtin_amdgcn_fence(__ATOMIC_RELEASE, "agent");
            asm volatile("s_waitcnt vmcnt(0)" ::: "memory");
            const unsigned og = xb_add(&bar[XB_TOP], 1u);
            const unsigned tg = og / nx;
            if (og + 1u == (tg + 1u) * nx) xb_add(&bar[XB_TOPGEN], 1u);
            else XB_SPIN(xb_ld(&bar[XB_TOPGEN]) == tg, bar);
            __builtin_amdgcn_fence(__ATOMIC_ACQUIRE, "agent");
            xb_add(&bar[XB_XGEN(b.x)], 1u);
            asm volatile("s_waitcnt vmcnt(0)" ::: "memory");
        } else {
            XB_SPIN(xb_ld(&bar[XB_XGEN(b.x)]) == gen, bar);
            __builtin_amdgcn_fence(__ATOMIC_ACQUIRE, "agent");
            asm volatile("s_waitcnt vmcnt(0)" ::: "memory");
        }
    }
    __syncthreads();
}

struct Frame {
    LAS unsigned char* lds;
    volatile LAS unsigned* MISC;
    int tid, lane, wave;
    int vcu, G;
};
__device__ __forceinline__ float wave_sum(float v) {
#pragma unroll
    for (int o = 1; o < 64; o <<= 1) v += __shfl_xor(v, o);
    return v;
}
__device__ __forceinline__ float bflo(unsigned w) { return __uint_as_float(w << 16); }
__device__ __forceinline__ float bfhi(unsigned w) { return __uint_as_float(w & 0xffff0000u); }
__device__ __forceinline__ void unpack8(const v4u w, float (&f)[8]) { f[0] = bflo(w.x); f[1] = bfhi(w.x); f[2] = bflo(w.y); f[3] = bfhi(w.y); f[4] = bflo(w.z); f[5] = bfhi(w.z); f[6] = bflo(w.w); f[7] = bfhi(w.w); }
__device__ __forceinline__ v4u pack8(const float (&f)[8]) { v4u o; o.x = pk2(f[0], f[1]); o.y = pk2(f[2], f[3]); o.z = pk2(f[4], f[5]); o.w = pk2(f[6], f[7]); return o; }

__device__ __forceinline__ void p0_transpose_item(const float* W, int K, int N, bf16* WT, LAS float* scr, int item, int lane) {
    const int nblk = N / 32, kb = item / nblk, nb = item % nblk, k0 = 64 * kb, n0 = 32 * nb;
#pragma unroll 8
    for (int i = 0; i < 32; ++i) { const int kk = 2 * i + (lane >> 5); scr[kk * 33 + (lane & 31)] = W[(size_t)(k0 + kk) * N + n0 + (lane & 31)]; }
    LDS_WAIT(); asm volatile("" ::: "memory");
    const int c = lane & 7;
#pragma unroll
    for (int j = 0; j < 4; ++j) { const int n = (lane >> 3) + 8 * j; const LAS float* s = scr + (8 * c) * 33 + n;
        v4u o; o.x = pk2(s[0 * 33], s[1 * 33]); o.y = pk2(s[2 * 33], s[3 * 33]); o.z = pk2(s[4 * 33], s[5 * 33]); o.w = pk2(s[6 * 33], s[7 * 33]);
        *(GAS v4u*)(WT + (size_t)(n0 + n) * K + k0 + 8 * c) = o; }
    LDS_WAIT(); asm volatile("" ::: "memory");
}
__device__ __forceinline__ void fold_tile(LAS float* sm, const float* Ap, int sAi, int sAk, const float* As, const float* Bp, int sBj, int K, bf16* Cp, int ldc, int tid) {
    LAS float* sA = sm; LAS float* sB = sm + 32 * 65;
    float acc[8];
#pragma unroll
    for (int q = 0; q < 8; ++q) acc[q] = 0.f;
    const int tj = tid & 63, ti0 = tid >> 6;
    for (int k0 = 0; k0 < K; k0 += 32) {
#pragma unroll
        for (int r = 0; r < 4; ++r) { const int e = tid + 512 * r; int i, k;
            if (sAk == 1) { k = e & 31; i = e >> 5; } else { i = e & 63; k = e >> 6; }
            float a = Ap[(size_t)i * sAi + (size_t)(k0 + k) * sAk]; if (As) a *= As[k0 + k];
            sA[k * 65 + i] = a;
            const int kb = e & 31, jb = e >> 5;
            sB[kb * 65 + jb] = Bp[(size_t)jb * sBj + k0 + kb]; }
        __syncthreads();
#pragma unroll 4
        for (int k = 0; k < 32; ++k) { const float b = sB[k * 65 + tj];
#pragma unroll
            for (int q = 0; q < 8; ++q) acc[q] += sA[k * 65 + ti0 + 8 * q] * b; }
        __syncthreads();
    }
#pragma unroll
    for (int q = 0; q < 8; ++q) Cp[(size_t)(ti0 + 8 * q) * ldc + tj] = (bf16)f2bf(acc[q]);
}
__device__ __forceinline__ void rms_row_to_bf16(int lane, const float* xrow, const float* g, bf16* orow) {
    const GAS f32x4* xr = (const GAS f32x4*)xrow + lane; const GAS f32x4* gr = (const GAS f32x4*)g + lane;
    f32x4 v[4]; float s = 0.f;
#pragma unroll
    for (int j = 0; j < 4; ++j) { v[j] = xr[64 * j]; s += (v[j].x * v[j].x + v[j].y * v[j].y) + (v[j].z * v[j].z + v[j].w * v[j].w); }
    const float rstd = 1.f / sqrtf(wave_sum(s) * (1.f / D) + EPS);
    GAS unsigned long long* o8 = (GAS unsigned long long*)orow + lane;
#pragma unroll
    for (int j = 0; j < 4; ++j) { const f32x4 gg = gr[64 * j];
        o8[64 * j] = (unsigned long long)pk2(v[j].x * rstd * gg.x, v[j].y * rstd * gg.y) | ((unsigned long long)pk2(v[j].z * rstd * gg.z, v[j].w * rstd * gg.w) << 32); }
}
__device__ __forceinline__ void p2_conv_pool(Frame& F, const bf16* PB, const float* conv_w, bf16* AIN, bf16* POOLED) {
    const int gt = F.vcu * (NWAVES * 64) + F.tid, NT = F.G * (NWAVES * 64);
    for (int it = gt; it < (T / 16) * (D / 8); it += NT) {
        const int cv = it & 127, rc = it >> 7, col = cv * 8, t0 = rc * 16, s0 = t0 & (SEQ - 1);
        float w0[8], w1[8], w2[8];
        { const f32x4 a = *(const GAS f32x4*)(conv_w + col), b = *(const GAS f32x4*)(conv_w + col + 4); w0[0] = a.x; w0[1] = a.y; w0[2] = a.z; w0[3] = a.w; w0[4] = b.x; w0[5] = b.y; w0[6] = b.z; w0[7] = b.w; }
        { const f32x4 a = *(const GAS f32x4*)(conv_w + D + col), b = *(const GAS f32x4*)(conv_w + D + col + 4); w1[0] = a.x; w1[1] = a.y; w1[2] = a.z; w1[3] = a.w; w1[4] = b.x; w1[5] = b.y; w1[6] = b.z; w1[7] = b.w; }
        { const f32x4 a = *(const GAS f32x4*)(conv_w + 2 * D + col), b = *(const GAS f32x4*)(conv_w + 2 * D + col + 4); w2[0] = a.x; w2[1] = a.y; w2[2] = a.z; w2[3] = a.w; w2[4] = b.x; w2[5] = b.y; w2[6] = b.z; w2[7] = b.w; }
        float um2[8], um1[8];
#pragma unroll
        for (int i = 0; i < 8; ++i) { um2[i] = 0.f; um1[i] = 0.f; }
        if (s0 != 0) {
            float c[8], h[8];
            unpack8(*(const GAS v4u*)(PB + (size_t)(t0 - 2) * 4096 + 1024 + col), c); unpack8(*(const GAS v4u*)(PB + (size_t)(t0 - 2) * 4096 + 2048 + col), h);
#pragma unroll
            for (int i = 0; i < 8; ++i) um2[i] = c[i] * h[i];
            unpack8(*(const GAS v4u*)(PB + (size_t)(t0 - 1) * 4096 + 1024 + col), c); unpack8(*(const GAS v4u*)(PB + (size_t)(t0 - 1) * 4096 + 2048 + col), h);
#pragma unroll
            for (int i = 0; i < 8; ++i) um1[i] = c[i] * h[i];
        }
        for (int r = 0; r < 16; ++r) {
            const size_t rowb = (size_t)(t0 + r) * 4096;
            float b[8], c[8], h[8], o[8];
            unpack8(*(const GAS v4u*)(PB + rowb + col), b); unpack8(*(const GAS v4u*)(PB + rowb + 1024 + col), c); unpack8(*(const GAS v4u*)(PB + rowb + 2048 + col), h);
#pragma unroll
            for (int i = 0; i < 8; ++i) { const float u = c[i] * h[i]; o[i] = b[i] * (w0[i] * um2[i] + w1[i] * um1[i] + w2[i] * u); um2[i] = um1[i]; um1[i] = u; }
            *(GAS v4u*)(AIN + (size_t)(t0 + r) * D + col) = pack8(o);
        }
        const int win = 2 << (col >> 8);
        for (int r = 0; r < 16; ++r) {
            const int t = t0 + r, s = s0 + r;
            float p0[8], sum[8], o[8];
            unpack8(*(const GAS v4u*)(PB + (size_t)t * 4096 + 3072 + col), p0);
#pragma unroll
            for (int i = 0; i < 8; ++i) sum[i] = p0[i];
            const int nb = (s < win - 1) ? s : (win - 1);
            for (int j = 1; j <= nb; ++j) { float pj[8]; unpack8(*(const GAS v4u*)(PB + (size_t)(t - j) * 4096 + 3072 + col), pj);
#pragma unroll
                for (int i = 0; i < 8; ++i) sum[i] += pj[i]; }
            const float inv = 1.0f / (float)(nb + 1);
#pragma unroll
            for (int i = 0; i < 8; ++i) o[i] = sum[i] * inv - p0[i];
            *(GAS v4u*)(POOLED + (size_t)t * D + col) = pack8(o);
        }
    }
}

typedef int v4i __attribute__((ext_vector_type(4)));
__device__ __forceinline__ unsigned fkey(float f) { const unsigned u = __float_as_uint(f); return (u & 0x80000000u) ? ~u : (u | 0x80000000u); }
__device__ __forceinline__ float fkey_inv(unsigned k) { return __uint_as_float((k & 0x80000000u) ? (k & 0x7fffffffu) : ~k); }
__device__ __forceinline__ void ce_desc(unsigned& a, unsigned& b) { const unsigned hi = a > b ? a : b, lo = a > b ? b : a; a = hi; b = lo; }
template <int K, int J> __device__ __forceinline__ void bitonic_stage(unsigned (&a)[16]) {
#pragma unroll
    for (int i = 0; i < 16; ++i) { const int l = i ^ J; if (l > i) { if ((i & K) == 0) ce_desc(a[i], a[l]); else ce_desc(a[l], a[i]); } }
}
__device__ __forceinline__ void bitonic_merge16(unsigned (&a)[16]) { bitonic_stage<16, 8>(a); bitonic_stage<16, 4>(a); bitonic_stage<16, 2>(a); bitonic_stage<16, 1>(a); }
__device__ __forceinline__ void bitonic_sort16(unsigned (&a)[16]) {
    bitonic_stage<2, 1>(a); bitonic_stage<4, 2>(a); bitonic_stage<4, 1>(a); bitonic_stage<8, 4>(a); bitonic_stage<8, 2>(a); bitonic_stage<8, 1>(a); bitonic_merge16(a);
}
__device__ __forceinline__ void top16_merge(unsigned (&top)[16], unsigned (&ch)[16]) {
#pragma unroll
    for (int i = 0; i < 16; ++i) top[i] = top[i] > ch[15 - i] ? top[i] : ch[15 - i];
    bitonic_merge16(top);
}
__device__ __forceinline__ void p7_topk(Frame& F, const float* SC, int* IDX, float* GATE) {
    constexpr int RS = 36;
    LAS float* stg = (LAS float*)(F.lds + RING_OFF + F.wave * 9216);
    const int gw = F.vcu * NWAVES + F.wave, NGW = F.G * NWAVES, lane = F.lane, r8 = lane >> 3, c = lane & 7;
    for (int batch = gw; batch < T / 8; batch += NGW) {
        const float* base = SC + (size_t)batch * (8 * NSC);
        unsigned top[16], top1[16];
#pragma unroll
        for (int i = 0; i < 16; ++i) { top[i] = 0u; top1[i] = 0u; }
        f32x4 ld[8];
#pragma unroll
        for (int q = 0; q < 8; ++q) ld[q] = *(const GAS f32x4*)(base + (size_t)(8 * q + r8) * 256 + c * 4);
        for (int ch = 0; ch < 8; ++ch) {
#pragma unroll
            for (int q = 0; q < 8; ++q) *(LAS f32x4*)(stg + (8 * q + r8) * RS + c * 4) = ld[q];
            if (ch < 7) {
#pragma unroll
                for (int q = 0; q < 8; ++q) ld[q] = *(const GAS f32x4*)(base + (size_t)(8 * q + r8) * 256 + (ch + 1) * 32 + c * 4);
            }
            LDS_WAIT(); asm volatile("" ::: "memory");
#pragma unroll
            for (int hf = 0; hf < 2; ++hf) {
                unsigned k[16];
                const unsigned pb = 127u - (unsigned)((ch & 3) * 32 + hf * 16);
#pragma unroll
                for (int q = 0; q < 4; ++q) { const f32x4 v = *(const LAS f32x4*)(stg + lane * RS + hf * 16 + q * 4);
                    k[4 * q] = (fkey(v.x) & ~0x7fu) | (pb - (unsigned)(4 * q)); k[4 * q + 1] = (fkey(v.y) & ~0x7fu) | (pb - (unsigned)(4 * q + 1));
                    k[4 * q + 2] = (fkey(v.z) & ~0x7fu) | (pb - (unsigned)(4 * q + 2)); k[4 * q + 3] = (fkey(v.w) & ~0x7fu) | (pb - (unsigned)(4 * q + 3)); }
                bitonic_sort16(k);
                top16_merge(top, k);
            }
            LDS_WAIT(); asm volatile("" ::: "memory");
            if (ch == 3) {
#pragma unroll
                for (int i = 0; i < 16; ++i) { top1[i] = top[i]; top[i] = 0u; }
            }
        }
        LAS int* tab = (LAS int*)stg + lane * 33;
        float v1[16], v2[16];
#pragma unroll
        for (int i = 0; i < 16; ++i) { tab[i] = 127 - (int)(top1[i] & 0x7fu); tab[16 + i] = 127 - (int)(top[i] & 0x7fu); v1[i] = fkey_inv(top1[i] & ~0x7fu); v2[i] = fkey_inv(top[i] & ~0x7fu); }
#define P7_KEY(i, j) ((fkey(v1[i] + v2[j]) & ~0xffu) | (unsigned)((i) * 16 + (j)))
        unsigned best[16], cb[16];
#pragma unroll
        for (int jj = 0; jj < 16; ++jj) best[jj] = P7_KEY(0, jj);
#pragma unroll
        for (int jj = 0; jj < 8; ++jj) { cb[jj] = P7_KEY(1, jj); cb[8 + jj] = 0u; }
        top16_merge(best, cb);
        cb[0] = P7_KEY(2, 0); cb[1] = P7_KEY(2, 1); cb[2] = P7_KEY(2, 2); cb[3] = P7_KEY(2, 3); cb[4] = P7_KEY(2, 4); cb[5] = P7_KEY(3, 0); cb[6] = P7_KEY(3, 1); cb[7] = P7_KEY(3, 2);
        cb[8] = P7_KEY(3, 3); cb[9] = P7_KEY(4, 0); cb[10] = P7_KEY(4, 1); cb[11] = P7_KEY(4, 2); cb[12] = 0u; cb[13] = 0u; cb[14] = 0u; cb[15] = 0u;
        bitonic_sort16(cb); top16_merge(best, cb);
        cb[0] = P7_KEY(5, 0); cb[1] = P7_KEY(5, 1); cb[2] = P7_KEY(6, 0); cb[3] = P7_KEY(6, 1); cb[4] = P7_KEY(7, 0); cb[5] = P7_KEY(7, 1); cb[6] = P7_KEY(8, 0); cb[7] = P7_KEY(9, 0);
        cb[8] = P7_KEY(10, 0); cb[9] = P7_KEY(11, 0); cb[10] = P7_KEY(12, 0); cb[11] = P7_KEY(13, 0); cb[12] = P7_KEY(14, 0); cb[13] = P7_KEY(15, 0); cb[14] = 0u; cb[15] = 0u;
        bitonic_sort16(cb); top16_merge(best, cb);
#undef P7_KEY
        LDS_WAIT(); asm volatile("" ::: "memory");
        int eo[16]; float go[16]; float sm = 0.f;
        const float bmax = fkey_inv(best[0] & ~0xffu);
#pragma unroll
        for (int r = 0; r < 16; ++r) { const int ij = (int)(best[r] & 0xffu); eo[r] = tab[ij >> 4] * 128 + tab[16 + (ij & 15)]; go[r] = __expf(fkey_inv(best[r] & ~0xffu) - bmax); sm += go[r]; }
        const float inv = 1.0f / sm;
        int* ip = IDX + (size_t)batch * 1024 + lane * 16; float* gp = GATE + (size_t)batch * 1024 + lane * 16;
#pragma unroll
        for (int q = 0; q < 4; ++q) { *(GAS v4i*)(ip + 4 * q) = (v4i){eo[4 * q], eo[4 * q + 1], eo[4 * q + 2], eo[4 * q + 3]};
            *(GAS f32x4*)(gp + 4 * q) = (f32x4){go[4 * q] * inv, go[4 * q + 1] * inv, go[4 * q + 2] * inv, go[4 * q + 3] * inv}; }
        LDS_WAIT(); asm volatile("" ::: "memory");
    }
}
typedef __bf16 bf16x2_t __attribute__((ext_vector_type(2)));
__device__ __forceinline__ float dpp_f(float v, const int ctrl_sel) {
    const int x = __builtin_bit_cast(int, v);
    int r;
    if (ctrl_sel == 0) r = __builtin_amdgcn_update_dpp(0, x, 0xB1, 0xF, 0xF, true);
    else if (ctrl_sel == 1) r = __builtin_amdgcn_update_dpp(0, x, 0x4E, 0xF, 0xF, true);
    else if (ctrl_sel == 2) r = __builtin_amdgcn_update_dpp(0, x, 0x141, 0xF, 0xF, true);
    else r = __builtin_amdgcn_update_dpp(0, x, 0x128, 0xF, 0xF, true);
    return __builtin_bit_cast(float, r);
}
__device__ __forceinline__ float sum8(float v) { v += dpp_f(v, 0); v += dpp_f(v, 1); v += dpp_f(v, 2); return v; }
__device__ __forceinline__ float dot2bf(unsigned a, unsigned b, float acc) { return __builtin_amdgcn_fdot2_f32_bf16(__builtin_bit_cast(bf16x2_t, a), __builtin_bit_cast(bf16x2_t, b), acc, false); }
__device__ __forceinline__ float dot8(const v4u d, const v4u x, float acc) {
    acc = dot2bf(d.x, x.x, acc); acc = dot2bf(d.y, x.y, acc); acc = dot2bf(d.z, x.z, acc); acc = dot2bf(d.w, x.w, acc);
    return acc;
}
__device__ __forceinline__ float gelu_erf(float z) { return 0.5f * z * (1.0f + erff(z * 0.70710678118654752f)); }
__device__ __forceinline__ void p8_issue(v4u (&d)[8], const LAS int* li8, __amdgpu_buffer_rsrc_t rs, int soff, int c16) {
    const v4i e0 = *(const LAS v4i*)li8, e1 = *(const LAS v4i*)(li8 + 4);
    d[0] = __builtin_amdgcn_raw_buffer_load_b128(rs, e0.x * (D * 2) + c16, soff, 0); d[1] = __builtin_amdgcn_raw_buffer_load_b128(rs, e0.y * (D * 2) + c16, soff, 0);
    d[2] = __builtin_amdgcn_raw_buffer_load_b128(rs, e0.z * (D * 2) + c16, soff, 0); d[3] = __builtin_amdgcn_raw_buffer_load_b128(rs, e0.w * (D * 2) + c16, soff, 0);
    d[4] = __builtin_amdgcn_raw_buffer_load_b128(rs, e1.x * (D * 2) + c16, soff, 0); d[5] = __builtin_amdgcn_raw_buffer_load_b128(rs, e1.y * (D * 2) + c16, soff, 0);
    d[6] = __builtin_amdgcn_raw_buffer_load_b128(rs, e1.z * (D * 2) + c16, soff, 0); d[7] = __builtin_amdgcn_raw_buffer_load_b128(rs, e1.w * (D * 2) + c16, soff, 0);
}
__device__ __forceinline__ void p8_compute_u(const v4u (&d)[8], const v4u xs, LAS float* lz8, int c) {
    float p[8];
#pragma unroll
    for (int g = 0; g < 8; ++g) p[g] = sum8(dot8(d[g], xs, 0.f));
    if (c == 0) {
#pragma unroll
        for (int q = 0; q < 2; ++q) { f32x4 z = *(LAS f32x4*)(lz8 + 4 * q); z.x += p[4 * q]; z.y += p[4 * q + 1]; z.z += p[4 * q + 2]; z.w += p[4 * q + 3]; *(LAS f32x4*)(lz8 + 4 * q) = z; }
    }
}
__device__ __forceinline__ void p8_compute_v(const v4u (&d)[8], const LAS float* la8, float (&y)[8]) {
    const f32x4 a0 = *(const LAS f32x4*)la8, a1 = *(const LAS f32x4*)(la8 + 4);
    const float a[8] = {a0.x, a0.y, a0.z, a0.w, a1.x, a1.y, a1.z, a1.w};
#pragma unroll
    for (int g = 0; g < 8; ++g) {
        y[0] += a[g] * bflo(d[g].x); y[1] += a[g] * bfhi(d[g].x); y[2] += a[g] * bflo(d[g].y); y[3] += a[g] * bfhi(d[g].y);
        y[4] += a[g] * bflo(d[g].z); y[5] += a[g] * bfhi(d[g].z); y[6] += a[g] * bflo(d[g].w); y[7] += a[g] * bfhi(d[g].w); }
}
__device__ __forceinline__ void p8_peer(Frame& F, const bf16* XN2, const bf16* U16, const bf16* V16, const int* IDX, const float* GATE, float* HOUT, const float* gfin) {
    LAS int* lidx = (LAS int*)(F.lds + RING_OFF + F.wave * 8704);
    LAS float* lza = (LAS float*)(F.lds + RING_OFF + F.wave * 8704 + 4096);
    LAS float* lss = (LAS float*)(F.lds + RING_OFF + F.wave * 8704 + 8192);
    const int gw = F.vcu * NWAVES + F.wave, NGW = F.G * NWAVES, lane = F.lane, j = lane >> 3, c = lane & 7, c16 = c * 16;
    const __amdgpu_buffer_rsrc_t rsU = __builtin_amdgcn_make_buffer_rsrc((void*)U16, (short)0, NEXP * D * 2, 0x00020000);
    const __amdgpu_buffer_rsrc_t rsV = __builtin_amdgcn_make_buffer_rsrc((void*)V16, (short)0, NEXP * D * 2, 0x00020000);
    for (int grp = gw; grp < T / 8; grp += NGW) {
        const int tb = grp * 8;
#pragma unroll
        for (int i = 0; i < 8; ++i) { lidx[i * 128 + lane] = IDX[(size_t)(tb + i) * NSEL + lane]; lidx[i * 128 + 64 + lane] = IDX[(size_t)(tb + i) * NSEL + 64 + lane]; lza[i * 128 + lane] = 0.f; lza[i * 128 + 64 + lane] = 0.f; }
        if (lane < 8) lss[lane] = 0.f;
        LDS_WAIT(); asm volatile("" ::: "memory");
        {
            v4u dA[8], dB[8], xc, xn;
            p8_issue(dA, lidx + j * 16, rsU, 0, c16); xc = *(const GAS v4u*)(XN2 + (size_t)tb * D + c * 8);
            for (int n = 0; n < 128; ++n) {
                const int s = n >> 3, i = n & 7, n1 = (n + 1) & 127, s1 = n1 >> 3, i1 = n1 & 7;
                xn = *(const GAS v4u*)(XN2 + (size_t)(tb + i1) * D + s1 * 64 + c * 8);
                p8_issue(dB, lidx + i * 128 + j * 16 + 8, rsU, s * 128, c16);
                p8_compute_u(dA, xc, lza + i * 128 + j * 16, c);
                p8_issue(dA, lidx + i1 * 128 + j * 16, rsU, s1 * 128, c16);
                p8_compute_u(dB, xc, lza + i * 128 + j * 16 + 8, c);
                xc = xn;
            }
        }
        LDS_WAIT(); asm volatile("" ::: "memory");
#pragma unroll
        for (int i = 0; i < 8; ++i) {
            const float z0 = lza[i * 128 + lane], z1 = lza[i * 128 + 64 + lane];
            const float g0 = GATE[(size_t)(tb + i) * NSEL + lane], g1 = GATE[(size_t)(tb + i) * NSEL + 64 + lane];
            lza[i * 128 + lane] = gelu_erf(z0) * g0; lza[i * 128 + 64 + lane] = gelu_erf(z1) * g1;
        }
        LDS_WAIT(); asm volatile("" ::: "memory");
        {
            v4u dA[8], dB[8];
            p8_issue(dA, lidx + j * 16, rsV, 0, c16);
            for (int n = 0; n < 128; ++n) {
                const int s = n >> 3, i = n & 7, n1 = (n + 1) & 127, s1 = n1 >> 3, i1 = n1 & 7;
                p8_issue(dB, lidx + i * 128 + j * 16 + 8, rsV, s * 128, c16);
                float* hp = HOUT + (size_t)(tb + i) * D + s * 64 + c * 8;
                f32x4 h0 = {0.f, 0.f, 0.f, 0.f}, h1 = {0.f, 0.f, 0.f, 0.f};
                if (lane < 8) { h0 = *(const GAS f32x4*)hp; h1 = *(const GAS f32x4*)(hp + 4); }
                float y[8];
#pragma unroll
                for (int q = 0; q < 8; ++q) y[q] = 0.f;
                p8_compute_v(dA, lza + i * 128 + j * 16, y);
                p8_issue(dA, lidx + i1 * 128 + j * 16, rsV, s1 * 128, c16);
                p8_compute_v(dB, lza + i * 128 + j * 16 + 8, y);
#pragma unroll
                for (int q = 0; q < 8; ++q) { float v = y[q]; v += dpp_f(v, 3); v += __shfl_xor(v, 16); v += __shfl_xor(v, 32); y[q] = v; }
                if (lane < 8) {
                    const f32x4 o0 = {y[0] + h0.x, y[1] + h0.y, y[2] + h0.z, y[3] + h0.w}, o1 = {y[4] + h1.x, y[5] + h1.y, y[6] + h1.z, y[7] + h1.w};
                    *(GAS f32x4*)hp = o0; *(GAS f32x4*)(hp + 4) = o1;
                    const float q2 = (o0.x * o0.x + o0.y * o0.y) + (o0.z * o0.z + o0.w * o0.w) + (o1.x * o1.x + o1.y * o1.y) + (o1.z * o1.z + o1.w * o1.w);
                    const float tot = sum8(q2);
                    if (lane == 0) lss[i] += tot;
                }
            }
        }
        VM_WAIT(); __builtin_amdgcn_fence(__ATOMIC_ACQUIRE, "agent"); VM_WAIT(); LDS_WAIT(); asm volatile("" ::: "memory");
#pragma unroll
        for (int i = 0; i < 8; ++i) {
            const float rstd = 1.f / sqrtf(lss[i] * (1.f / D) + EPS);
            float* hr = HOUT + (size_t)(tb + i) * D;
#pragma unroll
            for (int q = 0; q < 4; ++q) { const f32x4 yv = *(const GAS f32x4*)(hr + 256 * q + 4 * lane), gg = *(const GAS f32x4*)(gfin + 256 * q + 4 * lane);
                *(GAS f32x4*)(hr + 256 * q + 4 * lane) = (f32x4){yv.x * rstd * gg.x, yv.y * rstd * gg.y, yv.z * rstd * gg.z, yv.w * rstd * gg.w}; }
        }
        LDS_WAIT(); asm volatile("" ::: "memory");
    }
}
__device__ __forceinline__ void cvt_stream(Frame& F, const float* src, bf16* dst, size_t n) {
    const size_t gt = (size_t)F.vcu * (NWAVES * 64) + F.tid, NT = (size_t)F.G * (NWAVES * 64);
    for (size_t i = gt; i < n / 8; i += NT) { const f32x4 a = *(const GAS f32x4*)(src + 8 * i), b = *(const GAS f32x4*)(src + 8 * i + 4);
        v4u o; o.x = pk2(a.x, a.y); o.y = pk2(a.z, a.w); o.z = pk2(b.x, b.y); o.w = pk2(b.z, b.w); *(GAS v4u*)(dst + 8 * i) = o; }
}

struct Args { const float* in[15]; float* out; unsigned char* ws; int ph_lo, ph_hi; };
__global__ void __launch_bounds__(NWAVES * 64, 2) hyb_fwd(Args args) {
    extern __shared__ __attribute__((aligned(16))) unsigned char lds[];
    Frame F;
    F.lds = (LAS unsigned char*)lds;
    F.MISC = (volatile LAS unsigned*)(F.lds + MISC_OFF);
    F.tid = threadIdx.x; F.lane = F.tid & 63; F.wave = __builtin_amdgcn_readfirstlane(F.tid >> 6);
    F.G = gridDim.x; { const int bx = blockIdx.x; F.vcu = (F.G % 8 == 0) ? (bx % 8) * (F.G / 8) + bx / 8 : bx; }
    unsigned char* ws = args.ws;
    gu32* ctl = (gu32*)(ws + WS_CTL);
    const float* x = args.in[0]; const float* g_mix = args.in[1]; const float* w_in = args.in[2]; const float* conv_w = args.in[3]; const float* w_conv_out = args.in[4];
    const float* pool_w = args.in[5]; const float* pool_scale = args.in[6]; const float* w_pool_out = args.in[7]; const float* w_out = args.in[8]; const float* g_ffn = args.in[9];
    const float* w_query = args.in[10]; const float* sub_keys = args.in[11]; const float* expert_u = args.in[12]; const float* expert_v = args.in[13]; const float* g_fin = args.in[14];
    bf16* WIN = (bf16*)(ws + WS_WIN); bf16* WC = (bf16*)(ws + WS_WC); bf16* WPB = (bf16*)(ws + WS_WPB); bf16* WOUT = (bf16*)(ws + WS_WOUT); bf16* WSC = (bf16*)(ws + WS_WS);
    bf16* XN = (bf16*)(ws + WS_XN); bf16* PB = (bf16*)(ws + WS_PB); bf16* PG = (bf16*)(ws + WS_PG); bf16* TMP = (bf16*)(ws + WS_TMP); bf16* MG = (bf16*)(ws + WS_MG);
    float* SC = (float*)(ws + WS_SC); int* IDX = (int*)(ws + WS_IDX); float* GATE = (float*)(ws + WS_GATE); bf16* U16 = (bf16*)(ws + WS_U16); bf16* V16 = (bf16*)(ws + WS_V16);
    bf16* AIN = (bf16*)args.out; bf16* POOLED = (bf16*)args.out + (size_t)T * D; float* H = args.out;

    for (int u = F.tid; u < (LDS_BYTES - LDSCTL_OFF) / 4; u += NWAVES * 64) ((LAS unsigned*)(F.lds + LDSCTL_OFF))[u] = 0u;
    __syncthreads();
    XcdBarrier bar; bar.bar = (unsigned*)(ctl + CW_BAR); bar.x = 0; bar.st = nullptr;
    if (N_LAUNCHES == 1) bar = xcd_barrier_post((unsigned*)(ctl + CW_BAR), F.MISC + 8);
#define GRID_BAR() do { if (N_LAUNCHES == 1) xcd_barrier(bar); } while (0)
    const int lo = args.ph_lo, hi = args.ph_hi;
#define IN(k) (lo <= (k) && (k) < hi)
#define BOTH(k) (IN(k) && IN((k) + 1))
    const int gw = F.vcu * NWAVES + F.wave, NGW = F.G * NWAVES;

    if (IN(0)) { for (int rep = 0; rep < REPS(0); ++rep) {
        LAS float* sm = (LAS float*)(F.lds + RING_OFF);
        for (int it = blockIdx.x; it < 768; it += F.G) {
            if (it < 256) { const int g = it >> 6, i0 = ((it >> 2) & 15) * 64, j0 = (it & 3) * 64;
                fold_tile(sm, w_pool_out + (size_t)g * 256 * D + i0, 1, D, pool_scale + g * 256, pool_w + (size_t)g * 65536 + (size_t)j0 * 256, 256, 256, WPB + (size_t)i0 * D + g * 256 + j0, D, F.tid);
            } else { const int r = it - 256, hp = r >> 5, i0 = ((r >> 4) & 1) * 64, j0 = (r & 15) * 64;
                fold_tile(sm, sub_keys + (size_t)hp * 16384 + (size_t)i0 * 128, 128, 1, nullptr, w_query + (size_t)j0 * NSC + hp * 128, NSC, 128, WSC + (size_t)(hp * 128 + i0) * D + j0, D, F.tid); }
        }
        __syncthreads();
        LAS float* scr = (LAS float*)(F.lds + RING_OFF + F.wave * 16384);
        constexpr int I_IN = (D / 64) * (NIN / 32), I_SQ = (D / 64) * (D / 32);
        for (int it = gw; it < I_IN + 2 * I_SQ; it += NGW) {
            int r = it;
            if (r < I_IN) { p0_transpose_item(w_in, D, NIN, WIN, scr, r, F.lane); continue; } r -= I_IN;
            if (r < I_SQ) { p0_transpose_item(w_conv_out, D, D, WC, scr, r, F.lane); continue; } r -= I_SQ;
            p0_transpose_item(w_out, D, D, WOUT, scr, r, F.lane);
        }
        for (int m = gw; m < T; m += NGW) rms_row_to_bf16(F.lane, x + (size_t)m * D, g_mix, XN + (size_t)m * D);
        }
        if (BOTH(0)) GRID_BAR();
    }
    if (IN(1)) { for (int rep = 0; rep < REPS(1); ++rep) {
        pg8::Gemm g{XN, WIN, 0l, 0l, T, NIN, D}; pg8::StaticOrder S; S.init(T, NIN, F.G, (int)blockIdx.x);
        pg8::EpiProj E{PB, PG};
        pg8::gemm_phase<pg8::EpiProj, pg8::StaticOrder, true, true>(F.lds + RING_OFF, g, S, E);
        }
        if (BOTH(1)) GRID_BAR();
    }
    if (IN(2)) { for (int rep = 0; rep < REPS(2); ++rep) {
        p2_conv_pool(F, PB, conv_w, AIN, POOLED);
        }
        if (BOTH(2)) GRID_BAR();
    }
    if (IN(3)) { for (int rep = 0; rep < REPS(3); ++rep) {
        pg8::Gemm g{AIN, WC, (long)T * D * 2, (long)(WS_WPB - WS_WC), T, D, D}; pg8::MergeOrder S; S.base.init(T, D, F.G, (int)blockIdx.x);
        pg8::EpiMerge E{PG, TMP, (long)((WS_MG - WS_TMP) / 2)};
        pg8::gemm_phase<pg8::EpiMerge, pg8::MergeOrder, true, true>(F.lds + RING_OFF, g, S, E);
        }
        if (BOTH(3)) GRID_BAR();
    }
    if (IN(4)) { for (int rep = 0; rep < REPS(4); ++rep) {
        pg8::Gemm g{MG, WOUT, 0l, 0l, T, D, D}; pg8::StaticOrder S; S.init(T, D, F.G, (int)blockIdx.x);
        pg8::EpiRes E{x, H};
        pg8::gemm_phase<pg8::EpiRes, pg8::StaticOrder, true, true>(F.lds + RING_OFF, g, S, E);
        cvt_stream(F, expert_u, U16, (size_t)NEXP * D);
        cvt_stream(F, expert_v, V16, (size_t)NEXP * D);
        }
        if (BOTH(4)) GRID_BAR();
    }
    if (IN(5)) { for (int rep = 0; rep < REPS(5); ++rep) {
        for (int m = gw; m < T; m += NGW) rms_row_to_bf16(F.lane, H + (size_t)m * D, g_ffn, XN + (size_t)m * D);
        }
        if (BOTH(5)) GRID_BAR();
    }
    if (IN(6)) { for (int rep = 0; rep < REPS(6); ++rep) {
        pg8::Gemm g{XN, WSC, 0l, 0l, T, NSC, D}; pg8::StaticOrder S; S.init(T, NSC, F.G, (int)blockIdx.x);
        pg8::EpiF32 E{SC, NSC};
        pg8::gemm_phase<pg8::EpiF32, pg8::StaticOrder, true, true>(F.lds + RING_OFF, g, S, E);
        }
        if (BOTH(6)) GRID_BAR();
    }
    if (IN(7)) { for (int rep = 0; rep < REPS(7); ++rep) {
        p7_topk(F, SC, IDX, GATE);
        }
        if (BOTH(7)) GRID_BAR();
    }
    if (IN(8)) {
        p8_peer(F, XN, U16, V16, IDX, GATE, H, g_fin);
    }
#undef IN
#undef BOTH
}

extern "C" void kernel_launch(void* const* d_in, const int* in_sizes, int n_in, void* d_out, int out_size, void* d_ws, size_t ws_size, hipStream_t stream) {
    static int grid = 0;
    if (grid == 0) {
        if (n_in != 15 || in_sizes[0] != T * D || out_size != T * D || ws_size < WS_END) { fprintf(stderr, "kernel_launch: shape/workspace mismatch (n_in %d, in0 %d, out %d, ws %zu)\n", n_in, n_in > 0 ? in_sizes[0] : -1, out_size, ws_size); grid = -1; return; }
        int dev = 0, cus = 0, per_cu = 0;
        if (hipGetDevice(&dev) != hipSuccess || hipDeviceGetAttribute(&cus, hipDeviceAttributeMultiprocessorCount, dev) != hipSuccess) { grid = -1; return; }
        if (hipFuncSetAttribute((const void*)hyb_fwd, hipFuncAttributeMaxDynamicSharedMemorySize, LDS_BYTES) != hipSuccess) { fprintf(stderr, "kernel_launch: hipFuncSetAttribute failed\n"); grid = -1; return; }
        if (hipOccupancyMaxActiveBlocksPerMultiprocessor(&per_cu, (const void*)hyb_fwd, NWAVES * 64, LDS_BYTES) != hipSuccess || per_cu < 1)
            fprintf(stderr, "kernel_launch: note: occupancy query reports %d workgroups per CU\n", per_cu);
        (void)hipGetLastError();
        grid = cus;
    }
    if (grid < 0) return;
    if (hipMemsetAsync((char*)d_ws + WS_CTL, 0, CTL_ZERO_BYTES, stream) != hipSuccess) { fprintf(stderr, "kernel_launch: hipMemsetAsync failed\n"); return; }
    Args a{};
    for (int i = 0; i < 15; ++i) a.in[i] = (const float*)d_in[i];
    a.out = (float*)d_out; a.ws = (unsigned char*)d_ws;
    for (int li = 0; li < N_LAUNCHES; ++li) {
        a.ph_lo = (N_LAUNCHES == 1) ? 0 : li; a.ph_hi = (N_LAUNCHES == 1) ? NPHASE : li + 1;
        hipLaunchKernelGGL(hyb_fwd, dim3(grid), dim3(NWAVES * 64), LDS_BYTES, stream, a);
        const hipError_t le = hipPeekAtLastError();
        if (le != hipSuccess) { fprintf(stderr, "kernel_launch: launch %d failed: %s\n", li, hipGetErrorName(le)); break; }
    }
}
```

```cpp
#include <hip/hip_runtime.h>
#include <cstdio>
#include <cstdint>
namespace pg8 {
#define PG8_LAS __attribute__((address_space(3)))
typedef unsigned short bf16_t;
typedef short bf16x8 __attribute__((ext_vector_type(8)));
typedef float f32x4 __attribute__((ext_vector_type(4)));
typedef unsigned u32x4 __attribute__((ext_vector_type(4)));
constexpr int BM = 256, BK = 64, HALF = 128, HTB = HALF * BK * 2  , STAGE_BYTES = 8 * HTB, NXCD = 8, WGM = 8;

__host__ __device__ __forceinline__ int lds_byte(int r, int c) { const int st = (r >> 4) * 2 + (c >> 5), rr = r & 15, cc = c & 31, ob = rr * 64 + cc * 2; return st * 1024 + (ob ^ (((ob >> 9) & 1) << 5)); }
__host__ __device__ __forceinline__ void stage_rc(int b, int& R, int& C) { const int st = b / 1024, sb = b % 1024, swz = sb ^ (((sb >> 9) & 1) << 5); R = (st >> 1) * 16 + swz / 64; C = (st & 1) * 32 + (swz % 64) / 2; }
__host__ __device__ __forceinline__ int perm32(int rho) { const int n = rho >> 4, i = rho & 15; return 8 * (i >> 2) + 4 * n + (i & 3); }

struct Unit { int pm, pn, sel; };
struct Gemm { const bf16_t* A; const bf16_t* Bt; long offA1, offB1; int M, N, K; };

struct StaticOrder {
    int nM, nN, nwg, G, c;
    __host__ __device__ void init(int M, int N, int G_, int c_) { nM = M / BM; nN = N / BM; nwg = nM * nN; G = G_; c = c_; }
    __host__ __device__ __forceinline__ bool next(int i, Unit& u) const {
        const long L = (long)i * G + c; if (L >= nwg) return false;
        int wgid = (int)L; { const int q = nwg / NXCD, r = nwg % NXCD, xcd = wgid % NXCD, off = wgid / NXCD; wgid = (xcd < r ? xcd * (q + 1) : r * (q + 1) + (xcd - r) * q) + off; }
        const int nig = WGM * nN, gid = wgid / nig, fm = gid * WGM, gsz = (nM - fm) < WGM ? (nM - fm) : WGM;
        u.pm = fm + ((wgid % nig) % gsz); u.pn = (wgid % nig) / gsz; u.sel = 0; return true;
    }
    __device__ __forceinline__ void a_ready(const Unit&) const {}
    __device__ __forceinline__ void done(const Unit&) const {}
};


__device__ __forceinline__ unsigned cvt_pk_bf16(float lo, float hi) { unsigned r; asm volatile("v_cvt_pk_bf16_f32 %0, %1, %2" : "=v"(r) : "v"(lo), "v"(hi)); return r; }
__device__ __forceinline__ float sigm(float x) { return __builtin_amdgcn_rcpf(1.0f + __expf(-x)); }
__device__ __forceinline__ float bflo(unsigned w) { return __uint_as_float(w << 16); }
__device__ __forceinline__ float bfhi(unsigned w) { return __uint_as_float(w & 0xffff0000u); }

struct EpiProj {
    static constexpr bool PERM = true, AFTER_DRAIN = false;
    bf16_t* PB; bf16_t* PG;
    __device__ __forceinline__ void operator()(const f32x4 (&acc)[2][2][4][2], const Unit& u, int wr, int wc, int fr, int fq) const {
        const bool gate = u.pn >= 16;
        bf16_t* base = gate ? PG : PB; const int ldc = gate ? 2048 : 4096; const int colt = (gate ? u.pn - 16 : u.pn) * BM;
        const int row0 = u.pm * BM + wr * 64 + fr, col0 = colt + wc * 32 + 8 * fq;
#pragma unroll
        for (int ai = 0; ai < 2; ++ai)
#pragma unroll
            for (int m = 0; m < 4; ++m) { bf16_t* rowp = base + (size_t)(row0 + ai * HALF + m * 16) * ldc + col0;
#pragma unroll
                for (int bj = 0; bj < 2; ++bj) { f32x4 v0 = acc[ai][bj][m][0], v1 = acc[ai][bj][m][1];
                    if (gate) { v0[0] = sigm(v0[0]); v0[1] = sigm(v0[1]); v0[2] = sigm(v0[2]); v0[3] = sigm(v0[3]); v1[0] = sigm(v1[0]); v1[1] = sigm(v1[1]); v1[2] = sigm(v1[2]); v1[3] = sigm(v1[3]); }
                    u32x4 w; w.x = cvt_pk_bf16(v0[0], v0[1]); w.y = cvt_pk_bf16(v0[2], v0[3]); w.z = cvt_pk_bf16(v1[0], v1[1]); w.w = cvt_pk_bf16(v1[2], v1[3]);
                    *(u32x4*)(rowp + bj * HALF) = w; } }
    }
};
struct EpiMerge {
    static constexpr bool PERM = true, AFTER_DRAIN = false;
    const bf16_t* PG; bf16_t* TMP; long mg_off;
    __device__ __forceinline__ void operator()(const f32x4 (&acc)[2][2][4][2], const Unit& u, int wr, int wc, int fr, int fq) const {
        const int row0 = u.pm * BM + wr * 64 + fr, col0 = u.pn * BM + wc * 32 + 8 * fq; const int goff = u.sel ? 1024 : 0;
#pragma unroll
        for (int ai = 0; ai < 2; ++ai)
#pragma unroll
            for (int m = 0; m < 4; ++m) { const size_t row = (size_t)(row0 + ai * HALF + m * 16);
#pragma unroll
                for (int bj = 0; bj < 2; ++bj) { const int col = col0 + bj * HALF;
                    const u32x4 g = *(const u32x4*)(PG + row * 2048 + goff + col);
                    const f32x4 v0 = acc[ai][bj][m][0], v1 = acc[ai][bj][m][1];
                    float o0 = v0[0] * bflo(g.x), o1 = v0[1] * bfhi(g.x), o2 = v0[2] * bflo(g.y), o3 = v0[3] * bfhi(g.y);
                    float o4 = v1[0] * bflo(g.z), o5 = v1[1] * bfhi(g.z), o6 = v1[2] * bflo(g.w), o7 = v1[3] * bfhi(g.w);
                    if (u.sel) { const u32x4 t = *(const u32x4*)(TMP + row * 1024 + col);
                        o0 += bflo(t.x); o1 += bfhi(t.x); o2 += bflo(t.y); o3 += bfhi(t.y); o4 += bflo(t.z); o5 += bfhi(t.z); o6 += bflo(t.w); o7 += bfhi(t.w); }
                    u32x4 w; w.x = cvt_pk_bf16(o0, o1); w.y = cvt_pk_bf16(o2, o3); w.z = cvt_pk_bf16(o4, o5); w.w = cvt_pk_bf16(o6, o7);
                    *(u32x4*)(TMP + (u.sel ? mg_off : 0l) + row * 1024 + col) = w; } }
    }
};
struct EpiRes {
    static constexpr bool PERM = false, AFTER_DRAIN = false;
    const float* X; float* H;
    __device__ __forceinline__ void operator()(const f32x4 (&acc)[2][2][4][2], const Unit& u, int wr, int wc, int fr, int fq) const {
        const int row0 = u.pm * BM + wr * 64 + fr, col0 = u.pn * BM + wc * 32 + 4 * fq;
#pragma unroll
        for (int ai = 0; ai < 2; ++ai)
#pragma unroll
            for (int m = 0; m < 4; ++m) { const size_t off = (size_t)(row0 + ai * HALF + m * 16) * 1024 + col0;
#pragma unroll
                for (int bj = 0; bj < 2; ++bj)
#pragma unroll
                    for (int n = 0; n < 2; ++n) { const f32x4 xv = *(const f32x4*)(X + off + bj * HALF + n * 16); *(f32x4*)(H + off + bj * HALF + n * 16) = xv + acc[ai][bj][m][n]; } }
    }
};
struct EpiF32 {
    static constexpr bool PERM = false, AFTER_DRAIN = false;
    float* C; int ldc;
    __device__ __forceinline__ void operator()(const f32x4 (&acc)[2][2][4][2], const Unit& u, int wr, int wc, int fr, int fq) const {
        const int row0 = u.pm * BM + wr * 64 + fr, col0 = u.pn * BM + wc * 32 + 4 * fq;
#pragma unroll
        for (int ai = 0; ai < 2; ++ai)
#pragma unroll
            for (int m = 0; m < 4; ++m) { float* rowp = C + (size_t)(row0 + ai * HALF + m * 16) * ldc + col0;
#pragma unroll
                for (int bj = 0; bj < 2; ++bj)
#pragma unroll
                    for (int n = 0; n < 2; ++n) *(f32x4*)(rowp + bj * HALF + n * 16) = acc[ai][bj][m][n]; }
    }
};
struct MergeOrder {
    StaticOrder base;
    __device__ __forceinline__ bool next(int i, Unit& u) const { if (!base.next(i >> 1, u)) return false; u.sel = i & 1; return true; }
    __device__ __forceinline__ void a_ready(const Unit&) const {}
    __device__ __forceinline__ void done(const Unit&) const {}
};

template <class Epi, class Sched, bool ALIGN_EPI = false, bool SP2 = false>
__device__ __forceinline__ void gemm_phase(PG8_LAS unsigned char* lds, const Gemm g, const Sched& S, const Epi& E) {
    const int tid = threadIdx.x, wid = __builtin_amdgcn_readfirstlane(tid >> 6), lane = tid & 63, wr = wid >> 2, wc = wid & 3, fr = lane & 15, fq = lane >> 4;
    const int K = g.K, nt = K / BK;
    unsigned voffA[2], voffB[2];
#pragma unroll
    for (int i = 0; i < 2; ++i) { int R, C; stage_rc(tid * 16 + i * 8192, R, C); const int Rb = Epi::PERM ? ((R & ~31) + perm32(R & 31)) : R;
        voffA[i] = (unsigned)(R * K + C) * 2u; voffB[i] = (unsigned)(Rb * K + C) * 2u; }
    const size_t kstep = (size_t)(BK * 2);
    const size_t hstep = (size_t)HALF * K * 2;
    const size_t tstep = 2 * hstep;
    const unsigned ldsw = (unsigned)wid * 1024u;
    const int aoff = lds_byte(wr * 64 + fr, fq * 8), boff = lds_byte(wc * 32 + fr, fq * 8);
#define PG8_SA(b, h) (((b) * 2 + (h)) * HTB)
#define PG8_SB(b, h) ((4 + (b) * 2 + (h)) * HTB)
#define PG8_STAGE(bufoff, gbase, voff) do { _Pragma("unroll") for (int _i = 0; _i < 2; ++_i) \
        __builtin_amdgcn_global_load_lds((const unsigned*)((const char*)(gbase) + (voff)[_i]), (PG8_LAS unsigned*)(lds + (bufoff) + ldsw + _i * 8192), 16, 0, 0); } while (0)
#define PG8_LDA(dst, b, h) do { _Pragma("unroll") for (int m = 0; m < 4; ++m) _Pragma("unroll") for (int k = 0; k < 2; ++k) dst[m][k] = *(const PG8_LAS bf16x8*)(lds + PG8_SA(b, h) + aoff + m * 2048 + k * 1024); } while (0)
#define PG8_LDB(dst, b, h) do { _Pragma("unroll") for (int n = 0; n < 2; ++n) _Pragma("unroll") for (int k = 0; k < 2; ++k) dst[n][k] = *(const PG8_LAS bf16x8*)(lds + PG8_SB(b, h) + boff + n * 2048 + k * 1024); } while (0)
#define PG8_MMA(ai, bj, At, Bt) do { __builtin_amdgcn_s_setprio(1); _Pragma("unroll") for (int m = 0; m < 4; ++m) _Pragma("unroll") for (int n = 0; n < 2; ++n) _Pragma("unroll") for (int k = 0; k < 2; ++k) \
        acc[ai][bj][m][n] = __builtin_amdgcn_mfma_f32_16x16x32_bf16(Bt[n][k], At[m][k], acc[ai][bj][m][n], 0, 0, 0); __builtin_amdgcn_s_setprio(0); } while (0)
#define PG8_WAIT_V(n) asm volatile("s_waitcnt vmcnt(" #n ")" ::: "memory")
#define PG8_WAIT_L(n) asm volatile("s_waitcnt lgkmcnt(" #n ")" ::: "memory")
#define PG8_BAR __builtin_amdgcn_s_barrier()
#define PG8_SCHED __builtin_amdgcn_sched_barrier(0)
    Unit cur, nxt; int ui = 0;
    if (!S.next(0, cur)) return;
    f32x4 acc[2][2][4][2];
#pragma unroll
    for (int a = 0; a < 2; ++a)
#pragma unroll
        for (int b = 0; b < 2; ++b)
#pragma unroll
            for (int m = 0; m < 4; ++m)
#pragma unroll
                for (int n = 0; n < 2; ++n) acc[a][b][m][n] = (f32x4){0.f, 0.f, 0.f, 0.f};
    bf16x8 At[4][2], B0[2][2], B1[2][2];
    const char* cA = (const char*)g.A + (cur.sel ? g.offA1 : 0l) + (size_t)cur.pm * tstep; const char* cB = (const char*)g.Bt + (cur.sel ? g.offB1 : 0l) + (size_t)cur.pn * tstep;
    S.a_ready(cur);
    if constexpr (SP2) {
        PG8_STAGE(PG8_SB(0, 0), cB, voffB); PG8_STAGE(PG8_SB(0, 1), cB + hstep, voffB); PG8_STAGE(PG8_SA(0, 0), cA, voffA); PG8_STAGE(PG8_SA(0, 1), cA + hstep, voffA);
        if (wr == 1) PG8_BAR;
        PG8_WAIT_V(2); PG8_BAR;
        PG8_STAGE(PG8_SB(1, 0), cB + kstep, voffB); PG8_STAGE(PG8_SA(1, 0), cA + kstep, voffA); PG8_STAGE(PG8_SB(1, 1), cB + hstep + kstep, voffB);
        PG8_WAIT_V(6); PG8_BAR;
    } else {
        PG8_STAGE(PG8_SB(0, 0), cB, voffB); PG8_STAGE(PG8_SA(0, 0), cA, voffA); PG8_STAGE(PG8_SB(0, 1), cB + hstep, voffB); PG8_STAGE(PG8_SA(0, 1), cA + hstep, voffA);
        if (wr == 1) PG8_BAR;
        PG8_WAIT_V(4); PG8_BAR;
        PG8_STAGE(PG8_SB(1, 0), cB + kstep, voffB); PG8_STAGE(PG8_SA(1, 0), cA + kstep, voffA); PG8_STAGE(PG8_SB(1, 1), cB + hstep + kstep, voffB);
        PG8_WAIT_V(6); PG8_BAR;
    }
    for (;;) {
        const bool has_next = S.next(ui + 1, nxt);
        const char* nA = has_next ? (const char*)g.A + (nxt.sel ? g.offA1 : 0l) + (size_t)nxt.pm * tstep : cA; const char* nB = has_next ? (const char*)g.Bt + (nxt.sel ? g.offB1 : 0l) + (size_t)nxt.pn * tstep : cB;
        for (int t = 0; t < nt; t += 2) {
            const bool last = (t == nt - 2);
            const char* a1 = cA + (size_t)(t + 1) * kstep;
            const char* a2 = last ? nA : cA + (size_t)(t + 2) * kstep; const char* b2 = last ? nB : cB + (size_t)(t + 2) * kstep;
            const char* a3 = a2 + kstep; const char* b3 = b2 + kstep;
            if (last && has_next) S.a_ready(nxt);
            if constexpr (SP2) {
            PG8_LDB(B0, 0, 0); PG8_LDB(B1, 0, 1); PG8_SCHED; PG8_LDA(At, 0, 0); PG8_STAGE(PG8_SA(1, 1), a1 + hstep, voffA);
            PG8_WAIT_V(8); PG8_WAIT_L(0); PG8_BAR; PG8_MMA(0, 0, At, B0); PG8_MMA(0, 1, At, B1); PG8_BAR; PG8_SCHED;
            PG8_LDA(At, 0, 1); PG8_STAGE(PG8_SB(0, 0), b2, voffB); PG8_STAGE(PG8_SB(0, 1), b2 + hstep, voffB); PG8_STAGE(PG8_SA(0, 0), a2, voffA);
            PG8_WAIT_V(8); PG8_WAIT_L(0); PG8_BAR; PG8_MMA(1, 0, At, B0); PG8_MMA(1, 1, At, B1); PG8_BAR; PG8_SCHED;
            PG8_LDB(B0, 1, 0); PG8_LDB(B1, 1, 1); PG8_SCHED; PG8_LDA(At, 1, 0); PG8_STAGE(PG8_SA(0, 1), a2 + hstep, voffA);
            PG8_WAIT_V(8); PG8_WAIT_L(0); PG8_BAR; PG8_MMA(0, 0, At, B0); PG8_MMA(0, 1, At, B1); PG8_BAR; PG8_SCHED;
            PG8_LDA(At, 1, 1); PG8_STAGE(PG8_SB(1, 0), b3, voffB); PG8_STAGE(PG8_SB(1, 1), b3 + hstep, voffB); PG8_STAGE(PG8_SA(1, 0), a3, voffA);
            PG8_WAIT_V(8); PG8_WAIT_L(0); PG8_BAR; PG8_MMA(1, 0, At, B0); PG8_MMA(1, 1, At, B1); PG8_BAR; PG8_SCHED;
            } else {
            PG8_LDB(B0, 0, 0); PG8_SCHED; PG8_LDA(At, 0, 0); PG8_STAGE(PG8_SA(1, 1), a1 + hstep, voffA);
            PG8_WAIT_L(8); PG8_BAR; PG8_WAIT_L(0); PG8_MMA(0, 0, At, B0); PG8_BAR; PG8_SCHED;
            PG8_LDB(B1, 0, 1); PG8_STAGE(PG8_SB(0, 0), b2, voffB);
            PG8_BAR; PG8_WAIT_L(0); PG8_MMA(0, 1, At, B1); PG8_BAR;
            PG8_LDA(At, 0, 1); PG8_STAGE(PG8_SA(0, 0), a2, voffA);
            PG8_BAR; PG8_WAIT_L(0); PG8_MMA(1, 0, At, B0); PG8_BAR; PG8_SCHED;
            PG8_STAGE(PG8_SB(0, 1), b2 + hstep, voffB);
            PG8_WAIT_V(6); PG8_BAR; PG8_MMA(1, 1, At, B1); PG8_BAR;
            PG8_LDB(B0, 1, 0); PG8_SCHED; PG8_LDA(At, 1, 0); PG8_STAGE(PG8_SA(0, 1), a2 + hstep, voffA);
            PG8_WAIT_L(8); PG8_BAR; PG8_WAIT_L(0); PG8_MMA(0, 0, At, B0); PG8_BAR; PG8_SCHED;
            PG8_LDB(B1, 1, 1); PG8_STAGE(PG8_SB(1, 0), b3, voffB);
            PG8_BAR; PG8_WAIT_L(0); PG8_MMA(0, 1, At, B1); PG8_BAR;
            PG8_LDA(At, 1, 1); PG8_STAGE(PG8_SA(1, 0), a3, voffA);
            PG8_BAR; PG8_WAIT_L(0); PG8_MMA(1, 0, At, B0); PG8_BAR; PG8_SCHED;
            PG8_STAGE(PG8_SB(1, 1), b3 + hstep, voffB);
            PG8_WAIT_V(6); PG8_BAR; PG8_MMA(1, 1, At, B1); PG8_BAR;
            }
        }
        if constexpr (ALIGN_EPI) { if (wr == 0) PG8_BAR; }
        if constexpr (!Epi::AFTER_DRAIN) { E(acc, cur, wr, wc, fr, fq); S.done(cur); }
        if (!has_next) break;
#pragma unroll
        for (int a = 0; a < 2; ++a)
#pragma unroll
            for (int b = 0; b < 2; ++b)
#pragma unroll
                for (int m = 0; m < 4; ++m)
#pragma unroll
                    for (int n = 0; n < 2; ++n) acc[a][b][m][n] = (f32x4){0.f, 0.f, 0.f, 0.f};
        cur = nxt; cA = nA; cB = nB; ++ui;
        if constexpr (ALIGN_EPI) { if (wr == 1) PG8_BAR; }
    }
    PG8_WAIT_V(0);
    if constexpr (!ALIGN_EPI) { if (wr == 0) PG8_BAR; }
    PG8_BAR;
    if constexpr (Epi::AFTER_DRAIN) { E.fused(acc, cur, wr, wc, fr, fq, lds, wid, lane); S.done(cur); }
#undef PG8_SA
#undef PG8_SB
#undef PG8_STAGE
#undef PG8_LDA
#undef PG8_LDB
#undef PG8_MMA
#undef PG8_WAIT_V
#undef PG8_WAIT_L
#undef PG8_BAR
#undef PG8_SCHED
}
}
constexpr int NWAVES = 8;
#ifndef MK_N_LAUNCHES
#define MK_N_LAUNCHES 1
#endif
constexpr int NPHASE = 9;
#ifndef PROBE_DUP
#define PROBE_DUP 0
#endif
#define REPS(k) (1 + ((PROBE_DUP >> (k)) & 1))
constexpr int N_LAUNCHES = MK_N_LAUNCHES;
static_assert(N_LAUNCHES == 1 || N_LAUNCHES == NPHASE, "MK_N_LAUNCHES is 1 or NPHASE");

constexpr int T = 16384, SEQ = 2048, D = 1024, NIN = 6144, NSC = 2048, NEXP = 16384, NSEL = 128;
constexpr float EPS = 1e-6f;

constexpr size_t MiB = 1u << 20;
constexpr size_t WS_CTL = 0, CTL_ZERO_BYTES = 64 * 1024;
constexpr size_t WS_WIN = 1 * MiB, WS_WC = 13 * MiB, WS_WPB = 15 * MiB, WS_WOUT = 17 * MiB, WS_WS = 19 * MiB;
constexpr size_t WS_IDX = 1 * MiB, WS_GATE = 9 * MiB;
constexpr size_t WS_XN = 32 * MiB;
constexpr size_t WS_PB = 64 * MiB;
constexpr size_t WS_TMP = 64 * MiB, WS_MG = 96 * MiB;
constexpr size_t WS_SC = 64 * MiB;
constexpr size_t WS_PG = 192 * MiB;
constexpr size_t WS_U8 = 192 * MiB, WS_V8 = 208 * MiB, WS_SU = 224 * MiB, WS_SV = 225 * MiB;
constexpr size_t WS_END = 256 * MiB;
constexpr int CW_BAR = 1024;

constexpr int RING_OFF = 0, RING_BYTES = 131072;
constexpr int LDSCTL_OFF = RING_BYTES, MISC_OFF = LDSCTL_OFF + 320;
constexpr int LDS_BYTES = 147456;
#define GAS __attribute__((address_space(1)))
#define LAS __attribute__((address_space(3)))
typedef unsigned short bf16;
typedef unsigned v4u __attribute__((ext_vector_type(4)));
typedef float f32x4 __attribute__((ext_vector_type(4)));
typedef short bf16x8 __attribute__((ext_vector_type(8)));
typedef GAS unsigned gu32;
typedef GAS unsigned long long gu64;
#define RLX_AGENT __ATOMIC_RELAXED, __HIP_MEMORY_SCOPE_AGENT
#define LDS_WAIT() asm volatile("s_waitcnt lgkmcnt(0)" ::: "memory")
#define VM_WAIT() asm volatile("s_waitcnt vmcnt(0)" ::: "memory")
__device__ __forceinline__ unsigned long long rt() { return __builtin_amdgcn_s_memrealtime(); }
__device__ __forceinline__ unsigned f2bf(float f) { unsigned u = __builtin_bit_cast(unsigned, f); return (u + 0x7fffu + ((u >> 16) & 1u)) >> 16; }
__device__ __forceinline__ unsigned pk2(float lo, float hi) { return f2bf(lo) | (f2bf(hi) << 16); }

#define XB_TMO      128
#define XB_XCNT(j)  (256  + 64 * (j))
#define XB_XSUB(j)  (1280 + 64 * (j))
#define XB_XGEN(j)  (2304 + 64 * (j))
#define XB_TOP      3328
#define XB_TOPGEN   3392
#define XCD_BAR_WORDS 3456
#define XB_SPIN_CAP (1u << 18)

__device__ __forceinline__ unsigned xb_ld(unsigned* p)              { return __hip_atomic_load(p, __ATOMIC_RELAXED, __HIP_MEMORY_SCOPE_AGENT); }
__device__ __forceinline__ unsigned xb_add(unsigned* p, unsigned v) { return __hip_atomic_fetch_add(p, v, __ATOMIC_RELAXED, __HIP_MEMORY_SCOPE_AGENT); }
__device__ __forceinline__ unsigned xb_xcc_id() { return (unsigned)__builtin_amdgcn_s_getreg((3 << 11) | 20) & 0xFu; }
#define XB_SPIN(cond, bar) do { unsigned _sp = 0; while (cond) { __builtin_amdgcn_s_sleep(1); \
    if ((++_sp & 255u) == 0u) { if (xb_ld(&(bar)[XB_TMO])) break; if (_sp > XB_SPIN_CAP) { atomicAdd(&(bar)[XB_TMO], 1u); break; } } } } while (0)

struct XcdBarrier {
    unsigned* bar; unsigned x;
    volatile LAS unsigned* st;
};

__device__ __forceinline__ XcdBarrier xcd_barrier_post(unsigned* bar, volatile LAS unsigned* st) {
    XcdBarrier b; b.bar = bar; b.x = xb_xcc_id(); b.st = st;
    if (threadIdx.x == 0) (void)xb_add(&bar[XB_XCNT(b.x)], 1u);
    return b;
}
__device__ __forceinline__ void xcd_barrier_complete(unsigned* bar, unsigned x, unsigned& nloc, unsigned& nx) {
    const unsigned G = gridDim.x * gridDim.y * gridDim.z;
    unsigned sum, cnt, mine, sp = 0u;
    for (;;) {
        sum = 0u; cnt = 0u; mine = 0u;
#pragma unroll
        for (unsigned j = 0; j < 16; ++j) { const unsigned c = xb_ld(&bar[XB_XCNT(j)]); sum += c; cnt += (c > 0u) ? 1u : 0u; mine = (j == x) ? c : mine; }
        if (sum == G) break;
        __builtin_amdgcn_s_sleep(1);
        if ((++sp & 255u) == 0u) { if (xb_ld(&bar[XB_TMO])) break; if (sp > XB_SPIN_CAP) { atomicAdd(&bar[XB_TMO], 1u); break; } }
    }
    nloc = mine > 0u ? mine : 1u; nx = cnt > 0u ? cnt : 1u;
}

__device__ __forceinline__ void xcd_barrier(const XcdBarrier& b) {
    asm volatile("s_waitcnt vmcnt(0)" ::: "memory");
    __syncthreads();
    if (threadIdx.x == 0) {
        unsigned* bar = b.bar;
        __builtin_amdgcn_s_waitcnt(0);
        unsigned nloc = b.st[0], nx = b.st[1];
        if (nloc == 0u) { xcd_barrier_complete(bar, b.x, nloc, nx); b.st[0] = nloc; b.st[1] = nx; }
        const unsigned old = xb_add(&bar[XB_XSUB(b.x)], 1u);
        const unsigned gen = old / nloc;
        if (old + 1u == (gen + 1u) * nloc) {
            __builtin_amdgcn_fence(__ATOMIC_RELEASE, "agent");
            asm volatile("s_waitcnt vmcnt(0)" ::: "memory");
            const unsigned og = xb_add(&bar[XB_TOP], 1u);
            const unsigned tg = og / nx;
            if (og + 1u == (tg + 1u) * nx) xb_add(&bar[XB_TOPGEN], 1u);
            else XB_SPIN(xb_ld(&bar[XB_TOPGEN]) == tg, bar);
            __builtin_amdgcn_fence(__ATOMIC_ACQUIRE, "agent");
            xb_add(&bar[XB_XGEN(b.x)], 1u);
            asm volatile("s_waitcnt vmcnt(0)" ::: "memory");
        } else {
            XB_SPIN(xb_ld(&bar[XB_XGEN(b.x)]) == gen, bar);
            __builtin_amdgcn_fence(__ATOMIC_ACQUIRE, "agent");
            asm volatile("s_waitcnt vmcnt(0)" ::: "memory");
        }
    }
    __syncthreads();
}

struct Frame {
    LAS unsigned char* lds;
    volatile LAS unsigned* MISC;
    int tid, lane, wave;
    int vcu, G;
};
__device__ __forceinline__ float wave_sum(float v) {
#pragma unroll
    for (int o = 1; o < 64; o <<= 1) v += __shfl_xor(v, o);
    return v;
}
__device__ __forceinline__ float bflo(unsigned w) { return __uint_as_float(w << 16); }
__device__ __forceinline__ float bfhi(unsigned w) { return __uint_as_float(w & 0xffff0000u); }
__device__ __forceinline__ void unpack8(const v4u w, float (&f)[8]) { f[0] = bflo(w.x); f[1] = bfhi(w.x); f[2] = bflo(w.y); f[3] = bfhi(w.y); f[4] = bflo(w.z); f[5] = bfhi(w.z); f[6] = bflo(w.w); f[7] = bfhi(w.w); }
__device__ __forceinline__ v4u pack8(const float (&f)[8]) { v4u o; o.x = pk2(f[0], f[1]); o.y = pk2(f[2], f[3]); o.z = pk2(f[4], f[5]); o.w = pk2(f[6], f[7]); return o; }

__device__ __forceinline__ void p0_transpose_item(const float* W, int K, int N, bf16* WT, LAS float* scr, int item, int lane) {
    const int nblk = N / 32, kb = item / nblk, nb = item % nblk, k0 = 64 * kb, n0 = 32 * nb;
#pragma unroll 8
    for (int i = 0; i < 32; ++i) { const int kk = 2 * i + (lane >> 5); scr[kk * 33 + (lane & 31)] = W[(size_t)(k0 + kk) * N + n0 + (lane & 31)]; }
    LDS_WAIT(); asm volatile("" ::: "memory");
    const int c = lane & 7;
#pragma unroll
    for (int j = 0; j < 4; ++j) { const int n = (lane >> 3) + 8 * j; const LAS float* s = scr + (8 * c) * 33 + n;
        v4u o; o.x = pk2(s[0 * 33], s[1 * 33]); o.y = pk2(s[2 * 33], s[3 * 33]); o.z = pk2(s[4 * 33], s[5 * 33]); o.w = pk2(s[6 * 33], s[7 * 33]);
        *(GAS v4u*)(WT + (size_t)(n0 + n) * K + k0 + 8 * c) = o; }
    LDS_WAIT(); asm volatile("" ::: "memory");
}
__device__ __forceinline__ void fold_tile(LAS float* sm, const float* Ap, int sAi, int sAk, const float* As, const float* Bp, int sBj, int K, bf16* Cp, int ldc, int tid) {
    LAS float* sA = sm; LAS float* sB = sm + 32 * 65;
    float acc[8];
#pragma unroll
    for (int q = 0; q < 8; ++q) acc[q] = 0.f;
    const int tj = tid & 63, ti0 = tid >> 6;
    for (int k0 = 0; k0 < K; k0 += 32) {
#pragma unroll
        for (int r = 0; r < 4; ++r) { const int e = tid + 512 * r; int i, k;
            if (sAk == 1) { k = e & 31; i = e >> 5; } else { i = e & 63; k = e >> 6; }
            float a = Ap[(size_t)i * sAi + (size_t)(k0 + k) * sAk]; if (As) a *= As[k0 + k];
            sA[k * 65 + i] = a;
            const int kb = e & 31, jb = e >> 5;
            sB[kb * 65 + jb] = Bp[(size_t)jb * sBj + k0 + kb]; }
        __syncthreads();
#pragma unroll 4
        for (int k = 0; k < 32; ++k) { const float b = sB[k * 65 + tj];
#pragma unroll
            for (int q = 0; q < 8; ++q) acc[q] += sA[k * 65 + ti0 + 8 * q] * b; }
        __syncthreads();
    }
#pragma unroll
    for (int q = 0; q < 8; ++q) Cp[(size_t)(ti0 + 8 * q) * ldc + tj] = (bf16)f2bf(acc[q]);
}
__device__ __forceinline__ void rms_row_to_bf16(int lane, const float* xrow, const float* g, bf16* orow) {
    const GAS f32x4* xr = (const GAS f32x4*)xrow + lane; const GAS f32x4* gr = (const GAS f32x4*)g + lane;
    f32x4 v[4]; float s = 0.f;
#pragma unroll
    for (int j = 0; j < 4; ++j) { v[j] = xr[64 * j]; s += (v[j].x * v[j].x + v[j].y * v[j].y) + (v[j].z * v[j].z + v[j].w * v[j].w); }
    const float rstd = 1.f / sqrtf(wave_sum(s) * (1.f / D) + EPS);
    GAS unsigned long long* o8 = (GAS unsigned long long*)orow + lane;
#pragma unroll
    for (int j = 0; j < 4; ++j) { const f32x4 gg = gr[64 * j];
        o8[64 * j] = (unsigned long long)pk2(v[j].x * rstd * gg.x, v[j].y * rstd * gg.y) | ((unsigned long long)pk2(v[j].z * rstd * gg.z, v[j].w * rstd * gg.w) << 32); }
}
__device__ __forceinline__ void p2_conv_pool(Frame& F, const bf16* PB, const float* conv_w, bf16* AIN, bf16* POOLED) {
    const int gt = F.vcu * (NWAVES * 64) + F.tid, NT = F.G * (NWAVES * 64);
    for (int it = gt; it < (T / 16) * (D / 8); it += NT) {
        const int cv = it & 127, rc = it >> 7, col = cv * 8, t0 = rc * 16, s0 = t0 & (SEQ - 1);
        float w0[8], w1[8], w2[8];
        { const f32x4 a = *(const GAS f32x4*)(conv_w + col), b = *(const GAS f32x4*)(conv_w + col + 4); w0[0] = a.x; w0[1] = a.y; w0[2] = a.z; w0[3] = a.w; w0[4] = b.x; w0[5] = b.y; w0[6] = b.z; w0[7] = b.w; }
        { const f32x4 a = *(const GAS f32x4*)(conv_w + D + col), b = *(const GAS f32x4*)(conv_w + D + col + 4); w1[0] = a.x; w1[1] = a.y; w1[2] = a.z; w1[3] = a.w; w1[4] = b.x; w1[5] = b.y; w1[6] = b.z; w1[7] = b.w; }
        { const f32x4 a = *(const GAS f32x4*)(conv_w + 2 * D + col), b = *(const GAS f32x4*)(conv_w + 2 * D + col + 4); w2[0] = a.x; w2[1] = a.y; w2[2] = a.z; w2[3] = a.w; w2[4] = b.x; w2[5] = b.y; w2[6] = b.z; w2[7] = b.w; }
        float um2[8], um1[8];
#pragma unroll
        for (int i = 0; i < 8; ++i) { um2[i] = 0.f; um1[i] = 0.f; }
        if (s0 != 0) {
            float c[8], h[8];
            unpack8(*(const GAS v4u*)(PB + (size_t)(t0 - 2) * 4096 + 1024 + col), c); unpack8(*(const GAS v4u*)(PB + (size_t)(t0 - 2) * 4096 + 2048 + col), h);
#pragma unroll
            for (int i = 0; i < 8; ++i) um2[i] = c[i] * h[i];
            unpack8(*(const GAS v4u*)(PB + (size_t)(t0 - 1) * 4096 + 1024 + col), c); unpack8(*(const GAS v4u*)(PB + (size_t)(t0 - 1) * 4096 + 2048 + col), h);
#pragma unroll
            for (int i = 0; i < 8; ++i) um1[i] = c[i] * h[i];
        }
        for (int r = 0; r < 16; ++r) {
            const size_t rowb = (size_t)(t0 + r) * 4096;
            float b[8], c[8], h[8], o[8];
            unpack8(*(const GAS v4u*)(PB + rowb + col), b); unpack8(*(const GAS v4u*)(PB + rowb + 1024 + col), c); unpack8(*(const GAS v4u*)(PB + rowb + 2048 + col), h);
#pragma unroll
            for (int i = 0; i < 8; ++i) { const float u = c[i] * h[i]; o[i] = b[i] * (w0[i] * um2[i] + w1[i] * um1[i] + w2[i] * u); um2[i] = um1[i]; um1[i] = u; }
            *(GAS v4u*)(AIN + (size_t)(t0 + r) * D + col) = pack8(o);
        }
        const int win = 2 << (col >> 8);
        for (int r = 0; r < 16; ++r) {
            const int t = t0 + r, s = s0 + r;
            float p0[8], sum[8], o[8];
            unpack8(*(const GAS v4u*)(PB + (size_t)t * 4096 + 3072 + col), p0);
#pragma unroll
            for (int i = 0; i < 8; ++i) sum[i] = p0[i];
            const int nb = (s < win - 1) ? s : (win - 1);
            for (int j = 1; j <= nb; ++j) { float pj[8]; unpack8(*(const GAS v4u*)(PB + (size_t)(t - j) * 4096 + 3072 + col), pj);
#pragma unroll
                for (int i = 0; i < 8; ++i) sum[i] += pj[i]; }
            const float inv = 1.0f / (float)(nb + 1);
#pragma unroll
            for (int i = 0; i < 8; ++i) o[i] = sum[i] * inv - p0[i];
            *(GAS v4u*)(POOLED + (size_t)t * D + col) = pack8(o);
        }
    }
}

typedef int v4i __attribute__((ext_vector_type(4)));
__device__ __forceinline__ unsigned fkey(float f) { const unsigned u = __float_as_uint(f); return (u & 0x80000000u) ? ~u : (u | 0x80000000u); }
__device__ __forceinline__ float fkey_inv(unsigned k) { return __uint_as_float((k & 0x80000000u) ? (k & 0x7fffffffu) : ~k); }
__device__ __forceinline__ void ce_desc(unsigned& a, unsigned& b) { const unsigned hi = a > b ? a : b, lo = a > b ? b : a; a = hi; b = lo; }
template <int K, int J> __device__ __forceinline__ void bitonic_stage(unsigned (&a)[16]) {
#pragma unroll
    for (int i = 0; i < 16; ++i) { const int l = i ^ J; if (l > i) { if ((i & K) == 0) ce_desc(a[i], a[l]); else ce_desc(a[l], a[i]); } }
}
__device__ __forceinline__ void bitonic_merge16(unsigned (&a)[16]) { bitonic_stage<16, 8>(a); bitonic_stage<16, 4>(a); bitonic_stage<16, 2>(a); bitonic_stage<16, 1>(a); }
__device__ __forceinline__ void bitonic_sort16(unsigned (&a)[16]) {
    bitonic_stage<2, 1>(a); bitonic_stage<4, 2>(a); bitonic_stage<4, 1>(a); bitonic_stage<8, 4>(a); bitonic_stage<8, 2>(a); bitonic_stage<8, 1>(a); bitonic_merge16(a);
}
__device__ __forceinline__ void top16_merge(unsigned (&top)[16], unsigned (&ch)[16]) {
#pragma unroll
    for (int i = 0; i < 16; ++i) top[i] = top[i] > ch[15 - i] ? top[i] : ch[15 - i];
    bitonic_merge16(top);
}
__device__ __forceinline__ void p7_topk(Frame& F, const float* SC, int* IDX, float* GATE) {
    constexpr int RS = 36;
    LAS float* stg = (LAS float*)(F.lds + RING_OFF + F.wave * 9216);
    const int gw = F.vcu * NWAVES + F.wave, NGW = F.G * NWAVES, lane = F.lane, r8 = lane >> 3, c = lane & 7;
    for (int batch = gw; batch < T / 8; batch += NGW) {
        const float* base = SC + (size_t)batch * (8 * NSC);
        unsigned top[16], top1[16];
#pragma unroll
        for (int i = 0; i < 16; ++i) { top[i] = 0u; top1[i] = 0u; }
        f32x4 ld[8];
#pragma unroll
        for (int q = 0; q < 8; ++q) ld[q] = *(const GAS f32x4*)(base + (size_t)(8 * q + r8) * 256 + c * 4);
        for (int ch = 0; ch < 8; ++ch) {
#pragma unroll
            for (int q = 0; q < 8; ++q) *(LAS f32x4*)(stg + (8 * q + r8) * RS + c * 4) = ld[q];
            if (ch < 7) {
#pragma unroll
                for (int q = 0; q < 8; ++q) ld[q] = *(const GAS f32x4*)(base + (size_t)(8 * q + r8) * 256 + (ch + 1) * 32 + c * 4);
            }
            LDS_WAIT(); asm volatile("" ::: "memory");
#pragma unroll
            for (int hf = 0; hf < 2; ++hf) {
                unsigned k[16];
                const unsigned pb = 127u - (unsigned)((ch & 3) * 32 + hf * 16);
#pragma unroll
                for (int q = 0; q < 4; ++q) { const f32x4 v = *(const LAS f32x4*)(stg + lane * RS + hf * 16 + q * 4);
                    k[4 * q] = (fkey(v.x) & ~0x7fu) | (pb - (unsigned)(4 * q)); k[4 * q + 1] = (fkey(v.y) & ~0x7fu) | (pb - (unsigned)(4 * q + 1));
                    k[4 * q + 2] = (fkey(v.z) & ~0x7fu) | (pb - (unsigned)(4 * q + 2)); k[4 * q + 3] = (fkey(v.w) & ~0x7fu) | (pb - (unsigned)(4 * q + 3)); }
                bitonic_sort16(k);
                top16_merge(top, k);
            }
            LDS_WAIT(); asm volatile("" ::: "memory");
            if (ch == 3) {
#pragma unroll
                for (int i = 0; i < 16; ++i) { top1[i] = top[i]; top[i] = 0u; }
            }
        }
        LAS int* tab = (LAS int*)stg + lane * 33;
        float v1[16], v2[16];
#pragma unroll
        for (int i = 0; i < 16; ++i) { tab[i] = 127 - (int)(top1[i] & 0x7fu); tab[16 + i] = 127 - (int)(top[i] & 0x7fu); v1[i] = fkey_inv(top1[i] & ~0x7fu); v2[i] = fkey_inv(top[i] & ~0x7fu); }
#define P7_KEY(i, j) ((fkey(v1[i] + v2[j]) & ~0xffu) | (unsigned)((i) * 16 + (j)))
        unsigned best[16], cb[16];
#pragma unroll
        for (int jj = 0; jj < 16; ++jj) best[jj] = P7_KEY(0, jj);
#pragma unroll
        for (int jj = 0; jj < 8; ++jj) { cb[jj] = P7_KEY(1, jj); cb[8 + jj] = 0u; }
        top16_merge(best, cb);
        cb[0] = P7_KEY(2, 0); cb[1] = P7_KEY(2, 1); cb[2] = P7_KEY(2, 2); cb[3] = P7_KEY(2, 3); cb[4] = P7_KEY(2, 4); cb[5] = P7_KEY(3, 0); cb[6] = P7_KEY(3, 1); cb[7] = P7_KEY(3, 2);
        cb[8] = P7_KEY(3, 3); cb[9] = P7_KEY(4, 0); cb[10] = P7_KEY(4, 1); cb[11] = P7_KEY(4, 2); cb[12] = 0u; cb[13] = 0u; cb[14] = 0u; cb[15] = 0u;
        bitonic_sort16(cb); top16_merge(best, cb);
        cb[0] = P7_KEY(5, 0); cb[1] = P7_KEY(5, 1); cb[2] = P7_KEY(6, 0); cb[3] = P7_KEY(6, 1); cb[4] = P7_KEY(7, 0); cb[5] = P7_KEY(7, 1); cb[6] = P7_KEY(8, 0); cb[7] = P7_KEY(9, 0);
        cb[8] = P7_KEY(10, 0); cb[9] = P7_KEY(11, 0); cb[10] = P7_KEY(12, 0); cb[11] = P7_KEY(13, 0); cb[12] = P7_KEY(14, 0); cb[13] = P7_KEY(15, 0); cb[14] = 0u; cb[15] = 0u;
        bitonic_sort16(cb); top16_merge(best, cb);
#undef P7_KEY
        LDS_WAIT(); asm volatile("" ::: "memory");
        int eo[16]; float go[16]; float sm = 0.f;
        const float bmax = fkey_inv(best[0] & ~0xffu);
#pragma unroll
        for (int r = 0; r < 16; ++r) { const int ij = (int)(best[r] & 0xffu); eo[r] = tab[ij >> 4] * 128 + tab[16 + (ij & 15)]; go[r] = __expf(fkey_inv(best[r] & ~0xffu) - bmax); sm += go[r]; }
        const float inv = 1.0f / sm;
        int* ip = IDX + (size_t)batch * 1024 + lane * 16; float* gp = GATE + (size_t)batch * 1024 + lane * 16;
#pragma unroll
        for (int q = 0; q < 4; ++q) { *(GAS v4i*)(ip + 4 * q) = (v4i){eo[4 * q], eo[4 * q + 1], eo[4 * q + 2], eo[4 * q + 3]};
            *(GAS f32x4*)(gp + 4 * q) = (f32x4){go[4 * q] * inv, go[4 * q + 1] * inv, go[4 * q + 2] * inv, go[4 * q + 3] * inv}; }
        LDS_WAIT(); asm volatile("" ::: "memory");
    }
}
typedef __bf16 bf16x2_t __attribute__((ext_vector_type(2)));
__device__ __forceinline__ float dpp_f(float v, const int ctrl_sel) {
    const int x = __builtin_bit_cast(int, v);
    int r;
    if (ctrl_sel == 0) r = __builtin_amdgcn_update_dpp(0, x, 0xB1, 0xF, 0xF, true);
    else if (ctrl_sel == 1) r = __builtin_amdgcn_update_dpp(0, x, 0x4E, 0xF, 0xF, true);
    else if (ctrl_sel == 2) r = __builtin_amdgcn_update_dpp(0, x, 0x141, 0xF, 0xF, true);
    else r = __builtin_amdgcn_update_dpp(0, x, 0x128, 0xF, 0xF, true);
    return __builtin_bit_cast(float, r);
}
__device__ __forceinline__ float sum8(float v) { v += dpp_f(v, 0); v += dpp_f(v, 1); v += dpp_f(v, 2); return v; }
__device__ __forceinline__ float dot2bf(unsigned a, unsigned b, float acc) { return __builtin_amdgcn_fdot2_f32_bf16(__builtin_bit_cast(bf16x2_t, a), __builtin_bit_cast(bf16x2_t, b), acc, false); }
__device__ __forceinline__ float dot8(const v4u d, const v4u x, float acc) {
    acc = dot2bf(d.x, x.x, acc); acc = dot2bf(d.y, x.y, acc); acc = dot2bf(d.z, x.z, acc); acc = dot2bf(d.w, x.w, acc);
    return acc;
}
__device__ __forceinline__ float gelu_erf(float z) { return 0.5f * z * (1.0f + erff(z * 0.70710678118654752f)); }
__device__ __forceinline__ void p8_issue(v4u (&d)[8], const LAS int* li8, __amdgpu_buffer_rsrc_t rs, int soff, int c16) {
    const v4i e0 = *(const LAS v4i*)li8, e1 = *(const LAS v4i*)(li8 + 4);
    d[0] = __builtin_amdgcn_raw_buffer_load_b128(rs, e0.x * D + c16, soff, 0); d[1] = __builtin_amdgcn_raw_buffer_load_b128(rs, e0.y * D + c16, soff, 0);
    d[2] = __builtin_amdgcn_raw_buffer_load_b128(rs, e0.z * D + c16, soff, 0); d[3] = __builtin_amdgcn_raw_buffer_load_b128(rs, e0.w * D + c16, soff, 0);
    d[4] = __builtin_amdgcn_raw_buffer_load_b128(rs, e1.x * D + c16, soff, 0); d[5] = __builtin_amdgcn_raw_buffer_load_b128(rs, e1.y * D + c16, soff, 0);
    d[6] = __builtin_amdgcn_raw_buffer_load_b128(rs, e1.z * D + c16, soff, 0); d[7] = __builtin_amdgcn_raw_buffer_load_b128(rs, e1.w * D + c16, soff, 0);
}
typedef float f32x2 __attribute__((ext_vector_type(2)));
__device__ __forceinline__ f32x2 fp8lo(unsigned w) { return __builtin_amdgcn_cvt_pk_f32_fp8((int)w, false); }
__device__ __forceinline__ f32x2 fp8hi(unsigned w) { return __builtin_amdgcn_cvt_pk_f32_fp8((int)w, true); }
__device__ __forceinline__ float dot16q(const v4u d, const f32x2 (&xx)[8]) {
    f32x2 acc = fp8lo(d.x) * xx[0];
    acc += fp8hi(d.x) * xx[1]; acc += fp8lo(d.y) * xx[2]; acc += fp8hi(d.y) * xx[3]; acc += fp8lo(d.z) * xx[4]; acc += fp8hi(d.z) * xx[5]; acc += fp8lo(d.w) * xx[6]; acc += fp8hi(d.w) * xx[7];
    return acc.x + acc.y;
}
__device__ __forceinline__ void p8_compute_u(const v4u (&d)[8], const f32x2 (&xx)[8], LAS float* lz8, int c) {
    float p[8];
#pragma unroll
    for (int g = 0; g < 8; ++g) p[g] = sum8(dot16q(d[g], xx));
    if (c == 0) {
#pragma unroll
        for (int q = 0; q < 2; ++q) { f32x4 z = *(LAS f32x4*)(lz8 + 4 * q); z.x += p[4 * q]; z.y += p[4 * q + 1]; z.z += p[4 * q + 2]; z.w += p[4 * q + 3]; *(LAS f32x4*)(lz8 + 4 * q) = z; }
    }
}
__device__ __forceinline__ void p8_compute_v(const v4u (&d)[8], const LAS float* la8, f32x2 (&y)[8]) {
    const f32x4 a0 = *(const LAS f32x4*)la8, a1 = *(const LAS f32x4*)(la8 + 4);
    const float a[8] = {a0.x, a0.y, a0.z, a0.w, a1.x, a1.y, a1.z, a1.w};
#pragma unroll
    for (int g = 0; g < 8; ++g) { const f32x2 ag = {a[g], a[g]};
        y[0] += ag * fp8lo(d[g].x); y[1] += ag * fp8hi(d[g].x); y[2] += ag * fp8lo(d[g].y); y[3] += ag * fp8hi(d[g].y);
        y[4] += ag * fp8lo(d[g].z); y[5] += ag * fp8hi(d[g].z); y[6] += ag * fp8lo(d[g].w); y[7] += ag * fp8hi(d[g].w); }
}
__device__ __forceinline__ void p8_load_x(f32x2 (&xx)[8], const bf16* xp) {
    const v4u a = *(const GAS v4u*)xp, b = *(const GAS v4u*)(xp + 8);
    xx[0] = (f32x2){bflo(a.x), bfhi(a.x)}; xx[1] = (f32x2){bflo(a.y), bfhi(a.y)}; xx[2] = (f32x2){bflo(a.z), bfhi(a.z)}; xx[3] = (f32x2){bflo(a.w), bfhi(a.w)};
    xx[4] = (f32x2){bflo(b.x), bfhi(b.x)}; xx[5] = (f32x2){bflo(b.y), bfhi(b.y)}; xx[6] = (f32x2){bflo(b.z), bfhi(b.z)}; xx[7] = (f32x2){bflo(b.w), bfhi(b.w)};
}
__device__ __forceinline__ void p8_peer(Frame& F, const bf16* XN2, const unsigned char* U8, const unsigned char* V8, const float* SU, const float* SV, const int* IDX, const float* GATE, float* HOUT, const float* gfin) {
    LAS int* lidx = (LAS int*)(F.lds + RING_OFF + F.wave * 8704);
    LAS float* lza = (LAS float*)(F.lds + RING_OFF + F.wave * 8704 + 4096);
    LAS float* lss = (LAS float*)(F.lds + RING_OFF + F.wave * 8704 + 8192);
    const int gw = F.vcu * NWAVES + F.wave, NGW = F.G * NWAVES, lane = F.lane, j = lane >> 3, c = lane & 7, c16 = c * 16;
    const __amdgpu_buffer_rsrc_t rsU = __builtin_amdgcn_make_buffer_rsrc((void*)U8, (short)0, NEXP * D, 0x00020000);
    const __amdgpu_buffer_rsrc_t rsV = __builtin_amdgcn_make_buffer_rsrc((void*)V8, (short)0, NEXP * D, 0x00020000);
    for (int grp = gw; grp < T / 8; grp += NGW) {
        const int tb = grp * 8;
#pragma unroll
        for (int i = 0; i < 8; ++i) { lidx[i * 128 + lane] = IDX[(size_t)(tb + i) * NSEL + lane]; lidx[i * 128 + 64 + lane] = IDX[(size_t)(tb + i) * NSEL + 64 + lane]; lza[i * 128 + lane] = 0.f; lza[i * 128 + 64 + lane] = 0.f; }
        if (lane < 8) lss[lane] = 0.f;
        LDS_WAIT(); asm volatile("" ::: "memory");
        {
            v4u dA[8], dB[8]; f32x2 xc[8], xn[8];
            p8_issue(dA, lidx + j * 16, rsU, 0, c16); p8_load_x(xc, XN2 + (size_t)tb * D + c * 16);
            for (int n = 0; n < 64; ++n) {
                const int s = n >> 3, i = n & 7, n1 = (n + 1) & 63, s1 = n1 >> 3, i1 = n1 & 7;
                p8_load_x(xn, XN2 + (size_t)(tb + i1) * D + s1 * 128 + c * 16);
                p8_issue(dB, lidx + i * 128 + j * 16 + 8, rsU, s * 128, c16);
                p8_compute_u(dA, xc, lza + i * 128 + j * 16, c);
                p8_issue(dA, lidx + i1 * 128 + j * 16, rsU, s1 * 128, c16);
                p8_compute_u(dB, xc, lza + i * 128 + j * 16 + 8, c);
#pragma unroll
                for (int q = 0; q < 8; ++q) xc[q] = xn[q];
            }
        }
        LDS_WAIT(); asm volatile("" ::: "memory");
#pragma unroll
        for (int i = 0; i < 8; ++i) {
            const int e0 = lidx[i * 128 + lane], e1 = lidx[i * 128 + 64 + lane];
            const float z0 = lza[i * 128 + lane] * SU[e0], z1 = lza[i * 128 + 64 + lane] * SU[e1];
            const float g0 = GATE[(size_t)(tb + i) * NSEL + lane] * SV[e0], g1 = GATE[(size_t)(tb + i) * NSEL + 64 + lane] * SV[e1];
            lza[i * 128 + lane] = gelu_erf(z0) * g0; lza[i * 128 + 64 + lane] = gelu_erf(z1) * g1;
        }
        LDS_WAIT(); asm volatile("" ::: "memory");
        {
            v4u dA[8], dB[8];
            p8_issue(dA, lidx + j * 16, rsV, 0, c16);
            for (int n = 0; n < 64; ++n) {
                const int s = n >> 3, i = n & 7, n1 = (n + 1) & 63, s1 = n1 >> 3, i1 = n1 & 7;
                p8_issue(dB, lidx + i * 128 + j * 16 + 8, rsV, s * 128, c16);
                float* hp = HOUT + (size_t)(tb + i) * D + s * 128 + c * 16;
                f32x4 h[4];
#pragma unroll
                for (int q = 0; q < 4; ++q) h[q] = (f32x4){0.f, 0.f, 0.f, 0.f};
                if (lane < 8) {
#pragma unroll
                    for (int q = 0; q < 4; ++q) h[q] = *(const GAS f32x4*)(hp + 4 * q); }
                f32x2 y[8];
#pragma unroll
                for (int q = 0; q < 8; ++q) y[q] = (f32x2){0.f, 0.f};
                p8_compute_v(dA, lza + i * 128 + j * 16, y);
                p8_issue(dA, lidx + i1 * 128 + j * 16, rsV, s1 * 128, c16);
                p8_compute_v(dB, lza + i * 128 + j * 16 + 8, y);
                float yy[16];
#pragma unroll
                for (int q = 0; q < 8; ++q) { yy[2 * q] = y[q].x; yy[2 * q + 1] = y[q].y; }
#pragma unroll
                for (int q = 0; q < 16; ++q) { float v = yy[q]; v += dpp_f(v, 3); v += __shfl_xor(v, 16); v += __shfl_xor(v, 32); yy[q] = v; }
                if (lane < 8) {
                    float q2 = 0.f;
#pragma unroll
                    for (int q = 0; q < 4; ++q) { const f32x4 o = {yy[4 * q] + h[q].x, yy[4 * q + 1] + h[q].y, yy[4 * q + 2] + h[q].z, yy[4 * q + 3] + h[q].w};
                        *(GAS f32x4*)(hp + 4 * q) = o; q2 += (o.x * o.x + o.y * o.y) + (o.z * o.z + o.w * o.w); }
                    const float tot = sum8(q2);
                    if (lane == 0) lss[i] += tot;
                }
            }
        }
        VM_WAIT(); __builtin_amdgcn_fence(__ATOMIC_ACQUIRE, "agent"); VM_WAIT(); LDS_WAIT(); asm volatile("" ::: "memory");
#pragma unroll
        for (int i = 0; i < 8; ++i) {
            const float rstd = 1.f / sqrtf(lss[i] * (1.f / D) + EPS);
            float* hr = HOUT + (size_t)(tb + i) * D;
#pragma unroll
            for (int q = 0; q < 4; ++q) { const f32x4 yv = *(const GAS f32x4*)(hr + 256 * q + 4 * lane), gg = *(const GAS f32x4*)(gfin + 256 * q + 4 * lane);
                *(GAS f32x4*)(hr + 256 * q + 4 * lane) = (f32x4){yv.x * rstd * gg.x, yv.y * rstd * gg.y, yv.z * rstd * gg.z, yv.w * rstd * gg.w}; }
        }
        LDS_WAIT(); asm volatile("" ::: "memory");
    }
}
__device__ __forceinline__ void cvt_fp8_rows(Frame& F, const float* src, unsigned char* dst, float* scale) {
    const int gw = F.vcu * NWAVES + F.wave, NGW = F.G * NWAVES, lane = F.lane;
    for (int r = gw; r < NEXP; r += NGW) {
        const GAS f32x4* sp = (const GAS f32x4*)(src + (size_t)r * D) + 4 * lane;
        const f32x4 a = sp[0], b = sp[1], c = sp[2], d = sp[3];
        float m = fmaxf(fmaxf(fmaxf(fabsf(a.x), fabsf(a.y)), fmaxf(fabsf(a.z), fabsf(a.w))), fmaxf(fmaxf(fabsf(b.x), fabsf(b.y)), fmaxf(fabsf(b.z), fabsf(b.w))));
        m = fmaxf(m, fmaxf(fmaxf(fmaxf(fabsf(c.x), fabsf(c.y)), fmaxf(fabsf(c.z), fabsf(c.w))), fmaxf(fmaxf(fabsf(d.x), fabsf(d.y)), fmaxf(fabsf(d.z), fabsf(d.w)))));
#pragma unroll
        for (int o = 1; o < 64; o <<= 1) m = fmaxf(m, __shfl_xor(m, o));
        const float sc = (m > 0.f) ? m * (1.0f / 448.0f) : 1.0f, inv = 1.0f / sc;
        v4u o;
        o.x = (unsigned)__builtin_amdgcn_cvt_pk_fp8_f32(a.z * inv, a.w * inv, __builtin_amdgcn_cvt_pk_fp8_f32(a.x * inv, a.y * inv, 0, false), true);
        o.y = (unsigned)__builtin_amdgcn_cvt_pk_fp8_f32(b.z * inv, b.w * inv, __builtin_amdgcn_cvt_pk_fp8_f32(b.x * inv, b.y * inv, 0, false), true);
        o.z = (unsigned)__builtin_amdgcn_cvt_pk_fp8_f32(c.z * inv, c.w * inv, __builtin_amdgcn_cvt_pk_fp8_f32(c.x * inv, c.y * inv, 0, false), true);
        o.w = (unsigned)__builtin_amdgcn_cvt_pk_fp8_f32(d.z * inv, d.w * inv, __builtin_amdgcn_cvt_pk_fp8_f32(d.x * inv, d.y * inv, 0, false), true);
        *(GAS v4u*)(dst + (size_t)r * D + 16 * lane) = o;
        if (lane == 0) scale[r] = sc;
    }
}
__device__ __forceinline__ void cvt_stream(Frame& F, const float* src, bf16* dst, size_t n) {
    const size_t gt = (size_t)F.vcu * (NWAVES * 64) + F.tid, NT = (size_t)F.G * (NWAVES * 64);
    for (size_t i = gt; i < n / 8; i += NT) { const f32x4 a = *(const GAS f32x4*)(src + 8 * i), b = *(const GAS f32x4*)(src + 8 * i + 4);
        v4u o; o.x = pk2(a.x, a.y); o.y = pk2(a.z, a.w); o.z = pk2(b.x, b.y); o.w = pk2(b.z, b.w); *(GAS v4u*)(dst + 8 * i) = o; }
}

struct Args { const float* in[15]; float* out; unsigned char* ws; int ph_lo, ph_hi; };
__global__ void __launch_bounds__(NWAVES * 64, 2) hyb_fwd(Args args) {
    extern __shared__ __attribute__((aligned(16))) unsigned char lds[];
    Frame F;
    F.lds = (LAS unsigned char*)lds;
    F.MISC = (volatile LAS unsigned*)(F.lds + MISC_OFF);
    F.tid = threadIdx.x; F.lane = F.tid & 63; F.wave = __builtin_amdgcn_readfirstlane(F.tid >> 6);
    F.G = gridDim.x; { const int bx = blockIdx.x; F.vcu = (F.G % 8 == 0) ? (bx % 8) * (F.G / 8) + bx / 8 : bx; }
    unsigned char* ws = args.ws;
    gu32* ctl = (gu32*)(ws + WS_CTL);
    const float* x = args.in[0]; const float* g_mix = args.in[1]; const float* w_in = args.in[2]; const float* conv_w = args.in[3]; const float* w_conv_out = args.in[4];
    const float* pool_w = args.in[5]; const float* pool_scale = args.in[6]; const float* w_pool_out = args.in[7]; const float* w_out = args.in[8]; const float* g_ffn = args.in[9];
    const float* w_query = args.in[10]; const float* sub_keys = args.in[11]; const float* expert_u = args.in[12]; const float* expert_v = args.in[13]; const float* g_fin = args.in[14];
    bf16* WIN = (bf16*)(ws + WS_WIN); bf16* WC = (bf16*)(ws + WS_WC); bf16* WPB = (bf16*)(ws + WS_WPB); bf16* WOUT = (bf16*)(ws + WS_WOUT); bf16* WSC = (bf16*)(ws + WS_WS);
    bf16* XN = (bf16*)(ws + WS_XN); bf16* PB = (bf16*)(ws + WS_PB); bf16* PG = (bf16*)(ws + WS_PG); bf16* TMP = (bf16*)(ws + WS_TMP); bf16* MG = (bf16*)(ws + WS_MG);
    float* SC = (float*)(ws + WS_SC); int* IDX = (int*)(ws + WS_IDX); float* GATE = (float*)(ws + WS_GATE); unsigned char* U8 = ws + WS_U8; unsigned char* V8 = ws + WS_V8; float* SU = (float*)(ws + WS_SU); float* SV = (float*)(ws + WS_SV);
    bf16* AIN = (bf16*)args.out; bf16* POOLED = (bf16*)args.out + (size_t)T * D; float* H = args.out;

    for (int u = F.tid; u < (LDS_BYTES - LDSCTL_OFF) / 4; u += NWAVES * 64) ((LAS unsigned*)(F.lds + LDSCTL_OFF))[u] = 0u;
    __syncthreads();
    XcdBarrier bar; bar.bar = (unsigned*)(ctl + CW_BAR); bar.x = 0; bar.st = nullptr;
    if (N_LAUNCHES == 1) bar = xcd_barrier_post((unsigned*)(ctl + CW_BAR), F.MISC + 8);
#define GRID_BAR() do { if (N_LAUNCHES == 1) xcd_barrier(bar); } while (0)
    const int lo = args.ph_lo, hi = args.ph_hi;
#define IN(k) (lo <= (k) && (k) < hi)
#define BOTH(k) (IN(k) && IN((k) + 1))
    const int gw = F.vcu * NWAVES + F.wave, NGW = F.G * NWAVES;

    if (IN(0)) { for (int rep = 0; rep < REPS(0); ++rep) {
        LAS float* sm = (LAS float*)(F.lds + RING_OFF);
        for (int it = blockIdx.x; it < 768; it += F.G) {
            if (it < 256) { const int g = it >> 6, i0 = ((it >> 2) & 15) * 64, j0 = (it & 3) * 64;
                fold_tile(sm, w_pool_out + (size_t)g * 256 * D + i0, 1, D, pool_scale + g * 256, pool_w + (size_t)g * 65536 + (size_t)j0 * 256, 256, 256, WPB + (size_t)i0 * D + g * 256 + j0, D, F.tid);
            } else { const int r = it - 256, hp = r >> 5, i0 = ((r >> 4) & 1) * 64, j0 = (r & 15) * 64;
                fold_tile(sm, sub_keys + (size_t)hp * 16384 + (size_t)i0 * 128, 128, 1, nullptr, w_query + (size_t)j0 * NSC + hp * 128, NSC, 128, WSC + (size_t)(hp * 128 + i0) * D + j0, D, F.tid); }
        }
        __syncthreads();
        LAS float* scr = (LAS float*)(F.lds + RING_OFF + F.wave * 16384);
        constexpr int I_IN = (D / 64) * (NIN / 32), I_SQ = (D / 64) * (D / 32);
        for (int it = gw; it < I_IN + 2 * I_SQ; it += NGW) {
            int r = it;
            if (r < I_IN) { p0_transpose_item(w_in, D, NIN, WIN, scr, r, F.lane); continue; } r -= I_IN;
            if (r < I_SQ) { p0_transpose_item(w_conv_out, D, D, WC, scr, r, F.lane); continue; } r -= I_SQ;
            p0_transpose_item(w_out, D, D, WOUT, scr, r, F.lane);
        }
        for (int m = gw; m < T; m += NGW) rms_row_to_bf16(F.lane, x + (size_t)m * D, g_mix, XN + (size_t)m * D);
        }
        if (BOTH(0)) GRID_BAR();
    }
    if (IN(1)) { for (int rep = 0; rep < REPS(1); ++rep) {
        pg8::Gemm g{XN, WIN, 0l, 0l, T, NIN, D}; pg8::StaticOrder S; S.init(T, NIN, F.G, (int)blockIdx.x);
        pg8::EpiProj E{PB, PG};
        pg8::gemm_phase<pg8::EpiProj, pg8::StaticOrder, true, true>(F.lds + RING_OFF, g, S, E);
        }
        if (BOTH(1)) GRID_BAR();
    }
    if (IN(2)) { for (int rep = 0; rep < REPS(2); ++rep) {
        p2_conv_pool(F, PB, conv_w, AIN, POOLED);
        }
        if (BOTH(2)) GRID_BAR();
    }
    if (IN(3)) { for (int rep = 0; rep < REPS(3); ++rep) {
        pg8::Gemm g{AIN, WC, (long)T * D * 2, (long)(WS_WPB - WS_WC), T, D, D}; pg8::MergeOrder S; S.base.init(T, D, F.G, (int)blockIdx.x);
        pg8::EpiMerge E{PG, TMP, (long)((WS_MG - WS_TMP) / 2)};
        pg8::gemm_phase<pg8::EpiMerge, pg8::MergeOrder, true, true>(F.lds + RING_OFF, g, S, E);
        }
        if (BOTH(3)) GRID_BAR();
    }
    if (IN(4)) { for (int rep = 0; rep < REPS(4); ++rep) {
        pg8::Gemm g{MG, WOUT, 0l, 0l, T, D, D}; pg8::StaticOrder S; S.init(T, D, F.G, (int)blockIdx.x);
        pg8::EpiRes E{x, H};
        pg8::gemm_phase<pg8::EpiRes, pg8::StaticOrder, true, true>(F.lds + RING_OFF, g, S, E);
        cvt_fp8_rows(F, expert_u, U8, SU);
        cvt_fp8_rows(F, expert_v, V8, SV);
        }
        if (BOTH(4)) GRID_BAR();
    }
    if (IN(5)) { for (int rep = 0; rep < REPS(5); ++rep) {
        for (int m = gw; m < T; m += NGW) rms_row_to_bf16(F.lane, H + (size_t)m * D, g_ffn, XN + (size_t)m * D);
        }
        if (BOTH(5)) GRID_BAR();
    }
    if (IN(6)) { for (int rep = 0; rep < REPS(6); ++rep) {
        pg8::Gemm g{XN, WSC, 0l, 0l, T, NSC, D}; pg8::StaticOrder S; S.init(T, NSC, F.G, (int)blockIdx.x);
        pg8::EpiF32 E{SC, NSC};
        pg8::gemm_phase<pg8::EpiF32, pg8::StaticOrder, true, true>(F.lds + RING_OFF, g, S, E);
        }
        if (BOTH(6)) GRID_BAR();
    }
    if (IN(7)) { for (int rep = 0; rep < REPS(7); ++rep) {
        p7_topk(F, SC, IDX, GATE);
        }
        if (BOTH(7)) GRID_BAR();
    }
    if (IN(8)) {
        p8_peer(F, XN, U8, V8, SU, SV, IDX, GATE, H, g_fin);
    }
#undef IN
#undef BOTH
}

extern "C" void kernel_launch(void* const* d_in, const int* in_sizes, int n_in, void* d_out, int out_size, void* d_ws, size_t ws_size, hipStream_t stream) {
    static int grid = 0;
    if (grid == 0) {
        if (n_in != 15 || in_sizes[0] != T * D || out_size != T * D || ws_size < WS_END) { fprintf(stderr, "kernel_launch: shape/workspace mismatch (n_in %d, in0 %d, out %d, ws %zu)\n", n_in, n_in > 0 ? in_sizes[0] : -1, out_size, ws_size); grid = -1; return; }
        int dev = 0, cus = 0, per_cu = 0;
        if (hipGetDevice(&dev) != hipSuccess || hipDeviceGetAttribute(&cus, hipDeviceAttributeMultiprocessorCount, dev) != hipSuccess) { grid = -1; return; }
        if (hipFuncSetAttribute((const void*)hyb_fwd, hipFuncAttributeMaxDynamicSharedMemorySize, LDS_BYTES) != hipSuccess) { fprintf(stderr, "kernel_launch: hipFuncSetAttribute failed\n"); grid = -1; return; }
        if (hipOccupancyMaxActiveBlocksPerMultiprocessor(&per_cu, (const void*)hyb_fwd, NWAVES * 64, LDS_BYTES) != hipSuccess || per_cu < 1)
            fprintf(stderr, "kernel_launch: note: occupancy query reports %d workgroups per CU\n", per_cu);
        (void)hipGetLastError();
        grid = cus;
    }
    if (grid < 0) return;
    if (hipMemsetAsync((char*)d_ws + WS_CTL, 0, CTL_ZERO_BYTES, stream) != hipSuccess) { fprintf(stderr, "kernel_launch: hipMemsetAsync failed\n"); return; }
    Args a{};
    for (int i = 0; i < 15; ++i) a.in[i] = (const float*)d_in[i];
    a.out = (float*)d_out; a.ws = (unsigned char*)d_ws;
    for (int li = 0; li < N_LAUNCHES; ++li) {
        a.ph_lo = (N_LAUNCHES == 1) ? 0 : li; a.ph_hi = (N_LAUNCHES == 1) ? NPHASE : li + 1;
        hipLaunchKernelGGL(hyb_fwd, dim3(grid), dim3(NWAVES * 64), LDS_BYTES, stream, a);
        const hipError_t le = hipPeekAtLastError();
        if (le != hipSuccess) { fprintf(stderr, "kernel_launch: launch %d failed: %s\n", li, hipGetErrorName(le)); break; }
    }
}
```

```cpp
#include <hip/hip_runtime.h>
#include <cstdio>
#include <cstdint>
namespace pg8 {
#define PG8_LAS __attribute__((address_space(3)))
typedef unsigned short bf16_t;
typedef short bf16x8 __attribute__((ext_vector_type(8)));
typedef float f32x4 __attribute__((ext_vector_type(4)));
typedef unsigned u32x4 __attribute__((ext_vector_type(4)));
constexpr int BM = 256, BK = 64, HALF = 128, HTB = HALF * BK * 2  , STAGE_BYTES = 8 * HTB, NXCD = 8, WGM = 8;

__host__ __device__ __forceinline__ int lds_byte(int r, int c) { const int st = (r >> 4) * 2 + (c >> 5), rr = r & 15, cc = c & 31, ob = rr * 64 + cc * 2; return st * 1024 + (ob ^ (((ob >> 9) & 1) << 5)); }
__host__ __device__ __forceinline__ void stage_rc(int b, int& R, int& C) { const int st = b / 1024, sb = b % 1024, swz = sb ^ (((sb >> 9) & 1) << 5); R = (st >> 1) * 16 + swz / 64; C = (st & 1) * 32 + (swz % 64) / 2; }
__host__ __device__ __forceinline__ int perm32(int rho) { const int n = rho >> 4, i = rho & 15; return 8 * (i >> 2) + 4 * n + (i & 3); }

struct Unit { int pm, pn, sel; };
struct Gemm { const bf16_t* A; const bf16_t* Bt; long offA1, offB1; int M, N, K; };

struct StaticOrder {
    int nM, nN, nwg, G, c;
    __host__ __device__ void init(int M, int N, int G_, int c_) { nM = M / BM; nN = N / BM; nwg = nM * nN; G = G_; c = c_; }
    __host__ __device__ __forceinline__ bool next(int i, Unit& u) const {
        const long L = (long)i * G + c; if (L >= nwg) return false;
        int wgid = (int)L; { const int q = nwg / NXCD, r = nwg % NXCD, xcd = wgid % NXCD, off = wgid / NXCD; wgid = (xcd < r ? xcd * (q + 1) : r * (q + 1) + (xcd - r) * q) + off; }
        const int nig = WGM * nN, gid = wgid / nig, fm = gid * WGM, gsz = (nM - fm) < WGM ? (nM - fm) : WGM;
        u.pm = fm + ((wgid % nig) % gsz); u.pn = (wgid % nig) / gsz; u.sel = 0; return true;
    }
    __device__ __forceinline__ void a_ready(const Unit&) const {}
    __device__ __forceinline__ void done(const Unit&) const {}
};


__device__ __forceinline__ unsigned cvt_pk_bf16(float lo, float hi) { unsigned r; asm volatile("v_cvt_pk_bf16_f32 %0, %1, %2" : "=v"(r) : "v"(lo), "v"(hi)); return r; }
__device__ __forceinline__ float sigm(float x) { return __builtin_amdgcn_rcpf(1.0f + __expf(-x)); }
__device__ __forceinline__ float sig255(float x) { return fmaxf(255.0f * __builtin_amdgcn_rcpf(1.0f + __expf(-x)), 1.0f); }
__device__ __forceinline__ unsigned q8(float a, float b, float c, float d) {
    unsigned w = __builtin_amdgcn_cvt_pk_u8_f32(sig255(a), 0u, 0u); w = __builtin_amdgcn_cvt_pk_u8_f32(sig255(b), 1u, w); w = __builtin_amdgcn_cvt_pk_u8_f32(sig255(c), 2u, w); return __builtin_amdgcn_cvt_pk_u8_f32(sig255(d), 3u, w); }
__device__ __forceinline__ float ub0(unsigned w) { return (float)(w & 0xffu); }
__device__ __forceinline__ float ub1(unsigned w) { return (float)((w >> 8) & 0xffu); }
__device__ __forceinline__ float ub2(unsigned w) { return (float)((w >> 16) & 0xffu); }
__device__ __forceinline__ float ub3(unsigned w) { return (float)(w >> 24); }
__device__ __forceinline__ float bflo(unsigned w) { return __uint_as_float(w << 16); }
__device__ __forceinline__ float bfhi(unsigned w) { return __uint_as_float(w & 0xffff0000u); }

struct EpiProj {
    static constexpr bool PERM = true, AFTER_DRAIN = false, CHAIN = false;
    bf16_t* PB; long pg_off;
    __device__ __forceinline__ void operator()(const f32x4 (&acc)[2][2][4][2], const Unit& u, int wr, int wc, int fr, int fq) const {
        const int row0 = u.pm * BM + wr * 64 + fr, lc = wc * 32 + 8 * fq;
        if (u.pn >= 4 && u.pn < 12) {
            bf16_t* base = PB + 1024 + (u.pn - 4) * HALF + lc;
#pragma unroll
            for (int ai = 0; ai < 2; ++ai)
#pragma unroll
                for (int m = 0; m < 4; ++m) { const f32x4 v0 = acc[ai][0][m][0] * acc[ai][1][m][0], v1 = acc[ai][0][m][1] * acc[ai][1][m][1];
                    u32x4 w; w.x = cvt_pk_bf16(v0[0], v0[1]); w.y = cvt_pk_bf16(v0[2], v0[3]); w.z = cvt_pk_bf16(v1[0], v1[1]); w.w = cvt_pk_bf16(v1[2], v1[3]);
                    *(u32x4*)(base + (size_t)(row0 + ai * HALF + m * 16) * 3072) = w; }
            return;
        }
        if (u.pn >= 16) {
            unsigned char* base = (unsigned char*)PB + pg_off + (u.pn - 16) * BM + lc;
#pragma unroll
            for (int ai = 0; ai < 2; ++ai)
#pragma unroll
                for (int m = 0; m < 4; ++m) { unsigned char* rowp = base + (size_t)(row0 + ai * HALF + m * 16) * 2048;
#pragma unroll
                    for (int bj = 0; bj < 2; ++bj) { const f32x4 v0 = acc[ai][bj][m][0], v1 = acc[ai][bj][m][1];
                        typedef unsigned u32x2g __attribute__((ext_vector_type(2))); u32x2g w;
                        w.x = q8(v0[0], v0[1], v0[2], v0[3]); w.y = q8(v1[0], v1[1], v1[2], v1[3]);
                        *(u32x2g*)(rowp + bj * HALF) = w; } }
            return;
        }
        const long boff = (u.pn < 4 ? (long)(u.pn * BM) : (long)(2048 + (u.pn - 12) * BM)); bf16_t* base = PB + boff;
#pragma unroll
        for (int ai = 0; ai < 2; ++ai)
#pragma unroll
            for (int m = 0; m < 4; ++m) { bf16_t* rowp = base + (size_t)(row0 + ai * HALF + m * 16) * 3072 + lc;
#pragma unroll
                for (int bj = 0; bj < 2; ++bj) { const f32x4 v0 = acc[ai][bj][m][0], v1 = acc[ai][bj][m][1];
                    u32x4 w; w.x = cvt_pk_bf16(v0[0], v0[1]); w.y = cvt_pk_bf16(v0[2], v0[3]); w.z = cvt_pk_bf16(v1[0], v1[1]); w.w = cvt_pk_bf16(v1[2], v1[3]);
                    *(u32x4*)(rowp + bj * HALF) = w; } }
    }
};
struct EpiMerge {
    static constexpr bool PERM = true, AFTER_DRAIN = false, CHAIN = true;
    const unsigned char* PG; bf16_t* MG;
    typedef unsigned u32x2g __attribute__((ext_vector_type(2)));
    __device__ __forceinline__ void operator()(f32x4 (&acc)[2][2][4][2], const Unit& u, int wr, int wc, int fr, int fq) const {
        const int row0 = u.pm * BM + wr * 64 + fr, col0 = u.pn * BM + wc * 32 + 8 * fq;
        const unsigned char* pg = PG + (size_t)row0 * 2048 + col0;
        if (u.sel == 0) {
            u32x2g ga[2][4][2], gb[2][4][2];
#pragma unroll
            for (int ai = 0; ai < 2; ++ai)
#pragma unroll
                for (int m = 0; m < 4; ++m)
#pragma unroll
                    for (int bj = 0; bj < 2; ++bj) { const unsigned char* p = pg + (size_t)(ai * HALF + m * 16) * 2048 + bj * HALF; ga[ai][m][bj] = *(const u32x2g*)p; gb[ai][m][bj] = *(const u32x2g*)(p + 1024); }
#pragma unroll
            for (int ai = 0; ai < 2; ++ai)
#pragma unroll
                for (int m = 0; m < 4; ++m)
#pragma unroll
                    for (int bj = 0; bj < 2; ++bj) { const unsigned a0 = ga[ai][m][bj].x, a1 = ga[ai][m][bj].y, b0 = gb[ai][m][bj].x, b1 = gb[ai][m][bj].y; f32x4 v0 = acc[ai][bj][m][0], v1 = acc[ai][bj][m][1];
                        v0[0] *= ub0(a0) * __builtin_amdgcn_rcpf(ub0(b0)); v0[1] *= ub1(a0) * __builtin_amdgcn_rcpf(ub1(b0)); v0[2] *= ub2(a0) * __builtin_amdgcn_rcpf(ub2(b0)); v0[3] *= ub3(a0) * __builtin_amdgcn_rcpf(ub3(b0));
                        v1[0] *= ub0(a1) * __builtin_amdgcn_rcpf(ub0(b1)); v1[1] *= ub1(a1) * __builtin_amdgcn_rcpf(ub1(b1)); v1[2] *= ub2(a1) * __builtin_amdgcn_rcpf(ub2(b1)); v1[3] *= ub3(a1) * __builtin_amdgcn_rcpf(ub3(b1));
                        acc[ai][bj][m][0] = v0; acc[ai][bj][m][1] = v1; }
            asm volatile("" ::: "memory");
        } else {
            u32x2g gb[2][4][2];
#pragma unroll
            for (int ai = 0; ai < 2; ++ai)
#pragma unroll
                for (int m = 0; m < 4; ++m)
#pragma unroll
                    for (int bj = 0; bj < 2; ++bj) gb[ai][m][bj] = *(const u32x2g*)(pg + (size_t)(ai * HALF + m * 16) * 2048 + bj * HALF + 1024);
            const float k = 1.0f / 255.0f;
#pragma unroll
            for (int ai = 0; ai < 2; ++ai)
#pragma unroll
                for (int m = 0; m < 4; ++m)
#pragma unroll
                    for (int bj = 0; bj < 2; ++bj) { const unsigned b0 = gb[ai][m][bj].x, b1 = gb[ai][m][bj].y; const f32x4 v0 = acc[ai][bj][m][0], v1 = acc[ai][bj][m][1];
                        u32x4 w; w.x = cvt_pk_bf16(v0[0] * (ub0(b0) * k), v0[1] * (ub1(b0) * k)); w.y = cvt_pk_bf16(v0[2] * (ub2(b0) * k), v0[3] * (ub3(b0) * k));
                        w.z = cvt_pk_bf16(v1[0] * (ub0(b1) * k), v1[1] * (ub1(b1) * k)); w.w = cvt_pk_bf16(v1[2] * (ub2(b1) * k), v1[3] * (ub3(b1) * k));
                        *(u32x4*)(MG + (size_t)(row0 + ai * HALF + m * 16) * 1024 + col0 + bj * HALF) = w; }
            asm volatile("" ::: "memory");
        }
    }
};
struct EpiRes {
    static constexpr bool PERM = false, AFTER_DRAIN = false, CHAIN = false;
    const float* X; float* H;
    __device__ __forceinline__ void operator()(const f32x4 (&acc)[2][2][4][2], const Unit& u, int wr, int wc, int fr, int fq) const {
        const int row0 = u.pm * BM + wr * 64 + fr, col0 = u.pn * BM + wc * 32 + 4 * fq;
#pragma unroll
        for (int ai = 0; ai < 2; ++ai)
#pragma unroll
            for (int m = 0; m < 4; ++m) { const size_t off = (size_t)(row0 + ai * HALF + m * 16) * 1024 + col0;
#pragma unroll
                for (int bj = 0; bj < 2; ++bj)
#pragma unroll
                    for (int n = 0; n < 2; ++n) { const f32x4 xv = *(const f32x4*)(X + off + bj * HALF + n * 16); *(f32x4*)(H + off + bj * HALF + n * 16) = xv + acc[ai][bj][m][n]; } }
    }
};
struct EpiF16 {
    static constexpr bool PERM = true, AFTER_DRAIN = false, CHAIN = false;
    unsigned short* C; int ldc;
    __device__ __forceinline__ unsigned pkh(float a, float b) const { typedef _Float16 h2 __attribute__((ext_vector_type(2))); h2 v; v.x = (_Float16)a; v.y = (_Float16)b; return __builtin_bit_cast(unsigned, v); }
    __device__ __forceinline__ void operator()(const f32x4 (&acc)[2][2][4][2], const Unit& u, int wr, int wc, int fr, int fq) const {
        const int row0 = u.pm * BM + wr * 64 + fr, col0 = u.pn * BM + wc * 32 + 8 * fq;
#pragma unroll
        for (int ai = 0; ai < 2; ++ai)
#pragma unroll
            for (int m = 0; m < 4; ++m) { unsigned short* rowp = C + (size_t)(row0 + ai * HALF + m * 16) * ldc + col0;
#pragma unroll
                for (int bj = 0; bj < 2; ++bj) { const f32x4 v0 = acc[ai][bj][m][0], v1 = acc[ai][bj][m][1];
                    u32x4 w; w.x = pkh(v0[0], v0[1]); w.y = pkh(v0[2], v0[3]); w.z = pkh(v1[0], v1[1]); w.w = pkh(v1[2], v1[3]);
                    *(u32x4*)(rowp + bj * HALF) = w; } }
    }
};
struct EpiResRms {
    static constexpr bool PERM = true, AFTER_DRAIN = true, CHAIN = false;
    const float* X; bf16_t* H16; const float* G; bf16_t* XN; unsigned char* X8; float* SSQ; float* SXQ;
    __device__ __forceinline__ void fused(f32x4 (&acc)[2][2][4][2], const Unit& u, int wr, int wc, int fr, int fq, PG8_LAS unsigned char* lds, int wid, int lane) const {
        typedef float f32x2v __attribute__((ext_vector_type(2))); typedef unsigned u32x2v __attribute__((ext_vector_type(2)));
        PG8_LAS f32x2v* P = (PG8_LAS f32x2v*)lds;
        PG8_LAS f32x2v* S = (PG8_LAS f32x2v*)(lds + 8192);
        int col0 = u.pn * BM + wc * 32 + 8 * fq; asm volatile("" : "+v"(col0));
        f32x4 gv[2][2];
#pragma unroll
        for (int bj = 0; bj < 2; ++bj)
#pragma unroll
            for (int n = 0; n < 2; ++n) gv[bj][n] = *(const f32x4*)(G + col0 + bj * HALF + n * 4);
        const float* xb = X + (size_t)(u.pm * BM + wr * 64 + fr) * 1024 + col0;
        f32x4 xq[3][2][2];
#pragma unroll
        for (int pre = 0; pre < 2; ++pre)
#pragma unroll
            for (int bj = 0; bj < 2; ++bj)
#pragma unroll
                for (int n = 0; n < 2; ++n) xq[pre][bj][n] = *(const f32x4*)(xb + (size_t)(pre * 16) * 1024 + bj * HALF + n * 4);
#pragma unroll
        for (int am = 0; am < 8; ++am) { const int ai = am >> 2, m = am & 3, r = ai * HALF + wr * 64 + m * 16 + fr;
            if (am < 6) { const int a2 = (am + 2) >> 2, m2 = (am + 2) & 3;
#pragma unroll
                for (int bj = 0; bj < 2; ++bj)
#pragma unroll
                    for (int n = 0; n < 2; ++n) xq[(am + 2) % 3][bj][n] = *(const f32x4*)(xb + (size_t)(a2 * HALF + m2 * 16) * 1024 + bj * HALF + n * 4); }
            asm volatile("" ::: "memory");
            float s = 0.f, a = 0.f;
#pragma unroll
            for (int bj = 0; bj < 2; ++bj)
#pragma unroll
                for (int n = 0; n < 2; ++n) { const f32x4 h = xq[am % 3][bj][n] + acc[ai][bj][m][n]; acc[ai][bj][m][n] = h;
                    s += (h[0] * h[0] + h[1] * h[1]) + (h[2] * h[2] + h[3] * h[3]);
                    const f32x4 hg = h * gv[bj][n]; a = fmaxf(a, fmaxf(fmaxf(fabsf(hg[0]), fabsf(hg[1])), fmaxf(fabsf(hg[2]), fabsf(hg[3])))); }
            s += __shfl_xor(s, 16); s += __shfl_xor(s, 32); a = fmaxf(a, __shfl_xor(a, 16)); a = fmaxf(a, __shfl_xor(a, 32));
            if (fq == 0) P[r * 4 + wc] = (f32x2v){s, a};
            asm volatile("" ::: "memory"); }
        asm volatile("s_waitcnt lgkmcnt(0)" ::: "memory"); __builtin_amdgcn_s_barrier(); asm volatile("" ::: "memory");
        const int row = wid * 32 + (lane & 31);
        if (lane < 32) {
            const f32x2v a = P[row * 4 + 0], b = P[row * 4 + 1], c = P[row * 4 + 2], d = P[row * 4 + 3];
            const float st = (a.x + b.x) + (c.x + d.x), am = fmaxf(fmaxf(a.y, b.y), fmaxf(c.y, d.y));
            const float sc = (am > 0.f) ? am * (1.0f / 448.0f) : 1.0f;
            S[row] = (f32x2v){st, 1.0f / sc};
            SSQ[(size_t)(u.pm * BM + row) * 4 + u.pn] = st; SXQ[(size_t)(u.pm * BM + row) * 4 + u.pn] = sc;
        }
        asm volatile("s_waitcnt lgkmcnt(0)" ::: "memory"); __builtin_amdgcn_s_barrier(); asm volatile("" ::: "memory");
        asm volatile("" : "+v"(col0), "+v"(fr));
        asm volatile("" : "+v"(gv[0][0]), "+v"(gv[0][1]), "+v"(gv[1][0]), "+v"(gv[1][1]));
#pragma unroll
        for (int ai = 0; ai < 2; ++ai)
#pragma unroll
            for (int m = 0; m < 4; ++m) { const int r = ai * HALF + wr * 64 + m * 16 + fr; const f32x2v sr = S[r]; const size_t off = (size_t)(u.pm * BM + r) * 1024 + col0;
#pragma unroll
                for (int bj = 0; bj < 2; ++bj) { const f32x4 h0 = acc[ai][bj][m][0], h1 = acc[ai][bj][m][1];
                    u32x4 hw; hw.x = cvt_pk_bf16(h0[0], h0[1]); hw.y = cvt_pk_bf16(h0[2], h0[3]); hw.z = cvt_pk_bf16(h1[0], h1[1]); hw.w = cvt_pk_bf16(h1[2], h1[3]);
                    *(u32x4*)(H16 + off + bj * HALF) = hw;
                    const f32x4 o0 = h0 * gv[bj][0], o1 = h1 * gv[bj][1];
                    u32x4 w; w.x = cvt_pk_bf16(o0[0], o0[1]); w.y = cvt_pk_bf16(o0[2], o0[3]); w.z = cvt_pk_bf16(o1[0], o1[1]); w.w = cvt_pk_bf16(o1[2], o1[3]);
                    *(u32x4*)(XN + off + bj * HALF) = w;
                    { const f32x4 q0 = o0 * sr.y, q1 = o1 * sr.y; u32x2v w8;
                        w8.x = (unsigned)__builtin_amdgcn_cvt_pk_fp8_f32(q0[2], q0[3], __builtin_amdgcn_cvt_pk_fp8_f32(q0[0], q0[1], 0, false), true);
                        w8.y = (unsigned)__builtin_amdgcn_cvt_pk_fp8_f32(q1[2], q1[3], __builtin_amdgcn_cvt_pk_fp8_f32(q1[0], q1[1], 0, false), true);
                        *(u32x2v*)(X8 + off + bj * HALF) = w8; } }
                asm volatile("" ::: "memory"); }
    }
};
struct MergeOrder {
    StaticOrder base;
    __device__ __forceinline__ bool next(int i, Unit& u) const { if (!base.next(i >> 1, u)) return false; u.sel = i & 1; return true; }
    __device__ __forceinline__ void a_ready(const Unit&) const {}
    __device__ __forceinline__ void done(const Unit&) const {}
};

template <class Epi, class Sched, bool ALIGN_EPI = false, bool SP2 = false>
__device__ __forceinline__ void gemm_phase(PG8_LAS unsigned char* lds, const Gemm g, const Sched& S, const Epi& E) {
    const int tid = threadIdx.x, wid = __builtin_amdgcn_readfirstlane(tid >> 6), lane = tid & 63, wr = wid >> 2, wc = wid & 3, fr = lane & 15, fq = lane >> 4;
    const int K = g.K, nt = K / BK;
    unsigned voffA[2], voffB[2];
#pragma unroll
    for (int i = 0; i < 2; ++i) { int R, C; stage_rc(tid * 16 + i * 8192, R, C); const int Rb = Epi::PERM ? ((R & ~31) + perm32(R & 31)) : R;
        voffA[i] = (unsigned)(R * K + C) * 2u; voffB[i] = (unsigned)(Rb * K + C) * 2u; }
    const size_t kstep = (size_t)(BK * 2);
    const size_t hstep = (size_t)HALF * K * 2;
    const size_t tstep = 2 * hstep;
    const unsigned ldsw = (unsigned)wid * 1024u;
    const int aoff = lds_byte(wr * 64 + fr, fq * 8), boff = lds_byte(wc * 32 + fr, fq * 8);
#define PG8_SA(b, h) (((b) * 2 + (h)) * HTB)
#define PG8_SB(b, h) ((4 + (b) * 2 + (h)) * HTB)
#define PG8_STAGE(bufoff, gbase, voff) do { _Pragma("unroll") for (int _i = 0; _i < 2; ++_i) \
        __builtin_amdgcn_global_load_lds((const unsigned*)((const char*)(gbase) + (voff)[_i]), (PG8_LAS unsigned*)(lds + (bufoff) + ldsw + _i * 8192), 16, 0, 0); } while (0)
#define PG8_LDA(dst, b, h) do { _Pragma("unroll") for (int m = 0; m < 4; ++m) _Pragma("unroll") for (int k = 0; k < 2; ++k) dst[m][k] = *(const PG8_LAS bf16x8*)(lds + PG8_SA(b, h) + aoff + m * 2048 + k * 1024); } while (0)
#define PG8_LDB(dst, b, h) do { _Pragma("unroll") for (int n = 0; n < 2; ++n) _Pragma("unroll") for (int k = 0; k < 2; ++k) dst[n][k] = *(const PG8_LAS bf16x8*)(lds + PG8_SB(b, h) + boff + n * 2048 + k * 1024); } while (0)
#define PG8_MMA(ai, bj, At, Bt) do { __builtin_amdgcn_s_setprio(1); _Pragma("unroll") for (int m = 0; m < 4; ++m) _Pragma("unroll") for (int n = 0; n < 2; ++n) _Pragma("unroll") for (int k = 0; k < 2; ++k) \
        acc[ai][bj][m][n] = __builtin_amdgcn_mfma_f32_16x16x32_bf16(Bt[n][k], At[m][k], acc[ai][bj][m][n], 0, 0, 0); __builtin_amdgcn_s_setprio(0); } while (0)
#define PG8_WAIT_V(n) asm volatile("s_waitcnt vmcnt(" #n ")" ::: "memory")
#define PG8_WAIT_L(n) asm volatile("s_waitcnt lgkmcnt(" #n ")" ::: "memory")
#define PG8_BAR __builtin_amdgcn_s_barrier()
#define PG8_SCHED __builtin_amdgcn_sched_barrier(0)
    Unit cur, nxt; int ui = 0;
    if (!S.next(0, cur)) return;
    f32x4 acc[2][2][4][2];
#pragma unroll
    for (int a = 0; a < 2; ++a)
#pragma unroll
        for (int b = 0; b < 2; ++b)
#pragma unroll
            for (int m = 0; m < 4; ++m)
#pragma unroll
                for (int n = 0; n < 2; ++n) acc[a][b][m][n] = (f32x4){0.f, 0.f, 0.f, 0.f};
    bf16x8 At[4][2], B0[2][2], B1[2][2];
    const char* cA = (const char*)g.A + (cur.sel ? g.offA1 : 0l) + (size_t)cur.pm * tstep; const char* cB = (const char*)g.Bt + (cur.sel ? g.offB1 : 0l) + (size_t)cur.pn * tstep;
    S.a_ready(cur);
    if constexpr (SP2) {
        PG8_STAGE(PG8_SB(0, 0), cB, voffB); PG8_STAGE(PG8_SB(0, 1), cB + hstep, voffB); PG8_STAGE(PG8_SA(0, 0), cA, voffA); PG8_STAGE(PG8_SA(0, 1), cA + hstep, voffA);
        if (wr == 1) PG8_BAR;
        PG8_WAIT_V(2); PG8_BAR;
        PG8_STAGE(PG8_SB(1, 0), cB + kstep, voffB); PG8_STAGE(PG8_SA(1, 0), cA + kstep, voffA); PG8_STAGE(PG8_SB(1, 1), cB + hstep + kstep, voffB);
        PG8_WAIT_V(6); PG8_BAR;
    } else {
        PG8_STAGE(PG8_SB(0, 0), cB, voffB); PG8_STAGE(PG8_SA(0, 0), cA, voffA); PG8_STAGE(PG8_SB(0, 1), cB + hstep, voffB); PG8_STAGE(PG8_SA(0, 1), cA + hstep, voffA);
        if (wr == 1) PG8_BAR;
        PG8_WAIT_V(4); PG8_BAR;
        PG8_STAGE(PG8_SB(1, 0), cB + kstep, voffB); PG8_STAGE(PG8_SA(1, 0), cA + kstep, voffA); PG8_STAGE(PG8_SB(1, 1), cB + hstep + kstep, voffB);
        PG8_WAIT_V(6); PG8_BAR;
    }
    for (;;) {
        const bool has_next = S.next(ui + 1, nxt);
        const char* nA = has_next ? (const char*)g.A + (nxt.sel ? g.offA1 : 0l) + (size_t)nxt.pm * tstep : cA; const char* nB = has_next ? (const char*)g.Bt + (nxt.sel ? g.offB1 : 0l) + (size_t)nxt.pn * tstep : cB;
        for (int t = 0; t < nt; t += 2) {
            const bool last = (t == nt - 2);
            const char* a1 = cA + (size_t)(t + 1) * kstep;
            const char* a2 = last ? nA : cA + (size_t)(t + 2) * kstep; const char* b2 = last ? nB : cB + (size_t)(t + 2) * kstep;
            const char* a3 = a2 + kstep; const char* b3 = b2 + kstep;
            if (last && has_next) S.a_ready(nxt);
            if constexpr (SP2) {
            PG8_LDB(B0, 0, 0); PG8_LDB(B1, 0, 1); PG8_SCHED; PG8_LDA(At, 0, 0); PG8_STAGE(PG8_SA(1, 1), a1 + hstep, voffA);
            PG8_WAIT_V(8); PG8_WAIT_L(0); PG8_BAR; PG8_MMA(0, 0, At, B0); PG8_MMA(0, 1, At, B1); PG8_BAR; PG8_SCHED;
            PG8_LDA(At, 0, 1); PG8_STAGE(PG8_SB(0, 0), b2, voffB); PG8_STAGE(PG8_SB(0, 1), b2 + hstep, voffB); PG8_STAGE(PG8_SA(0, 0), a2, voffA);
            PG8_WAIT_V(8); PG8_WAIT_L(0); PG8_BAR; PG8_MMA(1, 0, At, B0); PG8_MMA(1, 1, At, B1); PG8_BAR; PG8_SCHED;
            PG8_LDB(B0, 1, 0); PG8_LDB(B1, 1, 1); PG8_SCHED; PG8_LDA(At, 1, 0); PG8_STAGE(PG8_SA(0, 1), a2 + hstep, voffA);
            PG8_WAIT_V(8); PG8_WAIT_L(0); PG8_BAR; PG8_MMA(0, 0, At, B0); PG8_MMA(0, 1, At, B1); PG8_BAR; PG8_SCHED;
            PG8_LDA(At, 1, 1); PG8_STAGE(PG8_SB(1, 0), b3, voffB); PG8_STAGE(PG8_SB(1, 1), b3 + hstep, voffB); PG8_STAGE(PG8_SA(1, 0), a3, voffA);
            PG8_WAIT_V(8); PG8_WAIT_L(0); PG8_BAR; PG8_MMA(1, 0, At, B0); PG8_MMA(1, 1, At, B1); PG8_BAR; PG8_SCHED;
            } else {
            PG8_LDB(B0, 0, 0); PG8_SCHED; PG8_LDA(At, 0, 0); PG8_STAGE(PG8_SA(1, 1), a1 + hstep, voffA);
            PG8_WAIT_L(8); PG8_BAR; PG8_WAIT_L(0); PG8_MMA(0, 0, At, B0); PG8_BAR; PG8_SCHED;
            PG8_LDB(B1, 0, 1); PG8_STAGE(PG8_SB(0, 0), b2, voffB);
            PG8_BAR; PG8_WAIT_L(0); PG8_MMA(0, 1, At, B1); PG8_BAR;
            PG8_LDA(At, 0, 1); PG8_STAGE(PG8_SA(0, 0), a2, voffA);
            PG8_BAR; PG8_WAIT_L(0); PG8_MMA(1, 0, At, B0); PG8_BAR; PG8_SCHED;
            PG8_STAGE(PG8_SB(0, 1), b2 + hstep, voffB);
            PG8_WAIT_V(6); PG8_BAR; PG8_MMA(1, 1, At, B1); PG8_BAR;
            PG8_LDB(B0, 1, 0); PG8_SCHED; PG8_LDA(At, 1, 0); PG8_STAGE(PG8_SA(0, 1), a2 + hstep, voffA);
            PG8_WAIT_L(8); PG8_BAR; PG8_WAIT_L(0); PG8_MMA(0, 0, At, B0); PG8_BAR; PG8_SCHED;
            PG8_LDB(B1, 1, 1); PG8_STAGE(PG8_SB(1, 0), b3, voffB);
            PG8_BAR; PG8_WAIT_L(0); PG8_MMA(0, 1, At, B1); PG8_BAR;
            PG8_LDA(At, 1, 1); PG8_STAGE(PG8_SA(1, 0), a3, voffA);
            PG8_BAR; PG8_WAIT_L(0); PG8_MMA(1, 0, At, B0); PG8_BAR; PG8_SCHED;
            PG8_STAGE(PG8_SB(1, 1), b3 + hstep, voffB);
            PG8_WAIT_V(6); PG8_BAR; PG8_MMA(1, 1, At, B1); PG8_BAR;
            }
        }
        if constexpr (ALIGN_EPI) { if (wr == 0) PG8_BAR; }
        if constexpr (!Epi::AFTER_DRAIN) { E(acc, cur, wr, wc, fr, fq); S.done(cur); }
        if (!has_next) break;
        if (!Epi::CHAIN || nxt.sel == 0) {
#pragma unroll
        for (int a = 0; a < 2; ++a)
#pragma unroll
            for (int b = 0; b < 2; ++b)
#pragma unroll
                for (int m = 0; m < 4; ++m)
#pragma unroll
                    for (int n = 0; n < 2; ++n) acc[a][b][m][n] = (f32x4){0.f, 0.f, 0.f, 0.f};
        }
        cur = nxt; cA = nA; cB = nB; ++ui;
        if constexpr (ALIGN_EPI) { if (wr == 1) PG8_BAR; }
    }
    PG8_WAIT_V(0);
    if constexpr (!ALIGN_EPI) { if (wr == 0) PG8_BAR; }
    PG8_BAR;
    if constexpr (Epi::AFTER_DRAIN) { E.fused(acc, cur, wr, wc, fr, fq, lds, wid, lane); S.done(cur); }
#undef PG8_SA
#undef PG8_SB
#undef PG8_STAGE
#undef PG8_LDA
#undef PG8_LDB
#undef PG8_MMA
#undef PG8_WAIT_V
#undef PG8_WAIT_L
#undef PG8_BAR
#undef PG8_SCHED
}
}
constexpr int NWAVES = 8;
#ifndef MK_N_LAUNCHES
#define MK_N_LAUNCHES 1
#endif
constexpr int NPHASE = 8;
#ifndef PROBE_DUP
#define PROBE_DUP 0
#endif
#ifndef PROBE_DELAY
#define PROBE_DELAY (-1)
#endif
#define DELAY_T0(k) const unsigned long long _t0_##k = (PROBE_DELAY == (k)) ? __builtin_amdgcn_s_memrealtime() : 0ull
#define DELAY_END(k) do { if (PROBE_DELAY == (k)) { const unsigned long long _t1 = __builtin_amdgcn_s_memrealtime(), _dt = _t1 - _t0_##k; while (__builtin_amdgcn_s_memrealtime() - _t1 < _dt) __builtin_amdgcn_s_sleep(8); } } while (0)
#define REPS(k) (1 + ((PROBE_DUP >> (k)) & 1))
constexpr int N_LAUNCHES = MK_N_LAUNCHES;
static_assert(N_LAUNCHES == 1 || N_LAUNCHES == NPHASE, "MK_N_LAUNCHES is 1 or NPHASE");

constexpr int T = 16384, SEQ = 2048, D = 1024, NIN = 6144, NSC = 2048, NEXP = 16384, NSEL = 128;
constexpr float EPS = 1e-6f;

constexpr size_t MiB = 1u << 20;
constexpr size_t WS_CTL = 0, CTL_ZERO_BYTES = 64 * 1024;
constexpr size_t WS_WIN = 1 * MiB, WS_WC = 13 * MiB, WS_WPB = 15 * MiB, WS_WOUT = 17 * MiB, WS_WS = 19 * MiB;
constexpr size_t WS_IDX = 1 * MiB, WS_GATE = 9 * MiB;
constexpr size_t WS_XN = 32 * MiB;
constexpr size_t WS_PB = 64 * MiB;
constexpr size_t WS_TMP = 64 * MiB, WS_MG = 96 * MiB;
constexpr size_t WS_X8 = 128 * MiB, WS_SX = 144 * MiB;
constexpr size_t WS_PO = 64 * MiB;
constexpr size_t WS_SC = 64 * MiB;
constexpr size_t WS_PG = 192 * MiB;
constexpr size_t WS_U8 = 192 * MiB, WS_V8 = 208 * MiB, WS_H16 = 224 * MiB, WS_SU = 31 * MiB + 512 * 1024, WS_SV = 31 * MiB + 576 * 1024;
constexpr size_t WS_END = 256 * MiB;
constexpr int CW_TMO = 0;
constexpr int CW_BAR = 1024;
constexpr int CW_SEAM = 8192;
constexpr size_t WS_XBUF = 31 * MiB;

constexpr int RING_OFF = 0, RING_BYTES = 131072;
constexpr int P7_WAVE_BYTES = 18432;
constexpr int P7_IDX_OFF = 0, P7_OUT_OFF = 4096, P7_STAGE_OFF = 6144, P7_ZA_OFF = 14336;
constexpr int LDSCTL_OFF = 8 * P7_WAVE_BYTES, MISC_OFF = LDSCTL_OFF + 320;
constexpr int P7_AUX_OFF = LDSCTL_OFF + 1024;
constexpr int LDS_BYTES = 150528;
#define GAS __attribute__((address_space(1)))
#define LAS __attribute__((address_space(3)))
typedef unsigned short bf16;
typedef unsigned v4u __attribute__((ext_vector_type(4)));
typedef float f32x4 __attribute__((ext_vector_type(4)));
typedef short bf16x8 __attribute__((ext_vector_type(8)));
typedef GAS unsigned gu32;
typedef GAS unsigned long long gu64;
#define RLX_AGENT __ATOMIC_RELAXED, __HIP_MEMORY_SCOPE_AGENT
#define LDS_WAIT() asm volatile("s_waitcnt lgkmcnt(0)" ::: "memory")
#define VM_WAIT() asm volatile("s_waitcnt vmcnt(0)" ::: "memory")
__device__ __forceinline__ unsigned long long rt() { return __builtin_amdgcn_s_memrealtime(); }
__device__ __forceinline__ unsigned f2bf(float f) { unsigned u = __builtin_bit_cast(unsigned, f); return (u + 0x7fffu + ((u >> 16) & 1u)) >> 16; }
__device__ __forceinline__ unsigned pk2(float lo, float hi) { return f2bf(lo) | (f2bf(hi) << 16); }

#define XB_TMO      128
#define XB_XCNT(j)  (256  + 64 * (j))
#define XB_XSUB(j)  (1280 + 64 * (j))
#define XB_XGEN(j)  (2304 + 64 * (j))
#define XB_TOP      3328
#define XB_TOPGEN   3392
#define XCD_BAR_WORDS 3456
#define XB_SPIN_CAP (1u << 18)

__device__ __forceinline__ unsigned xb_ld(unsigned* p)              { return __hip_atomic_load(p, __ATOMIC_RELAXED, __HIP_MEMORY_SCOPE_AGENT); }
__device__ __forceinline__ unsigned xb_add(unsigned* p, unsigned v) { return __hip_atomic_fetch_add(p, v, __ATOMIC_RELAXED, __HIP_MEMORY_SCOPE_AGENT); }
__device__ __forceinline__ unsigned xb_xcc_id() { return (unsigned)__builtin_amdgcn_s_getreg((3 << 11) | 20) & 0xFu; }
#define XB_SPIN(cond, bar) do { unsigned _sp = 0; while (cond) { __builtin_amdgcn_s_sleep(1); \
    if ((++_sp & 255u) == 0u) { if (xb_ld(&(bar)[XB_TMO])) break; if (_sp > XB_SPIN_CAP) { atomicAdd(&(bar)[XB_TMO], 1u); break; } } } } while (0)

struct XcdBarrier {
    unsigned* bar; unsigned x;
    volatile LAS unsigned* st;
};

__device__ __forceinline__ XcdBarrier xcd_barrier_post(unsigned* bar, volatile LAS unsigned* st) {
    XcdBarrier b; b.bar = bar; b.x = xb_xcc_id(); b.st = st;
    if (threadIdx.x == 0) (void)xb_add(&bar[XB_XCNT(b.x)], 1u);
    return b;
}
__device__ __forceinline__ void xcd_barrier_complete(unsigned* bar, unsigned x, unsigned& nloc, unsigned& nx) {
    const unsigned G = gridDim.x * gridDim.y * gridDim.z;
    unsigned sum, cnt, mine, sp = 0u;
    for (;;) {
        sum = 0u; cnt = 0u; mine = 0u;
#pragma unroll
        for (unsigned j = 0; j < 16; ++j) { const unsigned c = xb_ld(&bar[XB_XCNT(j)]); sum += c; cnt += (c > 0u) ? 1u : 0u; mine = (j == x) ? c : mine; }
        if (sum == G) break;
        __builtin_amdgcn_s_sleep(1);
        if ((++sp & 255u) == 0u) { if (xb_ld(&bar[XB_TMO])) break; if (sp > XB_SPIN_CAP) { atomicAdd(&bar[XB_TMO], 1u); break; } }
    }
    nloc = mine > 0u ? mine : 1u; nx = cnt > 0u ? cnt : 1u;
}

__device__ __forceinline__ void xcd_barrier(const XcdBarrier& b) {
    asm volatile("s_waitcnt vmcnt(0)" ::: "memory");
    __syncthreads();
    if (threadIdx.x == 0) {
        unsigned* bar = b.bar;
        __builtin_amdgcn_s_waitcnt(0);
        unsigned nloc = b.st[0], nx = b.st[1];
        if (nloc == 0u) { xcd_barrier_complete(bar, b.x, nloc, nx); b.st[0] = nloc; b.st[1] = nx; }
        const unsigned old = xb_add(&bar[XB_XSUB(b.x)], 1u);
        const unsigned gen = old / nloc;
        if (old + 1u == (gen + 1u) * nloc) {
            __builtin_amdgcn_fence(__ATOMIC_RELEASE, "agent");
            asm volatile("s_waitcnt vmcnt(0)" ::: "memory");
            const unsigned og = xb_add(&bar[XB_TOP], 1u);
            const unsigned tg = og / nx;
            if (og + 1u == (tg + 1u) * nx) xb_add(&bar[XB_TOPGEN], 1u);
            else XB_SPIN(xb_ld(&bar[XB_TOPGEN]) == tg, bar);
            __builtin_amdgcn_fence(__ATOMIC_ACQUIRE, "agent");
            xb_add(&bar[XB_XGEN(b.x)], 1u);
            asm volatile("s_waitcnt vmcnt(0)" ::: "memory");
        } else {
            XB_SPIN(xb_ld(&bar[XB_XGEN(b.x)]) == gen, bar);
            __builtin_amdgcn_fence(__ATOMIC_ACQUIRE, "agent");
            asm volatile("s_waitcnt vmcnt(0)" ::: "memory");
        }
    }
    __syncthreads();
}

struct Frame {
    LAS unsigned char* lds;
    volatile LAS unsigned* MISC;
    int tid, lane, wave;
    int vcu, G;
};
__device__ __forceinline__ float wave_sum(float v) {
#pragma unroll
    for (int o = 1; o < 64; o <<= 1) v += __shfl_xor(v, o);
    return v;
}
__device__ __forceinline__ float bflo(unsigned w) { return __uint_as_float(w << 16); }
__device__ __forceinline__ float bfhi(unsigned w) { return __uint_as_float(w & 0xffff0000u); }
__device__ __forceinline__ void unpack8(const v4u w, float (&f)[8]) { f[0] = bflo(w.x); f[1] = bfhi(w.x); f[2] = bflo(w.y); f[3] = bfhi(w.y); f[4] = bflo(w.z); f[5] = bfhi(w.z); f[6] = bflo(w.w); f[7] = bfhi(w.w); }
__device__ __forceinline__ v4u pack8(const float (&f)[8]) { v4u o; o.x = pk2(f[0], f[1]); o.y = pk2(f[2], f[3]); o.z = pk2(f[4], f[5]); o.w = pk2(f[6], f[7]); return o; }

__device__ __forceinline__ void rms_row_to_fp8(int lane, const float* xrow, const float* g, unsigned char* orow, float* sc_out) {
    const GAS f32x4* xr = (const GAS f32x4*)xrow + 4 * lane; const GAS f32x4* gr = (const GAS f32x4*)g + 4 * lane;
    f32x4 v[4]; float s = 0.f, am = 0.f;
#pragma unroll
    for (int jj = 0; jj < 4; ++jj) { v[jj] = xr[jj]; s += (v[jj].x * v[jj].x + v[jj].y * v[jj].y) + (v[jj].z * v[jj].z + v[jj].w * v[jj].w); v[jj] = v[jj] * gr[jj];
        am = fmaxf(am, fmaxf(fmaxf(fabsf(v[jj].x), fabsf(v[jj].y)), fmaxf(fabsf(v[jj].z), fabsf(v[jj].w)))); }
#pragma unroll
    for (int o = 1; o < 64; o <<= 1) am = fmaxf(am, __shfl_xor(am, o));
    const float rstd = 1.f / sqrtf(wave_sum(s) * (1.f / D) + EPS), xm = am * rstd, sc = (xm > 0.f) ? xm * (1.0f / 448.0f) : 1.0f, mul = rstd / sc;
    v4u o;
    o.x = (unsigned)__builtin_amdgcn_cvt_pk_fp8_f32(v[0].z * mul, v[0].w * mul, __builtin_amdgcn_cvt_pk_fp8_f32(v[0].x * mul, v[0].y * mul, 0, false), true);
    o.y = (unsigned)__builtin_amdgcn_cvt_pk_fp8_f32(v[1].z * mul, v[1].w * mul, __builtin_amdgcn_cvt_pk_fp8_f32(v[1].x * mul, v[1].y * mul, 0, false), true);
    o.z = (unsigned)__builtin_amdgcn_cvt_pk_fp8_f32(v[2].z * mul, v[2].w * mul, __builtin_amdgcn_cvt_pk_fp8_f32(v[2].x * mul, v[2].y * mul, 0, false), true);
    o.w = (unsigned)__builtin_amdgcn_cvt_pk_fp8_f32(v[3].z * mul, v[3].w * mul, __builtin_amdgcn_cvt_pk_fp8_f32(v[3].x * mul, v[3].y * mul, 0, false), true);
    *(GAS v4u*)(orow + 16 * lane) = o;
    if (lane == 0) *sc_out = sc;
}
__device__ __forceinline__ void p4_row_defer(int lane, const float* hrow, const float* g, bf16* hg, unsigned char* x8, float* ssq, float* sxq, bf16* h16) {
    const GAS f32x4* xr = (const GAS f32x4*)hrow + 4 * lane; const GAS f32x4* gr = (const GAS f32x4*)g + 4 * lane;
    f32x4 v[4], h[4]; float s = 0.f, am = 0.f;
#pragma unroll
    for (int jj = 0; jj < 4; ++jj) { h[jj] = xr[jj]; s += (h[jj].x * h[jj].x + h[jj].y * h[jj].y) + (h[jj].z * h[jj].z + h[jj].w * h[jj].w); v[jj] = h[jj] * gr[jj];
        am = fmaxf(am, fmaxf(fmaxf(fabsf(v[jj].x), fabsf(v[jj].y)), fmaxf(fabsf(v[jj].z), fabsf(v[jj].w)))); }
#pragma unroll
    for (int o = 1; o < 64; o <<= 1) am = fmaxf(am, __shfl_xor(am, o));
    s = wave_sum(s);
    const float sc = (am > 0.f) ? am * (1.0f / 448.0f) : 1.0f, mul = 1.0f / sc;
    v4u o;
    o.x = (unsigned)__builtin_amdgcn_cvt_pk_fp8_f32(v[0].z * mul, v[0].w * mul, __builtin_amdgcn_cvt_pk_fp8_f32(v[0].x * mul, v[0].y * mul, 0, false), true);
    o.y = (unsigned)__builtin_amdgcn_cvt_pk_fp8_f32(v[1].z * mul, v[1].w * mul, __builtin_amdgcn_cvt_pk_fp8_f32(v[1].x * mul, v[1].y * mul, 0, false), true);
    o.z = (unsigned)__builtin_amdgcn_cvt_pk_fp8_f32(v[2].z * mul, v[2].w * mul, __builtin_amdgcn_cvt_pk_fp8_f32(v[2].x * mul, v[2].y * mul, 0, false), true);
    o.w = (unsigned)__builtin_amdgcn_cvt_pk_fp8_f32(v[3].z * mul, v[3].w * mul, __builtin_amdgcn_cvt_pk_fp8_f32(v[3].x * mul, v[3].y * mul, 0, false), true);
    *(GAS v4u*)(x8 + 16 * lane) = o;
    v4u a0, a1, b0, b1;
    a0.x = pk2(v[0].x, v[0].y); a0.y = pk2(v[0].z, v[0].w); a0.z = pk2(v[1].x, v[1].y); a0.w = pk2(v[1].z, v[1].w); a1.x = pk2(v[2].x, v[2].y); a1.y = pk2(v[2].z, v[2].w); a1.z = pk2(v[3].x, v[3].y); a1.w = pk2(v[3].z, v[3].w);
    b0.x = pk2(h[0].x, h[0].y); b0.y = pk2(h[0].z, h[0].w); b0.z = pk2(h[1].x, h[1].y); b0.w = pk2(h[1].z, h[1].w); b1.x = pk2(h[2].x, h[2].y); b1.y = pk2(h[2].z, h[2].w); b1.z = pk2(h[3].x, h[3].y); b1.w = pk2(h[3].z, h[3].w);
    *(GAS v4u*)(hg + 16 * lane) = a0; *(GAS v4u*)(hg + 16 * lane + 8) = a1; *(GAS v4u*)(h16 + 16 * lane) = b0; *(GAS v4u*)(h16 + 16 * lane + 8) = b1;
    if (lane == 0) { ssq[0] = s; ssq[1] = 0.f; ssq[2] = 0.f; ssq[3] = 0.f; sxq[0] = sc; sxq[1] = sc; sxq[2] = sc; sxq[3] = sc; }
}
__device__ __forceinline__ void rms_rows4_to_bf16(int lane, const float* xrow, const float* g, bf16* orow) {
    asm volatile("" : "+v"(lane));
    const GAS f32x4* gr = (const GAS f32x4*)g + lane;
    f32x4 v[4][4]; float s[4];
#pragma unroll
    for (int rr = 0; rr < 4; ++rr) { const GAS f32x4* xr = (const GAS f32x4*)(xrow + (size_t)rr * D) + lane;
#pragma unroll
        for (int jj = 0; jj < 4; ++jj) v[rr][jj] = xr[64 * jj]; }
#pragma unroll
    for (int rr = 0; rr < 4; ++rr) { float a = 0.f;
#pragma unroll
        for (int jj = 0; jj < 4; ++jj) a += (v[rr][jj].x * v[rr][jj].x + v[rr][jj].y * v[rr][jj].y) + (v[rr][jj].z * v[rr][jj].z + v[rr][jj].w * v[rr][jj].w);
        s[rr] = a; }
#pragma unroll
    for (int o = 1; o < 64; o <<= 1) {
#pragma unroll
        for (int rr = 0; rr < 4; ++rr) s[rr] += __shfl_xor(s[rr], o); }
    f32x4 gg[4];
#pragma unroll
    for (int jj = 0; jj < 4; ++jj) gg[jj] = gr[64 * jj];
#pragma unroll
    for (int rr = 0; rr < 4; ++rr) { const float rstd = 1.f / sqrtf(s[rr] * (1.f / D) + EPS);
        GAS unsigned long long* o8 = (GAS unsigned long long*)(orow + (size_t)rr * D) + lane;
#pragma unroll
        for (int jj = 0; jj < 4; ++jj) o8[64 * jj] = (unsigned long long)pk2(v[rr][jj].x * rstd * gg[jj].x, v[rr][jj].y * rstd * gg[jj].y) | ((unsigned long long)pk2(v[rr][jj].z * rstd * gg[jj].z, v[rr][jj].w * rstd * gg[jj].w) << 32); }
}
template <bool PERM_IN>
__device__ __forceinline__ void p0_transpose_item(const float* W, int K, int N, bf16* WT, LAS float* scr, int item, int lane) {
    const int nblk = N / 32, kb = item / nblk, nb = item % nblk, k0 = 64 * kb, n0 = 32 * nb;
    int ns = n0;
    if (PERM_IN && n0 >= 1024 && n0 < 3072) { const int q = n0 - 1024; ns = (((q >> 7) & 1) ? 2048 : 1024) + 128 * (q >> 8) + (q & 127); }
    float tv[32];
#pragma unroll
    for (int i = 0; i < 32; ++i) tv[i] = W[(size_t)(k0 + 2 * i + (lane >> 5)) * N + ns + (lane & 31)];
#pragma unroll
    for (int i = 0; i < 32; ++i) scr[(2 * i + (lane >> 5)) * 33 + (lane & 31)] = tv[i];
    LDS_WAIT(); asm volatile("" ::: "memory");
    const int c = lane & 7;
#pragma unroll
    for (int j = 0; j < 4; ++j) { const int n = (lane >> 3) + 8 * j; const LAS float* s = scr + (8 * c) * 33 + n;
        v4u o; o.x = pk2(s[0 * 33], s[1 * 33]); o.y = pk2(s[2 * 33], s[3 * 33]); o.z = pk2(s[4 * 33], s[5 * 33]); o.w = pk2(s[6 * 33], s[7 * 33]);
        *(GAS v4u*)(WT + (size_t)(n0 + n) * K + k0 + 8 * c) = o; }
    LDS_WAIT(); asm volatile("" ::: "memory");
}
template <int NS>
__device__ __forceinline__ void fold_tile(LAS float* sm, const float* Ap, int sAi, int sAk, const float* As, const float* Bp, int sBj, bf16* Cp, int ldc, int tid) {
    LAS float* sA = sm; LAS float* sB = sm + 32 * 68;
    float ra[NS][4], rb[NS][4];
#pragma unroll
    for (int sl = 0; sl < NS; ++sl)
#pragma unroll
        for (int r = 0; r < 4; ++r) { const int e = tid + 512 * r; int i, kq;
            if (sAk == 1) { kq = e & 31; i = e >> 5; } else { i = e & 63; kq = e >> 6; }
            float a = Ap[(size_t)i * sAi + (size_t)(sl * 32 + kq) * sAk]; if (As) a *= As[sl * 32 + kq]; ra[sl][r] = a;
            rb[sl][r] = Bp[(size_t)(e >> 5) * sBj + sl * 32 + (e & 31)]; }
    float acc[2][4];
#pragma unroll
    for (int q = 0; q < 2; ++q)
#pragma unroll
        for (int p = 0; p < 4; ++p) acc[q][p] = 0.f;
    const int tj4 = (tid & 15) * 4, ti2 = (tid >> 4) * 2;
#pragma unroll
    for (int sl = 0; sl < NS; ++sl) {
#pragma unroll
        for (int r = 0; r < 4; ++r) { const int e = tid + 512 * r; int i, kq;
            if (sAk == 1) { kq = e & 31; i = e >> 5; } else { i = e & 63; kq = e >> 6; }
            sA[kq * 68 + i] = ra[sl][r]; sB[(e & 31) * 68 + (e >> 5)] = rb[sl][r]; }
        __syncthreads();
#pragma unroll 8
        for (int kk = 0; kk < 32; ++kk) { const f32x4 bq = *(const LAS f32x4*)(sB + kk * 68 + tj4); const float a0 = sA[kk * 68 + ti2], a1 = sA[kk * 68 + ti2 + 1];
            acc[0][0] += a0 * bq.x; acc[0][1] += a0 * bq.y; acc[0][2] += a0 * bq.z; acc[0][3] += a0 * bq.w;
            acc[1][0] += a1 * bq.x; acc[1][1] += a1 * bq.y; acc[1][2] += a1 * bq.z; acc[1][3] += a1 * bq.w; }
        __syncthreads();
    }
#pragma unroll
    for (int q = 0; q < 2; ++q) *(GAS unsigned long long*)(Cp + (size_t)(ti2 + q) * ldc + tj4) = (unsigned long long)pk2(acc[q][0], acc[q][1]) | ((unsigned long long)pk2(acc[q][2], acc[q][3]) << 32);
}
template <int NS, int TJ, bool A_ICONTIG>
__device__ __forceinline__ void fold_wave(LAS float* sm, const float* Ap, int sA, const float* As, const float* Bp, int sBj, bf16* Cp, int ldc, int lane) {
    constexpr int NB = TJ / 8, RB = TJ / 8;
    LAS float* sAl = sm; LAS float* sBl = sm + 32 * 36;
    const int l8 = lane >> 3, l7 = lane & 7;
    f32x4 ra[4], rb[RB];
#define FW_LOAD(sl_) do { _Pragma("unroll") for (int r = 0; r < 4; ++r) { \
            if (A_ICONTIG) { const int kq = l8 + 8 * r; f32x4 a = *(const GAS f32x4*)(Ap + (size_t)((sl_) * 32 + kq) * sA + l7 * 4); const float sc = As[(sl_) * 32 + kq]; ra[r] = a * sc; } \
            else ra[r] = *(const GAS f32x4*)(Ap + (size_t)(l8 + 8 * r) * sA + (sl_) * 32 + l7 * 4); } \
        _Pragma("unroll") for (int r = 0; r < RB; ++r) rb[r] = *(const GAS f32x4*)(Bp + (size_t)(l8 + 8 * r) * sBj + (sl_) * 32 + l7 * 4); } while (0)
    FW_LOAD(0);
    float acc[4][NB];
#pragma unroll
    for (int p = 0; p < 4; ++p)
#pragma unroll
        for (int q = 0; q < NB; ++q) acc[p][q] = 0.f;
#pragma unroll
    for (int sl = 0; sl < NS; ++sl) {
#pragma unroll
        for (int r = 0; r < 4; ++r) {
            if (A_ICONTIG) *(LAS f32x4*)(sAl + (l8 + 8 * r) * 36 + l7 * 4) = ra[r];
            else { const int i = l8 + 8 * r, kq = l7 * 4; sAl[kq * 36 + i] = ra[r].x; sAl[(kq + 1) * 36 + i] = ra[r].y; sAl[(kq + 2) * 36 + i] = ra[r].z; sAl[(kq + 3) * 36 + i] = ra[r].w; } }
#pragma unroll
        for (int r = 0; r < RB; ++r) { const int jj = l8 + 8 * r, kq = l7 * 4; sBl[kq * 36 + jj] = rb[r].x; sBl[(kq + 1) * 36 + jj] = rb[r].y; sBl[(kq + 2) * 36 + jj] = rb[r].z; sBl[(kq + 3) * 36 + jj] = rb[r].w; }
        LDS_WAIT(); asm volatile("" ::: "memory");
        if (sl + 1 < NS) FW_LOAD(sl + 1);
#pragma unroll 8
        for (int kk = 0; kk < 32; ++kk) { const f32x4 a4 = *(const LAS f32x4*)(sAl + kk * 36 + 4 * l8);
            float bq[NB];
            if (NB == 4) { const f32x4 b4 = *(const LAS f32x4*)(sBl + kk * 36 + 4 * l7); bq[0] = b4.x; bq[1] = b4.y; bq[2] = b4.z; bq[NB - 1] = b4.w; }
            else { bq[0] = sBl[kk * 36 + 2 * l7]; bq[NB - 1] = sBl[kk * 36 + 2 * l7 + 1]; }
#pragma unroll
            for (int q = 0; q < NB; ++q) { acc[0][q] += a4.x * bq[q]; acc[1][q] += a4.y * bq[q]; acc[2][q] += a4.z * bq[q]; acc[3][q] += a4.w * bq[q]; } }
        LDS_WAIT(); asm volatile("" ::: "memory");
    }
#undef FW_LOAD
#pragma unroll
    for (int p = 0; p < 4; ++p) { bf16* cp = Cp + (size_t)(4 * l8 + p) * ldc + NB * l7;
        if (NB == 4) *(GAS unsigned long long*)cp = (unsigned long long)pk2(acc[p][0], acc[p][1]) | ((unsigned long long)pk2(acc[p][2], acc[p][NB - 1]) << 32);
        else *(GAS unsigned*)cp = pk2(acc[p][0], acc[p][NB - 1]); }
}
__device__ __forceinline__ void rms_row_to_bf16(int lane, const float* xrow, const float* g, bf16* orow) {
    const GAS f32x4* xr = (const GAS f32x4*)xrow + lane; const GAS f32x4* gr = (const GAS f32x4*)g + lane;
    f32x4 v[4]; float s = 0.f;
#pragma unroll
    for (int j = 0; j < 4; ++j) { v[j] = xr[64 * j]; s += (v[j].x * v[j].x + v[j].y * v[j].y) + (v[j].z * v[j].z + v[j].w * v[j].w); }
    const float rstd = 1.f / sqrtf(wave_sum(s) * (1.f / D) + EPS);
    GAS unsigned long long* o8 = (GAS unsigned long long*)orow + lane;
#pragma unroll
    for (int j = 0; j < 4; ++j) { const f32x4 gg = gr[64 * j];
        o8[64 * j] = (unsigned long long)pk2(v[j].x * rstd * gg.x, v[j].y * rstd * gg.y) | ((unsigned long long)pk2(v[j].z * rstd * gg.z, v[j].w * rstd * gg.w) << 32); }
}
__device__ __forceinline__ v4u ldv(const bf16* p) { return *(const GAS v4u*)p; }
template <int WIN> __device__ __forceinline__ void p2_pool(const bf16* pcol  , bf16* ocol  , int t0, bool first) {
    for (int hf = 0; hf < 2; ++hf) {
        const int base = t0 + 8 * hf;
        v4u raw[WIN + 7];
#pragma unroll
        for (int q = 0; q < WIN + 7; ++q) { const int rel = 8 * hf + q - (WIN - 1);
            raw[q] = (rel >= 0 || !first) ? ldv(pcol + (size_t)(base + q - (WIN - 1)) * 3072) : (v4u){0u, 0u, 0u, 0u}; }
        float S[8];
#pragma unroll
        for (int e = 0; e < 8; ++e) S[e] = 0.f;
#pragma unroll
        for (int q = 0; q < WIN - 1; ++q) { float f[8]; unpack8(raw[q], f);
#pragma unroll
            for (int e = 0; e < 8; ++e) S[e] += f[e]; }
#pragma unroll
        for (int r = 0; r < 8; ++r) {
            float pn[8], o[8]; unpack8(raw[r + WIN - 1], pn);
#pragma unroll
            for (int e = 0; e < 8; ++e) S[e] += pn[e];
            const int sr = 8 * hf + r;
            const float inv = (first && sr < WIN - 1) ? 1.0f / (float)(sr + 1) : 1.0f / (float)WIN;
#pragma unroll
            for (int e = 0; e < 8; ++e) o[e] = S[e] * inv - pn[e];
            *(GAS v4u*)(ocol + (size_t)(base + r) * D) = pack8(o);
            float po[8]; unpack8(raw[r], po);
#pragma unroll
            for (int e = 0; e < 8; ++e) S[e] -= po[e];
        }
        asm volatile("" ::: "memory");
    }
}
__device__ __forceinline__ void p2_conv_pool(Frame& F, const bf16* PB, const float* conv_w, bf16* AIN, bf16* POOLED) {
    const int gw = F.vcu * NWAVES + F.wave, NGW = F.G * NWAVES, lane = F.lane;
    for (int it = gw; it < 4 * (T / 32); it += NGW) {
        const int g = it & 3, rc = (it >> 2) * 2 + (lane >> 5), col = g * 256 + (lane & 31) * 8, t0 = rc * 16; const bool first = (t0 & (SEQ - 1)) == 0;
        float w0[8], w1[8], w2[8];
        { const f32x4 a = *(const GAS f32x4*)(conv_w + col), b = *(const GAS f32x4*)(conv_w + col + 4); w0[0] = a.x; w0[1] = a.y; w0[2] = a.z; w0[3] = a.w; w0[4] = b.x; w0[5] = b.y; w0[6] = b.z; w0[7] = b.w; }
        { const f32x4 a = *(const GAS f32x4*)(conv_w + D + col), b = *(const GAS f32x4*)(conv_w + D + col + 4); w1[0] = a.x; w1[1] = a.y; w1[2] = a.z; w1[3] = a.w; w1[4] = b.x; w1[5] = b.y; w1[6] = b.z; w1[7] = b.w; }
        { const f32x4 a = *(const GAS f32x4*)(conv_w + 2 * D + col), b = *(const GAS f32x4*)(conv_w + 2 * D + col + 4); w2[0] = a.x; w2[1] = a.y; w2[2] = a.z; w2[3] = a.w; w2[4] = b.x; w2[5] = b.y; w2[6] = b.z; w2[7] = b.w; }
        float um2[8], um1[8];
        { const v4u u2 = first ? (v4u){0u, 0u, 0u, 0u} : ldv(PB + (size_t)(t0 - 2) * 3072 + 1024 + col), u1 = first ? (v4u){0u, 0u, 0u, 0u} : ldv(PB + (size_t)(t0 - 1) * 3072 + 1024 + col);
          unpack8(u2, um2); unpack8(u1, um1); }
        for (int hf = 0; hf < 2; ++hf) {
            v4u rb[8], ru[8];
#pragma unroll
            for (int r = 0; r < 8; ++r) { const size_t rowb = (size_t)(t0 + 8 * hf + r) * 3072 + col; rb[r] = ldv(PB + rowb); ru[r] = ldv(PB + rowb + 1024); }
#pragma unroll
            for (int r = 0; r < 8; ++r) { float b[8], uu[8], o[8]; unpack8(rb[r], b); unpack8(ru[r], uu);
#pragma unroll
                for (int e = 0; e < 8; ++e) { o[e] = b[e] * (w0[e] * um2[e] + w1[e] * um1[e] + w2[e] * uu[e]); um2[e] = um1[e]; um1[e] = uu[e]; }
                *(GAS v4u*)(AIN + (size_t)(t0 + 8 * hf + r) * D + col) = pack8(o); }
            asm volatile("" ::: "memory");
        }
        asm volatile("" ::: "memory");
        const bf16* pcol = PB + 2048 + col; bf16* ocol = POOLED + col;
        if (g == 0) p2_pool<2>(pcol, ocol, t0, first); else if (g == 1) p2_pool<4>(pcol, ocol, t0, first); else if (g == 2) p2_pool<8>(pcol, ocol, t0, first); else p2_pool<16>(pcol, ocol, t0, first);
    }
}

typedef int v4i __attribute__((ext_vector_type(4)));
__device__ __forceinline__ unsigned fkey(float f) { const unsigned u = __float_as_uint(f); return (u & 0x80000000u) ? ~u : (u | 0x80000000u); }
__device__ __forceinline__ float fkey_inv(unsigned k) { return __uint_as_float((k & 0x80000000u) ? (k & 0x7fffffffu) : ~k); }
__device__ __forceinline__ void ce_desc(unsigned& a, unsigned& b) { const unsigned hi = a > b ? a : b, lo = a > b ? b : a; a = hi; b = lo; }
template <int K, int J> __device__ __forceinline__ void bitonic_stage(unsigned (&a)[16]) {
#pragma unroll
    for (int i = 0; i < 16; ++i) { const int l = i ^ J; if (l > i) { if ((i & K) == 0) ce_desc(a[i], a[l]); else ce_desc(a[l], a[i]); } }
}
__device__ __forceinline__ void bitonic_merge16(unsigned (&a)[16]) { bitonic_stage<16, 8>(a); bitonic_stage<16, 4>(a); bitonic_stage<16, 2>(a); bitonic_stage<16, 1>(a); }
__device__ __forceinline__ void bitonic_sort16(unsigned (&a)[16]) {
    bitonic_stage<2, 1>(a); bitonic_stage<4, 2>(a); bitonic_stage<4, 1>(a); bitonic_stage<8, 4>(a); bitonic_stage<8, 2>(a); bitonic_stage<8, 1>(a); bitonic_merge16(a);
}
__device__ __forceinline__ void top16_merge(unsigned (&top)[16], unsigned (&ch)[16]) {
#pragma unroll
    for (int i = 0; i < 16; ++i) top[i] = top[i] > ch[15 - i] ? top[i] : ch[15 - i];
    bitonic_merge16(top);
}
__device__ __forceinline__ unsigned hkey(unsigned h) { return (h & 0x8000u) ? (~h & 0xffffu) : (h | 0x8000u); }
__device__ __forceinline__ float hkey_inv(unsigned k16) { const unsigned h = (k16 & 0x8000u) ? (k16 & 0x7fffu) : (~k16 & 0xffffu); return (float)__builtin_bit_cast(_Float16, (unsigned short)h); }
__device__ __forceinline__ unsigned pkh2(float a, float b) { return __builtin_bit_cast(unsigned, __builtin_amdgcn_cvt_pkrtz(a, b)); }
__device__ __forceinline__ void p7_topk(Frame& F, const unsigned short* SC, const float* SSQ, int* IDX, float* GATE, int b_lo, int b_hi, int b_step, bool handoff) {
    constexpr int RS = 36;
    LAS unsigned* stg = (LAS unsigned*)(F.lds + RING_OFF + F.wave * P7_WAVE_BYTES + P7_STAGE_OFF);
    const int lane = F.lane, r8 = lane >> 3, c = lane & 7;
    for (int batch = b_lo; batch < b_hi; batch += b_step) {
        const unsigned short* base = SC + (size_t)batch * (8 * NSC);
        unsigned top[16], top1[16];
#pragma unroll
        for (int i = 0; i < 16; ++i) { top[i] = 0u; top1[i] = 0u; }
        v4u ld[8];
#pragma unroll
        for (int q = 0; q < 8; ++q) ld[q] = *(const GAS v4u*)(base + (size_t)(8 * q + r8) * 256 + c * 8);
        for (int ch = 0; ch < 4; ++ch) {
#pragma unroll
            for (int q = 0; q < 8; ++q) *(LAS v4u*)(stg + (8 * q + r8) * RS + c * 4) = ld[q];
            if (ch < 3) {
#pragma unroll
                for (int q = 0; q < 8; ++q) ld[q] = *(const GAS v4u*)(base + (size_t)(8 * q + r8) * 256 + (ch + 1) * 64 + c * 8);
            }
            LDS_WAIT(); asm volatile("" ::: "memory");
#pragma unroll
            for (int hf = 0; hf < 4; ++hf) {
                unsigned k[16];
                const unsigned pb = 127u - (unsigned)((ch & 1) * 64 + hf * 16);
#pragma unroll
                for (int q = 0; q < 2; ++q) { const v4u v = *(const LAS v4u*)(stg + lane * RS + hf * 8 + q * 4);
                    const unsigned w0 = v.x, w1 = v.y, w2 = v.z, w3 = v.w;
                    k[8 * q] = (hkey(w0 & 0xffffu) << 16) | (pb - (unsigned)(8 * q)); k[8 * q + 1] = (hkey(w0 >> 16) << 16) | (pb - (unsigned)(8 * q + 1));
                    k[8 * q + 2] = (hkey(w1 & 0xffffu) << 16) | (pb - (unsigned)(8 * q + 2)); k[8 * q + 3] = (hkey(w1 >> 16) << 16) | (pb - (unsigned)(8 * q + 3));
                    k[8 * q + 4] = (hkey(w2 & 0xffffu) << 16) | (pb - (unsigned)(8 * q + 4)); k[8 * q + 5] = (hkey(w2 >> 16) << 16) | (pb - (unsigned)(8 * q + 5));
                    k[8 * q + 6] = (hkey(w3 & 0xffffu) << 16) | (pb - (unsigned)(8 * q + 6)); k[8 * q + 7] = (hkey(w3 >> 16) << 16) | (pb - (unsigned)(8 * q + 7)); }
                bitonic_sort16(k);
                top16_merge(top, k);
            }
            LDS_WAIT(); asm volatile("" ::: "memory");
            if (ch == 1) {
#pragma unroll
                for (int i = 0; i < 16; ++i) { top1[i] = top[i]; top[i] = 0u; }
            }
        }
        LAS int* tab = (LAS int*)stg + lane * 33;
        float v1[16], v2[16];
#pragma unroll
        for (int i = 0; i < 16; ++i) { tab[i] = 127 - (int)(top1[i] & 0x7fu); tab[16 + i] = 127 - (int)(top[i] & 0x7fu); v1[i] = hkey_inv(top1[i] >> 16); v2[i] = hkey_inv(top[i] >> 16); }
#define P7_KEY(i, j) ((fkey(v1[i] + v2[j]) & ~0xffu) | (unsigned)((i) * 16 + (j)))
        unsigned best[16], cb[16];
#pragma unroll
        for (int jj = 0; jj < 16; ++jj) best[jj] = P7_KEY(0, jj);
#pragma unroll
        for (int jj = 0; jj < 8; ++jj) { cb[jj] = P7_KEY(1, jj); cb[8 + jj] = 0u; }
        top16_merge(best, cb);
        cb[0] = P7_KEY(2, 0); cb[1] = P7_KEY(2, 1); cb[2] = P7_KEY(2, 2); cb[3] = P7_KEY(2, 3); cb[4] = P7_KEY(2, 4); cb[5] = P7_KEY(3, 0); cb[6] = P7_KEY(3, 1); cb[7] = P7_KEY(3, 2);
        cb[8] = P7_KEY(3, 3); cb[9] = P7_KEY(4, 0); cb[10] = P7_KEY(4, 1); cb[11] = P7_KEY(4, 2); cb[12] = 0u; cb[13] = 0u; cb[14] = 0u; cb[15] = 0u;
        bitonic_sort16(cb); top16_merge(best, cb);
        cb[0] = P7_KEY(5, 0); cb[1] = P7_KEY(5, 1); cb[2] = P7_KEY(6, 0); cb[3] = P7_KEY(6, 1); cb[4] = P7_KEY(7, 0); cb[5] = P7_KEY(7, 1); cb[6] = P7_KEY(8, 0); cb[7] = P7_KEY(9, 0);
        cb[8] = P7_KEY(10, 0); cb[9] = P7_KEY(11, 0); cb[10] = P7_KEY(12, 0); cb[11] = P7_KEY(13, 0); cb[12] = P7_KEY(14, 0); cb[13] = P7_KEY(15, 0); cb[14] = 0u; cb[15] = 0u;
        bitonic_sort16(cb); top16_merge(best, cb);
#undef P7_KEY
        LDS_WAIT(); asm volatile("" ::: "memory");
        int eo[16]; float go[16]; float sm = 0.f;
        const float bmax = fkey_inv(best[0] & ~0xffu);
        const f32x4 ssq = *(const GAS f32x4*)(SSQ + (size_t)(batch * 8 + (lane >> 3)) * 4);
        const float rstd = 1.0f / sqrtf(((ssq.x + ssq.y) + (ssq.z + ssq.w)) * (1.0f / D) + EPS);
#pragma unroll
        for (int r = 0; r < 16; ++r) { const int ij = (int)(best[r] & 0xffu); eo[r] = tab[ij >> 4] * 128 + tab[16 + (ij & 15)]; go[r] = __expf((fkey_inv(best[r] & ~0xffu) - bmax) * rstd); sm += go[r]; }
        const float inv = 1.0f / sm;
        if (handoff) {
            LAS unsigned char* reg = F.lds + RING_OFF + (batch - 8 * F.vcu) * P7_WAVE_BYTES;
            LAS int* li = (LAS int*)(reg + P7_IDX_OFF) + lane * 16; LAS unsigned* lg = (LAS unsigned*)(reg + P7_OUT_OFF) + lane * 8;
#pragma unroll
            for (int q = 0; q < 4; ++q) *(LAS v4i*)(li + 4 * q) = (v4i){eo[4 * q], eo[4 * q + 1], eo[4 * q + 2], eo[4 * q + 3]};
#pragma unroll
            for (int q = 0; q < 2; ++q) *(LAS v4u*)(lg + 4 * q) = (v4u){pkh2(go[8 * q] * inv, go[8 * q + 1] * inv), pkh2(go[8 * q + 2] * inv, go[8 * q + 3] * inv), pkh2(go[8 * q + 4] * inv, go[8 * q + 5] * inv), pkh2(go[8 * q + 6] * inv, go[8 * q + 7] * inv)};
        } else {
        int* ip = IDX + (size_t)batch * 1024 + lane * 16; float* gp = GATE + (size_t)batch * 1024 + lane * 16;
#pragma unroll
        for (int q = 0; q < 4; ++q) { *(GAS v4i*)(ip + 4 * q) = (v4i){eo[4 * q], eo[4 * q + 1], eo[4 * q + 2], eo[4 * q + 3]};
            *(GAS f32x4*)(gp + 4 * q) = (f32x4){go[4 * q] * inv, go[4 * q + 1] * inv, go[4 * q + 2] * inv, go[4 * q + 3] * inv}; }
        }
        LDS_WAIT(); asm volatile("" ::: "memory");
    }
}
typedef __bf16 bf16x2_t __attribute__((ext_vector_type(2)));
__device__ __forceinline__ float dpp_f(float v, const int ctrl_sel) {
    const int x = __builtin_bit_cast(int, v);
    int r;
    if (ctrl_sel == 0) r = __builtin_amdgcn_update_dpp(0, x, 0xB1, 0xF, 0xF, true);
    else if (ctrl_sel == 1) r = __builtin_amdgcn_update_dpp(0, x, 0x4E, 0xF, 0xF, true);
    else if (ctrl_sel == 2) r = __builtin_amdgcn_update_dpp(0, x, 0x141, 0xF, 0xF, true);
    else r = __builtin_amdgcn_update_dpp(0, x, 0x128, 0xF, 0xF, true);
    return __builtin_bit_cast(float, r);
}
__device__ __forceinline__ float sum8(float v) { v += dpp_f(v, 0); v += dpp_f(v, 1); v += dpp_f(v, 2); return v; }
__device__ __forceinline__ float dot2bf(unsigned a, unsigned b, float acc) { return __builtin_amdgcn_fdot2_f32_bf16(__builtin_bit_cast(bf16x2_t, a), __builtin_bit_cast(bf16x2_t, b), acc, false); }
__device__ __forceinline__ float dot8(const v4u d, const v4u x, float acc) {
    acc = dot2bf(d.x, x.x, acc); acc = dot2bf(d.y, x.y, acc); acc = dot2bf(d.z, x.z, acc); acc = dot2bf(d.w, x.w, acc);
    return acc;
}
__device__ __forceinline__ float gelu_erf(float v) {
    const float t = __builtin_amdgcn_rcpf(fabsf(v) * 0.2316418882f + 1.0f);
    float q = t * 0.5307027145f + (-0.7265760135f); q = q * t + 0.7107068705f; q = q * t + (-0.142248368f); q = q * t + 0.127414796f; q = q * t;
    const float m = v * (q * __builtin_amdgcn_exp2f((v * v) * (-0.72134752044f)));
    return v < 0.f ? m : v - m;
}
__device__ __forceinline__ void p8_issue(v4u (&d)[8], const LAS int* li8, __amdgpu_buffer_rsrc_t rs, int soff, int c16) {
    const v4i e0 = *(const LAS v4i*)li8, e1 = *(const LAS v4i*)(li8 + 4);
    d[0] = __builtin_amdgcn_raw_buffer_load_b128(rs, e0.x * 128 + c16, soff, 0); d[1] = __builtin_amdgcn_raw_buffer_load_b128(rs, e0.y * 128 + c16, soff, 0);
    d[2] = __builtin_amdgcn_raw_buffer_load_b128(rs, e0.z * 128 + c16, soff, 0); d[3] = __builtin_amdgcn_raw_buffer_load_b128(rs, e0.w * 128 + c16, soff, 0);
    d[4] = __builtin_amdgcn_raw_buffer_load_b128(rs, e1.x * 128 + c16, soff, 0); d[5] = __builtin_amdgcn_raw_buffer_load_b128(rs, e1.y * 128 + c16, soff, 0);
    d[6] = __builtin_amdgcn_raw_buffer_load_b128(rs, e1.z * 128 + c16, soff, 0); d[7] = __builtin_amdgcn_raw_buffer_load_b128(rs, e1.w * 128 + c16, soff, 0);
}
typedef float f32x2 __attribute__((ext_vector_type(2)));
__device__ __forceinline__ f32x2 fp8lo(unsigned w) { return __builtin_amdgcn_cvt_pk_f32_fp8((int)w, false); }
__device__ __forceinline__ f32x2 fp8hi(unsigned w) { return __builtin_amdgcn_cvt_pk_f32_fp8((int)w, true); }
__device__ __forceinline__ float dot16q(const v4u d, const f32x2 (&xx)[8]) {
    f32x2 acc = fp8lo(d.x) * xx[0];
    acc += fp8hi(d.x) * xx[1]; acc += fp8lo(d.y) * xx[2]; acc += fp8hi(d.y) * xx[3]; acc += fp8lo(d.z) * xx[4]; acc += fp8hi(d.z) * xx[5]; acc += fp8lo(d.w) * xx[6]; acc += fp8hi(d.w) * xx[7];
    return acc.x + acc.y;
}
__device__ __forceinline__ void p8_compute_u(const v4u (&d)[8], const f32x2 (&xx)[8], LAS float* lz8, int c) {
    float p[8];
#pragma unroll
    for (int g = 0; g < 8; ++g) p[g] = sum8(dot16q(d[g], xx));
    if (c == 0) {
#pragma unroll
        for (int q = 0; q < 2; ++q) { f32x4 z = *(LAS f32x4*)(lz8 + 4 * q); z.x += p[4 * q]; z.y += p[4 * q + 1]; z.z += p[4 * q + 2]; z.w += p[4 * q + 3]; *(LAS f32x4*)(lz8 + 4 * q) = z; }
    }
}
__device__ __forceinline__ void p8_compute_v(const v4u (&d)[8], const LAS float* la8, f32x2 (&y)[8]) {
    const f32x4 a0 = *(const LAS f32x4*)la8, a1 = *(const LAS f32x4*)(la8 + 4);
    const float a[8] = {a0.x, a0.y, a0.z, a0.w, a1.x, a1.y, a1.z, a1.w};
#pragma unroll
    for (int g = 0; g < 8; ++g) { const f32x2 ag = {a[g], a[g]};
        y[0] += ag * fp8lo(d[g].x); y[1] += ag * fp8hi(d[g].x); y[2] += ag * fp8lo(d[g].y); y[3] += ag * fp8hi(d[g].y);
        y[4] += ag * fp8lo(d[g].z); y[5] += ag * fp8hi(d[g].z); y[6] += ag * fp8lo(d[g].w); y[7] += ag * fp8hi(d[g].w); }
}
__device__ __forceinline__ void p8_unpack_x(f32x2 (&xx)[8], const v4u a, const v4u b) {
    xx[0] = (f32x2){bflo(a.x), bfhi(a.x)}; xx[1] = (f32x2){bflo(a.y), bfhi(a.y)}; xx[2] = (f32x2){bflo(a.z), bfhi(a.z)}; xx[3] = (f32x2){bflo(a.w), bfhi(a.w)};
    xx[4] = (f32x2){bflo(b.x), bfhi(b.x)}; xx[5] = (f32x2){bflo(b.y), bfhi(b.y)}; xx[6] = (f32x2){bflo(b.z), bfhi(b.z)}; xx[7] = (f32x2){bflo(b.w), bfhi(b.w)};
}
typedef unsigned u32x2s __attribute__((ext_vector_type(2)));
__device__ __forceinline__ float u2f(unsigned u) { return __builtin_bit_cast(float, u); }
__device__ __forceinline__ float swap32_add(float a, float b) { const u32x2s r = __builtin_amdgcn_permlane32_swap(__builtin_bit_cast(unsigned, a), __builtin_bit_cast(unsigned, b), false, false); return u2f(r.x) + u2f(r.y); }
__device__ __forceinline__ float swap16_add(float a, float b) { const u32x2s r = __builtin_amdgcn_permlane16_swap(__builtin_bit_cast(unsigned, a), __builtin_bit_cast(unsigned, b), false, false); return u2f(r.x) + u2f(r.y); }
__device__ __forceinline__ void p8_reduce_heads(const f32x2 (&y)[8], int j, float& r0, float& r1) {
    float v[8], w[4];
#pragma unroll
    for (int q = 0; q < 4; ++q) { v[2 * q] = swap32_add(y[q].x, y[4 + q].x); v[2 * q + 1] = swap32_add(y[q].y, y[4 + q].y); }
#pragma unroll
    for (int q = 0; q < 4; ++q) w[q] = swap16_add(v[q], v[4 + q]);
    const bool odd = (j & 1) != 0;
    const float s0 = odd ? w[0] : w[2], s1 = odd ? w[1] : w[3], k0 = odd ? w[2] : w[0], k1 = odd ? w[3] : w[1];
    r0 = k0 + dpp_f(s0, 3); r1 = k1 + dpp_f(s1, 3);
}
typedef _Float16 h16x2 __attribute__((ext_vector_type(2)));
__device__ __forceinline__ h16x2 q2h_lo(unsigned w) { return __builtin_amdgcn_cvt_scalef32_pk_f16_fp8(w, 1.0f, false); }
__device__ __forceinline__ h16x2 q2h_hi(unsigned w) { return __builtin_amdgcn_cvt_scalef32_pk_f16_fp8(w, 1.0f, true); }
__device__ __forceinline__ h16x2 f2h(float a, float b) { h16x2 r; r.x = (_Float16)a; r.y = (_Float16)b; return r; }
__device__ __forceinline__ float dot16h(const v4u d, const h16x2 (&xh)[8]) {
    float acc = 0.f;
    acc = __builtin_amdgcn_fdot2(q2h_lo(d.x), xh[0], acc, false); acc = __builtin_amdgcn_fdot2(q2h_hi(d.x), xh[1], acc, false);
    acc = __builtin_amdgcn_fdot2(q2h_lo(d.y), xh[2], acc, false); acc = __builtin_amdgcn_fdot2(q2h_hi(d.y), xh[3], acc, false);
    acc = __builtin_amdgcn_fdot2(q2h_lo(d.z), xh[4], acc, false); acc = __builtin_amdgcn_fdot2(q2h_hi(d.z), xh[5], acc, false);
    acc = __builtin_amdgcn_fdot2(q2h_lo(d.w), xh[6], acc, false); acc = __builtin_amdgcn_fdot2(q2h_hi(d.w), xh[7], acc, false);
    return acc;
}
__device__ __forceinline__ void p8h_compute_u(const v4u (&d)[8], const h16x2 (&xh)[8], LAS float* lz8, int c) {
    float p[8];
#pragma unroll
    for (int g = 0; g < 8; ++g) p[g] = sum8(dot16h(d[g], xh));
    if (c == 0) {
#pragma unroll
        for (int q = 0; q < 2; ++q) { f32x4 z = *(LAS f32x4*)(lz8 + 4 * q); z.x += p[4 * q]; z.y += p[4 * q + 1]; z.z += p[4 * q + 2]; z.w += p[4 * q + 3]; *(LAS f32x4*)(lz8 + 4 * q) = z; }
    }
}
__device__ __forceinline__ void p8h_unpack_x(h16x2 (&xh)[8], const v4u a, const v4u b) {
    xh[0] = f2h(bflo(a.x), bfhi(a.x)); xh[1] = f2h(bflo(a.y), bfhi(a.y)); xh[2] = f2h(bflo(a.z), bfhi(a.z)); xh[3] = f2h(bflo(a.w), bfhi(a.w));
    xh[4] = f2h(bflo(b.x), bfhi(b.x)); xh[5] = f2h(bflo(b.y), bfhi(b.y)); xh[6] = f2h(bflo(b.z), bfhi(b.z)); xh[7] = f2h(bflo(b.w), bfhi(b.w));
}
__device__ __forceinline__ void p8h_compute_v(const v4u (&d)[8], const LAS float* la8, h16x2 (&y)[8]) {
    const f32x4 a0 = *(const LAS f32x4*)la8, a1 = *(const LAS f32x4*)(la8 + 4);
    const float a[8] = {a0.x, a0.y, a0.z, a0.w, a1.x, a1.y, a1.z, a1.w};
#pragma unroll
    for (int g = 0; g < 8; ++g) { const _Float16 ah = (_Float16)a[g]; const h16x2 ag = {ah, ah};
        y[0] += ag * q2h_lo(d[g].x); y[1] += ag * q2h_hi(d[g].x); y[2] += ag * q2h_lo(d[g].y); y[3] += ag * q2h_hi(d[g].y);
        y[4] += ag * q2h_lo(d[g].z); y[5] += ag * q2h_hi(d[g].z); y[6] += ag * q2h_lo(d[g].w); y[7] += ag * q2h_hi(d[g].w); }
}
__device__ __forceinline__ long pk64(unsigned lo, unsigned hi) { return (long)(((unsigned long long)hi << 32) | lo); }
__device__ __forceinline__ void p8m_issue(v4u (&d)[8], const LAS int* lig, __amdgpu_buffer_rsrc_t rs, int soff, int q16) {
    const int e0 = lig[0], e1 = lig[16], e2 = lig[32], e3 = lig[48];
    d[0] = __builtin_amdgcn_raw_buffer_load_b128(rs, e0 * D + q16, soff, 0); d[1] = __builtin_amdgcn_raw_buffer_load_b128(rs, e0 * D + q16 + 64, soff, 0);
    d[2] = __builtin_amdgcn_raw_buffer_load_b128(rs, e1 * D + q16, soff, 0); d[3] = __builtin_amdgcn_raw_buffer_load_b128(rs, e1 * D + q16 + 64, soff, 0);
    d[4] = __builtin_amdgcn_raw_buffer_load_b128(rs, e2 * D + q16, soff, 0); d[5] = __builtin_amdgcn_raw_buffer_load_b128(rs, e2 * D + q16 + 64, soff, 0);
    d[6] = __builtin_amdgcn_raw_buffer_load_b128(rs, e3 * D + q16, soff, 0); d[7] = __builtin_amdgcn_raw_buffer_load_b128(rs, e3 * D + q16 + 64, soff, 0);
}
__device__ __forceinline__ float p8m_dot(const v4u xa, const v4u xb, const v4u d0, const v4u d1) {
    f32x4 acc = {0.f, 0.f, 0.f, 0.f};
    acc = __builtin_amdgcn_mfma_f32_16x16x32_fp8_fp8(pk64(xa.x, xa.y), pk64(d0.x, d0.y), acc, 0, 0, 0);
    acc = __builtin_amdgcn_mfma_f32_16x16x32_fp8_fp8(pk64(xa.z, xa.w), pk64(d0.z, d0.w), acc, 0, 0, 0);
    acc = __builtin_amdgcn_mfma_f32_16x16x32_fp8_fp8(pk64(xb.x, xb.y), pk64(d1.x, d1.y), acc, 0, 0, 0);
    acc = __builtin_amdgcn_mfma_f32_16x16x32_fp8_fp8(pk64(xb.z, xb.w), pk64(d1.z, d1.w), acc, 0, 0, 0);
    return acc[0];
}
__device__ __forceinline__ void p8m_compute_u(const v4u (&d)[8], const v4u xa, const v4u xb, LAS float* lzq, int q) {
    const float z0 = p8m_dot(xa, xb, d[0], d[1]), z1 = p8m_dot(xa, xb, d[2], d[3]), z2 = p8m_dot(xa, xb, d[4], d[5]), z3 = p8m_dot(xa, xb, d[6], d[7]);
    const float z = (q == 0) ? z0 : (q == 1) ? z1 : (q == 2) ? z2 : z3;
    *lzq += z;
}
__device__ __forceinline__ void p8s_compute_u(const v4u (&d)[8], const v4u xa, const v4u xb, LAS unsigned char* stage, LAS float* lz  , int lane, const float sxq  ) {
    const int j8 = lane >> 3, c = lane & 7, n = lane & 15, q = lane >> 4;
#pragma unroll
    for (int r = 0; r < 8; ++r) { const int row = j8 * 8 + r; *(LAS v4u*)(stage + row * 128 + ((c ^ (row >> 1)) & 7) * 16) = d[r]; }
    LDS_WAIT(); asm volatile("" ::: "memory");
    float z[4];
#pragma unroll
    for (int t = 0; t < 4; ++t) { const int row = 16 * t + n, sw = (row >> 1) & 7;
        const v4u d0 = *(const LAS v4u*)(stage + row * 128 + ((q ^ sw) & 7) * 16), d1 = *(const LAS v4u*)(stage + row * 128 + (((q + 4) ^ sw) & 7) * 16);
        z[t] = p8m_dot(xa, xb, d0, d1); }
    asm volatile("" ::: "memory");
    const float zq = (q == 0) ? z[0] : (q == 1) ? z[1] : (q == 2) ? z[2] : z[3];
    LAS float* p = lz + (2 * q + (n >> 3)) * 16 + (n & 7);
    *p += zq * sxq;
}
__device__ __forceinline__ void p8_peer(Frame& F, const unsigned char* X8, const float* SSQ, const float* SXQ, const unsigned char* U8, const unsigned char* V8, const float* SU, const float* SV, const int* IDX, const float* GATE, const bf16* H16, float* YOUT, bf16* OUT, const float* gfin, bool handoff) {
    LAS unsigned char* lstage = F.lds + RING_OFF + F.wave * P7_WAVE_BYTES + P7_STAGE_OFF;
    LAS int* lidx = (LAS int*)(F.lds + RING_OFF + F.wave * P7_WAVE_BYTES + P7_IDX_OFF);
    LAS float* lza = (LAS float*)(F.lds + RING_OFF + F.wave * P7_WAVE_BYTES + P7_ZA_OFF);
    LAS unsigned* lout = (LAS unsigned*)(F.lds + RING_OFF + F.wave * P7_WAVE_BYTES + P7_OUT_OFF);
    const int gw = F.vcu * NWAVES + F.wave, NGW = F.G * NWAVES, lane = F.lane, j = lane >> 3, c = lane & 7, c16 = c * 16;
    const __amdgpu_buffer_rsrc_t rsU = __builtin_amdgcn_make_buffer_rsrc((void*)U8, (short)0, NEXP * D, 0x00020000);
    const __amdgpu_buffer_rsrc_t rsV = __builtin_amdgcn_make_buffer_rsrc((void*)V8, (short)0, NEXP * D, 0x00020000);
    const int pfrank = ((int)blockIdx.x >> 3) * NWAVES + F.wave; const int pfoff = (pfrank < 256) ? pfrank * 8192 + lane * 128 : 0; unsigned pf = 0u;
    for (int grp = gw; grp < T / 8; grp += NGW) {
        const int tb = grp * 8;
        for (int prep = 0; prep < REPS(13); ++prep) {
        LAS float* lsx = (LAS float*)(F.lds + P7_AUX_OFF + F.wave * 256); LAS float* lrs = lsx + 32;
        if (lane < 32) lsx[lane] = SXQ[(size_t)tb * 4 + lane];
        if (lane < 8) { const f32x4 q4 = *(const GAS f32x4*)(SSQ + (size_t)(tb + lane) * 4); lrs[lane] = 1.0f / sqrtf(((q4.x + q4.y) + (q4.z + q4.w)) * (1.0f / D) + EPS); }
        LAS _Float16* lgate = (LAS _Float16*)lout;
        if (!handoff) {
#pragma unroll
            for (int i = 0; i < 8; ++i) { lidx[i * 128 + lane] = IDX[(size_t)(tb + i) * NSEL + lane]; lidx[i * 128 + 64 + lane] = IDX[(size_t)(tb + i) * NSEL + 64 + lane];
                lgate[i * 128 + lane] = (_Float16)GATE[(size_t)(tb + i) * NSEL + lane]; lgate[i * 128 + 64 + lane] = (_Float16)GATE[(size_t)(tb + i) * NSEL + 64 + lane]; }
        }
#pragma unroll
        for (int i = 0; i < 8; ++i) { lza[i * 128 + lane] = 0.f; lza[i * 128 + 64 + lane] = 0.f; }
        LDS_WAIT(); asm volatile("" ::: "memory");
        for (int urep = 0; urep < REPS(8); ++urep) {
            if (urep) {
#pragma unroll
                for (int i = 0; i < 8; ++i) { lza[i * 128 + lane] = 0.f; lza[i * 128 + 64 + lane] = 0.f; }
                LDS_WAIT(); asm volatile("" ::: "memory"); }
            v4u b0[8], b1[8], b2[8], b3[8], xa0, xb0, xa1, xb1, xa2, xb2, xa3, xb3;
            const unsigned char* xbase = X8 + (size_t)tb * D + (lane >> 4) * 16;
            xa0 = *(const GAS v4u*)xbase; xb0 = *(const GAS v4u*)(xbase + 64); xa1 = *(const GAS v4u*)(xbase + D); xb1 = *(const GAS v4u*)(xbase + D + 64);
            p8_issue(b0, lidx + j * 16, rsU, 0, c16); p8_issue(b1, lidx + j * 16 + 8, rsU, 0, c16); p8_issue(b2, lidx + 128 + j * 16, rsU, 0, c16); p8_issue(b3, lidx + 128 + j * 16 + 8, rsU, 0, c16);
            for (int n = 0; n < 64; n += 2) {
                const int i = n & 7, n2 = (n + 2) & 63, s2 = n2 >> 3, i2 = n2 & 7;
                { const unsigned char* xp = xbase + (size_t)i2 * D + s2 * 128; xa2 = *(const GAS v4u*)xp; xb2 = *(const GAS v4u*)(xp + 64); xa3 = *(const GAS v4u*)(xp + D); xb3 = *(const GAS v4u*)(xp + D + 64); }
                if ((n & 7) == 6) {
                    asm volatile("" :: "v"(pf));
                    pf = (s2 != 0) ? __builtin_amdgcn_raw_buffer_load_b32(rsU, pfoff, s2 * (NEXP * 128), 0) : __builtin_amdgcn_raw_buffer_load_b32(rsV, pfoff, 0, 0); }
                const float sxa = lsx[i * 4 + (n >> 4)], sxb = lsx[(i + 1) * 4 + (n >> 4)];
                p8s_compute_u(b0, xa0, xb0, lstage, lza + i * 128, lane, sxa);           p8_issue(b0, lidx + i2 * 128 + j * 16, rsU, s2 * (NEXP * 128), c16);
                p8s_compute_u(b1, xa0, xb0, lstage, lza + i * 128 + 8, lane, sxa);       p8_issue(b1, lidx + i2 * 128 + j * 16 + 8, rsU, s2 * (NEXP * 128), c16);
                p8s_compute_u(b2, xa1, xb1, lstage, lza + (i + 1) * 128, lane, sxb);     p8_issue(b2, lidx + (i2 + 1) * 128 + j * 16, rsU, s2 * (NEXP * 128), c16);
                p8s_compute_u(b3, xa1, xb1, lstage, lza + (i + 1) * 128 + 8, lane, sxb); p8_issue(b3, lidx + (i2 + 1) * 128 + j * 16 + 8, rsU, s2 * (NEXP * 128), c16);
                xa0 = xa2; xb0 = xb2; xa1 = xa3; xb1 = xb3;
            }
        }
        LDS_WAIT(); asm volatile("" ::: "memory");
#pragma unroll
        for (int i = 0; i < 8; ++i) {
            const int e0 = lidx[i * 128 + lane], e1 = lidx[i * 128 + 64 + lane];
            const float sx = lrs[i];
            const float z0 = lza[i * 128 + lane] * SU[e0] * sx, z1 = lza[i * 128 + 64 + lane] * SU[e1] * sx;
            const float g0 = (float)lgate[i * 128 + lane] * SV[e0], g1 = (float)lgate[i * 128 + 64 + lane] * SV[e1];
            lza[i * 128 + lane] = gelu_erf(z0) * g0 * 1024.0f; lza[i * 128 + 64 + lane] = gelu_erf(z1) * g1 * 1024.0f;
        }
        LDS_WAIT(); asm volatile("" ::: "memory");
        for (int vrep = 0; vrep < REPS(9); ++vrep) {
            v4u b0[8], b1[8], b2[8], b3[8];
            LAS unsigned* lkeep = (LAS unsigned*)lstage;
            p8_issue(b0, lidx + j * 16, rsV, 0, c16); p8_issue(b1, lidx + j * 16 + 8, rsV, 0, c16); p8_issue(b2, lidx + 128 + j * 16, rsV, 0, c16); p8_issue(b3, lidx + 128 + j * 16 + 8, rsV, 0, c16);
            for (int n = 0; n < 64; n += 2) {
                const int s = n >> 3, i = n & 7, n2 = (n + 2) & 63, s2 = n2 >> 3, i2 = n2 & 7;
                if ((n & 7) == 6 && s2 != 0) { asm volatile("" :: "v"(pf)); pf = __builtin_amdgcn_raw_buffer_load_b32(rsV, pfoff, s2 * (NEXP * 128), 0); }
                LAS unsigned* lo = ((s < 4) ? lkeep + s * 512 : lout) + c * 8 + j;
                h16x2 yh[8]; f32x2 y[8]; float r0, r1;
#pragma unroll
                for (int q = 0; q < 8; ++q) yh[q] = (h16x2){(_Float16)0.f, (_Float16)0.f};
                p8h_compute_v(b0, lza + i * 128 + j * 16, yh);           p8_issue(b0, lidx + i2 * 128 + j * 16, rsV, s2 * (NEXP * 128), c16);
                p8h_compute_v(b1, lza + i * 128 + j * 16 + 8, yh);       p8_issue(b1, lidx + i2 * 128 + j * 16 + 8, rsV, s2 * (NEXP * 128), c16);
#pragma unroll
                for (int q = 0; q < 8; ++q) y[q] = (f32x2){(float)yh[q].x * (1.0f / 1024.0f), (float)yh[q].y * (1.0f / 1024.0f)};
                p8_reduce_heads(y, j, r0, r1);
                lo[i * 64] = pk2(r0, r1);
#pragma unroll
                for (int q = 0; q < 8; ++q) yh[q] = (h16x2){(_Float16)0.f, (_Float16)0.f};
                p8h_compute_v(b2, lza + (i + 1) * 128 + j * 16, yh);     p8_issue(b2, lidx + (i2 + 1) * 128 + j * 16, rsV, s2 * (NEXP * 128), c16);
                p8h_compute_v(b3, lza + (i + 1) * 128 + j * 16 + 8, yh); p8_issue(b3, lidx + (i2 + 1) * 128 + j * 16 + 8, rsV, s2 * (NEXP * 128), c16);
#pragma unroll
                for (int q = 0; q < 8; ++q) y[q] = (f32x2){(float)yh[q].x * (1.0f / 1024.0f), (float)yh[q].y * (1.0f / 1024.0f)};
                p8_reduce_heads(y, j, r0, r1);
                lo[(i + 1) * 64] = pk2(r0, r1);
                if (i == 6 && s >= 4) {
                    LDS_WAIT(); asm volatile("" ::: "memory");
                    const v4u w0 = *(const LAS v4u*)(lout + (lane >> 4) * 64 + (lane & 15) * 4), w1 = *(const LAS v4u*)(lout + (4 + (lane >> 4)) * 64 + (lane & 15) * 4);
                    bf16* op = OUT + (size_t)(tb + (lane >> 4)) * D + s * 128 + (lane & 15) * 8;
                    *(GAS v4u*)op = w0; *(GAS v4u*)(op + 4 * D) = w1;
                }
            }
        }
        }
        asm volatile("" :: "v"(pf));
        VM_WAIT(); __builtin_amdgcn_fence(__ATOMIC_ACQUIRE, "agent"); VM_WAIT(); LDS_WAIT(); asm volatile("" ::: "memory");
        for (int frep = 0; frep < REPS(14); ++frep)
        for (int i0 = 0; i0 < 8; i0 += 4) {
            u32x2s hv[4][4], ov[4][4]; float ss[4];
#pragma unroll
            for (int rr = 0; rr < 4; ++rr) { const bf16* hrow = H16 + (size_t)(tb + i0 + rr) * D + 4 * lane; const bf16* orow = OUT + (size_t)(tb + i0 + rr) * D + 4 * lane;
                const LAS unsigned* krow = (const LAS unsigned*)lstage + (lane >> 5) * 512 + (i0 + rr) * 64 + ((2 * lane) & 63);
#pragma unroll
                for (int q = 0; q < 4; ++q) { hv[rr][q] = *(const GAS u32x2s*)(hrow + 256 * q);
                    if (q < 2) ov[rr][q] = *(const LAS u32x2s*)(krow + q * 1024); else ov[rr][q] = *(const GAS u32x2s*)(orow + 256 * q); } }
            f32x4 gg[4];
#pragma unroll
            for (int q = 0; q < 4; ++q) gg[q] = *(const GAS f32x4*)(gfin + 256 * q + 4 * lane);
            f32x4 yv[4][4];
#pragma unroll
            for (int rr = 0; rr < 4; ++rr) { float a = 0.f;
#pragma unroll
                for (int q = 0; q < 4; ++q) { const unsigned h0 = hv[rr][q].x, h1 = hv[rr][q].y, o0 = ov[rr][q].x, o1 = ov[rr][q].y;
                    yv[rr][q] = (f32x4){bflo(h0) + bflo(o0), bfhi(h0) + bfhi(o0), bflo(h1) + bflo(o1), bfhi(h1) + bfhi(o1)};
                    a += (yv[rr][q].x * yv[rr][q].x + yv[rr][q].y * yv[rr][q].y) + (yv[rr][q].z * yv[rr][q].z + yv[rr][q].w * yv[rr][q].w); }
                ss[rr] = a; }
#pragma unroll
            for (int o = 1; o < 64; o <<= 1) {
#pragma unroll
                for (int rr = 0; rr < 4; ++rr) ss[rr] += __shfl_xor(ss[rr], o); }
#pragma unroll
            for (int rr = 0; rr < 4; ++rr) { const float rstd = 1.f / sqrtf(ss[rr] * (1.f / D) + EPS); float* yr = YOUT + (size_t)(tb + i0 + rr) * D + 4 * lane;
#pragma unroll
                for (int q = 0; q < 4; ++q) *(GAS f32x4*)(yr + 256 * q) = (f32x4){yv[rr][q].x * rstd * gg[q].x, yv[rr][q].y * rstd * gg[q].y, yv[rr][q].z * rstd * gg[q].z, yv[rr][q].w * rstd * gg[q].w}; }
        }
    }
}
__device__ __forceinline__ void cvt_fp8_rows(Frame& F, const float* src, unsigned char* dst, float* scale, int gw, int NGW) {
    const int lane = F.lane;
    for (int r0 = gw * 4; r0 < NEXP; r0 += NGW * 4) {
        f32x4 v[4][4];
#pragma unroll
        for (int rr = 0; rr < 4; ++rr) { const GAS f32x4* sp = (const GAS f32x4*)(src + (size_t)(r0 + rr) * D) + 4 * lane;
#pragma unroll
            for (int q = 0; q < 4; ++q) v[rr][q] = sp[q]; }
        float m[4];
#pragma unroll
        for (int rr = 0; rr < 4; ++rr) { float mm = 0.f;
#pragma unroll
            for (int q = 0; q < 4; ++q) mm = fmaxf(mm, fmaxf(fmaxf(fabsf(v[rr][q].x), fabsf(v[rr][q].y)), fmaxf(fabsf(v[rr][q].z), fabsf(v[rr][q].w))));
            m[rr] = mm; }
#pragma unroll
        for (int o = 1; o < 64; o <<= 1) {
#pragma unroll
            for (int rr = 0; rr < 4; ++rr) m[rr] = fmaxf(m[rr], __shfl_xor(m[rr], o)); }
#pragma unroll
        for (int rr = 0; rr < 4; ++rr) {
            const float sc = (m[rr] > 0.f) ? m[rr] * (1.0f / 448.0f) : 1.0f, inv = 1.0f / sc;
            unsigned o[4];
#pragma unroll
            for (int q = 0; q < 4; ++q) o[q] = (unsigned)__builtin_amdgcn_cvt_pk_fp8_f32(v[rr][q].z * inv, v[rr][q].w * inv, __builtin_amdgcn_cvt_pk_fp8_f32(v[rr][q].x * inv, v[rr][q].y * inv, 0, false), true);
            *(GAS v4u*)(dst + (size_t)(lane >> 3) * (NEXP * 128) + (size_t)(r0 + rr) * 128 + 16 * (lane & 7)) = (v4u){o[0], o[1], o[2], o[3]};
            if (lane == 0) scale[r0 + rr] = sc;
        }
    }
}
struct Args { const float* in[15]; float* out; unsigned char* ws; int ph_lo, ph_hi; };
__global__ void __launch_bounds__(NWAVES * 64, 2) hyb_fwd(Args args) {
    extern __shared__ __attribute__((aligned(16))) unsigned char lds[];
    Frame F;
    F.lds = (LAS unsigned char*)lds;
    F.MISC = (volatile LAS unsigned*)(F.lds + MISC_OFF);
    F.tid = threadIdx.x; F.lane = F.tid & 63; F.wave = __builtin_amdgcn_readfirstlane(F.tid >> 6);
    F.G = gridDim.x; { const int bx = blockIdx.x; F.vcu = (F.G % 8 == 0) ? (bx % 8) * (F.G / 8) + bx / 8 : bx; }
    unsigned char* ws = args.ws;
    gu32* ctl = (gu32*)(ws + WS_CTL);
    const float* x = args.in[0]; const float* g_mix = args.in[1]; const float* w_in = args.in[2]; const float* conv_w = args.in[3]; const float* w_conv_out = args.in[4];
    const float* pool_w = args.in[5]; const float* pool_scale = args.in[6]; const float* w_pool_out = args.in[7]; const float* w_out = args.in[8]; const float* g_ffn = args.in[9];
    const float* w_query = args.in[10]; const float* sub_keys = args.in[11]; const float* expert_u = args.in[12]; const float* expert_v = args.in[13]; const float* g_fin = args.in[14];
    bf16* WIN = (bf16*)(ws + WS_WIN); bf16* WC = (bf16*)(ws + WS_WC); bf16* WPB = (bf16*)(ws + WS_WPB); bf16* WOUT = (bf16*)(ws + WS_WOUT); bf16* WSC = (bf16*)(ws + WS_WS);
    bf16* XN = (bf16*)(ws + WS_XN); bf16* PB = (bf16*)(ws + WS_PB); bf16* PG = (bf16*)(ws + WS_PG); bf16* TMP = (bf16*)(ws + WS_TMP); bf16* MG = (bf16*)(ws + WS_MG);
    float* SC = (float*)(ws + WS_SC); int* IDX = (int*)(ws + WS_IDX); float* GATE = (float*)(ws + WS_GATE); unsigned char* U8 = ws + WS_U8; unsigned char* V8 = ws + WS_V8; float* SU = (float*)(ws + WS_SU); float* SV = (float*)(ws + WS_SV); bf16* H16 = (bf16*)(ws + WS_H16); unsigned char* X8 = ws + WS_X8; float* SX = (float*)(ws + WS_SX);
    float* SSQ = (float*)(ws + WS_XBUF); float* SXQ = (float*)(ws + WS_XBUF + 256 * 1024);
    bf16* AIN = (bf16*)args.out; bf16* POOLED = (bf16*)args.out + (size_t)T * D; float* H = args.out;

    for (int u = F.tid; u < (LDS_BYTES - LDSCTL_OFF) / 4; u += NWAVES * 64) ((LAS unsigned*)(F.lds + LDSCTL_OFF))[u] = 0u;
    __syncthreads();
    XcdBarrier bar; bar.bar = (unsigned*)(ctl + CW_BAR); bar.x = 0; bar.st = nullptr;
    if (N_LAUNCHES == 1) bar = xcd_barrier_post((unsigned*)(ctl + CW_BAR), F.MISC + 8);
#define GRID_BAR() do { if (N_LAUNCHES == 1) xcd_barrier(bar); } while (0)
    const int lo = args.ph_lo, hi = args.ph_hi;
#define IN(k) (lo <= (k) && (k) < hi)
#define BOTH(k) (IN(k) && IN((k) + 1))
    const int gw = F.vcu * NWAVES + F.wave, NGW = F.G * NWAVES;

    if (IN(0)) { DELAY_T0(0); for (int rep = 0; rep < REPS(0); ++rep) {
        LAS float* scr = (LAS float*)(F.lds + RING_OFF + F.wave * 16384);
        constexpr int I_IN = (D / 64) * (NIN / 32), I_SQ = (D / 64) * (D / 32);
#pragma unroll 1
        for (int stage = 0; stage < 2; ++stage) {
            if ((stage == 0) == ((F.wave & 1) == 0)) {
                for (int it = gw; it < 2048; it += NGW) {
                    { const int hp = it >> 7, i0 = ((it >> 5) & 3) * 32, j0 = (it & 31) * 32;
                      fold_wave<4, 32, false>(scr, sub_keys + (size_t)hp * 16384 + (size_t)i0 * 128, 128, nullptr, w_query + (size_t)j0 * NSC + hp * 128, NSC, WSC + (size_t)(hp * 128 + i0) * D + j0, D, F.lane); }
                    { const int g = it >> 9, i0 = ((it >> 4) & 31) * 32, j0 = (it & 15) * 16;
                      fold_wave<8, 16, true>(scr, w_pool_out + (size_t)g * 256 * D + i0, D, pool_scale + g * 256, pool_w + (size_t)g * 65536 + (size_t)j0 * 256, 256, WPB + (size_t)i0 * D + g * 256 + j0, D, F.lane); }
                }
            } else {
                for (int it = gw; it < I_IN + 2 * I_SQ; it += NGW) {
                    int r = it;
                    if (r < I_IN) { p0_transpose_item<true>(w_in, D, NIN, WIN, scr, r, F.lane); continue; } r -= I_IN;
                    if (r < I_SQ) { p0_transpose_item<false>(w_conv_out, D, D, WC, scr, r, F.lane); continue; } r -= I_SQ;
                    p0_transpose_item<false>(w_out, D, D, WOUT, scr, r, F.lane);
                }
                for (int m = gw * 4; m < T; m += NGW * 4) rms_rows4_to_bf16(F.lane, x + (size_t)m * D, g_mix, XN + (size_t)m * D);
            }
        }
        }
        DELAY_END(0);
        if (BOTH(0)) GRID_BAR();
    }
    if (PROBE_DUP & 1024) { for (int xb = 0; xb < 10; ++xb) GRID_BAR(); }
    if (IN(1)) { DELAY_T0(1); for (int rep = 0; rep < REPS(1); ++rep) {
        pg8::Gemm g{XN, WIN, 0l, 0l, T, NIN, D}; pg8::StaticOrder S; S.init(T, NIN, F.G, (int)blockIdx.x);
        pg8::EpiProj E{PB, (long)(WS_PG - WS_PB)};
        pg8::gemm_phase<pg8::EpiProj, pg8::StaticOrder, true, true>(F.lds + RING_OFF, g, S, E);
        }
        DELAY_END(1);
        if (BOTH(1)) GRID_BAR();
    }
    if (IN(2)) { DELAY_T0(2); for (int rep = 0; rep < REPS(2); ++rep) {
        p2_conv_pool(F, PB, conv_w, AIN, POOLED);
        }
        DELAY_END(2);
        if (BOTH(2)) GRID_BAR();
    }
    if (IN(3)) { DELAY_T0(3); for (int rep = 0; rep < REPS(3); ++rep) {
        pg8::Gemm g{AIN, WC, (long)T * D * 2, (long)(WS_WPB - WS_WC), T, D, D}; pg8::MergeOrder S; S.base.init(T, D, F.G, (int)blockIdx.x);
        pg8::EpiMerge E{(const unsigned char*)PG, MG};
        pg8::gemm_phase<pg8::EpiMerge, pg8::MergeOrder, true, true>(F.lds + RING_OFF, g, S, E);
        }
        DELAY_END(3);
        if (BOTH(3)) GRID_BAR();
    }
    if (IN(4)) { DELAY_T0(4); for (int rep = 0; rep < REPS(4); ++rep) {
        if (F.G == 256) {
            pg8::Gemm g{MG, WOUT, 0l, 0l, T, D, D}; pg8::StaticOrder S; S.init(T, D, F.G, (int)blockIdx.x);
            pg8::EpiResRms E{x, H16, g_ffn, XN, X8, SSQ, SXQ};
            pg8::gemm_phase<pg8::EpiResRms, pg8::StaticOrder, false, true>(F.lds + RING_OFF, g, S, E);
            if (PROBE_DUP & 4096) { __syncthreads(); pg8::gemm_phase<pg8::EpiResRms, pg8::StaticOrder, false, true>(F.lds + RING_OFF, g, S, E); }
        } else {
            pg8::Gemm g{MG, WOUT, 0l, 0l, T, D, D}; pg8::StaticOrder S; S.init(T, D, F.G, (int)blockIdx.x);
            pg8::EpiRes E{x, H};
            pg8::gemm_phase<pg8::EpiRes, pg8::StaticOrder, true, true>(F.lds + RING_OFF, g, S, E);
            GRID_BAR();
            for (int m = gw; m < T; m += NGW) p4_row_defer(F.lane, H + (size_t)m * D, g_ffn, XN + (size_t)m * D, X8 + (size_t)m * D, SSQ + (size_t)m * 4, SXQ + (size_t)m * 4, H16 + (size_t)m * D);
        }
        }
        DELAY_END(4);
        if (BOTH(4)) GRID_BAR();
    }
    if (IN(5)) { DELAY_T0(5); for (int rep = 0; rep < REPS(5); ++rep) {
        pg8::Gemm g{XN, WSC, 0l, 0l, T, NSC, D}; pg8::StaticOrder S; S.init(T, NSC, F.G, (int)blockIdx.x);
        pg8::EpiF16 E{(unsigned short*)SC, NSC};
        pg8::gemm_phase<pg8::EpiF16, pg8::StaticOrder, true, true>(F.lds + RING_OFF, g, S, E);
        }
        DELAY_END(5);
        if (BOTH(5)) GRID_BAR();
    }
    if (IN(6)) { DELAY_T0(6); for (int rep = 0; rep < REPS(6); ++rep) {
        const bool handoff = (F.G * NWAVES == T / 8);
        if (F.wave < 4) { if (handoff) p7_topk(F, (const unsigned short*)SC, SSQ, IDX, GATE, F.vcu * 8 + F.wave, F.vcu * 8 + 8, 4, true); else p7_topk(F, (const unsigned short*)SC, SSQ, IDX, GATE, F.vcu * 4 + F.wave, T / 8, F.G * 4, false); }
        else { cvt_fp8_rows(F, expert_u, U8, SU, F.vcu * 4 + F.wave - 4, F.G * 4); cvt_fp8_rows(F, expert_v, V8, SV, F.vcu * 4 + F.wave - 4, F.G * 4); }
        }
        DELAY_END(6);
        if (BOTH(6)) GRID_BAR();
    }
    if (IN(7)) { DELAY_T0(7);
        for (int rep = 0; rep < REPS(7); ++rep)
        p8_peer(F, X8, SSQ, SXQ, U8, V8, SU, SV, IDX, GATE, H16, args.out, (bf16*)(ws + WS_PO), g_fin, F.G * NWAVES == T / 8);
        DELAY_END(7);
    }
#undef IN
#undef BOTH
}

extern "C" void kernel_launch(void* const* d_in, const int* in_sizes, int n_in, void* d_out, int out_size, void* d_ws, size_t ws_size, hipStream_t stream) {
    static int grid = 0;
    if (grid == 0) {
        if (n_in != 15 || in_sizes[0] != T * D || out_size != T * D || ws_size < WS_END) { fprintf(stderr, "kernel_launch: shape/workspace mismatch (n_in %d, in0 %d, out %d, ws %zu)\n", n_in, n_in > 0 ? in_sizes[0] : -1, out_size, ws_size); grid = -1; return; }
        int dev = 0, cus = 0, per_cu = 0;
        if (hipGetDevice(&dev) != hipSuccess || hipDeviceGetAttribute(&cus, hipDeviceAttributeMultiprocessorCount, dev) != hipSuccess) { grid = -1; return; }
        if (hipFuncSetAttribute((const void*)hyb_fwd, hipFuncAttributeMaxDynamicSharedMemorySize, LDS_BYTES) != hipSuccess) { fprintf(stderr, "kernel_launch: hipFuncSetAttribute failed\n"); grid = -1; return; }
        if (hipOccupancyMaxActiveBlocksPerMultiprocessor(&per_cu, (const void*)hyb_fwd, NWAVES * 64, LDS_BYTES) != hipSuccess || per_cu < 1)
            fprintf(stderr, "kernel_launch: note: occupancy query reports %d workgroups per CU\n", per_cu);
        (void)hipGetLastError();
        grid = cus;
    }
    if (grid < 0) return;
    if (hipMemsetAsync((char*)d_ws + WS_CTL, 0, CTL_ZERO_BYTES, stream) != hipSuccess) { fprintf(stderr, "kernel_launch: hipMemsetAsync failed\n"); return; }
    Args a{};
    for (int i = 0; i < 15; ++i) a.in[i] = (const float*)d_in[i];
    a.out = (float*)d_out; a.ws = (unsigned char*)d_ws;
    for (int li = 0; li < N_LAUNCHES; ++li) {
        a.ph_lo = (N_LAUNCHES == 1) ? 0 : li; a.ph_hi = (N_LAUNCHES == 1) ? NPHASE : li + 1;
        hipLaunchKernelGGL(hyb_fwd, dim3(grid), dim3(NWAVES * 64), LDS_BYTES, stream, a);
        const hipError_t le = hipPeekAtLastError();
        if (le != hipSuccess) { fprintf(stderr, "kernel_launch: launch %d failed: %s\n", li, hipGetErrorName(le)); break; }
    }
}
```

```cpp
#include <hip/hip_runtime.h>
#include <cstdio>
#include <cstdint>
namespace pg8 {
#define PG8_LAS __attribute__((address_space(3)))
typedef unsigned short bf16_t;
typedef short bf16x8 __attribute__((ext_vector_type(8)));
typedef float f32x4 __attribute__((ext_vector_type(4)));
typedef unsigned u32x4 __attribute__((ext_vector_type(4)));
constexpr int BM = 256, BK = 64, HALF = 128, HTB = HALF * BK * 2  , STAGE_BYTES = 8 * HTB, NXCD = 8, WGM = 8;

__host__ __device__ __forceinline__ int lds_byte(int r, int c) { const int st = (r >> 4) * 2 + (c >> 5), rr = r & 15, cc = c & 31, ob = rr * 64 + cc * 2; return st * 1024 + (ob ^ (((ob >> 9) & 1) << 5)); }
__host__ __device__ __forceinline__ void stage_rc(int b, int& R, int& C) { const int st = b / 1024, sb = b % 1024, swz = sb ^ (((sb >> 9) & 1) << 5); R = (st >> 1) * 16 + swz / 64; C = (st & 1) * 32 + (swz % 64) / 2; }
__host__ __device__ __forceinline__ int perm32(int rho) { const int n = rho >> 4, i = rho & 15; return 8 * (i >> 2) + 4 * n + (i & 3); }

struct Unit { int pm, pn, sel; };
struct Gemm { const bf16_t* A; const bf16_t* Bt; long offA1, offB1; int M, N, K; };

struct StaticOrder {
    int nM, nN, nwg, G, c;
    __host__ __device__ void init(int M, int N, int G_, int c_) { nM = M / BM; nN = N / BM; nwg = nM * nN; G = G_; c = c_; }
    __host__ __device__ __forceinline__ bool next(int i, Unit& u) const {
        const long L = (long)i * G + c; if (L >= nwg) return false;
        int wgid = (int)L; { const int q = nwg / NXCD, r = nwg % NXCD, xcd = wgid % NXCD, off = wgid / NXCD; wgid = (xcd < r ? xcd * (q + 1) : r * (q + 1) + (xcd - r) * q) + off; }
        const int nig = WGM * nN, gid = wgid / nig, fm = gid * WGM, gsz = (nM - fm) < WGM ? (nM - fm) : WGM;
        u.pm = fm + ((wgid % nig) % gsz); u.pn = (wgid % nig) / gsz; u.sel = 0; return true;
    }
    __device__ __forceinline__ void a_ready(const Unit&) const {}
    __device__ __forceinline__ void done(const Unit&) const {}
};


__device__ __forceinline__ unsigned cvt_pk_bf16(float lo, float hi) { unsigned r; asm volatile("v_cvt_pk_bf16_f32 %0, %1, %2" : "=v"(r) : "v"(lo), "v"(hi)); return r; }
__device__ __forceinline__ float sigm(float x) { return __builtin_amdgcn_rcpf(1.0f + __expf(-x)); }
__device__ __forceinline__ float sig255(float x) { return fmaxf(255.0f * __builtin_amdgcn_rcpf(1.0f + __expf(-x)), 1.0f); }
__device__ __forceinline__ unsigned q8(float a, float b, float c, float d) {
    unsigned w = __builtin_amdgcn_cvt_pk_u8_f32(sig255(a), 0u, 0u); w = __builtin_amdgcn_cvt_pk_u8_f32(sig255(b), 1u, w); w = __builtin_amdgcn_cvt_pk_u8_f32(sig255(c), 2u, w); return __builtin_amdgcn_cvt_pk_u8_f32(sig255(d), 3u, w); }
__device__ __forceinline__ float ub0(unsigned w) { return (float)(w & 0xffu); }
__device__ __forceinline__ float ub1(unsigned w) { return (float)((w >> 8) & 0xffu); }
__device__ __forceinline__ float ub2(unsigned w) { return (float)((w >> 16) & 0xffu); }
__device__ __forceinline__ float ub3(unsigned w) { return (float)(w >> 24); }
__device__ __forceinline__ float bflo(unsigned w) { return __uint_as_float(w << 16); }
__device__ __forceinline__ float bfhi(unsigned w) { return __uint_as_float(w & 0xffff0000u); }

struct EpiProj {
    static constexpr bool PERM = true, AFTER_DRAIN = false, CHAIN = false;
    bf16_t* PB; long pg_off;
    __device__ __forceinline__ void operator()(const f32x4 (&acc)[2][2][4][2], const Unit& u, int wr, int wc, int fr, int fq) const {
        const int row0 = u.pm * BM + wr * 64 + fr, lc = wc * 32 + 8 * fq;
        if (u.pn >= 4 && u.pn < 12) {
            bf16_t* base = PB + 1024 + (u.pn - 4) * HALF + lc;
#pragma unroll
            for (int ai = 0; ai < 2; ++ai)
#pragma unroll
                for (int m = 0; m < 4; ++m) { const f32x4 v0 = acc[ai][0][m][0] * acc[ai][1][m][0], v1 = acc[ai][0][m][1] * acc[ai][1][m][1];
                    u32x4 w; w.x = cvt_pk_bf16(v0[0], v0[1]); w.y = cvt_pk_bf16(v0[2], v0[3]); w.z = cvt_pk_bf16(v1[0], v1[1]); w.w = cvt_pk_bf16(v1[2], v1[3]);
                    *(u32x4*)(base + (size_t)(row0 + ai * HALF + m * 16) * 3072) = w; }
            return;
        }
        if (u.pn >= 16) {
            unsigned char* base = (unsigned char*)PB + pg_off + (u.pn - 16) * BM + lc;
#pragma unroll
            for (int ai = 0; ai < 2; ++ai)
#pragma unroll
                for (int m = 0; m < 4; ++m) { unsigned char* rowp = base + (size_t)(row0 + ai * HALF + m * 16) * 2048;
#pragma unroll
                    for (int bj = 0; bj < 2; ++bj) { const f32x4 v0 = acc[ai][bj][m][0], v1 = acc[ai][bj][m][1];
                        typedef unsigned u32x2g __attribute__((ext_vector_type(2))); u32x2g w;
                        w.x = q8(v0[0], v0[1], v0[2], v0[3]); w.y = q8(v1[0], v1[1], v1[2], v1[3]);
                        *(u32x2g*)(rowp + bj * HALF) = w; } }
            return;
        }
        const long boff = (u.pn < 4 ? (long)(u.pn * BM) : (long)(2048 + (u.pn - 12) * BM)); bf16_t* base = PB + boff;
#pragma unroll
        for (int ai = 0; ai < 2; ++ai)
#pragma unroll
            for (int m = 0; m < 4; ++m) { bf16_t* rowp = base + (size_t)(row0 + ai * HALF + m * 16) * 3072 + lc;
#pragma unroll
                for (int bj = 0; bj < 2; ++bj) { const f32x4 v0 = acc[ai][bj][m][0], v1 = acc[ai][bj][m][1];
                    u32x4 w; w.x = cvt_pk_bf16(v0[0], v0[1]); w.y = cvt_pk_bf16(v0[2], v0[3]); w.z = cvt_pk_bf16(v1[0], v1[1]); w.w = cvt_pk_bf16(v1[2], v1[3]);
                    *(u32x4*)(rowp + bj * HALF) = w; } }
    }
};
struct EpiMerge {
    static constexpr bool PERM = true, AFTER_DRAIN = false, CHAIN = true;
    const unsigned char* PG; bf16_t* MG;
    typedef unsigned u32x2g __attribute__((ext_vector_type(2)));
    __device__ __forceinline__ void operator()(f32x4 (&acc)[2][2][4][2], const Unit& u, int wr, int wc, int fr, int fq) const {
        const int row0 = u.pm * BM + wr * 64 + fr, col0 = u.pn * BM + wc * 32 + 8 * fq;
        const unsigned char* pg = PG + (size_t)row0 * 2048 + col0;
        if (u.sel == 0) {
            u32x2g ga[2][4][2], gb[2][4][2];
#pragma unroll
            for (int ai = 0; ai < 2; ++ai)
#pragma unroll
                for (int m = 0; m < 4; ++m)
#pragma unroll
                    for (int bj = 0; bj < 2; ++bj) { const unsigned char* p = pg + (size_t)(ai * HALF + m * 16) * 2048 + bj * HALF; ga[ai][m][bj] = *(const u32x2g*)p; gb[ai][m][bj] = *(const u32x2g*)(p + 1024); }
#pragma unroll
            for (int ai = 0; ai < 2; ++ai)
#pragma unroll
                for (int m = 0; m < 4; ++m)
#pragma unroll
                    for (int bj = 0; bj < 2; ++bj) { const unsigned a0 = ga[ai][m][bj].x, a1 = ga[ai][m][bj].y, b0 = gb[ai][m][bj].x, b1 = gb[ai][m][bj].y; f32x4 v0 = acc[ai][bj][m][0], v1 = acc[ai][bj][m][1];
                        v0[0] *= ub0(a0) * __builtin_amdgcn_rcpf(ub0(b0)); v0[1] *= ub1(a0) * __builtin_amdgcn_rcpf(ub1(b0)); v0[2] *= ub2(a0) * __builtin_amdgcn_rcpf(ub2(b0)); v0[3] *= ub3(a0) * __builtin_amdgcn_rcpf(ub3(b0));
                        v1[0] *= ub0(a1) * __builtin_amdgcn_rcpf(ub0(b1)); v1[1] *= ub1(a1) * __builtin_amdgcn_rcpf(ub1(b1)); v1[2] *= ub2(a1) * __builtin_amdgcn_rcpf(ub2(b1)); v1[3] *= ub3(a1) * __builtin_amdgcn_rcpf(ub3(b1));
                        acc[ai][bj][m][0] = v0; acc[ai][bj][m][1] = v1; }
            asm volatile("" ::: "memory");
        } else {
            u32x2g gb[2][4][2];
#pragma unroll
            for (int ai = 0; ai < 2; ++ai)
#pragma unroll
                for (int m = 0; m < 4; ++m)
#pragma unroll
                    for (int bj = 0; bj < 2; ++bj) gb[ai][m][bj] = *(const u32x2g*)(pg + (size_t)(ai * HALF + m * 16) * 2048 + bj * HALF + 1024);
            const float k = 1.0f / 255.0f;
#pragma unroll
            for (int ai = 0; ai < 2; ++ai)
#pragma unroll
                for (int m = 0; m < 4; ++m)
#pragma unroll
                    for (int bj = 0; bj < 2; ++bj) { const unsigned b0 = gb[ai][m][bj].x, b1 = gb[ai][m][bj].y; const f32x4 v0 = acc[ai][bj][m][0], v1 = acc[ai][bj][m][1];
                        u32x4 w; w.x = cvt_pk_bf16(v0[0] * (ub0(b0) * k), v0[1] * (ub1(b0) * k)); w.y = cvt_pk_bf16(v0[2] * (ub2(b0) * k), v0[3] * (ub3(b0) * k));
                        w.z = cvt_pk_bf16(v1[0] * (ub0(b1) * k), v1[1] * (ub1(b1) * k)); w.w = cvt_pk_bf16(v1[2] * (ub2(b1) * k), v1[3] * (ub3(b1) * k));
                        *(u32x4*)(MG + (size_t)(row0 + ai * HALF + m * 16) * 1024 + col0 + bj * HALF) = w; }
            asm volatile("" ::: "memory");
        }
    }
};
struct EpiRes {
    static constexpr bool PERM = false, AFTER_DRAIN = false, CHAIN = false;
    const float* X; float* H;
    __device__ __forceinline__ void operator()(const f32x4 (&acc)[2][2][4][2], const Unit& u, int wr, int wc, int fr, int fq) const {
        const int row0 = u.pm * BM + wr * 64 + fr, col0 = u.pn * BM + wc * 32 + 4 * fq;
#pragma unroll
        for (int ai = 0; ai < 2; ++ai)
#pragma unroll
            for (int m = 0; m < 4; ++m) { const size_t off = (size_t)(row0 + ai * HALF + m * 16) * 1024 + col0;
#pragma unroll
                for (int bj = 0; bj < 2; ++bj)
#pragma unroll
                    for (int n = 0; n < 2; ++n) { const f32x4 xv = *(const f32x4*)(X + off + bj * HALF + n * 16); *(f32x4*)(H + off + bj * HALF + n * 16) = xv + acc[ai][bj][m][n]; } }
    }
};
struct EpiF16 {
    static constexpr bool PERM = true, AFTER_DRAIN = false, CHAIN = false;
    unsigned short* C; int ldc;
    __device__ __forceinline__ unsigned pkh(float a, float b) const { typedef _Float16 h2 __attribute__((ext_vector_type(2))); h2 v; v.x = (_Float16)a; v.y = (_Float16)b; return __builtin_bit_cast(unsigned, v); }
    __device__ __forceinline__ void operator()(const f32x4 (&acc)[2][2][4][2], const Unit& u, int wr, int wc, int fr, int fq) const {
        const int row0 = u.pm * BM + wr * 64 + fr, col0 = u.pn * BM + wc * 32 + 8 * fq;
#pragma unroll
        for (int ai = 0; ai < 2; ++ai)
#pragma unroll
            for (int m = 0; m < 4; ++m) { unsigned short* rowp = C + (size_t)(row0 + ai * HALF + m * 16) * ldc + col0;
#pragma unroll
                for (int bj = 0; bj < 2; ++bj) { const f32x4 v0 = acc[ai][bj][m][0], v1 = acc[ai][bj][m][1];
                    u32x4 w; w.x = pkh(v0[0], v0[1]); w.y = pkh(v0[2], v0[3]); w.z = pkh(v1[0], v1[1]); w.w = pkh(v1[2], v1[3]);
                    *(u32x4*)(rowp + bj * HALF) = w; } }
    }
};
struct EpiResRms {
    static constexpr bool PERM = true, AFTER_DRAIN = true, CHAIN = false;
    const float* X; bf16_t* H16; unsigned char* X8; float* SSQ; float* SXQ;
    __device__ __forceinline__ void fused(f32x4 (&acc)[2][2][4][2], const Unit& u, int wr, int wc, int fr, int fq, PG8_LAS unsigned char* lds, int wid, int lane) const {
        typedef float f32x2v __attribute__((ext_vector_type(2))); typedef unsigned u32x2v __attribute__((ext_vector_type(2)));
        PG8_LAS f32x2v* P = (PG8_LAS f32x2v*)lds;
        PG8_LAS f32x2v* S = (PG8_LAS f32x2v*)(lds + 8192);
        int col0 = u.pn * BM + wc * 32 + 8 * fq; asm volatile("" : "+v"(col0));
        const float* xb = X + (size_t)(u.pm * BM + wr * 64 + fr) * 1024 + col0;
        f32x4 xq[3][2][2];
#pragma unroll
        for (int pre = 0; pre < 2; ++pre)
#pragma unroll
            for (int bj = 0; bj < 2; ++bj)
#pragma unroll
                for (int n = 0; n < 2; ++n) xq[pre][bj][n] = *(const f32x4*)(xb + (size_t)(pre * 16) * 1024 + bj * HALF + n * 4);
#pragma unroll
        for (int am = 0; am < 8; ++am) { const int ai = am >> 2, m = am & 3, r = ai * HALF + wr * 64 + m * 16 + fr;
            if (am < 6) { const int a2 = (am + 2) >> 2, m2 = (am + 2) & 3;
#pragma unroll
                for (int bj = 0; bj < 2; ++bj)
#pragma unroll
                    for (int n = 0; n < 2; ++n) xq[(am + 2) % 3][bj][n] = *(const f32x4*)(xb + (size_t)(a2 * HALF + m2 * 16) * 1024 + bj * HALF + n * 4); }
            asm volatile("" ::: "memory");
            float s = 0.f, a = 0.f;
#pragma unroll
            for (int bj = 0; bj < 2; ++bj)
#pragma unroll
                for (int n = 0; n < 2; ++n) { const f32x4 h = xq[am % 3][bj][n] + acc[ai][bj][m][n]; acc[ai][bj][m][n] = h;
                    s += (h[0] * h[0] + h[1] * h[1]) + (h[2] * h[2] + h[3] * h[3]);
                    a = fmaxf(a, fmaxf(fmaxf(fabsf(h[0]), fabsf(h[1])), fmaxf(fabsf(h[2]), fabsf(h[3])))); }
            s += __shfl_xor(s, 16); s += __shfl_xor(s, 32); a = fmaxf(a, __shfl_xor(a, 16)); a = fmaxf(a, __shfl_xor(a, 32));
            if (fq == 0) P[r * 4 + wc] = (f32x2v){s, a};
            asm volatile("" ::: "memory"); }
        asm volatile("s_waitcnt lgkmcnt(0)" ::: "memory"); __builtin_amdgcn_s_barrier(); asm volatile("" ::: "memory");
        const int row = wid * 32 + (lane & 31);
        if (lane < 32) {
            const f32x2v a = P[row * 4 + 0], b = P[row * 4 + 1], c = P[row * 4 + 2], d = P[row * 4 + 3];
            const float st = (a.x + b.x) + (c.x + d.x), am = fmaxf(fmaxf(a.y, b.y), fmaxf(c.y, d.y));
            const float sc = (am > 0.f) ? am * (1.0f / 448.0f) : 1.0f;
            S[row] = (f32x2v){st, 1.0f / sc};
            SSQ[(size_t)(u.pm * BM + row) * 4 + u.pn] = st; SXQ[(size_t)(u.pm * BM + row) * 4 + u.pn] = sc;
        }
        asm volatile("s_waitcnt lgkmcnt(0)" ::: "memory"); __builtin_amdgcn_s_barrier(); asm volatile("" ::: "memory");
        asm volatile("" : "+v"(col0), "+v"(fr));
#pragma unroll
        for (int ai = 0; ai < 2; ++ai)
#pragma unroll
            for (int m = 0; m < 4; ++m) { const int r = ai * HALF + wr * 64 + m * 16 + fr; const f32x2v sr = S[r]; const size_t off = (size_t)(u.pm * BM + r) * 1024 + col0;
#pragma unroll
                for (int bj = 0; bj < 2; ++bj) { const f32x4 h0 = acc[ai][bj][m][0], h1 = acc[ai][bj][m][1];
                    u32x4 hw; hw.x = cvt_pk_bf16(h0[0], h0[1]); hw.y = cvt_pk_bf16(h0[2], h0[3]); hw.z = cvt_pk_bf16(h1[0], h1[1]); hw.w = cvt_pk_bf16(h1[2], h1[3]);
                    *(u32x4*)(H16 + off + bj * HALF) = hw;
                    { const f32x4 q0 = h0 * sr.y, q1 = h1 * sr.y; u32x2v w8;
                        w8.x = (unsigned)__builtin_amdgcn_cvt_pk_fp8_f32(q0[2], q0[3], __builtin_amdgcn_cvt_pk_fp8_f32(q0[0], q0[1], 0, false), true);
                        w8.y = (unsigned)__builtin_amdgcn_cvt_pk_fp8_f32(q1[2], q1[3], __builtin_amdgcn_cvt_pk_fp8_f32(q1[0], q1[1], 0, false), true);
                        *(u32x2v*)(X8 + off + bj * HALF) = w8; } }
                asm volatile("" ::: "memory"); }
    }
};
struct MergeOrder {
    StaticOrder base;
    __device__ __forceinline__ bool next(int i, Unit& u) const { if (!base.next(i >> 1, u)) return false; u.sel = i & 1; return true; }
    __device__ __forceinline__ void a_ready(const Unit&) const {}
    __device__ __forceinline__ void done(const Unit&) const {}
};

template <class Epi, class Sched, bool ALIGN_EPI = false, bool SP2 = false>
__device__ __forceinline__ void gemm_phase(PG8_LAS unsigned char* lds, const Gemm g, const Sched& S, const Epi& E) {
    const int tid = threadIdx.x, wid = __builtin_amdgcn_readfirstlane(tid >> 6), lane = tid & 63, wr = wid >> 2, wc = wid & 3, fr = lane & 15, fq = lane >> 4;
    const int K = g.K, nt = K / BK;
    unsigned voffA[2], voffB[2];
#pragma unroll
    for (int i = 0; i < 2; ++i) { int R, C; stage_rc(tid * 16 + i * 8192, R, C); const int Rb = Epi::PERM ? ((R & ~31) + perm32(R & 31)) : R;
        voffA[i] = (unsigned)(R * K + C) * 2u; voffB[i] = (unsigned)(Rb * K + C) * 2u; }
    const size_t kstep = (size_t)(BK * 2);
    const size_t hstep = (size_t)HALF * K * 2;
    const size_t tstep = 2 * hstep;
    const unsigned ldsw = (unsigned)wid * 1024u;
    const int aoff = lds_byte(wr * 64 + fr, fq * 8), boff = lds_byte(wc * 32 + fr, fq * 8);
#define PG8_SA(b, h) (((b) * 2 + (h)) * HTB)
#define PG8_SB(b, h) ((4 + (b) * 2 + (h)) * HTB)
#define PG8_STAGE(bufoff, gbase, voff) do { _Pragma("unroll") for (int _i = 0; _i < 2; ++_i) \
        __builtin_amdgcn_global_load_lds((const unsigned*)((const char*)(gbase) + (voff)[_i]), (PG8_LAS unsigned*)(lds + (bufoff) + ldsw + _i * 8192), 16, 0, 0); } while (0)
#define PG8_LDA(dst, b, h) do { _Pragma("unroll") for (int m = 0; m < 4; ++m) _Pragma("unroll") for (int k = 0; k < 2; ++k) dst[m][k] = *(const PG8_LAS bf16x8*)(lds + PG8_SA(b, h) + aoff + m * 2048 + k * 1024); } while (0)
#define PG8_LDB(dst, b, h) do { _Pragma("unroll") for (int n = 0; n < 2; ++n) _Pragma("unroll") for (int k = 0; k < 2; ++k) dst[n][k] = *(const PG8_LAS bf16x8*)(lds + PG8_SB(b, h) + boff + n * 2048 + k * 1024); } while (0)
#define PG8_MMA(ai, bj, At, Bt) do { __builtin_amdgcn_s_setprio(1); _Pragma("unroll") for (int m = 0; m < 4; ++m) _Pragma("unroll") for (int n = 0; n < 2; ++n) _Pragma("unroll") for (int k = 0; k < 2; ++k) \
        acc[ai][bj][m][n] = __builtin_amdgcn_mfma_f32_16x16x32_bf16(Bt[n][k], At[m][k], acc[ai][bj][m][n], 0, 0, 0); __builtin_amdgcn_s_setprio(0); } while (0)
#define PG8_WAIT_V(n) asm volatile("s_waitcnt vmcnt(" #n ")" ::: "memory")
#define PG8_WAIT_L(n) asm volatile("s_waitcnt lgkmcnt(" #n ")" ::: "memory")
#define PG8_BAR __builtin_amdgcn_s_barrier()
#define PG8_SCHED __builtin_amdgcn_sched_barrier(0)
    Unit cur, nxt; int ui = 0;
    if (!S.next(0, cur)) return;
    f32x4 acc[2][2][4][2];
#pragma unroll
    for (int a = 0; a < 2; ++a)
#pragma unroll
        for (int b = 0; b < 2; ++b)
#pragma unroll
            for (int m = 0; m < 4; ++m)
#pragma unroll
                for (int n = 0; n < 2; ++n) acc[a][b][m][n] = (f32x4){0.f, 0.f, 0.f, 0.f};
    bf16x8 At[4][2], B0[2][2], B1[2][2];
    const char* cA = (const char*)g.A + (cur.sel ? g.offA1 : 0l) + (size_t)cur.pm * tstep; const char* cB = (const char*)g.Bt + (cur.sel ? g.offB1 : 0l) + (size_t)cur.pn * tstep;
    S.a_ready(cur);
    if constexpr (SP2) {
        PG8_STAGE(PG8_SB(0, 0), cB, voffB); PG8_STAGE(PG8_SB(0, 1), cB + hstep, voffB); PG8_STAGE(PG8_SA(0, 0), cA, voffA); PG8_STAGE(PG8_SA(0, 1), cA + hstep, voffA);
        if (wr == 1) PG8_BAR;
        PG8_WAIT_V(2); PG8_BAR;
        PG8_STAGE(PG8_SB(1, 0), cB + kstep, voffB); PG8_STAGE(PG8_SA(1, 0), cA + kstep, voffA); PG8_STAGE(PG8_SB(1, 1), cB + hstep + kstep, voffB);
        PG8_WAIT_V(6); PG8_BAR;
    } else {
        PG8_STAGE(PG8_SB(0, 0), cB, voffB); PG8_STAGE(PG8_SA(0, 0), cA, voffA); PG8_STAGE(PG8_SB(0, 1), cB + hstep, voffB); PG8_STAGE(PG8_SA(0, 1), cA + hstep, voffA);
        if (wr == 1) PG8_BAR;
        PG8_WAIT_V(4); PG8_BAR;
        PG8_STAGE(PG8_SB(1, 0), cB + kstep, voffB); PG8_STAGE(PG8_SA(1, 0), cA + kstep, voffA); PG8_STAGE(PG8_SB(1, 1), cB + hstep + kstep, voffB);
        PG8_WAIT_V(6); PG8_BAR;
    }
    for (;;) {
        const bool has_next = S.next(ui + 1, nxt);
        const char* nA = has_next ? (const char*)g.A + (nxt.sel ? g.offA1 : 0l) + (size_t)nxt.pm * tstep : cA; const char* nB = has_next ? (const char*)g.Bt + (nxt.sel ? g.offB1 : 0l) + (size_t)nxt.pn * tstep : cB;
        for (int t = 0; t < nt; t += 2) {
            const bool last = (t == nt - 2);
            const char* a1 = cA + (size_t)(t + 1) * kstep;
            const char* a2 = last ? nA : cA + (size_t)(t + 2) * kstep; const char* b2 = last ? nB : cB + (size_t)(t + 2) * kstep;
            const char* a3 = a2 + kstep; const char* b3 = b2 + kstep;
            if (last && has_next) S.a_ready(nxt);
            if constexpr (SP2) {
            PG8_LDB(B0, 0, 0); PG8_LDB(B1, 0, 1); PG8_SCHED; PG8_LDA(At, 0, 0); PG8_STAGE(PG8_SA(1, 1), a1 + hstep, voffA);
            PG8_WAIT_V(8); PG8_WAIT_L(0); PG8_BAR; PG8_MMA(0, 0, At, B0); PG8_MMA(0, 1, At, B1); PG8_BAR; PG8_SCHED;
            PG8_LDA(At, 0, 1); PG8_STAGE(PG8_SB(0, 0), b2, voffB); PG8_STAGE(PG8_SB(0, 1), b2 + hstep, voffB); PG8_STAGE(PG8_SA(0, 0), a2, voffA);
            PG8_WAIT_V(8); PG8_WAIT_L(0); PG8_BAR; PG8_MMA(1, 0, At, B0); PG8_MMA(1, 1, At, B1); PG8_BAR; PG8_SCHED;
            PG8_LDB(B0, 1, 0); PG8_LDB(B1, 1, 1); PG8_SCHED; PG8_LDA(At, 1, 0); PG8_STAGE(PG8_SA(0, 1), a2 + hstep, voffA);
            PG8_WAIT_V(8); PG8_WAIT_L(0); PG8_BAR; PG8_MMA(0, 0, At, B0); PG8_MMA(0, 1, At, B1); PG8_BAR; PG8_SCHED;
            PG8_LDA(At, 1, 1); PG8_STAGE(PG8_SB(1, 0), b3, voffB); PG8_STAGE(PG8_SB(1, 1), b3 + hstep, voffB); PG8_STAGE(PG8_SA(1, 0), a3, voffA);
            PG8_WAIT_V(8); PG8_WAIT_L(0); PG8_BAR; PG8_MMA(1, 0, At, B0); PG8_MMA(1, 1, At, B1); PG8_BAR; PG8_SCHED;
            } else {
            PG8_LDB(B0, 0, 0); PG8_SCHED; PG8_LDA(At, 0, 0); PG8_STAGE(PG8_SA(1, 1), a1 + hstep, voffA);
            PG8_WAIT_L(8); PG8_BAR; PG8_WAIT_L(0); PG8_MMA(0, 0, At, B0); PG8_BAR; PG8_SCHED;
            PG8_LDB(B1, 0, 1); PG8_STAGE(PG8_SB(0, 0), b2, voffB);
            PG8_BAR; PG8_WAIT_L(0); PG8_MMA(0, 1, At, B1); PG8_BAR;
            PG8_LDA(At, 0, 1); PG8_STAGE(PG8_SA(0, 0), a2, voffA);
            PG8_BAR; PG8_WAIT_L(0); PG8_MMA(1, 0, At, B0); PG8_BAR; PG8_SCHED;
            PG8_STAGE(PG8_SB(0, 1), b2 + hstep, voffB);
            PG8_WAIT_V(6); PG8_BAR; PG8_MMA(1, 1, At, B1); PG8_BAR;
            PG8_LDB(B0, 1, 0); PG8_SCHED; PG8_LDA(At, 1, 0); PG8_STAGE(PG8_SA(0, 1), a2 + hstep, voffA);
            PG8_WAIT_L(8); PG8_BAR; PG8_WAIT_L(0); PG8_MMA(0, 0, At, B0); PG8_BAR; PG8_SCHED;
            PG8_LDB(B1, 1, 1); PG8_STAGE(PG8_SB(1, 0), b3, voffB);
            PG8_BAR; PG8_WAIT_L(0); PG8_MMA(0, 1, At, B1); PG8_BAR;
            PG8_LDA(At, 1, 1); PG8_STAGE(PG8_SA(1, 0), a3, voffA);
            PG8_BAR; PG8_WAIT_L(0); PG8_MMA(1, 0, At, B0); PG8_BAR; PG8_SCHED;
            PG8_STAGE(PG8_SB(1, 1), b3 + hstep, voffB);
            PG8_WAIT_V(6); PG8_BAR; PG8_MMA(1, 1, At, B1); PG8_BAR;
            }
        }
        if constexpr (ALIGN_EPI) { if (wr == 0) PG8_BAR; }
        if constexpr (!Epi::AFTER_DRAIN) { E(acc, cur, wr, wc, fr, fq); S.done(cur); }
        if (!has_next) break;
        if (!Epi::CHAIN || nxt.sel == 0) {
#pragma unroll
        for (int a = 0; a < 2; ++a)
#pragma unroll
            for (int b = 0; b < 2; ++b)
#pragma unroll
                for (int m = 0; m < 4; ++m)
#pragma unroll
                    for (int n = 0; n < 2; ++n) acc[a][b][m][n] = (f32x4){0.f, 0.f, 0.f, 0.f};
        }
        cur = nxt; cA = nA; cB = nB; ++ui;
        if constexpr (ALIGN_EPI) { if (wr == 1) PG8_BAR; }
    }
    PG8_WAIT_V(0);
    if constexpr (!ALIGN_EPI) { if (wr == 0) PG8_BAR; }
    PG8_BAR;
    if constexpr (Epi::AFTER_DRAIN) { E.fused(acc, cur, wr, wc, fr, fq, lds, wid, lane); S.done(cur); }
#undef PG8_SA
#undef PG8_SB
#undef PG8_STAGE
#undef PG8_LDA
#undef PG8_LDB
#undef PG8_MMA
#undef PG8_WAIT_V
#undef PG8_WAIT_L
#undef PG8_BAR
#undef PG8_SCHED
}
}
constexpr int NWAVES = 8;
#ifndef MK_N_LAUNCHES
#define MK_N_LAUNCHES 1
#endif
constexpr int NPHASE = 8;
#ifndef PROBE_DUP
#define PROBE_DUP 0
#endif
#ifndef PROBE_DELAY
#define PROBE_DELAY (-1)
#endif
#define DELAY_T0(k) const unsigned long long _t0_##k = (PROBE_DELAY == (k)) ? __builtin_amdgcn_s_memrealtime() : 0ull
#define DELAY_END(k) do { if (PROBE_DELAY == (k)) { const unsigned long long _t1 = __builtin_amdgcn_s_memrealtime(), _dt = _t1 - _t0_##k; while (__builtin_amdgcn_s_memrealtime() - _t1 < _dt) __builtin_amdgcn_s_sleep(8); } } while (0)
#define REPS(k) (1 + ((PROBE_DUP >> (k)) & 1))
constexpr int N_LAUNCHES = MK_N_LAUNCHES;
static_assert(N_LAUNCHES == 1 || N_LAUNCHES == NPHASE, "MK_N_LAUNCHES is 1 or NPHASE");

constexpr int T = 16384, SEQ = 2048, D = 1024, NIN = 6144, NSC = 2048, NEXP = 16384, NSEL = 128;
constexpr float EPS = 1e-6f;

constexpr size_t MiB = 1u << 20;
constexpr size_t WS_CTL = 0, CTL_ZERO_BYTES = 64 * 1024;
constexpr size_t WS_WIN = 1 * MiB, WS_WC = 13 * MiB, WS_WPB = 15 * MiB, WS_WOUT = 17 * MiB, WS_WS = 19 * MiB;
constexpr size_t WS_IDX = 1 * MiB, WS_GATE = 9 * MiB;
constexpr size_t WS_XN = 32 * MiB;
constexpr size_t WS_PB = 64 * MiB;
constexpr size_t WS_TMP = 64 * MiB, WS_MG = 96 * MiB;
constexpr size_t WS_X8 = 128 * MiB, WS_SX = 144 * MiB;
constexpr size_t WS_PO = 64 * MiB;
constexpr size_t WS_SC = 64 * MiB;
constexpr size_t WS_PG = 192 * MiB;
constexpr size_t WS_U8 = 192 * MiB, WS_V8 = 208 * MiB, WS_H16 = 224 * MiB, WS_SU = 31 * MiB + 512 * 1024, WS_SV = 31 * MiB + 576 * 1024;
constexpr size_t WS_END = 256 * MiB;
constexpr int CW_TMO = 0;
constexpr int CW_BAR = 1024;
constexpr int CW_SEAM = 8192;
constexpr size_t WS_XBUF = 31 * MiB;

constexpr int RING_OFF = 0, RING_BYTES = 131072;
constexpr int P7_WAVE_BYTES = 18432;
constexpr int P7_IDX_OFF = 0, P7_OUT_OFF = 4096, P7_STAGE_OFF = 6144, P7_ZA_OFF = 14336;
constexpr int LDSCTL_OFF = 8 * P7_WAVE_BYTES, MISC_OFF = LDSCTL_OFF + 320;
constexpr int P7_AUX_OFF = LDSCTL_OFF + 1024;
constexpr int LDS_BYTES = 150528;
#define GAS __attribute__((address_space(1)))
#define LAS __attribute__((address_space(3)))
typedef unsigned short bf16;
typedef unsigned v4u __attribute__((ext_vector_type(4)));
typedef float f32x4 __attribute__((ext_vector_type(4)));
typedef short bf16x8 __attribute__((ext_vector_type(8)));
typedef GAS unsigned gu32;
typedef GAS unsigned long long gu64;
#define RLX_AGENT __ATOMIC_RELAXED, __HIP_MEMORY_SCOPE_AGENT
#define LDS_WAIT() asm volatile("s_waitcnt lgkmcnt(0)" ::: "memory")
#define VM_WAIT() asm volatile("s_waitcnt vmcnt(0)" ::: "memory")
__device__ __forceinline__ unsigned long long rt() { return __builtin_amdgcn_s_memrealtime(); }
__device__ __forceinline__ unsigned f2bf(float f) { unsigned u = __builtin_bit_cast(unsigned, f); return (u + 0x7fffu + ((u >> 16) & 1u)) >> 16; }
__device__ __forceinline__ unsigned pk2(float lo, float hi) { return f2bf(lo) | (f2bf(hi) << 16); }

#define XB_TMO      128
#define XB_XCNT(j)  (256  + 64 * (j))
#define XB_XSUB(j)  (1280 + 64 * (j))
#define XB_XGEN(j)  (2304 + 64 * (j))
#define XB_TOP      3328
#define XB_TOPGEN   3392
#define XCD_BAR_WORDS 3456
#define XB_SPIN_CAP (1u << 18)

__device__ __forceinline__ unsigned xb_ld(unsigned* p)              { return __hip_atomic_load(p, __ATOMIC_RELAXED, __HIP_MEMORY_SCOPE_AGENT); }
__device__ __forceinline__ unsigned xb_add(unsigned* p, unsigned v) { return __hip_atomic_fetch_add(p, v, __ATOMIC_RELAXED, __HIP_MEMORY_SCOPE_AGENT); }
__device__ __forceinline__ unsigned xb_xcc_id() { return (unsigned)__builtin_amdgcn_s_getreg((3 << 11) | 20) & 0xFu; }
#define XB_SPIN(cond, bar) do { unsigned _sp = 0; while (cond) { __builtin_amdgcn_s_sleep(1); \
    if ((++_sp & 255u) == 0u) { if (xb_ld(&(bar)[XB_TMO])) break; if (_sp > XB_SPIN_CAP) { atomicAdd(&(bar)[XB_TMO], 1u); break; } } } } while (0)

struct XcdBarrier {
    unsigned* bar; unsigned x;
    volatile LAS unsigned* st;
};

__device__ __forceinline__ XcdBarrier xcd_barrier_post(unsigned* bar, volatile LAS unsigned* st) {
    XcdBarrier b; b.bar = bar; b.x = xb_xcc_id(); b.st = st;
    if (threadIdx.x == 0) (void)xb_add(&bar[XB_XCNT(b.x)], 1u);
    return b;
}
__device__ __forceinline__ void xcd_barrier_complete(unsigned* bar, unsigned x, unsigned& nloc, unsigned& nx) {
    const unsigned G = gridDim.x * gridDim.y * gridDim.z;
    unsigned sum, cnt, mine, sp = 0u;
    for (;;) {
        sum = 0u; cnt = 0u; mine = 0u;
#pragma unroll
        for (unsigned j = 0; j < 16; ++j) { const unsigned c = xb_ld(&bar[XB_XCNT(j)]); sum += c; cnt += (c > 0u) ? 1u : 0u; mine = (j == x) ? c : mine; }
        if (sum == G) break;
        __builtin_amdgcn_s_sleep(1);
        if ((++sp & 255u) == 0u) { if (xb_ld(&bar[XB_TMO])) break; if (sp > XB_SPIN_CAP) { atomicAdd(&bar[XB_TMO], 1u); break; } }
    }
    nloc = mine > 0u ? mine : 1u; nx = cnt > 0u ? cnt : 1u;
}

__device__ __forceinline__ void xcd_barrier(const XcdBarrier& b) {
    asm volatile("s_waitcnt vmcnt(0)" ::: "memory");
    __syncthreads();
    if (threadIdx.x == 0) {
        unsigned* bar = b.bar;
        __builtin_amdgcn_s_waitcnt(0);
        unsigned nloc = b.st[0], nx = b.st[1];
        if (nloc == 0u) { xcd_barrier_complete(bar, b.x, nloc, nx); b.st[0] = nloc; b.st[1] = nx; }
        const unsigned old = xb_add(&bar[XB_XSUB(b.x)], 1u);
        const unsigned gen = old / nloc;
        if (old + 1u == (gen + 1u) * nloc) {
            __builtin_amdgcn_fence(__ATOMIC_RELEASE, "agent");
            asm volatile("s_waitcnt vmcnt(0)" ::: "memory");
            const unsigned og = xb_add(&bar[XB_TOP], 1u);
            const unsigned tg = og / nx;
            if (og + 1u == (tg + 1u) * nx) xb_add(&bar[XB_TOPGEN], 1u);
            else XB_SPIN(xb_ld(&bar[XB_TOPGEN]) == tg, bar);
            __builtin_amdgcn_fence(__ATOMIC_ACQUIRE, "agent");
            xb_add(&bar[XB_XGEN(b.x)], 1u);
            asm volatile("s_waitcnt vmcnt(0)" ::: "memory");
        } else {
            XB_SPIN(xb_ld(&bar[XB_XGEN(b.x)]) == gen, bar);
            __builtin_amdgcn_fence(__ATOMIC_ACQUIRE, "agent");
            asm volatile("s_waitcnt vmcnt(0)" ::: "memory");
        }
    }
    __syncthreads();
}

struct Frame {
    LAS unsigned char* lds;
    volatile LAS unsigned* MISC;
    int tid, lane, wave;
    int vcu, G;
};
__device__ __forceinline__ float wave_sum(float v) {
#pragma unroll
    for (int o = 1; o < 64; o <<= 1) v += __shfl_xor(v, o);
    return v;
}
__device__ __forceinline__ float bflo(unsigned w) { return __uint_as_float(w << 16); }
__device__ __forceinline__ float bfhi(unsigned w) { return __uint_as_float(w & 0xffff0000u); }
__device__ __forceinline__ void unpack8(const v4u w, float (&f)[8]) { f[0] = bflo(w.x); f[1] = bfhi(w.x); f[2] = bflo(w.y); f[3] = bfhi(w.y); f[4] = bflo(w.z); f[5] = bfhi(w.z); f[6] = bflo(w.w); f[7] = bfhi(w.w); }
__device__ __forceinline__ v4u pack8(const float (&f)[8]) { v4u o; o.x = pk2(f[0], f[1]); o.y = pk2(f[2], f[3]); o.z = pk2(f[4], f[5]); o.w = pk2(f[6], f[7]); return o; }

__device__ __forceinline__ void rms_row_to_fp8(int lane, const float* xrow, const float* g, unsigned char* orow, float* sc_out) {
    const GAS f32x4* xr = (const GAS f32x4*)xrow + 4 * lane; const GAS f32x4* gr = (const GAS f32x4*)g + 4 * lane;
    f32x4 v[4]; float s = 0.f, am = 0.f;
#pragma unroll
    for (int jj = 0; jj < 4; ++jj) { v[jj] = xr[jj]; s += (v[jj].x * v[jj].x + v[jj].y * v[jj].y) + (v[jj].z * v[jj].z + v[jj].w * v[jj].w); v[jj] = v[jj] * gr[jj];
        am = fmaxf(am, fmaxf(fmaxf(fabsf(v[jj].x), fabsf(v[jj].y)), fmaxf(fabsf(v[jj].z), fabsf(v[jj].w)))); }
#pragma unroll
    for (int o = 1; o < 64; o <<= 1) am = fmaxf(am, __shfl_xor(am, o));
    const float rstd = 1.f / sqrtf(wave_sum(s) * (1.f / D) + EPS), xm = am * rstd, sc = (xm > 0.f) ? xm * (1.0f / 448.0f) : 1.0f, mul = rstd / sc;
    v4u o;
    o.x = (unsigned)__builtin_amdgcn_cvt_pk_fp8_f32(v[0].z * mul, v[0].w * mul, __builtin_amdgcn_cvt_pk_fp8_f32(v[0].x * mul, v[0].y * mul, 0, false), true);
    o.y = (unsigned)__builtin_amdgcn_cvt_pk_fp8_f32(v[1].z * mul, v[1].w * mul, __builtin_amdgcn_cvt_pk_fp8_f32(v[1].x * mul, v[1].y * mul, 0, false), true);
    o.z = (unsigned)__builtin_amdgcn_cvt_pk_fp8_f32(v[2].z * mul, v[2].w * mul, __builtin_amdgcn_cvt_pk_fp8_f32(v[2].x * mul, v[2].y * mul, 0, false), true);
    o.w = (unsigned)__builtin_amdgcn_cvt_pk_fp8_f32(v[3].z * mul, v[3].w * mul, __builtin_amdgcn_cvt_pk_fp8_f32(v[3].x * mul, v[3].y * mul, 0, false), true);
    *(GAS v4u*)(orow + 16 * lane) = o;
    if (lane == 0) *sc_out = sc;
}
__device__ __forceinline__ void p4_row_defer(int lane, const float* hrow, unsigned char* x8, float* ssq, float* sxq, bf16* h16) {
    const GAS f32x4* xr = (const GAS f32x4*)hrow + 4 * lane;
    f32x4 h[4]; float s = 0.f, am = 0.f;
#pragma unroll
    for (int jj = 0; jj < 4; ++jj) { h[jj] = xr[jj]; s += (h[jj].x * h[jj].x + h[jj].y * h[jj].y) + (h[jj].z * h[jj].z + h[jj].w * h[jj].w);
        am = fmaxf(am, fmaxf(fmaxf(fabsf(h[jj].x), fabsf(h[jj].y)), fmaxf(fabsf(h[jj].z), fabsf(h[jj].w)))); }
#pragma unroll
    for (int o = 1; o < 64; o <<= 1) am = fmaxf(am, __shfl_xor(am, o));
    s = wave_sum(s);
    const float sc = (am > 0.f) ? am * (1.0f / 448.0f) : 1.0f, mul = 1.0f / sc;
    v4u o;
    o.x = (unsigned)__builtin_amdgcn_cvt_pk_fp8_f32(h[0].z * mul, h[0].w * mul, __builtin_amdgcn_cvt_pk_fp8_f32(h[0].x * mul, h[0].y * mul, 0, false), true);
    o.y = (unsigned)__builtin_amdgcn_cvt_pk_fp8_f32(h[1].z * mul, h[1].w * mul, __builtin_amdgcn_cvt_pk_fp8_f32(h[1].x * mul, h[1].y * mul, 0, false), true);
    o.z = (unsigned)__builtin_amdgcn_cvt_pk_fp8_f32(h[2].z * mul, h[2].w * mul, __builtin_amdgcn_cvt_pk_fp8_f32(h[2].x * mul, h[2].y * mul, 0, false), true);
    o.w = (unsigned)__builtin_amdgcn_cvt_pk_fp8_f32(h[3].z * mul, h[3].w * mul, __builtin_amdgcn_cvt_pk_fp8_f32(h[3].x * mul, h[3].y * mul, 0, false), true);
    *(GAS v4u*)(x8 + 16 * lane) = o;
    v4u b0, b1;
    b0.x = pk2(h[0].x, h[0].y); b0.y = pk2(h[0].z, h[0].w); b0.z = pk2(h[1].x, h[1].y); b0.w = pk2(h[1].z, h[1].w); b1.x = pk2(h[2].x, h[2].y); b1.y = pk2(h[2].z, h[2].w); b1.z = pk2(h[3].x, h[3].y); b1.w = pk2(h[3].z, h[3].w);
    *(GAS v4u*)(h16 + 16 * lane) = b0; *(GAS v4u*)(h16 + 16 * lane + 8) = b1;
    if (lane == 0) { ssq[0] = s; ssq[1] = 0.f; ssq[2] = 0.f; ssq[3] = 0.f; sxq[0] = sc; sxq[1] = sc; sxq[2] = sc; sxq[3] = sc; }
}
__device__ __forceinline__ void rms_rows4_to_bf16(int lane, const float* xrow, const float* g, bf16* orow) {
    asm volatile("" : "+v"(lane));
    const GAS f32x4* gr = (const GAS f32x4*)g + lane;
    f32x4 v[4][4]; float s[4];
#pragma unroll
    for (int rr = 0; rr < 4; ++rr) { const GAS f32x4* xr = (const GAS f32x4*)(xrow + (size_t)rr * D) + lane;
#pragma unroll
        for (int jj = 0; jj < 4; ++jj) v[rr][jj] = xr[64 * jj]; }
#pragma unroll
    for (int rr = 0; rr < 4; ++rr) { float a = 0.f;
#pragma unroll
        for (int jj = 0; jj < 4; ++jj) a += (v[rr][jj].x * v[rr][jj].x + v[rr][jj].y * v[rr][jj].y) + (v[rr][jj].z * v[rr][jj].z + v[rr][jj].w * v[rr][jj].w);
        s[rr] = a; }
#pragma unroll
    for (int o = 1; o < 64; o <<= 1) {
#pragma unroll
        for (int rr = 0; rr < 4; ++rr) s[rr] += __shfl_xor(s[rr], o); }
    f32x4 gg[4];
#pragma unroll
    for (int jj = 0; jj < 4; ++jj) gg[jj] = gr[64 * jj];
#pragma unroll
    for (int rr = 0; rr < 4; ++rr) { const float rstd = 1.f / sqrtf(s[rr] * (1.f / D) + EPS);
        GAS unsigned long long* o8 = (GAS unsigned long long*)(orow + (size_t)rr * D) + lane;
#pragma unroll
        for (int jj = 0; jj < 4; ++jj) o8[64 * jj] = (unsigned long long)pk2(v[rr][jj].x * rstd * gg[jj].x, v[rr][jj].y * rstd * gg[jj].y) | ((unsigned long long)pk2(v[rr][jj].z * rstd * gg[jj].z, v[rr][jj].w * rstd * gg[jj].w) << 32); }
}
template <bool PERM_IN>
__device__ __forceinline__ void p0_transpose_item(const float* W, int K, int N, bf16* WT, LAS float* scr, int item, int lane) {
    const int nblk = N / 32, kb = item / nblk, nb = item % nblk, k0 = 64 * kb, n0 = 32 * nb;
    int ns = n0;
    if (PERM_IN && n0 >= 1024 && n0 < 3072) { const int q = n0 - 1024; ns = (((q >> 7) & 1) ? 2048 : 1024) + 128 * (q >> 8) + (q & 127); }
    float tv[32];
#pragma unroll
    for (int i = 0; i < 32; ++i) tv[i] = W[(size_t)(k0 + 2 * i + (lane >> 5)) * N + ns + (lane & 31)];
#pragma unroll
    for (int i = 0; i < 32; ++i) scr[(2 * i + (lane >> 5)) * 33 + (lane & 31)] = tv[i];
    LDS_WAIT(); asm volatile("" ::: "memory");
    const int c = lane & 7;
#pragma unroll
    for (int j = 0; j < 4; ++j) { const int n = (lane >> 3) + 8 * j; const LAS float* s = scr + (8 * c) * 33 + n;
        v4u o; o.x = pk2(s[0 * 33], s[1 * 33]); o.y = pk2(s[2 * 33], s[3 * 33]); o.z = pk2(s[4 * 33], s[5 * 33]); o.w = pk2(s[6 * 33], s[7 * 33]);
        *(GAS v4u*)(WT + (size_t)(n0 + n) * K + k0 + 8 * c) = o; }
    LDS_WAIT(); asm volatile("" ::: "memory");
}
template <int NS>
__device__ __forceinline__ void fold_tile(LAS float* sm, const float* Ap, int sAi, int sAk, const float* As, const float* Bp, int sBj, bf16* Cp, int ldc, int tid) {
    LAS float* sA = sm; LAS float* sB = sm + 32 * 68;
    float ra[NS][4], rb[NS][4];
#pragma unroll
    for (int sl = 0; sl < NS; ++sl)
#pragma unroll
        for (int r = 0; r < 4; ++r) { const int e = tid + 512 * r; int i, kq;
            if (sAk == 1) { kq = e & 31; i = e >> 5; } else { i = e & 63; kq = e >> 6; }
            float a = Ap[(size_t)i * sAi + (size_t)(sl * 32 + kq) * sAk]; if (As) a *= As[sl * 32 + kq]; ra[sl][r] = a;
            rb[sl][r] = Bp[(size_t)(e >> 5) * sBj + sl * 32 + (e & 31)]; }
    float acc[2][4];
#pragma unroll
    for (int q = 0; q < 2; ++q)
#pragma unroll
        for (int p = 0; p < 4; ++p) acc[q][p] = 0.f;
    const int tj4 = (tid & 15) * 4, ti2 = (tid >> 4) * 2;
#pragma unroll
    for (int sl = 0; sl < NS; ++sl) {
#pragma unroll
        for (int r = 0; r < 4; ++r) { const int e = tid + 512 * r; int i, kq;
            if (sAk == 1) { kq = e & 31; i = e >> 5; } else { i = e & 63; kq = e >> 6; }
            sA[kq * 68 + i] = ra[sl][r]; sB[(e & 31) * 68 + (e >> 5)] = rb[sl][r]; }
        __syncthreads();
#pragma unroll 8
        for (int kk = 0; kk < 32; ++kk) { const f32x4 bq = *(const LAS f32x4*)(sB + kk * 68 + tj4); const float a0 = sA[kk * 68 + ti2], a1 = sA[kk * 68 + ti2 + 1];
            acc[0][0] += a0 * bq.x; acc[0][1] += a0 * bq.y; acc[0][2] += a0 * bq.z; acc[0][3] += a0 * bq.w;
            acc[1][0] += a1 * bq.x; acc[1][1] += a1 * bq.y; acc[1][2] += a1 * bq.z; acc[1][3] += a1 * bq.w; }
        __syncthreads();
    }
#pragma unroll
    for (int q = 0; q < 2; ++q) *(GAS unsigned long long*)(Cp + (size_t)(ti2 + q) * ldc + tj4) = (unsigned long long)pk2(acc[q][0], acc[q][1]) | ((unsigned long long)pk2(acc[q][2], acc[q][3]) << 32);
}
template <int NS, int TJ, bool A_ICONTIG>
__device__ __forceinline__ void fold_wave(LAS float* sm, const float* Ap, int sA, const float* As, const float* Bp, int sBj, bf16* Cp, int ldc, int lane, const float* Cs = nullptr  ) {
    constexpr int NB = TJ / 8, RB = TJ / 8;
    LAS float* sAl = sm; LAS float* sBl = sm + 32 * 36;
    const int l8 = lane >> 3, l7 = lane & 7;
    f32x4 ra[4], rb[RB];
#define FW_LOAD(sl_) do { _Pragma("unroll") for (int r = 0; r < 4; ++r) { \
            if (A_ICONTIG) { const int kq = l8 + 8 * r; f32x4 a = *(const GAS f32x4*)(Ap + (size_t)((sl_) * 32 + kq) * sA + l7 * 4); const float sc = As[(sl_) * 32 + kq]; ra[r] = a * sc; } \
            else ra[r] = *(const GAS f32x4*)(Ap + (size_t)(l8 + 8 * r) * sA + (sl_) * 32 + l7 * 4); } \
        _Pragma("unroll") for (int r = 0; r < RB; ++r) rb[r] = *(const GAS f32x4*)(Bp + (size_t)(l8 + 8 * r) * sBj + (sl_) * 32 + l7 * 4); } while (0)
    FW_LOAD(0);
    float acc[4][NB];
#pragma unroll
    for (int p = 0; p < 4; ++p)
#pragma unroll
        for (int q = 0; q < NB; ++q) acc[p][q] = 0.f;
#pragma unroll
    for (int sl = 0; sl < NS; ++sl) {
#pragma unroll
        for (int r = 0; r < 4; ++r) {
            if (A_ICONTIG) *(LAS f32x4*)(sAl + (l8 + 8 * r) * 36 + l7 * 4) = ra[r];
            else { const int i = l8 + 8 * r, kq = l7 * 4; sAl[kq * 36 + i] = ra[r].x; sAl[(kq + 1) * 36 + i] = ra[r].y; sAl[(kq + 2) * 36 + i] = ra[r].z; sAl[(kq + 3) * 36 + i] = ra[r].w; } }
#pragma unroll
        for (int r = 0; r < RB; ++r) { const int jj = l8 + 8 * r, kq = l7 * 4; sBl[kq * 36 + jj] = rb[r].x; sBl[(kq + 1) * 36 + jj] = rb[r].y; sBl[(kq + 2) * 36 + jj] = rb[r].z; sBl[(kq + 3) * 36 + jj] = rb[r].w; }
        LDS_WAIT(); asm volatile("" ::: "memory");
        if (sl + 1 < NS) FW_LOAD(sl + 1);
#pragma unroll 8
        for (int kk = 0; kk < 32; ++kk) { const f32x4 a4 = *(const LAS f32x4*)(sAl + kk * 36 + 4 * l8);
            float bq[NB];
            if (NB == 4) { const f32x4 b4 = *(const LAS f32x4*)(sBl + kk * 36 + 4 * l7); bq[0] = b4.x; bq[1] = b4.y; bq[2] = b4.z; bq[NB - 1] = b4.w; }
            else { bq[0] = sBl[kk * 36 + 2 * l7]; bq[NB - 1] = sBl[kk * 36 + 2 * l7 + 1]; }
#pragma unroll
            for (int q = 0; q < NB; ++q) { acc[0][q] += a4.x * bq[q]; acc[1][q] += a4.y * bq[q]; acc[2][q] += a4.z * bq[q]; acc[3][q] += a4.w * bq[q]; } }
        LDS_WAIT(); asm volatile("" ::: "memory");
    }
#undef FW_LOAD
    if (Cs) {
#pragma unroll
        for (int q = 0; q < NB; ++q) { const float cs = Cs[NB * l7 + q];
#pragma unroll
            for (int p = 0; p < 4; ++p) acc[p][q] *= cs; } }
#pragma unroll
    for (int p = 0; p < 4; ++p) { bf16* cp = Cp + (size_t)(4 * l8 + p) * ldc + NB * l7;
        if (NB == 4) *(GAS unsigned long long*)cp = (unsigned long long)pk2(acc[p][0], acc[p][1]) | ((unsigned long long)pk2(acc[p][2], acc[p][NB - 1]) << 32);
        else *(GAS unsigned*)cp = pk2(acc[p][0], acc[p][NB - 1]); }
}
__device__ __forceinline__ void rms_row_to_bf16(int lane, const float* xrow, const float* g, bf16* orow) {
    const GAS f32x4* xr = (const GAS f32x4*)xrow + lane; const GAS f32x4* gr = (const GAS f32x4*)g + lane;
    f32x4 v[4]; float s = 0.f;
#pragma unroll
    for (int j = 0; j < 4; ++j) { v[j] = xr[64 * j]; s += (v[j].x * v[j].x + v[j].y * v[j].y) + (v[j].z * v[j].z + v[j].w * v[j].w); }
    const float rstd = 1.f / sqrtf(wave_sum(s) * (1.f / D) + EPS);
    GAS unsigned long long* o8 = (GAS unsigned long long*)orow + lane;
#pragma unroll
    for (int j = 0; j < 4; ++j) { const f32x4 gg = gr[64 * j];
        o8[64 * j] = (unsigned long long)pk2(v[j].x * rstd * gg.x, v[j].y * rstd * gg.y) | ((unsigned long long)pk2(v[j].z * rstd * gg.z, v[j].w * rstd * gg.w) << 32); }
}
__device__ __forceinline__ v4u ldv(const bf16* p) { return *(const GAS v4u*)p; }
template <int WIN> __device__ __forceinline__ void p2_pool(const bf16* pcol  , bf16* ocol  , int t0, bool first) {
    for (int hf = 0; hf < 2; ++hf) {
        const int base = t0 + 8 * hf;
        v4u raw[WIN + 7];
#pragma unroll
        for (int q = 0; q < WIN + 7; ++q) { const int rel = 8 * hf + q - (WIN - 1);
            raw[q] = (rel >= 0 || !first) ? ldv(pcol + (size_t)(base + q - (WIN - 1)) * 3072) : (v4u){0u, 0u, 0u, 0u}; }
        float S[8];
#pragma unroll
        for (int e = 0; e < 8; ++e) S[e] = 0.f;
#pragma unroll
        for (int q = 0; q < WIN - 1; ++q) { float f[8]; unpack8(raw[q], f);
#pragma unroll
            for (int e = 0; e < 8; ++e) S[e] += f[e]; }
#pragma unroll
        for (int r = 0; r < 8; ++r) {
            float pn[8], o[8]; unpack8(raw[r + WIN - 1], pn);
#pragma unroll
            for (int e = 0; e < 8; ++e) S[e] += pn[e];
            const int sr = 8 * hf + r;
            const float inv = (first && sr < WIN - 1) ? 1.0f / (float)(sr + 1) : 1.0f / (float)WIN;
#pragma unroll
            for (int e = 0; e < 8; ++e) o[e] = S[e] * inv - pn[e];
            *(GAS v4u*)(ocol + (size_t)(base + r) * D) = pack8(o);
            float po[8]; unpack8(raw[r], po);
#pragma unroll
            for (int e = 0; e < 8; ++e) S[e] -= po[e];
        }
        asm volatile("" ::: "memory");
    }
}
__device__ __forceinline__ void p2_conv_pool(Frame& F, const bf16* PB, const float* conv_w, bf16* AIN, bf16* POOLED) {
    const int gw = F.vcu * NWAVES + F.wave, NGW = F.G * NWAVES, lane = F.lane;
    for (int it = gw; it < 4 * (T / 32); it += NGW) {
        const int g = it & 3, rc = (it >> 2) * 2 + (lane >> 5), col = g * 256 + (lane & 31) * 8, t0 = rc * 16; const bool first = (t0 & (SEQ - 1)) == 0;
        float w0[8], w1[8], w2[8];
        { const f32x4 a = *(const GAS f32x4*)(conv_w + col), b = *(const GAS f32x4*)(conv_w + col + 4); w0[0] = a.x; w0[1] = a.y; w0[2] = a.z; w0[3] = a.w; w0[4] = b.x; w0[5] = b.y; w0[6] = b.z; w0[7] = b.w; }
        { const f32x4 a = *(const GAS f32x4*)(conv_w + D + col), b = *(const GAS f32x4*)(conv_w + D + col + 4); w1[0] = a.x; w1[1] = a.y; w1[2] = a.z; w1[3] = a.w; w1[4] = b.x; w1[5] = b.y; w1[6] = b.z; w1[7] = b.w; }
        { const f32x4 a = *(const GAS f32x4*)(conv_w + 2 * D + col), b = *(const GAS f32x4*)(conv_w + 2 * D + col + 4); w2[0] = a.x; w2[1] = a.y; w2[2] = a.z; w2[3] = a.w; w2[4] = b.x; w2[5] = b.y; w2[6] = b.z; w2[7] = b.w; }
        float um2[8], um1[8];
        { const v4u u2 = first ? (v4u){0u, 0u, 0u, 0u} : ldv(PB + (size_t)(t0 - 2) * 3072 + 1024 + col), u1 = first ? (v4u){0u, 0u, 0u, 0u} : ldv(PB + (size_t)(t0 - 1) * 3072 + 1024 + col);
          unpack8(u2, um2); unpack8(u1, um1); }
        for (int hf = 0; hf < 2; ++hf) {
            v4u rb[8], ru[8];
#pragma unroll
            for (int r = 0; r < 8; ++r) { const size_t rowb = (size_t)(t0 + 8 * hf + r) * 3072 + col; rb[r] = ldv(PB + rowb); ru[r] = ldv(PB + rowb + 1024); }
#pragma unroll
            for (int r = 0; r < 8; ++r) { float b[8], uu[8], o[8]; unpack8(rb[r], b); unpack8(ru[r], uu);
#pragma unroll
                for (int e = 0; e < 8; ++e) { o[e] = b[e] * (w0[e] * um2[e] + w1[e] * um1[e] + w2[e] * uu[e]); um2[e] = um1[e]; um1[e] = uu[e]; }
                *(GAS v4u*)(AIN + (size_t)(t0 + 8 * hf + r) * D + col) = pack8(o); }
            asm volatile("" ::: "memory");
        }
        asm volatile("" ::: "memory");
        const bf16* pcol = PB + 2048 + col; bf16* ocol = POOLED + col;
        if (g == 0) p2_pool<2>(pcol, ocol, t0, first); else if (g == 1) p2_pool<4>(pcol, ocol, t0, first); else if (g == 2) p2_pool<8>(pcol, ocol, t0, first); else p2_pool<16>(pcol, ocol, t0, first);
    }
}

typedef int v4i __attribute__((ext_vector_type(4)));
__device__ __forceinline__ unsigned fkey(float f) { const unsigned u = __float_as_uint(f); return (u & 0x80000000u) ? ~u : (u | 0x80000000u); }
__device__ __forceinline__ float fkey_inv(unsigned k) { return __uint_as_float((k & 0x80000000u) ? (k & 0x7fffffffu) : ~k); }
__device__ __forceinline__ void ce_desc(unsigned& a, unsigned& b) { const unsigned hi = a > b ? a : b, lo = a > b ? b : a; a = hi; b = lo; }
template <int K, int J> __device__ __forceinline__ void bitonic_stage(unsigned (&a)[16]) {
#pragma unroll
    for (int i = 0; i < 16; ++i) { const int l = i ^ J; if (l > i) { if ((i & K) == 0) ce_desc(a[i], a[l]); else ce_desc(a[l], a[i]); } }
}
__device__ __forceinline__ void bitonic_merge16(unsigned (&a)[16]) { bitonic_stage<16, 8>(a); bitonic_stage<16, 4>(a); bitonic_stage<16, 2>(a); bitonic_stage<16, 1>(a); }
__device__ __forceinline__ void bitonic_sort16(unsigned (&a)[16]) {
    bitonic_stage<2, 1>(a); bitonic_stage<4, 2>(a); bitonic_stage<4, 1>(a); bitonic_stage<8, 4>(a); bitonic_stage<8, 2>(a); bitonic_stage<8, 1>(a); bitonic_merge16(a);
}
__device__ __forceinline__ void top16_merge(unsigned (&top)[16], unsigned (&ch)[16]) {
#pragma unroll
    for (int i = 0; i < 16; ++i) top[i] = top[i] > ch[15 - i] ? top[i] : ch[15 - i];
    bitonic_merge16(top);
}
__device__ __forceinline__ unsigned hkey(unsigned h) { return (h & 0x8000u) ? (~h & 0xffffu) : (h | 0x8000u); }
__device__ __forceinline__ float hkey_inv(unsigned k16) { const unsigned h = (k16 & 0x8000u) ? (k16 & 0x7fffu) : (~k16 & 0xffffu); return (float)__builtin_bit_cast(_Float16, (unsigned short)h); }
__device__ __forceinline__ unsigned pkh2(float a, float b) { return __builtin_bit_cast(unsigned, __builtin_amdgcn_cvt_pkrtz(a, b)); }
__device__ __forceinline__ void p7_topk(Frame& F, const unsigned short* SC, const float* SSQ, int* IDX, float* GATE, int b_lo, int b_hi, int b_step, bool handoff) {
    constexpr int RS = 36;
    LAS unsigned* stg = (LAS unsigned*)(F.lds + RING_OFF + F.wave * P7_WAVE_BYTES + P7_STAGE_OFF);
    const int lane = F.lane, r8 = lane >> 3, c = lane & 7;
    for (int batch = b_lo; batch < b_hi; batch += b_step) {
        const unsigned short* base = SC + (size_t)batch * (8 * NSC);
        unsigned top[16], top1[16];
#pragma unroll
        for (int i = 0; i < 16; ++i) { top[i] = 0u; top1[i] = 0u; }
        v4u ld[8];
#pragma unroll
        for (int q = 0; q < 8; ++q) ld[q] = *(const GAS v4u*)(base + (size_t)(8 * q + r8) * 256 + c * 8);
        for (int ch = 0; ch < 4; ++ch) {
#pragma unroll
            for (int q = 0; q < 8; ++q) *(LAS v4u*)(stg + (8 * q + r8) * RS + c * 4) = ld[q];
            if (ch < 3) {
#pragma unroll
                for (int q = 0; q < 8; ++q) ld[q] = *(const GAS v4u*)(base + (size_t)(8 * q + r8) * 256 + (ch + 1) * 64 + c * 8);
            }
            LDS_WAIT(); asm volatile("" ::: "memory");
#pragma unroll
            for (int hf = 0; hf < 4; ++hf) {
                unsigned k[16];
                const unsigned pb = 127u - (unsigned)((ch & 1) * 64 + hf * 16);
#pragma unroll
                for (int q = 0; q < 2; ++q) { const v4u v = *(const LAS v4u*)(stg + lane * RS + hf * 8 + q * 4);
                    const unsigned w0 = v.x, w1 = v.y, w2 = v.z, w3 = v.w;
                    k[8 * q] = (hkey(w0 & 0xffffu) << 16) | (pb - (unsigned)(8 * q)); k[8 * q + 1] = (hkey(w0 >> 16) << 16) | (pb - (unsigned)(8 * q + 1));
                    k[8 * q + 2] = (hkey(w1 & 0xffffu) << 16) | (pb - (unsigned)(8 * q + 2)); k[8 * q + 3] = (hkey(w1 >> 16) << 16) | (pb - (unsigned)(8 * q + 3));
                    k[8 * q + 4] = (hkey(w2 & 0xffffu) << 16) | (pb - (unsigned)(8 * q + 4)); k[8 * q + 5] = (hkey(w2 >> 16) << 16) | (pb - (unsigned)(8 * q + 5));
                    k[8 * q + 6] = (hkey(w3 & 0xffffu) << 16) | (pb - (unsigned)(8 * q + 6)); k[8 * q + 7] = (hkey(w3 >> 16) << 16) | (pb - (unsigned)(8 * q + 7)); }
                bitonic_sort16(k);
                top16_merge(top, k);
            }
            LDS_WAIT(); asm volatile("" ::: "memory");
            if (ch == 1) {
#pragma unroll
                for (int i = 0; i < 16; ++i) { top1[i] = top[i]; top[i] = 0u; }
            }
        }
        LAS int* tab = (LAS int*)stg + lane * 33;
        float v1[16], v2[16];
#pragma unroll
        for (int i = 0; i < 16; ++i) { tab[i] = 127 - (int)(top1[i] & 0x7fu); tab[16 + i] = 127 - (int)(top[i] & 0x7fu); v1[i] = hkey_inv(top1[i] >> 16); v2[i] = hkey_inv(top[i] >> 16); }
#define P7_KEY(i, j) ((fkey(v1[i] + v2[j]) & ~0xffu) | (unsigned)((i) * 16 + (j)))
        unsigned best[16], cb[16];
#pragma unroll
        for (int jj = 0; jj < 16; ++jj) best[jj] = P7_KEY(0, jj);
#pragma unroll
        for (int jj = 0; jj < 8; ++jj) { cb[jj] = P7_KEY(1, jj); cb[8 + jj] = 0u; }
        top16_merge(best, cb);
        cb[0] = P7_KEY(2, 0); cb[1] = P7_KEY(2, 1); cb[2] = P7_KEY(2, 2); cb[3] = P7_KEY(2, 3); cb[4] = P7_KEY(2, 4); cb[5] = P7_KEY(3, 0); cb[6] = P7_KEY(3, 1); cb[7] = P7_KEY(3, 2);
        cb[8] = P7_KEY(3, 3); cb[9] = P7_KEY(4, 0); cb[10] = P7_KEY(4, 1); cb[11] = P7_KEY(4, 2); cb[12] = 0u; cb[13] = 0u; cb[14] = 0u; cb[15] = 0u;
        bitonic_sort16(cb); top16_merge(best, cb);
        cb[0] = P7_KEY(5, 0); cb[1] = P7_KEY(5, 1); cb[2] = P7_KEY(6, 0); cb[3] = P7_KEY(6, 1); cb[4] = P7_KEY(7, 0); cb[5] = P7_KEY(7, 1); cb[6] = P7_KEY(8, 0); cb[7] = P7_KEY(9, 0);
        cb[8] = P7_KEY(10, 0); cb[9] = P7_KEY(11, 0); cb[10] = P7_KEY(12, 0); cb[11] = P7_KEY(13, 0); cb[12] = P7_KEY(14, 0); cb[13] = P7_KEY(15, 0); cb[14] = 0u; cb[15] = 0u;
        bitonic_sort16(cb); top16_merge(best, cb);
#undef P7_KEY
        LDS_WAIT(); asm volatile("" ::: "memory");
        int eo[16]; float go[16]; float sm = 0.f;
        const float bmax = fkey_inv(best[0] & ~0xffu);
        const f32x4 ssq = *(const GAS f32x4*)(SSQ + (size_t)(batch * 8 + (lane >> 3)) * 4);
        const float rstd = 1.0f / sqrtf(((ssq.x + ssq.y) + (ssq.z + ssq.w)) * (1.0f / D) + EPS);
#pragma unroll
        for (int r = 0; r < 16; ++r) { const int ij = (int)(best[r] & 0xffu); eo[r] = tab[ij >> 4] * 128 + tab[16 + (ij & 15)]; go[r] = __expf((fkey_inv(best[r] & ~0xffu) - bmax) * rstd); sm += go[r]; }
        const float inv = 1.0f / sm;
        if (handoff) {
            LAS unsigned char* reg = F.lds + RING_OFF + (batch - 8 * F.vcu) * P7_WAVE_BYTES;
            LAS int* li = (LAS int*)(reg + P7_IDX_OFF) + lane * 16; LAS unsigned* lg = (LAS unsigned*)(reg + P7_OUT_OFF) + lane * 8;
#pragma unroll
            for (int q = 0; q < 4; ++q) *(LAS v4i*)(li + 4 * q) = (v4i){eo[4 * q], eo[4 * q + 1], eo[4 * q + 2], eo[4 * q + 3]};
#pragma unroll
            for (int q = 0; q < 2; ++q) *(LAS v4u*)(lg + 4 * q) = (v4u){pkh2(go[8 * q] * inv, go[8 * q + 1] * inv), pkh2(go[8 * q + 2] * inv, go[8 * q + 3] * inv), pkh2(go[8 * q + 4] * inv, go[8 * q + 5] * inv), pkh2(go[8 * q + 6] * inv, go[8 * q + 7] * inv)};
        } else {
        int* ip = IDX + (size_t)batch * 1024 + lane * 16; float* gp = GATE + (size_t)batch * 1024 + lane * 16;
#pragma unroll
        for (int q = 0; q < 4; ++q) { *(GAS v4i*)(ip + 4 * q) = (v4i){eo[4 * q], eo[4 * q + 1], eo[4 * q + 2], eo[4 * q + 3]};
            *(GAS f32x4*)(gp + 4 * q) = (f32x4){go[4 * q] * inv, go[4 * q + 1] * inv, go[4 * q + 2] * inv, go[4 * q + 3] * inv}; }
        }
        LDS_WAIT(); asm volatile("" ::: "memory");
    }
}
typedef __bf16 bf16x2_t __attribute__((ext_vector_type(2)));
__device__ __forceinline__ float dpp_f(float v, const int ctrl_sel) {
    const int x = __builtin_bit_cast(int, v);
    int r;
    if (ctrl_sel == 0) r = __builtin_amdgcn_update_dpp(0, x, 0xB1, 0xF, 0xF, true);
    else if (ctrl_sel == 1) r = __builtin_amdgcn_update_dpp(0, x, 0x4E, 0xF, 0xF, true);
    else if (ctrl_sel == 2) r = __builtin_amdgcn_update_dpp(0, x, 0x141, 0xF, 0xF, true);
    else r = __builtin_amdgcn_update_dpp(0, x, 0x128, 0xF, 0xF, true);
    return __builtin_bit_cast(float, r);
}
__device__ __forceinline__ float sum8(float v) { v += dpp_f(v, 0); v += dpp_f(v, 1); v += dpp_f(v, 2); return v; }
__device__ __forceinline__ float dot2bf(unsigned a, unsigned b, float acc) { return __builtin_amdgcn_fdot2_f32_bf16(__builtin_bit_cast(bf16x2_t, a), __builtin_bit_cast(bf16x2_t, b), acc, false); }
__device__ __forceinline__ float dot8(const v4u d, const v4u x, float acc) {
    acc = dot2bf(d.x, x.x, acc); acc = dot2bf(d.y, x.y, acc); acc = dot2bf(d.z, x.z, acc); acc = dot2bf(d.w, x.w, acc);
    return acc;
}
__device__ __forceinline__ float gelu_erf(float v) {
    const float t = __builtin_amdgcn_rcpf(fabsf(v) * 0.2316418882f + 1.0f);
    float q = t * 0.5307027145f + (-0.7265760135f); q = q * t + 0.7107068705f; q = q * t + (-0.142248368f); q = q * t + 0.127414796f; q = q * t;
    const float m = v * (q * __builtin_amdgcn_exp2f((v * v) * (-0.72134752044f)));
    return v < 0.f ? m : v - m;
}
__device__ __forceinline__ void p8_issue(v4u (&d)[8], const LAS int* li8, __amdgpu_buffer_rsrc_t rs, int soff, int c16) {
    const v4i e0 = *(const LAS v4i*)li8, e1 = *(const LAS v4i*)(li8 + 4);
    d[0] = __builtin_amdgcn_raw_buffer_load_b128(rs, e0.x * 128 + c16, soff, 0); d[1] = __builtin_amdgcn_raw_buffer_load_b128(rs, e0.y * 128 + c16, soff, 0);
    d[2] = __builtin_amdgcn_raw_buffer_load_b128(rs, e0.z * 128 + c16, soff, 0); d[3] = __builtin_amdgcn_raw_buffer_load_b128(rs, e0.w * 128 + c16, soff, 0);
    d[4] = __builtin_amdgcn_raw_buffer_load_b128(rs, e1.x * 128 + c16, soff, 0); d[5] = __builtin_amdgcn_raw_buffer_load_b128(rs, e1.y * 128 + c16, soff, 0);
    d[6] = __builtin_amdgcn_raw_buffer_load_b128(rs, e1.z * 128 + c16, soff, 0); d[7] = __builtin_amdgcn_raw_buffer_load_b128(rs, e1.w * 128 + c16, soff, 0);
}
typedef float f32x2 __attribute__((ext_vector_type(2)));
__device__ __forceinline__ f32x2 fp8lo(unsigned w) { return __builtin_amdgcn_cvt_pk_f32_fp8((int)w, false); }
__device__ __forceinline__ f32x2 fp8hi(unsigned w) { return __builtin_amdgcn_cvt_pk_f32_fp8((int)w, true); }
__device__ __forceinline__ float dot16q(const v4u d, const f32x2 (&xx)[8]) {
    f32x2 acc = fp8lo(d.x) * xx[0];
    acc += fp8hi(d.x) * xx[1]; acc += fp8lo(d.y) * xx[2]; acc += fp8hi(d.y) * xx[3]; acc += fp8lo(d.z) * xx[4]; acc += fp8hi(d.z) * xx[5]; acc += fp8lo(d.w) * xx[6]; acc += fp8hi(d.w) * xx[7];
    return acc.x + acc.y;
}
__device__ __forceinline__ void p8_compute_u(const v4u (&d)[8], const f32x2 (&xx)[8], LAS float* lz8, int c) {
    float p[8];
#pragma unroll
    for (int g = 0; g < 8; ++g) p[g] = sum8(dot16q(d[g], xx));
    if (c == 0) {
#pragma unroll
        for (int q = 0; q < 2; ++q) { f32x4 z = *(LAS f32x4*)(lz8 + 4 * q); z.x += p[4 * q]; z.y += p[4 * q + 1]; z.z += p[4 * q + 2]; z.w += p[4 * q + 3]; *(LAS f32x4*)(lz8 + 4 * q) = z; }
    }
}
__device__ __forceinline__ void p8_compute_v(const v4u (&d)[8], const LAS float* la8, f32x2 (&y)[8]) {
    const f32x4 a0 = *(const LAS f32x4*)la8, a1 = *(const LAS f32x4*)(la8 + 4);
    const float a[8] = {a0.x, a0.y, a0.z, a0.w, a1.x, a1.y, a1.z, a1.w};
#pragma unroll
    for (int g = 0; g < 8; ++g) { const f32x2 ag = {a[g], a[g]};
        y[0] += ag * fp8lo(d[g].x); y[1] += ag * fp8hi(d[g].x); y[2] += ag * fp8lo(d[g].y); y[3] += ag * fp8hi(d[g].y);
        y[4] += ag * fp8lo(d[g].z); y[5] += ag * fp8hi(d[g].z); y[6] += ag * fp8lo(d[g].w); y[7] += ag * fp8hi(d[g].w); }
}
__device__ __forceinline__ void p8_unpack_x(f32x2 (&xx)[8], const v4u a, const v4u b) {
    xx[0] = (f32x2){bflo(a.x), bfhi(a.x)}; xx[1] = (f32x2){bflo(a.y), bfhi(a.y)}; xx[2] = (f32x2){bflo(a.z), bfhi(a.z)}; xx[3] = (f32x2){bflo(a.w), bfhi(a.w)};
    xx[4] = (f32x2){bflo(b.x), bfhi(b.x)}; xx[5] = (f32x2){bflo(b.y), bfhi(b.y)}; xx[6] = (f32x2){bflo(b.z), bfhi(b.z)}; xx[7] = (f32x2){bflo(b.w), bfhi(b.w)};
}
typedef unsigned u32x2s __attribute__((ext_vector_type(2)));
__device__ __forceinline__ float u2f(unsigned u) { return __builtin_bit_cast(float, u); }
__device__ __forceinline__ float swap32_add(float a, float b) { const u32x2s r = __builtin_amdgcn_permlane32_swap(__builtin_bit_cast(unsigned, a), __builtin_bit_cast(unsigned, b), false, false); return u2f(r.x) + u2f(r.y); }
__device__ __forceinline__ float swap16_add(float a, float b) { const u32x2s r = __builtin_amdgcn_permlane16_swap(__builtin_bit_cast(unsigned, a), __builtin_bit_cast(unsigned, b), false, false); return u2f(r.x) + u2f(r.y); }
__device__ __forceinline__ void p8_reduce_heads(const f32x2 (&y)[8], int j, float& r0, float& r1) {
    float v[8], w[4];
#pragma unroll
    for (int q = 0; q < 4; ++q) { v[2 * q] = swap32_add(y[q].x, y[4 + q].x); v[2 * q + 1] = swap32_add(y[q].y, y[4 + q].y); }
#pragma unroll
    for (int q = 0; q < 4; ++q) w[q] = swap16_add(v[q], v[4 + q]);
    const bool odd = (j & 1) != 0;
    const float s0 = odd ? w[0] : w[2], s1 = odd ? w[1] : w[3], k0 = odd ? w[2] : w[0], k1 = odd ? w[3] : w[1];
    r0 = k0 + dpp_f(s0, 3); r1 = k1 + dpp_f(s1, 3);
}
typedef _Float16 h16x2 __attribute__((ext_vector_type(2)));
__device__ __forceinline__ h16x2 q2h_lo(unsigned w) { return __builtin_amdgcn_cvt_scalef32_pk_f16_fp8(w, 1.0f, false); }
__device__ __forceinline__ h16x2 q2h_hi(unsigned w) { return __builtin_amdgcn_cvt_scalef32_pk_f16_fp8(w, 1.0f, true); }
__device__ __forceinline__ h16x2 f2h(float a, float b) { h16x2 r; r.x = (_Float16)a; r.y = (_Float16)b; return r; }
__device__ __forceinline__ float dot16h(const v4u d, const h16x2 (&xh)[8]) {
    float acc = 0.f;
    acc = __builtin_amdgcn_fdot2(q2h_lo(d.x), xh[0], acc, false); acc = __builtin_amdgcn_fdot2(q2h_hi(d.x), xh[1], acc, false);
    acc = __builtin_amdgcn_fdot2(q2h_lo(d.y), xh[2], acc, false); acc = __builtin_amdgcn_fdot2(q2h_hi(d.y), xh[3], acc, false);
    acc = __builtin_amdgcn_fdot2(q2h_lo(d.z), xh[4], acc, false); acc = __builtin_amdgcn_fdot2(q2h_hi(d.z), xh[5], acc, false);
    acc = __builtin_amdgcn_fdot2(q2h_lo(d.w), xh[6], acc, false); acc = __builtin_amdgcn_fdot2(q2h_hi(d.w), xh[7], acc, false);
    return acc;
}
__device__ __forceinline__ void p8h_compute_u(const v4u (&d)[8], const h16x2 (&xh)[8], LAS float* lz8, int c) {
    float p[8];
#pragma unroll
    for (int g = 0; g < 8; ++g) p[g] = sum8(dot16h(d[g], xh));
    if (c == 0) {
#pragma unroll
        for (int q = 0; q < 2; ++q) { f32x4 z = *(LAS f32x4*)(lz8 + 4 * q); z.x += p[4 * q]; z.y += p[4 * q + 1]; z.z += p[4 * q + 2]; z.w += p[4 * q + 3]; *(LAS f32x4*)(lz8 + 4 * q) = z; }
    }
}
__device__ __forceinline__ void p8h_unpack_x(h16x2 (&xh)[8], const v4u a, const v4u b) {
    xh[0] = f2h(bflo(a.x), bfhi(a.x)); xh[1] = f2h(bflo(a.y), bfhi(a.y)); xh[2] = f2h(bflo(a.z), bfhi(a.z)); xh[3] = f2h(bflo(a.w), bfhi(a.w));
    xh[4] = f2h(bflo(b.x), bfhi(b.x)); xh[5] = f2h(bflo(b.y), bfhi(b.y)); xh[6] = f2h(bflo(b.z), bfhi(b.z)); xh[7] = f2h(bflo(b.w), bfhi(b.w));
}
__device__ __forceinline__ void p8h_compute_v(const v4u (&d)[8], const LAS float* la8, h16x2 (&y)[8]) {
    const f32x4 a0 = *(const LAS f32x4*)la8, a1 = *(const LAS f32x4*)(la8 + 4);
    const float a[8] = {a0.x, a0.y, a0.z, a0.w, a1.x, a1.y, a1.z, a1.w};
#pragma unroll
    for (int g = 0; g < 8; ++g) { const _Float16 ah = (_Float16)a[g]; const h16x2 ag = {ah, ah};
        y[0] += ag * q2h_lo(d[g].x); y[1] += ag * q2h_hi(d[g].x); y[2] += ag * q2h_lo(d[g].y); y[3] += ag * q2h_hi(d[g].y);
        y[4] += ag * q2h_lo(d[g].z); y[5] += ag * q2h_hi(d[g].z); y[6] += ag * q2h_lo(d[g].w); y[7] += ag * q2h_hi(d[g].w); }
}
__device__ __forceinline__ long pk64(unsigned lo, unsigned hi) { return (long)(((unsigned long long)hi << 32) | lo); }
__device__ __forceinline__ void p8m_issue(v4u (&d)[8], const LAS int* lig, __amdgpu_buffer_rsrc_t rs, int soff, int q16) {
    const int e0 = lig[0], e1 = lig[16], e2 = lig[32], e3 = lig[48];
    d[0] = __builtin_amdgcn_raw_buffer_load_b128(rs, e0 * D + q16, soff, 0); d[1] = __builtin_amdgcn_raw_buffer_load_b128(rs, e0 * D + q16 + 64, soff, 0);
    d[2] = __builtin_amdgcn_raw_buffer_load_b128(rs, e1 * D + q16, soff, 0); d[3] = __builtin_amdgcn_raw_buffer_load_b128(rs, e1 * D + q16 + 64, soff, 0);
    d[4] = __builtin_amdgcn_raw_buffer_load_b128(rs, e2 * D + q16, soff, 0); d[5] = __builtin_amdgcn_raw_buffer_load_b128(rs, e2 * D + q16 + 64, soff, 0);
    d[6] = __builtin_amdgcn_raw_buffer_load_b128(rs, e3 * D + q16, soff, 0); d[7] = __builtin_amdgcn_raw_buffer_load_b128(rs, e3 * D + q16 + 64, soff, 0);
}
__device__ __forceinline__ float p8m_dot(const v4u xa, const v4u xb, const v4u d0, const v4u d1) {
    f32x4 acc = {0.f, 0.f, 0.f, 0.f};
    acc = __builtin_amdgcn_mfma_f32_16x16x32_fp8_fp8(pk64(xa.x, xa.y), pk64(d0.x, d0.y), acc, 0, 0, 0);
    acc = __builtin_amdgcn_mfma_f32_16x16x32_fp8_fp8(pk64(xa.z, xa.w), pk64(d0.z, d0.w), acc, 0, 0, 0);
    acc = __builtin_amdgcn_mfma_f32_16x16x32_fp8_fp8(pk64(xb.x, xb.y), pk64(d1.x, d1.y), acc, 0, 0, 0);
    acc = __builtin_amdgcn_mfma_f32_16x16x32_fp8_fp8(pk64(xb.z, xb.w), pk64(d1.z, d1.w), acc, 0, 0, 0);
    return acc[0];
}
__device__ __forceinline__ void p8m_compute_u(const v4u (&d)[8], const v4u xa, const v4u xb, LAS float* lzq, int q) {
    const float z0 = p8m_dot(xa, xb, d[0], d[1]), z1 = p8m_dot(xa, xb, d[2], d[3]), z2 = p8m_dot(xa, xb, d[4], d[5]), z3 = p8m_dot(xa, xb, d[6], d[7]);
    const float z = (q == 0) ? z0 : (q == 1) ? z1 : (q == 2) ? z2 : z3;
    *lzq += z;
}
__device__ __forceinline__ void p8s_compute_u(const v4u (&d)[8], const v4u xa, const v4u xb, LAS unsigned char* stage, LAS float* lz  , int lane, const float sxq  ) {
    const int j8 = lane >> 3, c = lane & 7, n = lane & 15, q = lane >> 4;
#pragma unroll
    for (int r = 0; r < 8; ++r) { const int row = j8 * 8 + r; *(LAS v4u*)(stage + row * 128 + ((c ^ (row >> 1)) & 7) * 16) = d[r]; }
    LDS_WAIT(); asm volatile("" ::: "memory");
    float z[4];
#pragma unroll
    for (int t = 0; t < 4; ++t) { const int row = 16 * t + n, sw = (row >> 1) & 7;
        const v4u d0 = *(const LAS v4u*)(stage + row * 128 + ((q ^ sw) & 7) * 16), d1 = *(const LAS v4u*)(stage + row * 128 + (((q + 4) ^ sw) & 7) * 16);
        z[t] = p8m_dot(xa, xb, d0, d1); }
    asm volatile("" ::: "memory");
    const float zq = (q == 0) ? z[0] : (q == 1) ? z[1] : (q == 2) ? z[2] : z[3];
    LAS float* p = lz + (2 * q + (n >> 3)) * 16 + (n & 7);
    *p += zq * sxq;
}
__device__ __forceinline__ void p8_peer(Frame& F, const unsigned char* X8, const float* SSQ, const float* SXQ, const unsigned char* U8, const unsigned char* V8, const float* SU, const float* SV, const int* IDX, const float* GATE, const bf16* H16, float* YOUT, bf16* OUT, const float* gfin, bool handoff) {
    LAS unsigned char* lstage = F.lds + RING_OFF + F.wave * P7_WAVE_BYTES + P7_STAGE_OFF;
    LAS int* lidx = (LAS int*)(F.lds + RING_OFF + F.wave * P7_WAVE_BYTES + P7_IDX_OFF);
    LAS float* lza = (LAS float*)(F.lds + RING_OFF + F.wave * P7_WAVE_BYTES + P7_ZA_OFF);
    LAS unsigned* lout = (LAS unsigned*)(F.lds + RING_OFF + F.wave * P7_WAVE_BYTES + P7_OUT_OFF);
    const int gw = F.vcu * NWAVES + F.wave, NGW = F.G * NWAVES, lane = F.lane, j = lane >> 3, c = lane & 7, c16 = c * 16;
    const __amdgpu_buffer_rsrc_t rsU = __builtin_amdgcn_make_buffer_rsrc((void*)U8, (short)0, NEXP * D, 0x00020000);
    const __amdgpu_buffer_rsrc_t rsV = __builtin_amdgcn_make_buffer_rsrc((void*)V8, (short)0, NEXP * D, 0x00020000);
    const int pfrank = ((int)blockIdx.x >> 3) * NWAVES + F.wave; const int pfoff = (pfrank < 256) ? pfrank * 8192 + lane * 128 : 0; unsigned pf = 0u;
    for (int grp = gw; grp < T / 8; grp += NGW) {
        const int tb = grp * 8;
        for (int prep = 0; prep < REPS(13); ++prep) {
        LAS float* lsx = (LAS float*)(F.lds + P7_AUX_OFF + F.wave * 256); LAS float* lrs = lsx + 32;
        if (lane < 32) lsx[lane] = SXQ[(size_t)tb * 4 + lane];
        if (lane < 8) { const f32x4 q4 = *(const GAS f32x4*)(SSQ + (size_t)(tb + lane) * 4); lrs[lane] = 1.0f / sqrtf(((q4.x + q4.y) + (q4.z + q4.w)) * (1.0f / D) + EPS); }
        LAS _Float16* lgate = (LAS _Float16*)lout;
        if (!handoff) {
#pragma unroll
            for (int i = 0; i < 8; ++i) { lidx[i * 128 + lane] = IDX[(size_t)(tb + i) * NSEL + lane]; lidx[i * 128 + 64 + lane] = IDX[(size_t)(tb + i) * NSEL + 64 + lane];
                lgate[i * 128 + lane] = (_Float16)GATE[(size_t)(tb + i) * NSEL + lane]; lgate[i * 128 + 64 + lane] = (_Float16)GATE[(size_t)(tb + i) * NSEL + 64 + lane]; }
        }
#pragma unroll
        for (int i = 0; i < 8; ++i) { lza[i * 128 + lane] = 0.f; lza[i * 128 + 64 + lane] = 0.f; }
        LDS_WAIT(); asm volatile("" ::: "memory");
        for (int urep = 0; urep < REPS(8); ++urep) {
            if (urep) {
#pragma unroll
                for (int i = 0; i < 8; ++i) { lza[i * 128 + lane] = 0.f; lza[i * 128 + 64 + lane] = 0.f; }
                LDS_WAIT(); asm volatile("" ::: "memory"); }
            v4u b0[8], b1[8], b2[8], b3[8], xa0, xb0, xa1, xb1, xa2, xb2, xa3, xb3;
            const unsigned char* xbase = X8 + (size_t)tb * D + (lane >> 4) * 16;
            xa0 = *(const GAS v4u*)xbase; xb0 = *(const GAS v4u*)(xbase + 64); xa1 = *(const GAS v4u*)(xbase + D); xb1 = *(const GAS v4u*)(xbase + D + 64);
            p8_issue(b0, lidx + j * 16, rsU, 0, c16); p8_issue(b1, lidx + j * 16 + 8, rsU, 0, c16); p8_issue(b2, lidx + 128 + j * 16, rsU, 0, c16); p8_issue(b3, lidx + 128 + j * 16 + 8, rsU, 0, c16);
            for (int n = 0; n < 64; n += 2) {
                const int i = n & 7, n2 = (n + 2) & 63, s2 = n2 >> 3, i2 = n2 & 7;
                { const unsigned char* xp = xbase + (size_t)i2 * D + s2 * 128; xa2 = *(const GAS v4u*)xp; xb2 = *(const GAS v4u*)(xp + 64); xa3 = *(const GAS v4u*)(xp + D); xb3 = *(const GAS v4u*)(xp + D + 64); }
                if ((n & 7) == 6) {
                    asm volatile("" :: "v"(pf));
                    pf = (s2 != 0) ? __builtin_amdgcn_raw_buffer_load_b32(rsU, pfoff, s2 * (NEXP * 128), 0) : __builtin_amdgcn_raw_buffer_load_b32(rsV, pfoff, 0, 0); }
                const float sxa = lsx[i * 4 + (n >> 4)], sxb = lsx[(i + 1) * 4 + (n >> 4)];
                p8s_compute_u(b0, xa0, xb0, lstage, lza + i * 128, lane, sxa);           p8_issue(b0, lidx + i2 * 128 + j * 16, rsU, s2 * (NEXP * 128), c16);
                p8s_compute_u(b1, xa0, xb0, lstage, lza + i * 128 + 8, lane, sxa);       p8_issue(b1, lidx + i2 * 128 + j * 16 + 8, rsU, s2 * (NEXP * 128), c16);
                p8s_compute_u(b2, xa1, xb1, lstage, lza + (i + 1) * 128, lane, sxb);     p8_issue(b2, lidx + (i2 + 1) * 128 + j * 16, rsU, s2 * (NEXP * 128), c16);
                p8s_compute_u(b3, xa1, xb1, lstage, lza + (i + 1) * 128 + 8, lane, sxb); p8_issue(b3, lidx + (i2 + 1) * 128 + j * 16 + 8, rsU, s2 * (NEXP * 128), c16);
                xa0 = xa2; xb0 = xb2; xa1 = xa3; xb1 = xb3;
            }
        }
        LDS_WAIT(); asm volatile("" ::: "memory");
#pragma unroll
        for (int i = 0; i < 8; ++i) {
            const int e0 = lidx[i * 128 + lane], e1 = lidx[i * 128 + 64 + lane];
            const float sx = lrs[i];
            const float z0 = lza[i * 128 + lane] * SU[e0] * sx, z1 = lza[i * 128 + 64 + lane] * SU[e1] * sx;
            const float g0 = (float)lgate[i * 128 + lane] * SV[e0], g1 = (float)lgate[i * 128 + 64 + lane] * SV[e1];
            lza[i * 128 + lane] = gelu_erf(z0) * g0 * 1024.0f; lza[i * 128 + 64 + lane] = gelu_erf(z1) * g1 * 1024.0f;
        }
        LDS_WAIT(); asm volatile("" ::: "memory");
        for (int vrep = 0; vrep < REPS(9); ++vrep) {
            v4u b0[8], b1[8], b2[8], b3[8];
            LAS unsigned* lkeep = (LAS unsigned*)lstage;
            p8_issue(b0, lidx + j * 16, rsV, 0, c16); p8_issue(b1, lidx + j * 16 + 8, rsV, 0, c16); p8_issue(b2, lidx + 128 + j * 16, rsV, 0, c16); p8_issue(b3, lidx + 128 + j * 16 + 8, rsV, 0, c16);
            for (int n = 0; n < 64; n += 2) {
                const int s = n >> 3, i = n & 7, n2 = (n + 2) & 63, s2 = n2 >> 3, i2 = n2 & 7;
                if ((n & 7) == 6 && s2 != 0) { asm volatile("" :: "v"(pf)); pf = __builtin_amdgcn_raw_buffer_load_b32(rsV, pfoff, s2 * (NEXP * 128), 0); }
                LAS unsigned* lo = ((s < 4) ? lkeep + s * 512 : lout) + c * 8 + j;
                h16x2 yh[8]; f32x2 y[8]; float r0, r1;
#pragma unroll
                for (int q = 0; q < 8; ++q) yh[q] = (h16x2){(_Float16)0.f, (_Float16)0.f};
                p8h_compute_v(b0, lza + i * 128 + j * 16, yh);           p8_issue(b0, lidx + i2 * 128 + j * 16, rsV, s2 * (NEXP * 128), c16);
                p8h_compute_v(b1, lza + i * 128 + j * 16 + 8, yh);       p8_issue(b1, lidx + i2 * 128 + j * 16 + 8, rsV, s2 * (NEXP * 128), c16);
#pragma unroll
                for (int q = 0; q < 8; ++q) y[q] = (f32x2){(float)yh[q].x * (1.0f / 1024.0f), (float)yh[q].y * (1.0f / 1024.0f)};
                p8_reduce_heads(y, j, r0, r1);
                lo[i * 64] = pk2(r0, r1);
#pragma unroll
                for (int q = 0; q < 8; ++q) yh[q] = (h16x2){(_Float16)0.f, (_Float16)0.f};
                p8h_compute_v(b2, lza + (i + 1) * 128 + j * 16, yh);     p8_issue(b2, lidx + (i2 + 1) * 128 + j * 16, rsV, s2 * (NEXP * 128), c16);
                p8h_compute_v(b3, lza + (i + 1) * 128 + j * 16 + 8, yh); p8_issue(b3, lidx + (i2 + 1) * 128 + j * 16 + 8, rsV, s2 * (NEXP * 128), c16);
#pragma unroll
                for (int q = 0; q < 8; ++q) y[q] = (f32x2){(float)yh[q].x * (1.0f / 1024.0f), (float)yh[q].y * (1.0f / 1024.0f)};
                p8_reduce_heads(y, j, r0, r1);
                lo[(i + 1) * 64] = pk2(r0, r1);
                if (i == 6 && s >= 4) {
                    LDS_WAIT(); asm volatile("" ::: "memory");
                    const v4u w0 = *(const LAS v4u*)(lout + (lane >> 4) * 64 + (lane & 15) * 4), w1 = *(const LAS v4u*)(lout + (4 + (lane >> 4)) * 64 + (lane & 15) * 4);
                    bf16* op = OUT + (size_t)(tb + (lane >> 4)) * D + s * 128 + (lane & 15) * 8;
                    *(GAS v4u*)op = w0; *(GAS v4u*)(op + 4 * D) = w1;
                }
            }
        }
        }
        asm volatile("" :: "v"(pf));
        VM_WAIT(); __builtin_amdgcn_fence(__ATOMIC_ACQUIRE, "agent"); VM_WAIT(); LDS_WAIT(); asm volatile("" ::: "memory");
        for (int frep = 0; frep < REPS(14); ++frep)
        for (int i0 = 0; i0 < 8; i0 += 4) {
            u32x2s hv[4][4], ov[4][4]; float ss[4];
#pragma unroll
            for (int rr = 0; rr < 4; ++rr) { const bf16* hrow = H16 + (size_t)(tb + i0 + rr) * D + 4 * lane; const bf16* orow = OUT + (size_t)(tb + i0 + rr) * D + 4 * lane;
                const LAS unsigned* krow = (const LAS unsigned*)lstage + (lane >> 5) * 512 + (i0 + rr) * 64 + ((2 * lane) & 63);
#pragma unroll
                for (int q = 0; q < 4; ++q) { hv[rr][q] = *(const GAS u32x2s*)(hrow + 256 * q);
                    if (q < 2) ov[rr][q] = *(const LAS u32x2s*)(krow + q * 1024); else ov[rr][q] = *(const GAS u32x2s*)(orow + 256 * q); } }
            f32x4 gg[4];
#pragma unroll
            for (int q = 0; q < 4; ++q) gg[q] = *(const GAS f32x4*)(gfin + 256 * q + 4 * lane);
            f32x4 yv[4][4];
#pragma unroll
            for (int rr = 0; rr < 4; ++rr) { float a = 0.f;
#pragma unroll
                for (int q = 0; q < 4; ++q) { const unsigned h0 = hv[rr][q].x, h1 = hv[rr][q].y, o0 = ov[rr][q].x, o1 = ov[rr][q].y;
                    yv[rr][q] = (f32x4){bflo(h0) + bflo(o0), bfhi(h0) + bfhi(o0), bflo(h1) + bflo(o1), bfhi(h1) + bfhi(o1)};
                    a += (yv[rr][q].x * yv[rr][q].x + yv[rr][q].y * yv[rr][q].y) + (yv[rr][q].z * yv[rr][q].z + yv[rr][q].w * yv[rr][q].w); }
                ss[rr] = a; }
#pragma unroll
            for (int o = 1; o < 64; o <<= 1) {
#pragma unroll
                for (int rr = 0; rr < 4; ++rr) ss[rr] += __shfl_xor(ss[rr], o); }
#pragma unroll
            for (int rr = 0; rr < 4; ++rr) { const float rstd = 1.f / sqrtf(ss[rr] * (1.f / D) + EPS); float* yr = YOUT + (size_t)(tb + i0 + rr) * D + 4 * lane;
#pragma unroll
                for (int q = 0; q < 4; ++q) *(GAS f32x4*)(yr + 256 * q) = (f32x4){yv[rr][q].x * rstd * gg[q].x, yv[rr][q].y * rstd * gg[q].y, yv[rr][q].z * rstd * gg[q].z, yv[rr][q].w * rstd * gg[q].w}; }
        }
    }
}
template <bool GAIN>
__device__ __forceinline__ void cvt_fp8_rows(Frame& F, const float* src, unsigned char* dst, float* scale, int gw, int NGW, const float* gain) {
    const int lane = F.lane;
    f32x4 gq[4];
    if (GAIN) {
#pragma unroll
        for (int q = 0; q < 4; ++q) gq[q] = ((const GAS f32x4*)gain)[4 * lane + q]; }
    for (int r0 = gw * 4; r0 < NEXP; r0 += NGW * 4) {
        f32x4 v[4][4];
#pragma unroll
        for (int rr = 0; rr < 4; ++rr) { const GAS f32x4* sp = (const GAS f32x4*)(src + (size_t)(r0 + rr) * D) + 4 * lane;
#pragma unroll
            for (int q = 0; q < 4; ++q) v[rr][q] = sp[q]; }
        if (GAIN) {
#pragma unroll
            for (int rr = 0; rr < 4; ++rr)
#pragma unroll
                for (int q = 0; q < 4; ++q) v[rr][q] = v[rr][q] * gq[q]; }
        float m[4];
#pragma unroll
        for (int rr = 0; rr < 4; ++rr) { float mm = 0.f;
#pragma unroll
            for (int q = 0; q < 4; ++q) mm = fmaxf(mm, fmaxf(fmaxf(fabsf(v[rr][q].x), fabsf(v[rr][q].y)), fmaxf(fabsf(v[rr][q].z), fabsf(v[rr][q].w))));
            m[rr] = mm; }
#pragma unroll
        for (int o = 1; o < 64; o <<= 1) {
#pragma unroll
            for (int rr = 0; rr < 4; ++rr) m[rr] = fmaxf(m[rr], __shfl_xor(m[rr], o)); }
#pragma unroll
        for (int rr = 0; rr < 4; ++rr) {
            const float sc = (m[rr] > 0.f) ? m[rr] * (1.0f / 448.0f) : 1.0f, inv = 1.0f / sc;
            unsigned o[4];
#pragma unroll
            for (int q = 0; q < 4; ++q) o[q] = (unsigned)__builtin_amdgcn_cvt_pk_fp8_f32(v[rr][q].z * inv, v[rr][q].w * inv, __builtin_amdgcn_cvt_pk_fp8_f32(v[rr][q].x * inv, v[rr][q].y * inv, 0, false), true);
            *(GAS v4u*)(dst + (size_t)(lane >> 3) * (NEXP * 128) + (size_t)(r0 + rr) * 128 + 16 * (lane & 7)) = (v4u){o[0], o[1], o[2], o[3]};
            if (lane == 0) scale[r0 + rr] = sc;
        }
    }
}
struct Args { const float* in[15]; float* out; unsigned char* ws; int ph_lo, ph_hi; };
__global__ void __launch_bounds__(NWAVES * 64, 2) hyb_fwd(Args args) {
    extern __shared__ __attribute__((aligned(16))) unsigned char lds[];
    Frame F;
    F.lds = (LAS unsigned char*)lds;
    F.MISC = (volatile LAS unsigned*)(F.lds + MISC_OFF);
    F.tid = threadIdx.x; F.lane = F.tid & 63; F.wave = __builtin_amdgcn_readfirstlane(F.tid >> 6);
    F.G = gridDim.x; { const int bx = blockIdx.x; F.vcu = (F.G % 8 == 0) ? (bx % 8) * (F.G / 8) + bx / 8 : bx; }
    unsigned char* ws = args.ws;
    gu32* ctl = (gu32*)(ws + WS_CTL);
    const float* x = args.in[0]; const float* g_mix = args.in[1]; const float* w_in = args.in[2]; const float* conv_w = args.in[3]; const float* w_conv_out = args.in[4];
    const float* pool_w = args.in[5]; const float* pool_scale = args.in[6]; const float* w_pool_out = args.in[7]; const float* w_out = args.in[8]; const float* g_ffn = args.in[9];
    const float* w_query = args.in[10]; const float* sub_keys = args.in[11]; const float* expert_u = args.in[12]; const float* expert_v = args.in[13]; const float* g_fin = args.in[14];
    bf16* WIN = (bf16*)(ws + WS_WIN); bf16* WC = (bf16*)(ws + WS_WC); bf16* WPB = (bf16*)(ws + WS_WPB); bf16* WOUT = (bf16*)(ws + WS_WOUT); bf16* WSC = (bf16*)(ws + WS_WS);
    bf16* XN = (bf16*)(ws + WS_XN); bf16* PB = (bf16*)(ws + WS_PB); bf16* PG = (bf16*)(ws + WS_PG); bf16* TMP = (bf16*)(ws + WS_TMP); bf16* MG = (bf16*)(ws + WS_MG);
    float* SC = (float*)(ws + WS_SC); int* IDX = (int*)(ws + WS_IDX); float* GATE = (float*)(ws + WS_GATE); unsigned char* U8 = ws + WS_U8; unsigned char* V8 = ws + WS_V8; float* SU = (float*)(ws + WS_SU); float* SV = (float*)(ws + WS_SV); bf16* H16 = (bf16*)(ws + WS_H16); unsigned char* X8 = ws + WS_X8; float* SX = (float*)(ws + WS_SX);
    float* SSQ = (float*)(ws + WS_XBUF); float* SXQ = (float*)(ws + WS_XBUF + 256 * 1024);
    bf16* AIN = (bf16*)args.out; bf16* POOLED = (bf16*)args.out + (size_t)T * D; float* H = args.out;

    for (int u = F.tid; u < (LDS_BYTES - LDSCTL_OFF) / 4; u += NWAVES * 64) ((LAS unsigned*)(F.lds + LDSCTL_OFF))[u] = 0u;
    __syncthreads();
    XcdBarrier bar; bar.bar = (unsigned*)(ctl + CW_BAR); bar.x = 0; bar.st = nullptr;
    if (N_LAUNCHES == 1) bar = xcd_barrier_post((unsigned*)(ctl + CW_BAR), F.MISC + 8);
#define GRID_BAR() do { if (N_LAUNCHES == 1) xcd_barrier(bar); } while (0)
    const int lo = args.ph_lo, hi = args.ph_hi;
#define IN(k) (lo <= (k) && (k) < hi)
#define BOTH(k) (IN(k) && IN((k) + 1))
    const int gw = F.vcu * NWAVES + F.wave, NGW = F.G * NWAVES;

    if (IN(0)) { DELAY_T0(0); for (int rep = 0; rep < REPS(0); ++rep) {
        LAS float* scr = (LAS float*)(F.lds + RING_OFF + F.wave * 16384);
        constexpr int I_IN = (D / 64) * (NIN / 32), I_SQ = (D / 64) * (D / 32);
#pragma unroll 1
        for (int stage = 0; stage < 2; ++stage) {
            if ((stage == 0) == ((F.wave & 1) == 0)) {
                for (int it = gw; it < 2048; it += NGW) {
                    { const int hp = it >> 7, i0 = ((it >> 5) & 3) * 32, j0 = (it & 31) * 32;
                      fold_wave<4, 32, false>(scr, sub_keys + (size_t)hp * 16384 + (size_t)i0 * 128, 128, nullptr, w_query + (size_t)j0 * NSC + hp * 128, NSC, WSC + (size_t)(hp * 128 + i0) * D + j0, D, F.lane, g_ffn + j0); }
                    { const int g = it >> 9, i0 = ((it >> 4) & 31) * 32, j0 = (it & 15) * 16;
                      fold_wave<8, 16, true>(scr, w_pool_out + (size_t)g * 256 * D + i0, D, pool_scale + g * 256, pool_w + (size_t)g * 65536 + (size_t)j0 * 256, 256, WPB + (size_t)i0 * D + g * 256 + j0, D, F.lane); }
                }
            } else {
                for (int it = gw; it < I_IN + 2 * I_SQ; it += NGW) {
                    int r = it;
                    if (r < I_IN) { p0_transpose_item<true>(w_in, D, NIN, WIN, scr, r, F.lane); continue; } r -= I_IN;
                    if (r < I_SQ) { p0_transpose_item<false>(w_conv_out, D, D, WC, scr, r, F.lane); continue; } r -= I_SQ;
                    p0_transpose_item<false>(w_out, D, D, WOUT, scr, r, F.lane);
                }
                for (int m = gw * 4; m < T; m += NGW * 4) rms_rows4_to_bf16(F.lane, x + (size_t)m * D, g_mix, XN + (size_t)m * D);
            }
        }
        }
        DELAY_END(0);
        if (BOTH(0)) GRID_BAR();
    }
    if (PROBE_DUP & 1024) { for (int xb = 0; xb < 10; ++xb) GRID_BAR(); }
    if (IN(1)) { DELAY_T0(1); for (int rep = 0; rep < REPS(1); ++rep) {
        pg8::Gemm g{XN, WIN, 0l, 0l, T, NIN, D}; pg8::StaticOrder S; S.init(T, NIN, F.G, (int)blockIdx.x);
        pg8::EpiProj E{PB, (long)(WS_PG - WS_PB)};
        pg8::gemm_phase<pg8::EpiProj, pg8::StaticOrder, true, true>(F.lds + RING_OFF, g, S, E);
        }
        DELAY_END(1);
        if (BOTH(1)) GRID_BAR();
    }
    if (IN(2)) { DELAY_T0(2); for (int rep = 0; rep < REPS(2); ++rep) {
        p2_conv_pool(F, PB, conv_w, AIN, POOLED);
        }
        DELAY_END(2);
        if (BOTH(2)) GRID_BAR();
    }
    if (IN(3)) { DELAY_T0(3); for (int rep = 0; rep < REPS(3); ++rep) {
        pg8::Gemm g{AIN, WC, (long)T * D * 2, (long)(WS_WPB - WS_WC), T, D, D}; pg8::MergeOrder S; S.base.init(T, D, F.G, (int)blockIdx.x);
        pg8::EpiMerge E{(const unsigned char*)PG, MG};
        pg8::gemm_phase<pg8::EpiMerge, pg8::MergeOrder, true, true>(F.lds + RING_OFF, g, S, E);
        }
        DELAY_END(3);
        if (BOTH(3)) GRID_BAR();
    }
    if (IN(4)) { DELAY_T0(4); for (int rep = 0; rep < REPS(4); ++rep) {
        if (F.G == 256) {
            pg8::Gemm g{MG, WOUT, 0l, 0l, T, D, D}; pg8::StaticOrder S; S.init(T, D, F.G, (int)blockIdx.x);
            pg8::EpiResRms E{x, H16, X8, SSQ, SXQ};
            pg8::gemm_phase<pg8::EpiResRms, pg8::StaticOrder, false, true>(F.lds + RING_OFF, g, S, E);
            if (PROBE_DUP & 4096) { __syncthreads(); pg8::gemm_phase<pg8::EpiResRms, pg8::StaticOrder, false, true>(F.lds + RING_OFF, g, S, E); }
        } else {
            pg8::Gemm g{MG, WOUT, 0l, 0l, T, D, D}; pg8::StaticOrder S; S.init(T, D, F.G, (int)blockIdx.x);
            pg8::EpiRes E{x, H};
            pg8::gemm_phase<pg8::EpiRes, pg8::StaticOrder, true, true>(F.lds + RING_OFF, g, S, E);
            GRID_BAR();
            for (int m = gw; m < T; m += NGW) p4_row_defer(F.lane, H + (size_t)m * D, X8 + (size_t)m * D, SSQ + (size_t)m * 4, SXQ + (size_t)m * 4, H16 + (size_t)m * D);
        }
        }
        DELAY_END(4);
        if (BOTH(4)) GRID_BAR();
    }
    if (IN(5)) { DELAY_T0(5); for (int rep = 0; rep < REPS(5); ++rep) {
        pg8::Gemm g{(const pg8::bf16_t*)H16, WSC, 0l, 0l, T, NSC, D}; pg8::StaticOrder S; S.init(T, NSC, F.G, (int)blockIdx.x);
        pg8::EpiF16 E{(unsigned short*)SC, NSC};
        pg8::gemm_phase<pg8::EpiF16, pg8::StaticOrder, true, true>(F.lds + RING_OFF, g, S, E);
        }
        DELAY_END(5);
        if (BOTH(5)) GRID_BAR();
    }
    if (IN(6)) { DELAY_T0(6); for (int rep = 0; rep < REPS(6); ++rep) {
        const bool handoff = (F.G * NWAVES == T / 8);
        if (F.wave < 4) { if (handoff) p7_topk(F, (const unsigned short*)SC, SSQ, IDX, GATE, F.vcu * 8 + F.wave, F.vcu * 8 + 8, 4, true); else p7_topk(F, (const unsigned short*)SC, SSQ, IDX, GATE, F.vcu * 4 + F.wave, T / 8, F.G * 4, false); }
        else { cvt_fp8_rows<true>(F, expert_u, U8, SU, F.vcu * 4 + F.wave - 4, F.G * 4, g_ffn); cvt_fp8_rows<false>(F, expert_v, V8, SV, F.vcu * 4 + F.wave - 4, F.G * 4, nullptr); }
        }
        DELAY_END(6);
        if (BOTH(6)) GRID_BAR();
    }
    if (IN(7)) { DELAY_T0(7);
        for (int rep = 0; rep < REPS(7); ++rep)
        p8_peer(F, X8, SSQ, SXQ, U8, V8, SU, SV, IDX, GATE, H16, args.out, (bf16*)(ws + WS_PO), g_fin, F.G * NWAVES == T / 8);
        DELAY_END(7);
    }
#undef IN
#undef BOTH
}

extern "C" void kernel_launch(void* const* d_in, const int* in_sizes, int n_in, void* d_out, int out_size, void* d_ws, size_t ws_size, hipStream_t stream) {
    static int grid = 0;
    if (grid == 0) {
        if (n_in != 15 || in_sizes[0] != T * D || out_size != T * D || ws_size < WS_END) { fprintf(stderr, "kernel_launch: shape/workspace mismatch (n_in %d, in0 %d, out %d, ws %zu)\n", n_in, n_in > 0 ? in_sizes[0] : -1, out_size, ws_size); grid = -1; return; }
        int dev = 0, cus = 0, per_cu = 0;
        if (hipGetDevice(&dev) != hipSuccess || hipDeviceGetAttribute(&cus, hipDeviceAttributeMultiprocessorCount, dev) != hipSuccess) { grid = -1; return; }
        if (hipFuncSetAttribute((const void*)hyb_fwd, hipFuncAttributeMaxDynamicSharedMemorySize, LDS_BYTES) != hipSuccess) { fprintf(stderr, "kernel_launch: hipFuncSetAttribute failed\n"); grid = -1; return; }
        if (hipOccupancyMaxActiveBlocksPerMultiprocessor(&per_cu, (const void*)hyb_fwd, NWAVES * 64, LDS_BYTES) != hipSuccess || per_cu < 1)
            fprintf(stderr, "kernel_launch: note: occupancy query reports %d workgroups per CU\n", per_cu);
        (void)hipGetLastError();
        grid = cus;
    }
    if (grid < 0) return;
    if (hipMemsetAsync((char*)d_ws + WS_CTL, 0, CTL_ZERO_BYTES, stream) != hipSuccess) { fprintf(stderr, "kernel_launch: hipMemsetAsync failed\n"); return; }
    Args a{};
    for (int i = 0; i < 15; ++i) a.in[i] = (const float*)d_in[i];
    a.out = (float*)d_out; a.ws = (unsigned char*)d_ws;
    for (int li = 0; li < N_LAUNCHES; ++li) {
        a.ph_lo = (N_LAUNCHES == 1) ? 0 : li; a.ph_hi = (N_LAUNCHES == 1) ? NPHASE : li + 1;
        hipLaunchKernelGGL(hyb_fwd, dim3(grid), dim3(NWAVES * 64), LDS_BYTES, stream, a);
        const hipError_t le = hipPeekAtLastError();
        if (le != hipSuccess) { fprintf(stderr, "kernel_launch: launch %d failed: %s\n", li, hipGetErrorName(le)); break; }
    }
}
```

```cpp
#include <hip/hip_runtime.h>
#include <cstdio>
#include <cstdint>
namespace pg8 {
#define PG8_LAS __attribute__((address_space(3)))
typedef unsigned short bf16_t;
typedef short bf16x8 __attribute__((ext_vector_type(8)));
typedef float f32x4 __attribute__((ext_vector_type(4)));
typedef unsigned u32x4 __attribute__((ext_vector_type(4)));
constexpr int BM = 256, BK = 64, HALF = 128, HTB = HALF * BK * 2  , STAGE_BYTES = 8 * HTB, NXCD = 8, WGM = 8;

__host__ __device__ __forceinline__ int lds_byte(int r, int c) { const int st = (r >> 4) * 2 + (c >> 5), rr = r & 15, cc = c & 31, ob = rr * 64 + cc * 2; return st * 1024 + (ob ^ (((ob >> 9) & 1) << 5)); }
__host__ __device__ __forceinline__ void stage_rc(int b, int& R, int& C) { const int st = b / 1024, sb = b % 1024, swz = sb ^ (((sb >> 9) & 1) << 5); R = (st >> 1) * 16 + swz / 64; C = (st & 1) * 32 + (swz % 64) / 2; }
__host__ __device__ __forceinline__ int perm32(int rho) { const int n = rho >> 4, i = rho & 15; return 8 * (i >> 2) + 4 * n + (i & 3); }

struct Unit { int pm, pn, sel; };
struct Gemm { const bf16_t* A; const bf16_t* Bt; long offA1, offB1; int M, N, K; };

struct StaticOrder {
    int nM, nN, nwg, G, c;
    __host__ __device__ void init(int M, int N, int G_, int c_) { nM = M / BM; nN = N / BM; nwg = nM * nN; G = G_; c = c_; }
    __host__ __device__ __forceinline__ bool next(int i, Unit& u) const {
        const long L = (long)i * G + c; if (L >= nwg) return false;
        int wgid = (int)L; { const int q = nwg / NXCD, r = nwg % NXCD, xcd = wgid % NXCD, off = wgid / NXCD; wgid = (xcd < r ? xcd * (q + 1) : r * (q + 1) + (xcd - r) * q) + off; }
        const int nig = WGM * nN, gid = wgid / nig, fm = gid * WGM, gsz = (nM - fm) < WGM ? (nM - fm) : WGM;
        u.pm = fm + ((wgid % nig) % gsz); u.pn = (wgid % nig) / gsz; u.sel = 0; return true;
    }
    __device__ __forceinline__ void a_ready(const Unit&) const {}
    __device__ __forceinline__ void done(const Unit&) const {}
};


__device__ __forceinline__ unsigned cvt_pk_bf16(float lo, float hi) { unsigned r; asm volatile("v_cvt_pk_bf16_f32 %0, %1, %2" : "=v"(r) : "v"(lo), "v"(hi)); return r; }
__device__ __forceinline__ float sigm(float x) { return __builtin_amdgcn_rcpf(1.0f + __expf(-x)); }
__device__ __forceinline__ float sig255(float x) { return fmaxf(255.0f * __builtin_amdgcn_rcpf(1.0f + __expf(-x)), 1.0f); }
__device__ __forceinline__ unsigned q8(float a, float b, float c, float d) {
    unsigned w = __builtin_amdgcn_cvt_pk_u8_f32(sig255(a), 0u, 0u); w = __builtin_amdgcn_cvt_pk_u8_f32(sig255(b), 1u, w); w = __builtin_amdgcn_cvt_pk_u8_f32(sig255(c), 2u, w); return __builtin_amdgcn_cvt_pk_u8_f32(sig255(d), 3u, w); }
__device__ __forceinline__ float ub0(unsigned w) { return (float)(w & 0xffu); }
__device__ __forceinline__ float ub1(unsigned w) { return (float)((w >> 8) & 0xffu); }
__device__ __forceinline__ float ub2(unsigned w) { return (float)((w >> 16) & 0xffu); }
__device__ __forceinline__ float ub3(unsigned w) { return (float)(w >> 24); }
__device__ __forceinline__ float bflo(unsigned w) { return __uint_as_float(w << 16); }
__device__ __forceinline__ float bfhi(unsigned w) { return __uint_as_float(w & 0xffff0000u); }

struct EpiProj {
    static constexpr bool PERM = true, AFTER_DRAIN = false, CHAIN = false;
    static constexpr bool ROWSCALE = true;
    const float* RS; bf16_t* PB; long pg_off;
    __device__ __forceinline__ void unit_begin(const Unit& u, int ui, int tid, PG8_LAS unsigned char* buf) const {
        if (tid < 256) __builtin_amdgcn_global_load_lds((const unsigned*)(RS + u.pm * BM + tid), (PG8_LAS unsigned*)(buf + (ui & 1) * 1024 + (tid >> 6) * 256), 4, 0, 0);
    }
    __device__ __forceinline__ void operator()(const f32x4 (&acc)[2][2][4][2], const Unit& u, int wr, int wc, int fr, int fq, const PG8_LAS float* rsl) const {
        const int row0 = u.pm * BM + wr * 64 + fr, lc = wc * 32 + 8 * fq;
        float rs[2][4];
#pragma unroll
        for (int ai = 0; ai < 2; ++ai)
#pragma unroll
            for (int m = 0; m < 4; ++m) rs[ai][m] = rsl[wr * 64 + fr + ai * HALF + m * 16];
        if (u.pn >= 4 && u.pn < 12) {
            bf16_t* base = PB + 1024 + (u.pn - 4) * HALF + lc;
#pragma unroll
            for (int ai = 0; ai < 2; ++ai)
#pragma unroll
                for (int m = 0; m < 4; ++m) { const float r2 = rs[ai][m] * rs[ai][m]; const f32x4 v0 = acc[ai][0][m][0] * acc[ai][1][m][0] * r2, v1 = acc[ai][0][m][1] * acc[ai][1][m][1] * r2;
                    u32x4 w; w.x = cvt_pk_bf16(v0[0], v0[1]); w.y = cvt_pk_bf16(v0[2], v0[3]); w.z = cvt_pk_bf16(v1[0], v1[1]); w.w = cvt_pk_bf16(v1[2], v1[3]);
                    *(u32x4*)(base + (size_t)(row0 + ai * HALF + m * 16) * 3072) = w; }
            return;
        }
        if (u.pn >= 16) {
            unsigned char* base = (unsigned char*)PB + pg_off + (u.pn - 16) * BM + lc;
#pragma unroll
            for (int ai = 0; ai < 2; ++ai)
#pragma unroll
                for (int m = 0; m < 4; ++m) { unsigned char* rowp = base + (size_t)(row0 + ai * HALF + m * 16) * 2048;
#pragma unroll
                    for (int bj = 0; bj < 2; ++bj) { const f32x4 v0 = acc[ai][bj][m][0] * rs[ai][m], v1 = acc[ai][bj][m][1] * rs[ai][m];
                        typedef unsigned u32x2g __attribute__((ext_vector_type(2))); u32x2g w;
                        w.x = q8(v0[0], v0[1], v0[2], v0[3]); w.y = q8(v1[0], v1[1], v1[2], v1[3]);
                        *(u32x2g*)(rowp + bj * HALF) = w; } }
            return;
        }
        const long boff = (u.pn < 4 ? (long)(u.pn * BM) : (long)(2048 + (u.pn - 12) * BM)); bf16_t* base = PB + boff;
#pragma unroll
        for (int ai = 0; ai < 2; ++ai)
#pragma unroll
            for (int m = 0; m < 4; ++m) { bf16_t* rowp = base + (size_t)(row0 + ai * HALF + m * 16) * 3072 + lc;
#pragma unroll
                for (int bj = 0; bj < 2; ++bj) { const f32x4 v0 = acc[ai][bj][m][0] * rs[ai][m], v1 = acc[ai][bj][m][1] * rs[ai][m];
                    u32x4 w; w.x = cvt_pk_bf16(v0[0], v0[1]); w.y = cvt_pk_bf16(v0[2], v0[3]); w.z = cvt_pk_bf16(v1[0], v1[1]); w.w = cvt_pk_bf16(v1[2], v1[3]);
                    *(u32x4*)(rowp + bj * HALF) = w; } }
    }
};
struct EpiMerge {
    static constexpr bool PERM = true, AFTER_DRAIN = false, CHAIN = true;
    static constexpr bool ROWSCALE = false;
    const unsigned char* PG; bf16_t* MG;
    typedef unsigned u32x2g __attribute__((ext_vector_type(2)));
    __device__ __forceinline__ void operator()(f32x4 (&acc)[2][2][4][2], const Unit& u, int wr, int wc, int fr, int fq) const {
        const int row0 = u.pm * BM + wr * 64 + fr, col0 = u.pn * BM + wc * 32 + 8 * fq;
        const unsigned char* pg = PG + (size_t)row0 * 2048 + col0;
        if (u.sel == 0) {
            u32x2g ga[2][4][2], gb[2][4][2];
#pragma unroll
            for (int ai = 0; ai < 2; ++ai)
#pragma unroll
                for (int m = 0; m < 4; ++m)
#pragma unroll
                    for (int bj = 0; bj < 2; ++bj) { const unsigned char* p = pg + (size_t)(ai * HALF + m * 16) * 2048 + bj * HALF; ga[ai][m][bj] = *(const u32x2g*)p; gb[ai][m][bj] = *(const u32x2g*)(p + 1024); }
#pragma unroll
            for (int ai = 0; ai < 2; ++ai)
#pragma unroll
                for (int m = 0; m < 4; ++m)
#pragma unroll
                    for (int bj = 0; bj < 2; ++bj) { const unsigned a0 = ga[ai][m][bj].x, a1 = ga[ai][m][bj].y, b0 = gb[ai][m][bj].x, b1 = gb[ai][m][bj].y; f32x4 v0 = acc[ai][bj][m][0], v1 = acc[ai][bj][m][1];
                        v0[0] *= ub0(a0) * __builtin_amdgcn_rcpf(ub0(b0)); v0[1] *= ub1(a0) * __builtin_amdgcn_rcpf(ub1(b0)); v0[2] *= ub2(a0) * __builtin_amdgcn_rcpf(ub2(b0)); v0[3] *= ub3(a0) * __builtin_amdgcn_rcpf(ub3(b0));
                        v1[0] *= ub0(a1) * __builtin_amdgcn_rcpf(ub0(b1)); v1[1] *= ub1(a1) * __builtin_amdgcn_rcpf(ub1(b1)); v1[2] *= ub2(a1) * __builtin_amdgcn_rcpf(ub2(b1)); v1[3] *= ub3(a1) * __builtin_amdgcn_rcpf(ub3(b1));
                        acc[ai][bj][m][0] = v0; acc[ai][bj][m][1] = v1; }
            asm volatile("" ::: "memory");
        } else {
            u32x2g gb[2][4][2];
#pragma unroll
            for (int ai = 0; ai < 2; ++ai)
#pragma unroll
                for (int m = 0; m < 4; ++m)
#pragma unroll
                    for (int bj = 0; bj < 2; ++bj) gb[ai][m][bj] = *(const u32x2g*)(pg + (size_t)(ai * HALF + m * 16) * 2048 + bj * HALF + 1024);
            const float k = 1.0f / 255.0f;
#pragma unroll
            for (int ai = 0; ai < 2; ++ai)
#pragma unroll
                for (int m = 0; m < 4; ++m)
#pragma unroll
                    for (int bj = 0; bj < 2; ++bj) { const unsigned b0 = gb[ai][m][bj].x, b1 = gb[ai][m][bj].y; const f32x4 v0 = acc[ai][bj][m][0], v1 = acc[ai][bj][m][1];
                        u32x4 w; w.x = cvt_pk_bf16(v0[0] * (ub0(b0) * k), v0[1] * (ub1(b0) * k)); w.y = cvt_pk_bf16(v0[2] * (ub2(b0) * k), v0[3] * (ub3(b0) * k));
                        w.z = cvt_pk_bf16(v1[0] * (ub0(b1) * k), v1[1] * (ub1(b1) * k)); w.w = cvt_pk_bf16(v1[2] * (ub2(b1) * k), v1[3] * (ub3(b1) * k));
                        *(u32x4*)(MG + (size_t)(row0 + ai * HALF + m * 16) * 1024 + col0 + bj * HALF) = w; }
            asm volatile("" ::: "memory");
        }
    }
};
struct EpiRes {
    static constexpr bool PERM = false, AFTER_DRAIN = false, CHAIN = false;
    static constexpr bool ROWSCALE = false;
    const float* X; float* H;
    __device__ __forceinline__ void operator()(const f32x4 (&acc)[2][2][4][2], const Unit& u, int wr, int wc, int fr, int fq) const {
        const int row0 = u.pm * BM + wr * 64 + fr, col0 = u.pn * BM + wc * 32 + 4 * fq;
#pragma unroll
        for (int ai = 0; ai < 2; ++ai)
#pragma unroll
            for (int m = 0; m < 4; ++m) { const size_t off = (size_t)(row0 + ai * HALF + m * 16) * 1024 + col0;
#pragma unroll
                for (int bj = 0; bj < 2; ++bj)
#pragma unroll
                    for (int n = 0; n < 2; ++n) { const f32x4 xv = *(const f32x4*)(X + off + bj * HALF + n * 16); *(f32x4*)(H + off + bj * HALF + n * 16) = xv + acc[ai][bj][m][n]; } }
    }
};
struct EpiF16 {
    static constexpr bool PERM = true, AFTER_DRAIN = false, CHAIN = false;
    static constexpr bool ROWSCALE = false;
    unsigned short* C; int ldc;
    __device__ __forceinline__ unsigned pkh(float a, float b) const { typedef _Float16 h2 __attribute__((ext_vector_type(2))); h2 v; v.x = (_Float16)a; v.y = (_Float16)b; return __builtin_bit_cast(unsigned, v); }
    __device__ __forceinline__ void operator()(const f32x4 (&acc)[2][2][4][2], const Unit& u, int wr, int wc, int fr, int fq) const {
        const int row0 = u.pm * BM + wr * 64 + fr, col0 = u.pn * BM + wc * 32 + 8 * fq;
#pragma unroll
        for (int ai = 0; ai < 2; ++ai)
#pragma unroll
            for (int m = 0; m < 4; ++m) { unsigned short* rowp = C + (size_t)(row0 + ai * HALF + m * 16) * ldc + col0;
#pragma unroll
                for (int bj = 0; bj < 2; ++bj) { const f32x4 v0 = acc[ai][bj][m][0], v1 = acc[ai][bj][m][1];
                    u32x4 w; w.x = pkh(v0[0], v0[1]); w.y = pkh(v0[2], v0[3]); w.z = pkh(v1[0], v1[1]); w.w = pkh(v1[2], v1[3]);
                    *(u32x4*)(rowp + bj * HALF) = w; } }
    }
};
struct EpiResRms {
    static constexpr bool PERM = true, AFTER_DRAIN = true, CHAIN = false;
    static constexpr bool ROWSCALE = false;
    const bf16_t* X; bf16_t* H16; unsigned char* X8; float* SSQ; float* SXQ;
    __device__ __forceinline__ void fused(f32x4 (&acc)[2][2][4][2], const Unit& u, int wr, int wc, int fr, int fq, PG8_LAS unsigned char* lds, int wid, int lane) const {
        typedef float f32x2v __attribute__((ext_vector_type(2))); typedef unsigned u32x2v __attribute__((ext_vector_type(2)));
        PG8_LAS f32x2v* P = (PG8_LAS f32x2v*)lds;
        PG8_LAS f32x2v* S = (PG8_LAS f32x2v*)(lds + 8192);
        int col0 = u.pn * BM + wc * 32 + 8 * fq; asm volatile("" : "+v"(col0));
        const bf16_t* xb = X + (size_t)(u.pm * BM + wr * 64 + fr) * 1024 + col0;
        u32x4 xq[2][4][2];
#pragma unroll
        for (int ai = 0; ai < 2; ++ai)
#pragma unroll
            for (int m = 0; m < 4; ++m)
#pragma unroll
                for (int bj = 0; bj < 2; ++bj) xq[ai][m][bj] = *(const u32x4*)(xb + (size_t)(ai * HALF + m * 16) * 1024 + bj * HALF);
#pragma unroll
        for (int am = 0; am < 8; ++am) { const int ai = am >> 2, m = am & 3, r = ai * HALF + wr * 64 + m * 16 + fr;
            asm volatile("" ::: "memory");
            float s = 0.f, a = 0.f;
#pragma unroll
            for (int bj = 0; bj < 2; ++bj)
#pragma unroll
                for (int n = 0; n < 2; ++n) { const u32x4 xw = xq[ai][m][bj]; const unsigned w0 = n ? xw.z : xw.x, w1 = n ? xw.w : xw.y;
                    const f32x4 h = (f32x4){bflo(w0), bfhi(w0), bflo(w1), bfhi(w1)} + acc[ai][bj][m][n]; acc[ai][bj][m][n] = h;
                    s += (h[0] * h[0] + h[1] * h[1]) + (h[2] * h[2] + h[3] * h[3]);
                    a = fmaxf(a, fmaxf(fmaxf(fabsf(h[0]), fabsf(h[1])), fmaxf(fabsf(h[2]), fabsf(h[3])))); }
            s += __shfl_xor(s, 16); s += __shfl_xor(s, 32); a = fmaxf(a, __shfl_xor(a, 16)); a = fmaxf(a, __shfl_xor(a, 32));
            if (fq == 0) P[r * 4 + wc] = (f32x2v){s, a};
            asm volatile("" ::: "memory"); }
        asm volatile("s_waitcnt lgkmcnt(0)" ::: "memory"); __builtin_amdgcn_s_barrier(); asm volatile("" ::: "memory");
        const int row = wid * 32 + (lane & 31);
        if (lane < 32) {
            const f32x2v a = P[row * 4 + 0], b = P[row * 4 + 1], c = P[row * 4 + 2], d = P[row * 4 + 3];
            const float st = (a.x + b.x) + (c.x + d.x), am = fmaxf(fmaxf(a.y, b.y), fmaxf(c.y, d.y));
            const float sc = (am > 0.f) ? am * (1.0f / 448.0f) : 1.0f;
            S[row] = (f32x2v){st, 1.0f / sc};
            SSQ[(size_t)(u.pm * BM + row) * 4 + u.pn] = st; SXQ[(size_t)(u.pm * BM + row) * 4 + u.pn] = sc;
        }
        asm volatile("s_waitcnt lgkmcnt(0)" ::: "memory"); __builtin_amdgcn_s_barrier(); asm volatile("" ::: "memory");
        asm volatile("" : "+v"(col0), "+v"(fr));
#pragma unroll
        for (int ai = 0; ai < 2; ++ai)
#pragma unroll
            for (int m = 0; m < 4; ++m) { const int r = ai * HALF + wr * 64 + m * 16 + fr; const f32x2v sr = S[r]; const size_t off = (size_t)(u.pm * BM + r) * 1024 + col0;
#pragma unroll
                for (int bj = 0; bj < 2; ++bj) { const f32x4 h0 = acc[ai][bj][m][0], h1 = acc[ai][bj][m][1];
                    u32x4 hw; hw.x = cvt_pk_bf16(h0[0], h0[1]); hw.y = cvt_pk_bf16(h0[2], h0[3]); hw.z = cvt_pk_bf16(h1[0], h1[1]); hw.w = cvt_pk_bf16(h1[2], h1[3]);
                    *(u32x4*)(H16 + off + bj * HALF) = hw;
                    { const f32x4 q0 = h0 * sr.y, q1 = h1 * sr.y; u32x2v w8;
                        w8.x = (unsigned)__builtin_amdgcn_cvt_pk_fp8_f32(q0[2], q0[3], __builtin_amdgcn_cvt_pk_fp8_f32(q0[0], q0[1], 0, false), true);
                        w8.y = (unsigned)__builtin_amdgcn_cvt_pk_fp8_f32(q1[2], q1[3], __builtin_amdgcn_cvt_pk_fp8_f32(q1[0], q1[1], 0, false), true);
                        *(u32x2v*)(X8 + off + bj * HALF) = w8; } }
                asm volatile("" ::: "memory"); }
    }
};
struct MergeOrder {
    StaticOrder base;
    __device__ __forceinline__ bool next(int i, Unit& u) const { if (!base.next(i >> 1, u)) return false; u.sel = i & 1; return true; }
    __device__ __forceinline__ void a_ready(const Unit&) const {}
    __device__ __forceinline__ void done(const Unit&) const {}
};

template <class Epi, class Sched, bool ALIGN_EPI = false, bool SP2 = false>
__device__ __forceinline__ void gemm_phase(PG8_LAS unsigned char* lds, const Gemm g, const Sched& S, const Epi& E) {
    const int tid = threadIdx.x, wid = __builtin_amdgcn_readfirstlane(tid >> 6), lane = tid & 63, wr = wid >> 2, wc = wid & 3, fr = lane & 15, fq = lane >> 4;
    const int K = g.K, nt = K / BK;
    unsigned voffA[2], voffB[2];
#pragma unroll
    for (int i = 0; i < 2; ++i) { int R, C; stage_rc(tid * 16 + i * 8192, R, C); const int Rb = Epi::PERM ? ((R & ~31) + perm32(R & 31)) : R;
        voffA[i] = (unsigned)(R * K + C) * 2u; voffB[i] = (unsigned)(Rb * K + C) * 2u; }
    const size_t kstep = (size_t)(BK * 2);
    const size_t hstep = (size_t)HALF * K * 2;
    const size_t tstep = 2 * hstep;
    const unsigned ldsw = (unsigned)wid * 1024u;
    const int aoff = lds_byte(wr * 64 + fr, fq * 8), boff = lds_byte(wc * 32 + fr, fq * 8);
#define PG8_SA(b, h) (((b) * 2 + (h)) * HTB)
#define PG8_SB(b, h) ((4 + (b) * 2 + (h)) * HTB)
#define PG8_STAGE(bufoff, gbase, voff) do { _Pragma("unroll") for (int _i = 0; _i < 2; ++_i) \
        __builtin_amdgcn_global_load_lds((const unsigned*)((const char*)(gbase) + (voff)[_i]), (PG8_LAS unsigned*)(lds + (bufoff) + ldsw + _i * 8192), 16, 0, 0); } while (0)
#define PG8_LDA(dst, b, h) do { _Pragma("unroll") for (int m = 0; m < 4; ++m) _Pragma("unroll") for (int k = 0; k < 2; ++k) dst[m][k] = *(const PG8_LAS bf16x8*)(lds + PG8_SA(b, h) + aoff + m * 2048 + k * 1024); } while (0)
#define PG8_LDB(dst, b, h) do { _Pragma("unroll") for (int n = 0; n < 2; ++n) _Pragma("unroll") for (int k = 0; k < 2; ++k) dst[n][k] = *(const PG8_LAS bf16x8*)(lds + PG8_SB(b, h) + boff + n * 2048 + k * 1024); } while (0)
#define PG8_MMA(ai, bj, At, Bt) do { __builtin_amdgcn_s_setprio(1); _Pragma("unroll") for (int m = 0; m < 4; ++m) _Pragma("unroll") for (int n = 0; n < 2; ++n) _Pragma("unroll") for (int k = 0; k < 2; ++k) \
        acc[ai][bj][m][n] = __builtin_amdgcn_mfma_f32_16x16x32_bf16(Bt[n][k], At[m][k], acc[ai][bj][m][n], 0, 0, 0); __builtin_amdgcn_s_setprio(0); } while (0)
#define PG8_WAIT_V(n) asm volatile("s_waitcnt vmcnt(" #n ")" ::: "memory")
#define PG8_WAIT_L(n) asm volatile("s_waitcnt lgkmcnt(" #n ")" ::: "memory")
#define PG8_BAR __builtin_amdgcn_s_barrier()
#define PG8_SCHED __builtin_amdgcn_sched_barrier(0)
    Unit cur, nxt; int ui = 0;
    if (!S.next(0, cur)) return;
    f32x4 acc[2][2][4][2];
#pragma unroll
    for (int a = 0; a < 2; ++a)
#pragma unroll
        for (int b = 0; b < 2; ++b)
#pragma unroll
            for (int m = 0; m < 4; ++m)
#pragma unroll
                for (int n = 0; n < 2; ++n) acc[a][b][m][n] = (f32x4){0.f, 0.f, 0.f, 0.f};
    bf16x8 At[4][2], B0[2][2], B1[2][2];
    const char* cA = (const char*)g.A + (cur.sel ? g.offA1 : 0l) + (size_t)cur.pm * tstep; const char* cB = (const char*)g.Bt + (cur.sel ? g.offB1 : 0l) + (size_t)cur.pn * tstep;
    S.a_ready(cur);
    if constexpr (Epi::ROWSCALE) E.unit_begin(cur, 0, tid, lds + STAGE_BYTES);
    if constexpr (SP2) {
        PG8_STAGE(PG8_SB(0, 0), cB, voffB); PG8_STAGE(PG8_SB(0, 1), cB + hstep, voffB); PG8_STAGE(PG8_SA(0, 0), cA, voffA); PG8_STAGE(PG8_SA(0, 1), cA + hstep, voffA);
        if (wr == 1) PG8_BAR;
        PG8_WAIT_V(2); PG8_BAR;
        PG8_STAGE(PG8_SB(1, 0), cB + kstep, voffB); PG8_STAGE(PG8_SA(1, 0), cA + kstep, voffA); PG8_STAGE(PG8_SB(1, 1), cB + hstep + kstep, voffB);
        PG8_WAIT_V(6); PG8_BAR;
    } else {
        PG8_STAGE(PG8_SB(0, 0), cB, voffB); PG8_STAGE(PG8_SA(0, 0), cA, voffA); PG8_STAGE(PG8_SB(0, 1), cB + hstep, voffB); PG8_STAGE(PG8_SA(0, 1), cA + hstep, voffA);
        if (wr == 1) PG8_BAR;
        PG8_WAIT_V(4); PG8_BAR;
        PG8_STAGE(PG8_SB(1, 0), cB + kstep, voffB); PG8_STAGE(PG8_SA(1, 0), cA + kstep, voffA); PG8_STAGE(PG8_SB(1, 1), cB + hstep + kstep, voffB);
        PG8_WAIT_V(6); PG8_BAR;
    }
    for (;;) {
        const bool has_next = S.next(ui + 1, nxt);
        const char* nA = has_next ? (const char*)g.A + (nxt.sel ? g.offA1 : 0l) + (size_t)nxt.pm * tstep : cA; const char* nB = has_next ? (const char*)g.Bt + (nxt.sel ? g.offB1 : 0l) + (size_t)nxt.pn * tstep : cB;
        for (int t = 0; t < nt; t += 2) {
            const bool last = (t == nt - 2);
            const char* a1 = cA + (size_t)(t + 1) * kstep;
            const char* a2 = last ? nA : cA + (size_t)(t + 2) * kstep; const char* b2 = last ? nB : cB + (size_t)(t + 2) * kstep;
            const char* a3 = a2 + kstep; const char* b3 = b2 + kstep;
            if (last && has_next) S.a_ready(nxt);
            if constexpr (SP2) {
            PG8_LDB(B0, 0, 0); PG8_LDB(B1, 0, 1); PG8_SCHED; PG8_LDA(At, 0, 0); PG8_STAGE(PG8_SA(1, 1), a1 + hstep, voffA);
            PG8_WAIT_V(8); PG8_WAIT_L(0); PG8_BAR; PG8_MMA(0, 0, At, B0); PG8_MMA(0, 1, At, B1); PG8_BAR; PG8_SCHED;
            PG8_LDA(At, 0, 1); PG8_STAGE(PG8_SB(0, 0), b2, voffB); PG8_STAGE(PG8_SB(0, 1), b2 + hstep, voffB); PG8_STAGE(PG8_SA(0, 0), a2, voffA);
            PG8_WAIT_V(8); PG8_WAIT_L(0); PG8_BAR; PG8_MMA(1, 0, At, B0); PG8_MMA(1, 1, At, B1); PG8_BAR; PG8_SCHED;
            PG8_LDB(B0, 1, 0); PG8_LDB(B1, 1, 1); PG8_SCHED; PG8_LDA(At, 1, 0); PG8_STAGE(PG8_SA(0, 1), a2 + hstep, voffA);
            PG8_WAIT_V(8); PG8_WAIT_L(0); PG8_BAR; PG8_MMA(0, 0, At, B0); PG8_MMA(0, 1, At, B1); PG8_BAR; PG8_SCHED;
            PG8_LDA(At, 1, 1); PG8_STAGE(PG8_SB(1, 0), b3, voffB); PG8_STAGE(PG8_SB(1, 1), b3 + hstep, voffB); PG8_STAGE(PG8_SA(1, 0), a3, voffA);
            PG8_WAIT_V(8); PG8_WAIT_L(0); PG8_BAR; PG8_MMA(1, 0, At, B0); PG8_MMA(1, 1, At, B1); PG8_BAR; PG8_SCHED;
            } else {
            PG8_LDB(B0, 0, 0); PG8_SCHED; PG8_LDA(At, 0, 0); PG8_STAGE(PG8_SA(1, 1), a1 + hstep, voffA);
            PG8_WAIT_L(8); PG8_BAR; PG8_WAIT_L(0); PG8_MMA(0, 0, At, B0); PG8_BAR; PG8_SCHED;
            PG8_LDB(B1, 0, 1); PG8_STAGE(PG8_SB(0, 0), b2, voffB);
            PG8_BAR; PG8_WAIT_L(0); PG8_MMA(0, 1, At, B1); PG8_BAR;
            PG8_LDA(At, 0, 1); PG8_STAGE(PG8_SA(0, 0), a2, voffA);
            PG8_BAR; PG8_WAIT_L(0); PG8_MMA(1, 0, At, B0); PG8_BAR; PG8_SCHED;
            PG8_STAGE(PG8_SB(0, 1), b2 + hstep, voffB);
            PG8_WAIT_V(6); PG8_BAR; PG8_MMA(1, 1, At, B1); PG8_BAR;
            PG8_LDB(B0, 1, 0); PG8_SCHED; PG8_LDA(At, 1, 0); PG8_STAGE(PG8_SA(0, 1), a2 + hstep, voffA);
            PG8_WAIT_L(8); PG8_BAR; PG8_WAIT_L(0); PG8_MMA(0, 0, At, B0); PG8_BAR; PG8_SCHED;
            PG8_LDB(B1, 1, 1); PG8_STAGE(PG8_SB(1, 0), b3, voffB);
            PG8_BAR; PG8_WAIT_L(0); PG8_MMA(0, 1, At, B1); PG8_BAR;
            PG8_LDA(At, 1, 1); PG8_STAGE(PG8_SA(1, 0), a3, voffA);
            PG8_BAR; PG8_WAIT_L(0); PG8_MMA(1, 0, At, B0); PG8_BAR; PG8_SCHED;
            PG8_STAGE(PG8_SB(1, 1), b3 + hstep, voffB);
            PG8_WAIT_V(6); PG8_BAR; PG8_MMA(1, 1, At, B1); PG8_BAR;
            }
        }
        if constexpr (ALIGN_EPI) { if (wr == 0) PG8_BAR; }
        if constexpr (Epi::ROWSCALE) { E(acc, cur, wr, wc, fr, fq, (const PG8_LAS float*)(lds + STAGE_BYTES + (ui & 1) * 1024)); S.done(cur); }
        else if constexpr (!Epi::AFTER_DRAIN) { E(acc, cur, wr, wc, fr, fq); S.done(cur); }
        if (!has_next) break;
        if (!Epi::CHAIN || nxt.sel == 0) {
#pragma unroll
        for (int a = 0; a < 2; ++a)
#pragma unroll
            for (int b = 0; b < 2; ++b)
#pragma unroll
                for (int m = 0; m < 4; ++m)
#pragma unroll
                    for (int n = 0; n < 2; ++n) acc[a][b][m][n] = (f32x4){0.f, 0.f, 0.f, 0.f};
        }
        cur = nxt; cA = nA; cB = nB; ++ui;
        if constexpr (Epi::ROWSCALE) E.unit_begin(cur, ui, tid, lds + STAGE_BYTES);
        if constexpr (ALIGN_EPI) { if (wr == 1) PG8_BAR; }
    }
    PG8_WAIT_V(0);
    if constexpr (!ALIGN_EPI) { if (wr == 0) PG8_BAR; }
    PG8_BAR;
    if constexpr (Epi::AFTER_DRAIN) { E.fused(acc, cur, wr, wc, fr, fq, lds, wid, lane); S.done(cur); }
#undef PG8_SA
#undef PG8_SB
#undef PG8_STAGE
#undef PG8_LDA
#undef PG8_LDB
#undef PG8_MMA
#undef PG8_WAIT_V
#undef PG8_WAIT_L
#undef PG8_BAR
#undef PG8_SCHED
}
}
constexpr int NWAVES = 8;
#ifndef MK_N_LAUNCHES
#define MK_N_LAUNCHES 1
#endif
constexpr int NPHASE = 8;
#ifndef PROBE_DUP
#define PROBE_DUP 0
#endif
#ifndef PROBE_DELAY
#define PROBE_DELAY (-1)
#endif
#define DELAY_T0(k) const unsigned long long _t0_##k = (PROBE_DELAY == (k)) ? __builtin_amdgcn_s_memrealtime() : 0ull
#define DELAY_END(k) do { if (PROBE_DELAY == (k)) { const unsigned long long _t1 = __builtin_amdgcn_s_memrealtime(), _dt = _t1 - _t0_##k; while (__builtin_amdgcn_s_memrealtime() - _t1 < _dt) __builtin_amdgcn_s_sleep(8); } } while (0)
#define REPS(k) (1 + ((PROBE_DUP >> (k)) & 1))
constexpr int N_LAUNCHES = MK_N_LAUNCHES;
static_assert(N_LAUNCHES == 1 || N_LAUNCHES == NPHASE, "MK_N_LAUNCHES is 1 or NPHASE");

constexpr int T = 16384, SEQ = 2048, D = 1024, NIN = 6144, NSC = 2048, NEXP = 16384, NSEL = 128;
constexpr float EPS = 1e-6f;

constexpr size_t MiB = 1u << 20;
constexpr size_t WS_CTL = 0, CTL_ZERO_BYTES = 64 * 1024;
constexpr size_t WS_WIN = 1 * MiB, WS_WC = 13 * MiB, WS_WPB = 15 * MiB, WS_WOUT = 17 * MiB, WS_WS = 19 * MiB;
constexpr size_t WS_IDX = 1 * MiB, WS_GATE = 9 * MiB;
constexpr size_t WS_XN = 32 * MiB;
constexpr size_t WS_PB = 64 * MiB;
constexpr size_t WS_TMP = 64 * MiB, WS_MG = 96 * MiB;
constexpr size_t WS_X8 = 128 * MiB, WS_SX = 144 * MiB;
constexpr size_t WS_PO = 64 * MiB;
constexpr size_t WS_SC = 64 * MiB;
constexpr size_t WS_PG = 192 * MiB;
constexpr size_t WS_U8 = 192 * MiB, WS_V8 = 208 * MiB, WS_H16 = 224 * MiB, WS_SU = 31 * MiB + 512 * 1024, WS_SV = 31 * MiB + 576 * 1024;
constexpr size_t WS_END = 256 * MiB;
constexpr int CW_TMO = 0;
constexpr int CW_BAR = 1024;
constexpr int CW_SEAM = 8192;
constexpr size_t WS_RS1 = 31 * MiB + 640 * 1024;
constexpr size_t WS_XBUF = 31 * MiB;

constexpr int RING_OFF = 0, RING_BYTES = 131072;
constexpr int P7_WAVE_BYTES = 18432;
constexpr int P7_IDX_OFF = 0, P7_OUT_OFF = 4096, P7_STAGE_OFF = 6144, P7_ZA_OFF = 14336;
constexpr int LDSCTL_OFF = 8 * P7_WAVE_BYTES, MISC_OFF = LDSCTL_OFF + 320;
constexpr int P7_AUX_OFF = LDSCTL_OFF + 1024;
constexpr int LDS_BYTES = 150528;
#define GAS __attribute__((address_space(1)))
#define LAS __attribute__((address_space(3)))
typedef unsigned short bf16;
typedef unsigned v4u __attribute__((ext_vector_type(4)));
typedef float f32x4 __attribute__((ext_vector_type(4)));
typedef short bf16x8 __attribute__((ext_vector_type(8)));
typedef GAS unsigned gu32;
typedef GAS unsigned long long gu64;
#define RLX_AGENT __ATOMIC_RELAXED, __HIP_MEMORY_SCOPE_AGENT
#define LDS_WAIT() asm volatile("s_waitcnt lgkmcnt(0)" ::: "memory")
#define VM_WAIT() asm volatile("s_waitcnt vmcnt(0)" ::: "memory")
__device__ __forceinline__ unsigned long long rt() { return __builtin_amdgcn_s_memrealtime(); }
__device__ __forceinline__ unsigned f2bf(float f) { unsigned u = __builtin_bit_cast(unsigned, f); return (u + 0x7fffu + ((u >> 16) & 1u)) >> 16; }
__device__ __forceinline__ unsigned pk2(float lo, float hi) { return f2bf(lo) | (f2bf(hi) << 16); }

#define XB_TMO      128
#define XB_XCNT(j)  (256  + 64 * (j))
#define XB_XSUB(j)  (1280 + 64 * (j))
#define XB_XGEN(j)  (2304 + 64 * (j))
#define XB_TOP      3328
#define XB_TOPGEN   3392
#define XCD_BAR_WORDS 3456
#define XB_SPIN_CAP (1u << 18)

__device__ __forceinline__ unsigned xb_ld(unsigned* p)              { return __hip_atomic_load(p, __ATOMIC_RELAXED, __HIP_MEMORY_SCOPE_AGENT); }
__device__ __forceinline__ unsigned xb_add(unsigned* p, unsigned v) { return __hip_atomic_fetch_add(p, v, __ATOMIC_RELAXED, __HIP_MEMORY_SCOPE_AGENT); }
__device__ __forceinline__ unsigned xb_xcc_id() { return (unsigned)__builtin_amdgcn_s_getreg((3 << 11) | 20) & 0xFu; }
#define XB_SPIN(cond, bar) do { unsigned _sp = 0; while (cond) { __builtin_amdgcn_s_sleep(1); \
    if ((++_sp & 255u) == 0u) { if (xb_ld(&(bar)[XB_TMO])) break; if (_sp > XB_SPIN_CAP) { atomicAdd(&(bar)[XB_TMO], 1u); break; } } } } while (0)

struct XcdBarrier {
    unsigned* bar; unsigned x;
    volatile LAS unsigned* st;
};

__device__ __forceinline__ XcdBarrier xcd_barrier_post(unsigned* bar, volatile LAS unsigned* st) {
    XcdBarrier b; b.bar = bar; b.x = xb_xcc_id(); b.st = st;
    if (threadIdx.x == 0) (void)xb_add(&bar[XB_XCNT(b.x)], 1u);
    return b;
}
__device__ __forceinline__ void xcd_barrier_complete(unsigned* bar, unsigned x, unsigned& nloc, unsigned& nx) {
    const unsigned G = gridDim.x * gridDim.y * gridDim.z;
    unsigned sum, cnt, mine, sp = 0u;
    for (;;) {
        sum = 0u; cnt = 0u; mine = 0u;
#pragma unroll
        for (unsigned j = 0; j < 16; ++j) { const unsigned c = xb_ld(&bar[XB_XCNT(j)]); sum += c; cnt += (c > 0u) ? 1u : 0u; mine = (j == x) ? c : mine; }
        if (sum == G) break;
        __builtin_amdgcn_s_sleep(1);
        if ((++sp & 255u) == 0u) { if (xb_ld(&bar[XB_TMO])) break; if (sp > XB_SPIN_CAP) { atomicAdd(&bar[XB_TMO], 1u); break; } }
    }
    nloc = mine > 0u ? mine : 1u; nx = cnt > 0u ? cnt : 1u;
}

__device__ __forceinline__ void xcd_barrier(const XcdBarrier& b) {
    asm volatile("s_waitcnt vmcnt(0)" ::: "memory");
    __syncthreads();
    if (threadIdx.x == 0) {
        unsigned* bar = b.bar;
        __builtin_amdgcn_s_waitcnt(0);
        unsigned nloc = b.st[0], nx = b.st[1];
        if (nloc == 0u) { xcd_barrier_complete(bar, b.x, nloc, nx); b.st[0] = nloc; b.st[1] = nx; }
        const unsigned old = xb_add(&bar[XB_XSUB(b.x)], 1u);
        const unsigned gen = old / nloc;
        if (old + 1u == (gen + 1u) * nloc) {
            __builtin_amdgcn_fence(__ATOMIC_RELEASE, "agent");
            asm volatile("s_waitcnt vmcnt(0)" ::: "memory");
            const unsigned og = xb_add(&bar[XB_TOP], 1u);
            const unsigned tg = og / nx;
            if (og + 1u == (tg + 1u) * nx) xb_add(&bar[XB_TOPGEN], 1u);
            else XB_SPIN(xb_ld(&bar[XB_TOPGEN]) == tg, bar);
            __builtin_amdgcn_fence(__ATOMIC_ACQUIRE, "agent");
            xb_add(&bar[XB_XGEN(b.x)], 1u);
            asm volatile("s_waitcnt vmcnt(0)" ::: "memory");
        } else {
            XB_SPIN(xb_ld(&bar[XB_XGEN(b.x)]) == gen, bar);
            __builtin_amdgcn_fence(__ATOMIC_ACQUIRE, "agent");
            asm volatile("s_waitcnt vmcnt(0)" ::: "memory");
        }
    }
    __syncthreads();
}

struct Frame {
    LAS unsigned char* lds;
    volatile LAS unsigned* MISC;
    int tid, lane, wave;
    int vcu, G;
};
__device__ __forceinline__ float wave_sum(float v) {
#pragma unroll
    for (int o = 1; o < 64; o <<= 1) v += __shfl_xor(v, o);
    return v;
}
__device__ __forceinline__ float bflo(unsigned w) { return __uint_as_float(w << 16); }
__device__ __forceinline__ float bfhi(unsigned w) { return __uint_as_float(w & 0xffff0000u); }
__device__ __forceinline__ void unpack8(const v4u w, float (&f)[8]) { f[0] = bflo(w.x); f[1] = bfhi(w.x); f[2] = bflo(w.y); f[3] = bfhi(w.y); f[4] = bflo(w.z); f[5] = bfhi(w.z); f[6] = bflo(w.w); f[7] = bfhi(w.w); }
__device__ __forceinline__ v4u pack8(const float (&f)[8]) { v4u o; o.x = pk2(f[0], f[1]); o.y = pk2(f[2], f[3]); o.z = pk2(f[4], f[5]); o.w = pk2(f[6], f[7]); return o; }

__device__ __forceinline__ void rms_row_to_fp8(int lane, const float* xrow, const float* g, unsigned char* orow, float* sc_out) {
    const GAS f32x4* xr = (const GAS f32x4*)xrow + 4 * lane; const GAS f32x4* gr = (const GAS f32x4*)g + 4 * lane;
    f32x4 v[4]; float s = 0.f, am = 0.f;
#pragma unroll
    for (int jj = 0; jj < 4; ++jj) { v[jj] = xr[jj]; s += (v[jj].x * v[jj].x + v[jj].y * v[jj].y) + (v[jj].z * v[jj].z + v[jj].w * v[jj].w); v[jj] = v[jj] * gr[jj];
        am = fmaxf(am, fmaxf(fmaxf(fabsf(v[jj].x), fabsf(v[jj].y)), fmaxf(fabsf(v[jj].z), fabsf(v[jj].w)))); }
#pragma unroll
    for (int o = 1; o < 64; o <<= 1) am = fmaxf(am, __shfl_xor(am, o));
    const float rstd = 1.f / sqrtf(wave_sum(s) * (1.f / D) + EPS), xm = am * rstd, sc = (xm > 0.f) ? xm * (1.0f / 448.0f) : 1.0f, mul = rstd / sc;
    v4u o;
    o.x = (unsigned)__builtin_amdgcn_cvt_pk_fp8_f32(v[0].z * mul, v[0].w * mul, __builtin_amdgcn_cvt_pk_fp8_f32(v[0].x * mul, v[0].y * mul, 0, false), true);
    o.y = (unsigned)__builtin_amdgcn_cvt_pk_fp8_f32(v[1].z * mul, v[1].w * mul, __builtin_amdgcn_cvt_pk_fp8_f32(v[1].x * mul, v[1].y * mul, 0, false), true);
    o.z = (unsigned)__builtin_amdgcn_cvt_pk_fp8_f32(v[2].z * mul, v[2].w * mul, __builtin_amdgcn_cvt_pk_fp8_f32(v[2].x * mul, v[2].y * mul, 0, false), true);
    o.w = (unsigned)__builtin_amdgcn_cvt_pk_fp8_f32(v[3].z * mul, v[3].w * mul, __builtin_amdgcn_cvt_pk_fp8_f32(v[3].x * mul, v[3].y * mul, 0, false), true);
    *(GAS v4u*)(orow + 16 * lane) = o;
    if (lane == 0) *sc_out = sc;
}
__device__ __forceinline__ void p4_row_defer(int lane, const float* hrow, unsigned char* x8, float* ssq, float* sxq, bf16* h16) {
    const GAS f32x4* xr = (const GAS f32x4*)hrow + 4 * lane;
    f32x4 h[4]; float s = 0.f, am = 0.f;
#pragma unroll
    for (int jj = 0; jj < 4; ++jj) { h[jj] = xr[jj]; s += (h[jj].x * h[jj].x + h[jj].y * h[jj].y) + (h[jj].z * h[jj].z + h[jj].w * h[jj].w);
        am = fmaxf(am, fmaxf(fmaxf(fabsf(h[jj].x), fabsf(h[jj].y)), fmaxf(fabsf(h[jj].z), fabsf(h[jj].w)))); }
#pragma unroll
    for (int o = 1; o < 64; o <<= 1) am = fmaxf(am, __shfl_xor(am, o));
    s = wave_sum(s);
    const float sc = (am > 0.f) ? am * (1.0f / 448.0f) : 1.0f, mul = 1.0f / sc;
    v4u o;
    o.x = (unsigned)__builtin_amdgcn_cvt_pk_fp8_f32(h[0].z * mul, h[0].w * mul, __builtin_amdgcn_cvt_pk_fp8_f32(h[0].x * mul, h[0].y * mul, 0, false), true);
    o.y = (unsigned)__builtin_amdgcn_cvt_pk_fp8_f32(h[1].z * mul, h[1].w * mul, __builtin_amdgcn_cvt_pk_fp8_f32(h[1].x * mul, h[1].y * mul, 0, false), true);
    o.z = (unsigned)__builtin_amdgcn_cvt_pk_fp8_f32(h[2].z * mul, h[2].w * mul, __builtin_amdgcn_cvt_pk_fp8_f32(h[2].x * mul, h[2].y * mul, 0, false), true);
    o.w = (unsigned)__builtin_amdgcn_cvt_pk_fp8_f32(h[3].z * mul, h[3].w * mul, __builtin_amdgcn_cvt_pk_fp8_f32(h[3].x * mul, h[3].y * mul, 0, false), true);
    *(GAS v4u*)(x8 + 16 * lane) = o;
    v4u b0, b1;
    b0.x = pk2(h[0].x, h[0].y); b0.y = pk2(h[0].z, h[0].w); b0.z = pk2(h[1].x, h[1].y); b0.w = pk2(h[1].z, h[1].w); b1.x = pk2(h[2].x, h[2].y); b1.y = pk2(h[2].z, h[2].w); b1.z = pk2(h[3].x, h[3].y); b1.w = pk2(h[3].z, h[3].w);
    *(GAS v4u*)(h16 + 16 * lane) = b0; *(GAS v4u*)(h16 + 16 * lane + 8) = b1;
    if (lane == 0) { ssq[0] = s; ssq[1] = 0.f; ssq[2] = 0.f; ssq[3] = 0.f; sxq[0] = sc; sxq[1] = sc; sxq[2] = sc; sxq[3] = sc; }
}
__device__ __forceinline__ void rms_rows4_to_bf16(int lane, const float* xrow, bf16* orow, float* rs) {
    asm volatile("" : "+v"(lane));
    f32x4 v[4][4]; float s[4];
#pragma unroll
    for (int rr = 0; rr < 4; ++rr) { const GAS f32x4* xr = (const GAS f32x4*)(xrow + (size_t)rr * D) + lane;
#pragma unroll
        for (int jj = 0; jj < 4; ++jj) v[rr][jj] = xr[64 * jj]; }
#pragma unroll
    for (int rr = 0; rr < 4; ++rr) { float a = 0.f;
#pragma unroll
        for (int jj = 0; jj < 4; ++jj) a += (v[rr][jj].x * v[rr][jj].x + v[rr][jj].y * v[rr][jj].y) + (v[rr][jj].z * v[rr][jj].z + v[rr][jj].w * v[rr][jj].w);
        s[rr] = a; }
#pragma unroll
    for (int rr = 0; rr < 4; ++rr) { GAS unsigned long long* o8 = (GAS unsigned long long*)(orow + (size_t)rr * D) + lane;
#pragma unroll
        for (int jj = 0; jj < 4; ++jj) o8[64 * jj] = (unsigned long long)pk2(v[rr][jj].x, v[rr][jj].y) | ((unsigned long long)pk2(v[rr][jj].z, v[rr][jj].w) << 32); }
#pragma unroll
    for (int o = 1; o < 64; o <<= 1) {
#pragma unroll
        for (int rr = 0; rr < 4; ++rr) s[rr] += __shfl_xor(s[rr], o); }
    if (lane < 4) { const float sv = (lane == 0) ? s[0] : (lane == 1) ? s[1] : (lane == 2) ? s[2] : s[3]; rs[lane] = 1.f / sqrtf(sv * (1.f / D) + EPS); }
}
template <bool PERM_IN>
__device__ __forceinline__ void p0_transpose_item(const float* W, int K, int N, bf16* WT, LAS float* scr, int item, int lane, const float* ks = nullptr  ) {
    const int nblk = N / 32, kb = item / nblk, nb = item % nblk, k0 = 64 * kb, n0 = 32 * nb;
    int ns = n0;
    if (PERM_IN && n0 >= 1024 && n0 < 3072) { const int q = n0 - 1024; ns = (((q >> 7) & 1) ? 2048 : 1024) + 128 * (q >> 8) + (q & 127); }
    float tv[32];
#pragma unroll
    for (int i = 0; i < 32; ++i) tv[i] = W[(size_t)(k0 + 2 * i + (lane >> 5)) * N + ns + (lane & 31)];
    if (ks) {
#pragma unroll
        for (int i = 0; i < 32; ++i) tv[i] *= ks[k0 + 2 * i + (lane >> 5)]; }
#pragma unroll
    for (int i = 0; i < 32; ++i) scr[(2 * i + (lane >> 5)) * 33 + (lane & 31)] = tv[i];
    LDS_WAIT(); asm volatile("" ::: "memory");
    const int c = lane & 7;
#pragma unroll
    for (int j = 0; j < 4; ++j) { const int n = (lane >> 3) + 8 * j; const LAS float* s = scr + (8 * c) * 33 + n;
        v4u o; o.x = pk2(s[0 * 33], s[1 * 33]); o.y = pk2(s[2 * 33], s[3 * 33]); o.z = pk2(s[4 * 33], s[5 * 33]); o.w = pk2(s[6 * 33], s[7 * 33]);
        *(GAS v4u*)(WT + (size_t)(n0 + n) * K + k0 + 8 * c) = o; }
    LDS_WAIT(); asm volatile("" ::: "memory");
}
template <int NS>
__device__ __forceinline__ void fold_tile(LAS float* sm, const float* Ap, int sAi, int sAk, const float* As, const float* Bp, int sBj, bf16* Cp, int ldc, int tid) {
    LAS float* sA = sm; LAS float* sB = sm + 32 * 68;
    float ra[NS][4], rb[NS][4];
#pragma unroll
    for (int sl = 0; sl < NS; ++sl)
#pragma unroll
        for (int r = 0; r < 4; ++r) { const int e = tid + 512 * r; int i, kq;
            if (sAk == 1) { kq = e & 31; i = e >> 5; } else { i = e & 63; kq = e >> 6; }
            float a = Ap[(size_t)i * sAi + (size_t)(sl * 32 + kq) * sAk]; if (As) a *= As[sl * 32 + kq]; ra[sl][r] = a;
            rb[sl][r] = Bp[(size_t)(e >> 5) * sBj + sl * 32 + (e & 31)]; }
    float acc[2][4];
#pragma unroll
    for (int q = 0; q < 2; ++q)
#pragma unroll
        for (int p = 0; p < 4; ++p) acc[q][p] = 0.f;
    const int tj4 = (tid & 15) * 4, ti2 = (tid >> 4) * 2;
#pragma unroll
    for (int sl = 0; sl < NS; ++sl) {
#pragma unroll
        for (int r = 0; r < 4; ++r) { const int e = tid + 512 * r; int i, kq;
            if (sAk == 1) { kq = e & 31; i = e >> 5; } else { i = e & 63; kq = e >> 6; }
            sA[kq * 68 + i] = ra[sl][r]; sB[(e & 31) * 68 + (e >> 5)] = rb[sl][r]; }
        __syncthreads();
#pragma unroll 8
        for (int kk = 0; kk < 32; ++kk) { const f32x4 bq = *(const LAS f32x4*)(sB + kk * 68 + tj4); const float a0 = sA[kk * 68 + ti2], a1 = sA[kk * 68 + ti2 + 1];
            acc[0][0] += a0 * bq.x; acc[0][1] += a0 * bq.y; acc[0][2] += a0 * bq.z; acc[0][3] += a0 * bq.w;
            acc[1][0] += a1 * bq.x; acc[1][1] += a1 * bq.y; acc[1][2] += a1 * bq.z; acc[1][3] += a1 * bq.w; }
        __syncthreads();
    }
#pragma unroll
    for (int q = 0; q < 2; ++q) *(GAS unsigned long long*)(Cp + (size_t)(ti2 + q) * ldc + tj4) = (unsigned long long)pk2(acc[q][0], acc[q][1]) | ((unsigned long long)pk2(acc[q][2], acc[q][3]) << 32);
}
template <int NS, int TJ, bool A_ICONTIG>
__device__ __forceinline__ void fold_wave(LAS float* sm, const float* Ap, int sA, const float* As, const float* Bp, int sBj, bf16* Cp, int ldc, int lane, const float* Cs = nullptr  ) {
    constexpr int NB = TJ / 8, RB = TJ / 8;
    LAS float* sAl = sm; LAS float* sBl = sm + 32 * 36;
    const int l8 = lane >> 3, l7 = lane & 7;
    f32x4 ra[4], rb[RB];
#define FW_LOAD(sl_) do { _Pragma("unroll") for (int r = 0; r < 4; ++r) { \
            if (A_ICONTIG) { const int kq = l8 + 8 * r; f32x4 a = *(const GAS f32x4*)(Ap + (size_t)((sl_) * 32 + kq) * sA + l7 * 4); const float sc = As[(sl_) * 32 + kq]; ra[r] = a * sc; } \
            else ra[r] = *(const GAS f32x4*)(Ap + (size_t)(l8 + 8 * r) * sA + (sl_) * 32 + l7 * 4); } \
        _Pragma("unroll") for (int r = 0; r < RB; ++r) rb[r] = *(const GAS f32x4*)(Bp + (size_t)(l8 + 8 * r) * sBj + (sl_) * 32 + l7 * 4); } while (0)
    FW_LOAD(0);
    float acc[4][NB];
#pragma unroll
    for (int p = 0; p < 4; ++p)
#pragma unroll
        for (int q = 0; q < NB; ++q) acc[p][q] = 0.f;
#pragma unroll
    for (int sl = 0; sl < NS; ++sl) {
#pragma unroll
        for (int r = 0; r < 4; ++r) {
            if (A_ICONTIG) *(LAS f32x4*)(sAl + (l8 + 8 * r) * 36 + l7 * 4) = ra[r];
            else { const int i = l8 + 8 * r, kq = l7 * 4; sAl[kq * 36 + i] = ra[r].x; sAl[(kq + 1) * 36 + i] = ra[r].y; sAl[(kq + 2) * 36 + i] = ra[r].z; sAl[(kq + 3) * 36 + i] = ra[r].w; } }
#pragma unroll
        for (int r = 0; r < RB; ++r) { const int jj = l8 + 8 * r, kq = l7 * 4; sBl[kq * 36 + jj] = rb[r].x; sBl[(kq + 1) * 36 + jj] = rb[r].y; sBl[(kq + 2) * 36 + jj] = rb[r].z; sBl[(kq + 3) * 36 + jj] = rb[r].w; }
        LDS_WAIT(); asm volatile("" ::: "memory");
        if (sl + 1 < NS) FW_LOAD(sl + 1);
#pragma unroll 8
        for (int kk = 0; kk < 32; ++kk) { const f32x4 a4 = *(const LAS f32x4*)(sAl + kk * 36 + 4 * l8);
            float bq[NB];
            if (NB == 4) { const f32x4 b4 = *(const LAS f32x4*)(sBl + kk * 36 + 4 * l7); bq[0] = b4.x; bq[1] = b4.y; bq[2] = b4.z; bq[NB - 1] = b4.w; }
            else { bq[0] = sBl[kk * 36 + 2 * l7]; bq[NB - 1] = sBl[kk * 36 + 2 * l7 + 1]; }
#pragma unroll
            for (int q = 0; q < NB; ++q) { acc[0][q] += a4.x * bq[q]; acc[1][q] += a4.y * bq[q]; acc[2][q] += a4.z * bq[q]; acc[3][q] += a4.w * bq[q]; } }
        LDS_WAIT(); asm volatile("" ::: "memory");
    }
#undef FW_LOAD
    if (Cs) {
#pragma unroll
        for (int q = 0; q < NB; ++q) { const float cs = Cs[NB * l7 + q];
#pragma unroll
            for (int p = 0; p < 4; ++p) acc[p][q] *= cs; } }
#pragma unroll
    for (int p = 0; p < 4; ++p) { bf16* cp = Cp + (size_t)(4 * l8 + p) * ldc + NB * l7;
        if (NB == 4) *(GAS unsigned long long*)cp = (unsigned long long)pk2(acc[p][0], acc[p][1]) | ((unsigned long long)pk2(acc[p][2], acc[p][NB - 1]) << 32);
        else *(GAS unsigned*)cp = pk2(acc[p][0], acc[p][NB - 1]); }
}
__device__ __forceinline__ void rms_row_to_bf16(int lane, const float* xrow, const float* g, bf16* orow) {
    const GAS f32x4* xr = (const GAS f32x4*)xrow + lane; const GAS f32x4* gr = (const GAS f32x4*)g + lane;
    f32x4 v[4]; float s = 0.f;
#pragma unroll
    for (int j = 0; j < 4; ++j) { v[j] = xr[64 * j]; s += (v[j].x * v[j].x + v[j].y * v[j].y) + (v[j].z * v[j].z + v[j].w * v[j].w); }
    const float rstd = 1.f / sqrtf(wave_sum(s) * (1.f / D) + EPS);
    GAS unsigned long long* o8 = (GAS unsigned long long*)orow + lane;
#pragma unroll
    for (int j = 0; j < 4; ++j) { const f32x4 gg = gr[64 * j];
        o8[64 * j] = (unsigned long long)pk2(v[j].x * rstd * gg.x, v[j].y * rstd * gg.y) | ((unsigned long long)pk2(v[j].z * rstd * gg.z, v[j].w * rstd * gg.w) << 32); }
}
__device__ __forceinline__ v4u ldv(const bf16* p) { return *(const GAS v4u*)p; }
template <int WIN> __device__ __forceinline__ void p2_pool(const bf16* pcol  , bf16* ocol  , int t0, bool first) {
    for (int hf = 0; hf < 2; ++hf) {
        const int base = t0 + 8 * hf;
        v4u raw[WIN + 7];
#pragma unroll
        for (int q = 0; q < WIN + 7; ++q) { const int rel = 8 * hf + q - (WIN - 1);
            raw[q] = (rel >= 0 || !first) ? ldv(pcol + (size_t)(base + q - (WIN - 1)) * 3072) : (v4u){0u, 0u, 0u, 0u}; }
        float S[8];
#pragma unroll
        for (int e = 0; e < 8; ++e) S[e] = 0.f;
#pragma unroll
        for (int q = 0; q < WIN - 1; ++q) { float f[8]; unpack8(raw[q], f);
#pragma unroll
            for (int e = 0; e < 8; ++e) S[e] += f[e]; }
#pragma unroll
        for (int r = 0; r < 8; ++r) {
            float pn[8], o[8]; unpack8(raw[r + WIN - 1], pn);
#pragma unroll
            for (int e = 0; e < 8; ++e) S[e] += pn[e];
            const int sr = 8 * hf + r;
            const float inv = (first && sr < WIN - 1) ? 1.0f / (float)(sr + 1) : 1.0f / (float)WIN;
#pragma unroll
            for (int e = 0; e < 8; ++e) o[e] = S[e] * inv - pn[e];
            *(GAS v4u*)(ocol + (size_t)(base + r) * D) = pack8(o);
            float po[8]; unpack8(raw[r], po);
#pragma unroll
            for (int e = 0; e < 8; ++e) S[e] -= po[e];
        }
        asm volatile("" ::: "memory");
    }
}
__device__ __forceinline__ void p2_conv_pool(Frame& F, const bf16* PB, const float* conv_w, bf16* AIN, bf16* POOLED) {
    const int gw = F.vcu * NWAVES + F.wave, NGW = F.G * NWAVES, lane = F.lane;
    for (int it = gw; it < 4 * (T / 32); it += NGW) {
        const int g = it & 3, rc = (it >> 2) * 2 + (lane >> 5), col = g * 256 + (lane & 31) * 8, t0 = rc * 16; const bool first = (t0 & (SEQ - 1)) == 0;
        float w0[8], w1[8], w2[8];
        { const f32x4 a = *(const GAS f32x4*)(conv_w + col), b = *(const GAS f32x4*)(conv_w + col + 4); w0[0] = a.x; w0[1] = a.y; w0[2] = a.z; w0[3] = a.w; w0[4] = b.x; w0[5] = b.y; w0[6] = b.z; w0[7] = b.w; }
        { const f32x4 a = *(const GAS f32x4*)(conv_w + D + col), b = *(const GAS f32x4*)(conv_w + D + col + 4); w1[0] = a.x; w1[1] = a.y; w1[2] = a.z; w1[3] = a.w; w1[4] = b.x; w1[5] = b.y; w1[6] = b.z; w1[7] = b.w; }
        { const f32x4 a = *(const GAS f32x4*)(conv_w + 2 * D + col), b = *(const GAS f32x4*)(conv_w + 2 * D + col + 4); w2[0] = a.x; w2[1] = a.y; w2[2] = a.z; w2[3] = a.w; w2[4] = b.x; w2[5] = b.y; w2[6] = b.z; w2[7] = b.w; }
        float um2[8], um1[8];
        { const v4u u2 = first ? (v4u){0u, 0u, 0u, 0u} : ldv(PB + (size_t)(t0 - 2) * 3072 + 1024 + col), u1 = first ? (v4u){0u, 0u, 0u, 0u} : ldv(PB + (size_t)(t0 - 1) * 3072 + 1024 + col);
          unpack8(u2, um2); unpack8(u1, um1); }
        for (int hf = 0; hf < 2; ++hf) {
            v4u rb[8], ru[8];
#pragma unroll
            for (int r = 0; r < 8; ++r) { const size_t rowb = (size_t)(t0 + 8 * hf + r) * 3072 + col; rb[r] = ldv(PB + rowb); ru[r] = ldv(PB + rowb + 1024); }
#pragma unroll
            for (int r = 0; r < 8; ++r) { float b[8], uu[8], o[8]; unpack8(rb[r], b); unpack8(ru[r], uu);
#pragma unroll
                for (int e = 0; e < 8; ++e) { o[e] = b[e] * (w0[e] * um2[e] + w1[e] * um1[e] + w2[e] * uu[e]); um2[e] = um1[e]; um1[e] = uu[e]; }
                *(GAS v4u*)(AIN + (size_t)(t0 + 8 * hf + r) * D + col) = pack8(o); }
            asm volatile("" ::: "memory");
        }
        asm volatile("" ::: "memory");
        const bf16* pcol = PB + 2048 + col; bf16* ocol = POOLED + col;
        if (g == 0) p2_pool<2>(pcol, ocol, t0, first); else if (g == 1) p2_pool<4>(pcol, ocol, t0, first); else if (g == 2) p2_pool<8>(pcol, ocol, t0, first); else p2_pool<16>(pcol, ocol, t0, first);
    }
}

typedef int v4i __attribute__((ext_vector_type(4)));
__device__ __forceinline__ unsigned fkey(float f) { const unsigned u = __float_as_uint(f); return (u & 0x80000000u) ? ~u : (u | 0x80000000u); }
__device__ __forceinline__ float fkey_inv(unsigned k) { return __uint_as_float((k & 0x80000000u) ? (k & 0x7fffffffu) : ~k); }
__device__ __forceinline__ void ce_desc(unsigned& a, unsigned& b) { const unsigned hi = a > b ? a : b, lo = a > b ? b : a; a = hi; b = lo; }
template <int K, int J> __device__ __forceinline__ void bitonic_stage(unsigned (&a)[16]) {
#pragma unroll
    for (int i = 0; i < 16; ++i) { const int l = i ^ J; if (l > i) { if ((i & K) == 0) ce_desc(a[i], a[l]); else ce_desc(a[l], a[i]); } }
}
__device__ __forceinline__ void bitonic_merge16(unsigned (&a)[16]) { bitonic_stage<16, 8>(a); bitonic_stage<16, 4>(a); bitonic_stage<16, 2>(a); bitonic_stage<16, 1>(a); }
__device__ __forceinline__ void bitonic_sort16(unsigned (&a)[16]) {
    bitonic_stage<2, 1>(a); bitonic_stage<4, 2>(a); bitonic_stage<4, 1>(a); bitonic_stage<8, 4>(a); bitonic_stage<8, 2>(a); bitonic_stage<8, 1>(a); bitonic_merge16(a);
}
__device__ __forceinline__ void top16_merge(unsigned (&top)[16], unsigned (&ch)[16]) {
#pragma unroll
    for (int i = 0; i < 16; ++i) top[i] = top[i] > ch[15 - i] ? top[i] : ch[15 - i];
    bitonic_merge16(top);
}
__device__ __forceinline__ unsigned hkey(unsigned h) { return (h & 0x8000u) ? (~h & 0xffffu) : (h | 0x8000u); }
__device__ __forceinline__ float hkey_inv(unsigned k16) { const unsigned h = (k16 & 0x8000u) ? (k16 & 0x7fffu) : (~k16 & 0xffffu); return (float)__builtin_bit_cast(_Float16, (unsigned short)h); }
__device__ __forceinline__ unsigned pkh2(float a, float b) { return __builtin_bit_cast(unsigned, __builtin_amdgcn_cvt_pkrtz(a, b)); }
__device__ __forceinline__ void p7_topk(Frame& F, const unsigned short* SC, const float* SSQ, int* IDX, float* GATE, int b_lo, int b_hi, int b_step, bool handoff) {
    constexpr int RS = 36;
    LAS unsigned* stg = (LAS unsigned*)(F.lds + RING_OFF + F.wave * P7_WAVE_BYTES + P7_STAGE_OFF);
    const int lane = F.lane, r8 = lane >> 3, c = lane & 7;
    for (int batch = b_lo; batch < b_hi; batch += b_step) {
        const unsigned short* base = SC + (size_t)batch * (8 * NSC);
        unsigned top[16], top1[16];
#pragma unroll
        for (int i = 0; i < 16; ++i) { top[i] = 0u; top1[i] = 0u; }
        v4u ld[8];
#pragma unroll
        for (int q = 0; q < 8; ++q) ld[q] = *(const GAS v4u*)(base + (size_t)(8 * q + r8) * 256 + c * 8);
        for (int ch = 0; ch < 4; ++ch) {
#pragma unroll
            for (int q = 0; q < 8; ++q) *(LAS v4u*)(stg + (8 * q + r8) * RS + c * 4) = ld[q];
            if (ch < 3) {
#pragma unroll
                for (int q = 0; q < 8; ++q) ld[q] = *(const GAS v4u*)(base + (size_t)(8 * q + r8) * 256 + (ch + 1) * 64 + c * 8);
            }
            LDS_WAIT(); asm volatile("" ::: "memory");
#pragma unroll
            for (int hf = 0; hf < 4; ++hf) {
                unsigned k[16];
                const unsigned pb = 127u - (unsigned)((ch & 1) * 64 + hf * 16);
#pragma unroll
                for (int q = 0; q < 2; ++q) { const v4u v = *(const LAS v4u*)(stg + lane * RS + hf * 8 + q * 4);
                    const unsigned w0 = v.x, w1 = v.y, w2 = v.z, w3 = v.w;
                    k[8 * q] = (hkey(w0 & 0xffffu) << 16) | (pb - (unsigned)(8 * q)); k[8 * q + 1] = (hkey(w0 >> 16) << 16) | (pb - (unsigned)(8 * q + 1));
                    k[8 * q + 2] = (hkey(w1 & 0xffffu) << 16) | (pb - (unsigned)(8 * q + 2)); k[8 * q + 3] = (hkey(w1 >> 16) << 16) | (pb - (unsigned)(8 * q + 3));
                    k[8 * q + 4] = (hkey(w2 & 0xffffu) << 16) | (pb - (unsigned)(8 * q + 4)); k[8 * q + 5] = (hkey(w2 >> 16) << 16) | (pb - (unsigned)(8 * q + 5));
                    k[8 * q + 6] = (hkey(w3 & 0xffffu) << 16) | (pb - (unsigned)(8 * q + 6)); k[8 * q + 7] = (hkey(w3 >> 16) << 16) | (pb - (unsigned)(8 * q + 7)); }
                bitonic_sort16(k);
                top16_merge(top, k);
            }
            LDS_WAIT(); asm volatile("" ::: "memory");
            if (ch == 1) {
#pragma unroll
                for (int i = 0; i < 16; ++i) { top1[i] = top[i]; top[i] = 0u; }
            }
        }
        LAS int* tab = (LAS int*)stg + lane * 33;
        float v1[16], v2[16];
#pragma unroll
        for (int i = 0; i < 16; ++i) { tab[i] = 127 - (int)(top1[i] & 0x7fu); tab[16 + i] = 127 - (int)(top[i] & 0x7fu); v1[i] = hkey_inv(top1[i] >> 16); v2[i] = hkey_inv(top[i] >> 16); }
#define P7_KEY(i, j) ((fkey(v1[i] + v2[j]) & ~0xffu) | (unsigned)((i) * 16 + (j)))
        unsigned best[16], cb[16];
#pragma unroll
        for (int jj = 0; jj < 16; ++jj) best[jj] = P7_KEY(0, jj);
#pragma unroll
        for (int jj = 0; jj < 8; ++jj) { cb[jj] = P7_KEY(1, jj); cb[8 + jj] = 0u; }
        top16_merge(best, cb);
        cb[0] = P7_KEY(2, 0); cb[1] = P7_KEY(2, 1); cb[2] = P7_KEY(2, 2); cb[3] = P7_KEY(2, 3); cb[4] = P7_KEY(2, 4); cb[5] = P7_KEY(3, 0); cb[6] = P7_KEY(3, 1); cb[7] = P7_KEY(3, 2);
        cb[8] = P7_KEY(3, 3); cb[9] = P7_KEY(4, 0); cb[10] = P7_KEY(4, 1); cb[11] = P7_KEY(4, 2); cb[12] = 0u; cb[13] = 0u; cb[14] = 0u; cb[15] = 0u;
        bitonic_sort16(cb); top16_merge(best, cb);
        cb[0] = P7_KEY(5, 0); cb[1] = P7_KEY(5, 1); cb[2] = P7_KEY(6, 0); cb[3] = P7_KEY(6, 1); cb[4] = P7_KEY(7, 0); cb[5] = P7_KEY(7, 1); cb[6] = P7_KEY(8, 0); cb[7] = P7_KEY(9, 0);
        cb[8] = P7_KEY(10, 0); cb[9] = P7_KEY(11, 0); cb[10] = P7_KEY(12, 0); cb[11] = P7_KEY(13, 0); cb[12] = P7_KEY(14, 0); cb[13] = P7_KEY(15, 0); cb[14] = 0u; cb[15] = 0u;
        bitonic_sort16(cb); top16_merge(best, cb);
#undef P7_KEY
        LDS_WAIT(); asm volatile("" ::: "memory");
        int eo[16]; float go[16]; float sm = 0.f;
        const float bmax = fkey_inv(best[0] & ~0xffu);
        const f32x4 ssq = *(const GAS f32x4*)(SSQ + (size_t)(batch * 8 + (lane >> 3)) * 4);
        const float rstd = 1.0f / sqrtf(((ssq.x + ssq.y) + (ssq.z + ssq.w)) * (1.0f / D) + EPS);
#pragma unroll
        for (int r = 0; r < 16; ++r) { const int ij = (int)(best[r] & 0xffu); eo[r] = tab[ij >> 4] * 128 + tab[16 + (ij & 15)]; go[r] = __expf((fkey_inv(best[r] & ~0xffu) - bmax) * rstd); sm += go[r]; }
        const float inv = 1.0f / sm;
        if (handoff) {
            LAS unsigned char* reg = F.lds + RING_OFF + (batch - 8 * F.vcu) * P7_WAVE_BYTES;
            LAS int* li = (LAS int*)(reg + P7_IDX_OFF) + lane * 16; LAS unsigned* lg = (LAS unsigned*)(reg + P7_OUT_OFF) + lane * 8;
#pragma unroll
            for (int q = 0; q < 4; ++q) *(LAS v4i*)(li + 4 * q) = (v4i){eo[4 * q], eo[4 * q + 1], eo[4 * q + 2], eo[4 * q + 3]};
#pragma unroll
            for (int q = 0; q < 2; ++q) *(LAS v4u*)(lg + 4 * q) = (v4u){pkh2(go[8 * q] * inv, go[8 * q + 1] * inv), pkh2(go[8 * q + 2] * inv, go[8 * q + 3] * inv), pkh2(go[8 * q + 4] * inv, go[8 * q + 5] * inv), pkh2(go[8 * q + 6] * inv, go[8 * q + 7] * inv)};
        } else {
        int* ip = IDX + (size_t)batch * 1024 + lane * 16; float* gp = GATE + (size_t)batch * 1024 + lane * 16;
#pragma unroll
        for (int q = 0; q < 4; ++q) { *(GAS v4i*)(ip + 4 * q) = (v4i){eo[4 * q], eo[4 * q + 1], eo[4 * q + 2], eo[4 * q + 3]};
            *(GAS f32x4*)(gp + 4 * q) = (f32x4){go[4 * q] * inv, go[4 * q + 1] * inv, go[4 * q + 2] * inv, go[4 * q + 3] * inv}; }
        }
        LDS_WAIT(); asm volatile("" ::: "memory");
    }
}
typedef __bf16 bf16x2_t __attribute__((ext_vector_type(2)));
__device__ __forceinline__ float dpp_f(float v, const int ctrl_sel) {
    const int x = __builtin_bit_cast(int, v);
    int r;
    if (ctrl_sel == 0) r = __builtin_amdgcn_update_dpp(0, x, 0xB1, 0xF, 0xF, true);
    else if (ctrl_sel == 1) r = __builtin_amdgcn_update_dpp(0, x, 0x4E, 0xF, 0xF, true);
    else if (ctrl_sel == 2) r = __builtin_amdgcn_update_dpp(0, x, 0x141, 0xF, 0xF, true);
    else r = __builtin_amdgcn_update_dpp(0, x, 0x128, 0xF, 0xF, true);
    return __builtin_bit_cast(float, r);
}
__device__ __forceinline__ float sum8(float v) { v += dpp_f(v, 0); v += dpp_f(v, 1); v += dpp_f(v, 2); return v; }
__device__ __forceinline__ float dot2bf(unsigned a, unsigned b, float acc) { return __builtin_amdgcn_fdot2_f32_bf16(__builtin_bit_cast(bf16x2_t, a), __builtin_bit_cast(bf16x2_t, b), acc, false); }
__device__ __forceinline__ float dot8(const v4u d, const v4u x, float acc) {
    acc = dot2bf(d.x, x.x, acc); acc = dot2bf(d.y, x.y, acc); acc = dot2bf(d.z, x.z, acc); acc = dot2bf(d.w, x.w, acc);
    return acc;
}
__device__ __forceinline__ float gelu_erf(float v) {
    const float t = __builtin_amdgcn_rcpf(fabsf(v) * 0.2316418882f + 1.0f);
    float q = t * 0.5307027145f + (-0.7265760135f); q = q * t + 0.7107068705f; q = q * t + (-0.142248368f); q = q * t + 0.127414796f; q = q * t;
    const float m = v * (q * __builtin_amdgcn_exp2f((v * v) * (-0.72134752044f)));
    return v < 0.f ? m : v - m;
}
__device__ __forceinline__ void p8_issue(v4u (&d)[8], const LAS int* li8, __amdgpu_buffer_rsrc_t rs, int soff, int c16) {
    const v4i e0 = *(const LAS v4i*)li8, e1 = *(const LAS v4i*)(li8 + 4);
    d[0] = __builtin_amdgcn_raw_buffer_load_b128(rs, e0.x * 128 + c16, soff, 0); d[1] = __builtin_amdgcn_raw_buffer_load_b128(rs, e0.y * 128 + c16, soff, 0);
    d[2] = __builtin_amdgcn_raw_buffer_load_b128(rs, e0.z * 128 + c16, soff, 0); d[3] = __builtin_amdgcn_raw_buffer_load_b128(rs, e0.w * 128 + c16, soff, 0);
    d[4] = __builtin_amdgcn_raw_buffer_load_b128(rs, e1.x * 128 + c16, soff, 0); d[5] = __builtin_amdgcn_raw_buffer_load_b128(rs, e1.y * 128 + c16, soff, 0);
    d[6] = __builtin_amdgcn_raw_buffer_load_b128(rs, e1.z * 128 + c16, soff, 0); d[7] = __builtin_amdgcn_raw_buffer_load_b128(rs, e1.w * 128 + c16, soff, 0);
}
typedef float f32x2 __attribute__((ext_vector_type(2)));
__device__ __forceinline__ f32x2 fp8lo(unsigned w) { return __builtin_amdgcn_cvt_pk_f32_fp8((int)w, false); }
__device__ __forceinline__ f32x2 fp8hi(unsigned w) { return __builtin_amdgcn_cvt_pk_f32_fp8((int)w, true); }
__device__ __forceinline__ float dot16q(const v4u d, const f32x2 (&xx)[8]) {
    f32x2 acc = fp8lo(d.x) * xx[0];
    acc += fp8hi(d.x) * xx[1]; acc += fp8lo(d.y) * xx[2]; acc += fp8hi(d.y) * xx[3]; acc += fp8lo(d.z) * xx[4]; acc += fp8hi(d.z) * xx[5]; acc += fp8lo(d.w) * xx[6]; acc += fp8hi(d.w) * xx[7];
    return acc.x + acc.y;
}
__device__ __forceinline__ void p8_compute_u(const v4u (&d)[8], const f32x2 (&xx)[8], LAS float* lz8, int c) {
    float p[8];
#pragma unroll
    for (int g = 0; g < 8; ++g) p[g] = sum8(dot16q(d[g], xx));
    if (c == 0) {
#pragma unroll
        for (int q = 0; q < 2; ++q) { f32x4 z = *(LAS f32x4*)(lz8 + 4 * q); z.x += p[4 * q]; z.y += p[4 * q + 1]; z.z += p[4 * q + 2]; z.w += p[4 * q + 3]; *(LAS f32x4*)(lz8 + 4 * q) = z; }
    }
}
__device__ __forceinline__ void p8_compute_v(const v4u (&d)[8], const LAS float* la8, f32x2 (&y)[8]) {
    const f32x4 a0 = *(const LAS f32x4*)la8, a1 = *(const LAS f32x4*)(la8 + 4);
    const float a[8] = {a0.x, a0.y, a0.z, a0.w, a1.x, a1.y, a1.z, a1.w};
#pragma unroll
    for (int g = 0; g < 8; ++g) { const f32x2 ag = {a[g], a[g]};
        y[0] += ag * fp8lo(d[g].x); y[1] += ag * fp8hi(d[g].x); y[2] += ag * fp8lo(d[g].y); y[3] += ag * fp8hi(d[g].y);
        y[4] += ag * fp8lo(d[g].z); y[5] += ag * fp8hi(d[g].z); y[6] += ag * fp8lo(d[g].w); y[7] += ag * fp8hi(d[g].w); }
}
__device__ __forceinline__ void p8_unpack_x(f32x2 (&xx)[8], const v4u a, const v4u b) {
    xx[0] = (f32x2){bflo(a.x), bfhi(a.x)}; xx[1] = (f32x2){bflo(a.y), bfhi(a.y)}; xx[2] = (f32x2){bflo(a.z), bfhi(a.z)}; xx[3] = (f32x2){bflo(a.w), bfhi(a.w)};
    xx[4] = (f32x2){bflo(b.x), bfhi(b.x)}; xx[5] = (f32x2){bflo(b.y), bfhi(b.y)}; xx[6] = (f32x2){bflo(b.z), bfhi(b.z)}; xx[7] = (f32x2){bflo(b.w), bfhi(b.w)};
}
typedef unsigned u32x2s __attribute__((ext_vector_type(2)));
__device__ __forceinline__ float u2f(unsigned u) { return __builtin_bit_cast(float, u); }
__device__ __forceinline__ float swap32_add(float a, float b) { const u32x2s r = __builtin_amdgcn_permlane32_swap(__builtin_bit_cast(unsigned, a), __builtin_bit_cast(unsigned, b), false, false); return u2f(r.x) + u2f(r.y); }
__device__ __forceinline__ float swap16_add(float a, float b) { const u32x2s r = __builtin_amdgcn_permlane16_swap(__builtin_bit_cast(unsigned, a), __builtin_bit_cast(unsigned, b), false, false); return u2f(r.x) + u2f(r.y); }
__device__ __forceinline__ void p8_reduce_heads(const f32x2 (&y)[8], int j, float& r0, float& r1) {
    float v[8], w[4];
#pragma unroll
    for (int q = 0; q < 4; ++q) { v[2 * q] = swap32_add(y[q].x, y[4 + q].x); v[2 * q + 1] = swap32_add(y[q].y, y[4 + q].y); }
#pragma unroll
    for (int q = 0; q < 4; ++q) w[q] = swap16_add(v[q], v[4 + q]);
    const bool odd = (j & 1) != 0;
    const float s0 = odd ? w[0] : w[2], s1 = odd ? w[1] : w[3], k0 = odd ? w[2] : w[0], k1 = odd ? w[3] : w[1];
    r0 = k0 + dpp_f(s0, 3); r1 = k1 + dpp_f(s1, 3);
}
typedef _Float16 h16x2 __attribute__((ext_vector_type(2)));
__device__ __forceinline__ h16x2 q2h_lo(unsigned w) { return __builtin_amdgcn_cvt_scalef32_pk_f16_fp8(w, 1.0f, false); }
__device__ __forceinline__ h16x2 q2h_hi(unsigned w) { return __builtin_amdgcn_cvt_scalef32_pk_f16_fp8(w, 1.0f, true); }
__device__ __forceinline__ h16x2 f2h(float a, float b) { h16x2 r; r.x = (_Float16)a; r.y = (_Float16)b; return r; }
__device__ __forceinline__ float dot16h(const v4u d, const h16x2 (&xh)[8]) {
    float acc = 0.f;
    acc = __builtin_amdgcn_fdot2(q2h_lo(d.x), xh[0], acc, false); acc = __builtin_amdgcn_fdot2(q2h_hi(d.x), xh[1], acc, false);
    acc = __builtin_amdgcn_fdot2(q2h_lo(d.y), xh[2], acc, false); acc = __builtin_amdgcn_fdot2(q2h_hi(d.y), xh[3], acc, false);
    acc = __builtin_amdgcn_fdot2(q2h_lo(d.z), xh[4], acc, false); acc = __builtin_amdgcn_fdot2(q2h_hi(d.z), xh[5], acc, false);
    acc = __builtin_amdgcn_fdot2(q2h_lo(d.w), xh[6], acc, false); acc = __builtin_amdgcn_fdot2(q2h_hi(d.w), xh[7], acc, false);
    return acc;
}
__device__ __forceinline__ void p8h_compute_u(const v4u (&d)[8], const h16x2 (&xh)[8], LAS float* lz8, int c) {
    float p[8];
#pragma unroll
    for (int g = 0; g < 8; ++g) p[g] = sum8(dot16h(d[g], xh));
    if (c == 0) {
#pragma unroll
        for (int q = 0; q < 2; ++q) { f32x4 z = *(LAS f32x4*)(lz8 + 4 * q); z.x += p[4 * q]; z.y += p[4 * q + 1]; z.z += p[4 * q + 2]; z.w += p[4 * q + 3]; *(LAS f32x4*)(lz8 + 4 * q) = z; }
    }
}
__device__ __forceinline__ void p8h_unpack_x(h16x2 (&xh)[8], const v4u a, const v4u b) {
    xh[0] = f2h(bflo(a.x), bfhi(a.x)); xh[1] = f2h(bflo(a.y), bfhi(a.y)); xh[2] = f2h(bflo(a.z), bfhi(a.z)); xh[3] = f2h(bflo(a.w), bfhi(a.w));
    xh[4] = f2h(bflo(b.x), bfhi(b.x)); xh[5] = f2h(bflo(b.y), bfhi(b.y)); xh[6] = f2h(bflo(b.z), bfhi(b.z)); xh[7] = f2h(bflo(b.w), bfhi(b.w));
}
__device__ __forceinline__ void p8h_compute_v(const v4u (&d)[8], const LAS float* la8, h16x2 (&y)[8]) {
    const f32x4 a0 = *(const LAS f32x4*)la8, a1 = *(const LAS f32x4*)(la8 + 4);
    const float a[8] = {a0.x, a0.y, a0.z, a0.w, a1.x, a1.y, a1.z, a1.w};
#pragma unroll
    for (int g = 0; g < 8; ++g) { const _Float16 ah = (_Float16)a[g]; const h16x2 ag = {ah, ah};
        y[0] += ag * q2h_lo(d[g].x); y[1] += ag * q2h_hi(d[g].x); y[2] += ag * q2h_lo(d[g].y); y[3] += ag * q2h_hi(d[g].y);
        y[4] += ag * q2h_lo(d[g].z); y[5] += ag * q2h_hi(d[g].z); y[6] += ag * q2h_lo(d[g].w); y[7] += ag * q2h_hi(d[g].w); }
}
__device__ __forceinline__ long pk64(unsigned lo, unsigned hi) { return (long)(((unsigned long long)hi << 32) | lo); }
__device__ __forceinline__ void p8m_issue(v4u (&d)[8], const LAS int* lig, __amdgpu_buffer_rsrc_t rs, int soff, int q16) {
    const int e0 = lig[0], e1 = lig[16], e2 = lig[32], e3 = lig[48];
    d[0] = __builtin_amdgcn_raw_buffer_load_b128(rs, e0 * D + q16, soff, 0); d[1] = __builtin_amdgcn_raw_buffer_load_b128(rs, e0 * D + q16 + 64, soff, 0);
    d[2] = __builtin_amdgcn_raw_buffer_load_b128(rs, e1 * D + q16, soff, 0); d[3] = __builtin_amdgcn_raw_buffer_load_b128(rs, e1 * D + q16 + 64, soff, 0);
    d[4] = __builtin_amdgcn_raw_buffer_load_b128(rs, e2 * D + q16, soff, 0); d[5] = __builtin_amdgcn_raw_buffer_load_b128(rs, e2 * D + q16 + 64, soff, 0);
    d[6] = __builtin_amdgcn_raw_buffer_load_b128(rs, e3 * D + q16, soff, 0); d[7] = __builtin_amdgcn_raw_buffer_load_b128(rs, e3 * D + q16 + 64, soff, 0);
}
__device__ __forceinline__ float p8m_dot(const v4u xa, const v4u xb, const v4u d0, const v4u d1) {
    f32x4 acc = {0.f, 0.f, 0.f, 0.f};
    acc = __builtin_amdgcn_mfma_f32_16x16x32_fp8_fp8(pk64(xa.x, xa.y), pk64(d0.x, d0.y), acc, 0, 0, 0);
    acc = __builtin_amdgcn_mfma_f32_16x16x32_fp8_fp8(pk64(xa.z, xa.w), pk64(d0.z, d0.w), acc, 0, 0, 0);
    acc = __builtin_amdgcn_mfma_f32_16x16x32_fp8_fp8(pk64(xb.x, xb.y), pk64(d1.x, d1.y), acc, 0, 0, 0);
    acc = __builtin_amdgcn_mfma_f32_16x16x32_fp8_fp8(pk64(xb.z, xb.w), pk64(d1.z, d1.w), acc, 0, 0, 0);
    return acc[0];
}
__device__ __forceinline__ void p8m_compute_u(const v4u (&d)[8], const v4u xa, const v4u xb, LAS float* lzq, int q) {
    const float z0 = p8m_dot(xa, xb, d[0], d[1]), z1 = p8m_dot(xa, xb, d[2], d[3]), z2 = p8m_dot(xa, xb, d[4], d[5]), z3 = p8m_dot(xa, xb, d[6], d[7]);
    const float z = (q == 0) ? z0 : (q == 1) ? z1 : (q == 2) ? z2 : z3;
    *lzq += z;
}
__device__ __forceinline__ void p8s_compute_u(const v4u (&d)[8], const v4u xa, const v4u xb, LAS unsigned char* stage, LAS float* lz  , int lane, const float sxq  ) {
    const int j8 = lane >> 3, c = lane & 7, n = lane & 15, q = lane >> 4;
#pragma unroll
    for (int r = 0; r < 8; ++r) { const int row = j8 * 8 + r; *(LAS v4u*)(stage + row * 128 + ((c ^ (row >> 1)) & 7) * 16) = d[r]; }
    LDS_WAIT(); asm volatile("" ::: "memory");
    float z[4];
#pragma unroll
    for (int t = 0; t < 4; ++t) { const int row = 16 * t + n, sw = (row >> 1) & 7;
        const v4u d0 = *(const LAS v4u*)(stage + row * 128 + ((q ^ sw) & 7) * 16), d1 = *(const LAS v4u*)(stage + row * 128 + (((q + 4) ^ sw) & 7) * 16);
        z[t] = p8m_dot(xa, xb, d0, d1); }
    asm volatile("" ::: "memory");
    const float zq = (q == 0) ? z[0] : (q == 1) ? z[1] : (q == 2) ? z[2] : z[3];
    LAS float* p = lz + (2 * q + (n >> 3)) * 16 + (n & 7);
    *p += zq * sxq;
}
__device__ __forceinline__ void p8_peer(Frame& F, const unsigned char* X8, const float* SSQ, const float* SXQ, const unsigned char* U8, const unsigned char* V8, const float* SU, const float* SV, const int* IDX, const float* GATE, const bf16* H16, float* YOUT, bf16* OUT, const float* gfin, bool handoff) {
    LAS unsigned char* lstage = F.lds + RING_OFF + F.wave * P7_WAVE_BYTES + P7_STAGE_OFF;
    LAS int* lidx = (LAS int*)(F.lds + RING_OFF + F.wave * P7_WAVE_BYTES + P7_IDX_OFF);
    LAS float* lza = (LAS float*)(F.lds + RING_OFF + F.wave * P7_WAVE_BYTES + P7_ZA_OFF);
    LAS unsigned* lout = (LAS unsigned*)(F.lds + RING_OFF + F.wave * P7_WAVE_BYTES + P7_OUT_OFF);
    const int gw = F.vcu * NWAVES + F.wave, NGW = F.G * NWAVES, lane = F.lane, j = lane >> 3, c = lane & 7, c16 = c * 16;
    const __amdgpu_buffer_rsrc_t rsU = __builtin_amdgcn_make_buffer_rsrc((void*)U8, (short)0, NEXP * D, 0x00020000);
    const __amdgpu_buffer_rsrc_t rsV = __builtin_amdgcn_make_buffer_rsrc((void*)V8, (short)0, NEXP * D, 0x00020000);
    const int pfrank = ((int)blockIdx.x >> 3) * NWAVES + F.wave; const int pfoff = (pfrank < 256) ? pfrank * 8192 + lane * 128 : 0; unsigned pf = 0u;
    for (int grp = gw; grp < T / 8; grp += NGW) {
        const int tb = grp * 8;
        for (int prep = 0; prep < REPS(13); ++prep) {
        LAS float* lsx = (LAS float*)(F.lds + P7_AUX_OFF + F.wave * 256); LAS float* lrs = lsx + 32;
        if (lane < 32) lsx[lane] = SXQ[(size_t)tb * 4 + lane];
        if (lane < 8) { const f32x4 q4 = *(const GAS f32x4*)(SSQ + (size_t)(tb + lane) * 4); lrs[lane] = 1.0f / sqrtf(((q4.x + q4.y) + (q4.z + q4.w)) * (1.0f / D) + EPS); }
        LAS _Float16* lgate = (LAS _Float16*)lout;
        if (!handoff) {
#pragma unroll
            for (int i = 0; i < 8; ++i) { lidx[i * 128 + lane] = IDX[(size_t)(tb + i) * NSEL + lane]; lidx[i * 128 + 64 + lane] = IDX[(size_t)(tb + i) * NSEL + 64 + lane];
                lgate[i * 128 + lane] = (_Float16)GATE[(size_t)(tb + i) * NSEL + lane]; lgate[i * 128 + 64 + lane] = (_Float16)GATE[(size_t)(tb + i) * NSEL + 64 + lane]; }
        }
#pragma unroll
        for (int i = 0; i < 8; ++i) { lza[i * 128 + lane] = 0.f; lza[i * 128 + 64 + lane] = 0.f; }
        LDS_WAIT(); asm volatile("" ::: "memory");
        for (int urep = 0; urep < REPS(8); ++urep) {
            if (urep) {
#pragma unroll
                for (int i = 0; i < 8; ++i) { lza[i * 128 + lane] = 0.f; lza[i * 128 + 64 + lane] = 0.f; }
                LDS_WAIT(); asm volatile("" ::: "memory"); }
            v4u b0[8], b1[8], b2[8], b3[8], xa0, xb0, xa1, xb1, xa2, xb2, xa3, xb3;
            const unsigned char* xbase = X8 + (size_t)tb * D + (lane >> 4) * 16;
            xa0 = *(const GAS v4u*)xbase; xb0 = *(const GAS v4u*)(xbase + 64); xa1 = *(const GAS v4u*)(xbase + D); xb1 = *(const GAS v4u*)(xbase + D + 64);
            p8_issue(b0, lidx + j * 16, rsU, 0, c16); p8_issue(b1, lidx + j * 16 + 8, rsU, 0, c16); p8_issue(b2, lidx + 128 + j * 16, rsU, 0, c16); p8_issue(b3, lidx + 128 + j * 16 + 8, rsU, 0, c16);
            for (int n = 0; n < 64; n += 2) {
                const int i = n & 7, n2 = (n + 2) & 63, s2 = n2 >> 3, i2 = n2 & 7;
                { const unsigned char* xp = xbase + (size_t)i2 * D + s2 * 128; xa2 = *(const GAS v4u*)xp; xb2 = *(const GAS v4u*)(xp + 64); xa3 = *(const GAS v4u*)(xp + D); xb3 = *(const GAS v4u*)(xp + D + 64); }
                if ((n & 7) == 6) {
                    asm volatile("" :: "v"(pf));
                    pf = (s2 != 0) ? __builtin_amdgcn_raw_buffer_load_b32(rsU, pfoff, s2 * (NEXP * 128), 0) : __builtin_amdgcn_raw_buffer_load_b32(rsV, pfoff, 0, 0); }
                const float sxa = lsx[i * 4 + (n >> 4)], sxb = lsx[(i + 1) * 4 + (n >> 4)];
                p8s_compute_u(b0, xa0, xb0, lstage, lza + i * 128, lane, sxa);           p8_issue(b0, lidx + i2 * 128 + j * 16, rsU, s2 * (NEXP * 128), c16);
                p8s_compute_u(b1, xa0, xb0, lstage, lza + i * 128 + 8, lane, sxa);       p8_issue(b1, lidx + i2 * 128 + j * 16 + 8, rsU, s2 * (NEXP * 128), c16);
                p8s_compute_u(b2, xa1, xb1, lstage, lza + (i + 1) * 128, lane, sxb);     p8_issue(b2, lidx + (i2 + 1) * 128 + j * 16, rsU, s2 * (NEXP * 128), c16);
                p8s_compute_u(b3, xa1, xb1, lstage, lza + (i + 1) * 128 + 8, lane, sxb); p8_issue(b3, lidx + (i2 + 1) * 128 + j * 16 + 8, rsU, s2 * (NEXP * 128), c16);
                xa0 = xa2; xb0 = xb2; xa1 = xa3; xb1 = xb3;
            }
        }
        LDS_WAIT(); asm volatile("" ::: "memory");
#pragma unroll
        for (int i = 0; i < 8; ++i) {
            const int e0 = lidx[i * 128 + lane], e1 = lidx[i * 128 + 64 + lane];
            const float sx = lrs[i];
            const float z0 = lza[i * 128 + lane] * SU[e0] * sx, z1 = lza[i * 128 + 64 + lane] * SU[e1] * sx;
            const float g0 = (float)lgate[i * 128 + lane] * SV[e0], g1 = (float)lgate[i * 128 + 64 + lane] * SV[e1];
            lza[i * 128 + lane] = gelu_erf(z0) * g0 * 1024.0f; lza[i * 128 + 64 + lane] = gelu_erf(z1) * g1 * 1024.0f;
        }
        LDS_WAIT(); asm volatile("" ::: "memory");
        for (int vrep = 0; vrep < REPS(9); ++vrep) {
            v4u b0[8], b1[8], b2[8], b3[8];
            LAS unsigned* lkeep = (LAS unsigned*)lstage;
            p8_issue(b0, lidx + j * 16, rsV, 0, c16); p8_issue(b1, lidx + j * 16 + 8, rsV, 0, c16); p8_issue(b2, lidx + 128 + j * 16, rsV, 0, c16); p8_issue(b3, lidx + 128 + j * 16 + 8, rsV, 0, c16);
            for (int n = 0; n < 64; n += 2) {
                const int s = n >> 3, i = n & 7, n2 = (n + 2) & 63, s2 = n2 >> 3, i2 = n2 & 7;
                if ((n & 7) == 6 && s2 != 0) { asm volatile("" :: "v"(pf)); pf = __builtin_amdgcn_raw_buffer_load_b32(rsV, pfoff, s2 * (NEXP * 128), 0); }
                LAS unsigned* lo = ((s < 4) ? lkeep + s * 512 : lout) + c * 8 + j;
                h16x2 yh[8]; f32x2 y[8]; float r0, r1;
#pragma unroll
                for (int q = 0; q < 8; ++q) yh[q] = (h16x2){(_Float16)0.f, (_Float16)0.f};
                p8h_compute_v(b0, lza + i * 128 + j * 16, yh);           p8_issue(b0, lidx + i2 * 128 + j * 16, rsV, s2 * (NEXP * 128), c16);
                p8h_compute_v(b1, lza + i * 128 + j * 16 + 8, yh);       p8_issue(b1, lidx + i2 * 128 + j * 16 + 8, rsV, s2 * (NEXP * 128), c16);
#pragma unroll
                for (int q = 0; q < 8; ++q) y[q] = (f32x2){(float)yh[q].x * (1.0f / 1024.0f), (float)yh[q].y * (1.0f / 1024.0f)};
                p8_reduce_heads(y, j, r0, r1);
                lo[i * 64] = pk2(r0, r1);
#pragma unroll
                for (int q = 0; q < 8; ++q) yh[q] = (h16x2){(_Float16)0.f, (_Float16)0.f};
                p8h_compute_v(b2, lza + (i + 1) * 128 + j * 16, yh);     p8_issue(b2, lidx + (i2 + 1) * 128 + j * 16, rsV, s2 * (NEXP * 128), c16);
                p8h_compute_v(b3, lza + (i + 1) * 128 + j * 16 + 8, yh); p8_issue(b3, lidx + (i2 + 1) * 128 + j * 16 + 8, rsV, s2 * (NEXP * 128), c16);
#pragma unroll
                for (int q = 0; q < 8; ++q) y[q] = (f32x2){(float)yh[q].x * (1.0f / 1024.0f), (float)yh[q].y * (1.0f / 1024.0f)};
                p8_reduce_heads(y, j, r0, r1);
                lo[(i + 1) * 64] = pk2(r0, r1);
                if (i == 6 && s >= 4) {
                    LDS_WAIT(); asm volatile("" ::: "memory");
                    const v4u w0 = *(const LAS v4u*)(lout + (lane >> 4) * 64 + (lane & 15) * 4), w1 = *(const LAS v4u*)(lout + (4 + (lane >> 4)) * 64 + (lane & 15) * 4);
                    bf16* op = OUT + (size_t)(tb + (lane >> 4)) * D + s * 128 + (lane & 15) * 8;
                    *(GAS v4u*)op = w0; *(GAS v4u*)(op + 4 * D) = w1;
                }
            }
        }
        }
        asm volatile("" :: "v"(pf));
        VM_WAIT(); __builtin_amdgcn_fence(__ATOMIC_ACQUIRE, "agent"); VM_WAIT(); LDS_WAIT(); asm volatile("" ::: "memory");
        for (int frep = 0; frep < REPS(14); ++frep)
        for (int i0 = 0; i0 < 8; i0 += 4) {
            u32x2s hv[4][4], ov[4][4]; float ss[4];
#pragma unroll
            for (int rr = 0; rr < 4; ++rr) { const bf16* hrow = H16 + (size_t)(tb + i0 + rr) * D + 4 * lane; const bf16* orow = OUT + (size_t)(tb + i0 + rr) * D + 4 * lane;
                const LAS unsigned* krow = (const LAS unsigned*)lstage + (lane >> 5) * 512 + (i0 + rr) * 64 + ((2 * lane) & 63);
#pragma unroll
                for (int q = 0; q < 4; ++q) { hv[rr][q] = *(const GAS u32x2s*)(hrow + 256 * q);
                    if (q < 2) ov[rr][q] = *(const LAS u32x2s*)(krow + q * 1024); else ov[rr][q] = *(const GAS u32x2s*)(orow + 256 * q); } }
            f32x4 gg[4];
#pragma unroll
            for (int q = 0; q < 4; ++q) gg[q] = *(const GAS f32x4*)(gfin + 256 * q + 4 * lane);
            f32x4 yv[4][4];
#pragma unroll
            for (int rr = 0; rr < 4; ++rr) { float a = 0.f;
#pragma unroll
                for (int q = 0; q < 4; ++q) { const unsigned h0 = hv[rr][q].x, h1 = hv[rr][q].y, o0 = ov[rr][q].x, o1 = ov[rr][q].y;
                    yv[rr][q] = (f32x4){bflo(h0) + bflo(o0), bfhi(h0) + bfhi(o0), bflo(h1) + bflo(o1), bfhi(h1) + bfhi(o1)};
                    a += (yv[rr][q].x * yv[rr][q].x + yv[rr][q].y * yv[rr][q].y) + (yv[rr][q].z * yv[rr][q].z + yv[rr][q].w * yv[rr][q].w); }
                ss[rr] = a; }
#pragma unroll
            for (int o = 1; o < 64; o <<= 1) {
#pragma unroll
                for (int rr = 0; rr < 4; ++rr) ss[rr] += __shfl_xor(ss[rr], o); }
#pragma unroll
            for (int rr = 0; rr < 4; ++rr) { const float rstd = 1.f / sqrtf(ss[rr] * (1.f / D) + EPS); float* yr = YOUT + (size_t)(tb + i0 + rr) * D + 4 * lane;
#pragma unroll
                for (int q = 0; q < 4; ++q) *(GAS f32x4*)(yr + 256 * q) = (f32x4){yv[rr][q].x * rstd * gg[q].x, yv[rr][q].y * rstd * gg[q].y, yv[rr][q].z * rstd * gg[q].z, yv[rr][q].w * rstd * gg[q].w}; }
        }
    }
}
template <bool GAIN>
__device__ __forceinline__ void cvt_fp8_rows(Frame& F, const float* src, unsigned char* dst, float* scale, int gw, int NGW, const float* gain) {
    const int lane = F.lane;
    f32x4 gq[4];
    if (GAIN) {
#pragma unroll
        for (int q = 0; q < 4; ++q) gq[q] = ((const GAS f32x4*)gain)[4 * lane + q]; }
    for (int r0 = gw * 4; r0 < NEXP; r0 += NGW * 4) {
        f32x4 v[4][4];
#pragma unroll
        for (int rr = 0; rr < 4; ++rr) { const GAS f32x4* sp = (const GAS f32x4*)(src + (size_t)(r0 + rr) * D) + 4 * lane;
#pragma unroll
            for (int q = 0; q < 4; ++q) v[rr][q] = sp[q]; }
        if (GAIN) {
#pragma unroll
            for (int rr = 0; rr < 4; ++rr)
#pragma unroll
                for (int q = 0; q < 4; ++q) v[rr][q] = v[rr][q] * gq[q]; }
        float m[4];
#pragma unroll
        for (int rr = 0; rr < 4; ++rr) { float mm = 0.f;
#pragma unroll
            for (int q = 0; q < 4; ++q) mm = fmaxf(mm, fmaxf(fmaxf(fabsf(v[rr][q].x), fabsf(v[rr][q].y)), fmaxf(fabsf(v[rr][q].z), fabsf(v[rr][q].w))));
            m[rr] = mm; }
#pragma unroll
        for (int o = 1; o < 64; o <<= 1) {
#pragma unroll
            for (int rr = 0; rr < 4; ++rr) m[rr] = fmaxf(m[rr], __shfl_xor(m[rr], o)); }
#pragma unroll
        for (int rr = 0; rr < 4; ++rr) {
            const float sc = (m[rr] > 0.f) ? m[rr] * (1.0f / 448.0f) : 1.0f, inv = 1.0f / sc;
            unsigned o[4];
#pragma unroll
            for (int q = 0; q < 4; ++q) o[q] = (unsigned)__builtin_amdgcn_cvt_pk_fp8_f32(v[rr][q].z * inv, v[rr][q].w * inv, __builtin_amdgcn_cvt_pk_fp8_f32(v[rr][q].x * inv, v[rr][q].y * inv, 0, false), true);
            *(GAS v4u*)(dst + (size_t)(lane >> 3) * (NEXP * 128) + (size_t)(r0 + rr) * 128 + 16 * (lane & 7)) = (v4u){o[0], o[1], o[2], o[3]};
            if (lane == 0) scale[r0 + rr] = sc;
        }
    }
}
struct Args { const float* in[15]; float* out; unsigned char* ws; int ph_lo, ph_hi; };
__global__ void __launch_bounds__(NWAVES * 64, 2) hyb_fwd(Args args) {
    extern __shared__ __attribute__((aligned(16))) unsigned char lds[];
    Frame F;
    F.lds = (LAS unsigned char*)lds;
    F.MISC = (volatile LAS unsigned*)(F.lds + MISC_OFF);
    F.tid = threadIdx.x; F.lane = F.tid & 63; F.wave = __builtin_amdgcn_readfirstlane(F.tid >> 6);
    F.G = gridDim.x; { const int bx = blockIdx.x; F.vcu = (F.G % 8 == 0) ? (bx % 8) * (F.G / 8) + bx / 8 : bx; }
    unsigned char* ws = args.ws;
    gu32* ctl = (gu32*)(ws + WS_CTL);
    const float* x = args.in[0]; const float* g_mix = args.in[1]; const float* w_in = args.in[2]; const float* conv_w = args.in[3]; const float* w_conv_out = args.in[4];
    const float* pool_w = args.in[5]; const float* pool_scale = args.in[6]; const float* w_pool_out = args.in[7]; const float* w_out = args.in[8]; const float* g_ffn = args.in[9];
    const float* w_query = args.in[10]; const float* sub_keys = args.in[11]; const float* expert_u = args.in[12]; const float* expert_v = args.in[13]; const float* g_fin = args.in[14];
    bf16* WIN = (bf16*)(ws + WS_WIN); bf16* WC = (bf16*)(ws + WS_WC); bf16* WPB = (bf16*)(ws + WS_WPB); bf16* WOUT = (bf16*)(ws + WS_WOUT); bf16* WSC = (bf16*)(ws + WS_WS);
    bf16* XN = (bf16*)(ws + WS_XN); bf16* PB = (bf16*)(ws + WS_PB); bf16* PG = (bf16*)(ws + WS_PG); bf16* TMP = (bf16*)(ws + WS_TMP); bf16* MG = (bf16*)(ws + WS_MG);
    float* SC = (float*)(ws + WS_SC); int* IDX = (int*)(ws + WS_IDX); float* GATE = (float*)(ws + WS_GATE); unsigned char* U8 = ws + WS_U8; unsigned char* V8 = ws + WS_V8; float* SU = (float*)(ws + WS_SU); float* SV = (float*)(ws + WS_SV); bf16* H16 = (bf16*)(ws + WS_H16); unsigned char* X8 = ws + WS_X8; float* SX = (float*)(ws + WS_SX);
    float* RS1 = (float*)(ws + WS_RS1);
    float* SSQ = (float*)(ws + WS_XBUF); float* SXQ = (float*)(ws + WS_XBUF + 256 * 1024);
    bf16* AIN = (bf16*)args.out; bf16* POOLED = (bf16*)args.out + (size_t)T * D; float* H = args.out;

    for (int u = F.tid; u < (LDS_BYTES - LDSCTL_OFF) / 4; u += NWAVES * 64) ((LAS unsigned*)(F.lds + LDSCTL_OFF))[u] = 0u;
    __syncthreads();
    XcdBarrier bar; bar.bar = (unsigned*)(ctl + CW_BAR); bar.x = 0; bar.st = nullptr;
    if (N_LAUNCHES == 1) bar = xcd_barrier_post((unsigned*)(ctl + CW_BAR), F.MISC + 8);
#define GRID_BAR() do { if (N_LAUNCHES == 1) xcd_barrier(bar); } while (0)
    const int lo = args.ph_lo, hi = args.ph_hi;
#define IN(k) (lo <= (k) && (k) < hi)
#define BOTH(k) (IN(k) && IN((k) + 1))
    const int gw = F.vcu * NWAVES + F.wave, NGW = F.G * NWAVES;

    if (IN(0)) { DELAY_T0(0); for (int rep = 0; rep < REPS(0); ++rep) {
        LAS float* scr = (LAS float*)(F.lds + RING_OFF + F.wave * 16384);
        constexpr int I_IN = (D / 64) * (NIN / 32), I_SQ = (D / 64) * (D / 32);
#pragma unroll 1
        for (int stage = 0; stage < 2; ++stage) {
            if ((stage == 0) == ((F.wave & 1) == 0)) {
                for (int it = gw; it < 2048; it += NGW) {
                    { const int hp = it >> 7, i0 = ((it >> 5) & 3) * 32, j0 = (it & 31) * 32;
                      fold_wave<4, 32, false>(scr, sub_keys + (size_t)hp * 16384 + (size_t)i0 * 128, 128, nullptr, w_query + (size_t)j0 * NSC + hp * 128, NSC, WSC + (size_t)(hp * 128 + i0) * D + j0, D, F.lane, g_ffn + j0); }
                    { const int g = it >> 9, i0 = ((it >> 4) & 31) * 32, j0 = (it & 15) * 16;
                      fold_wave<8, 16, true>(scr, w_pool_out + (size_t)g * 256 * D + i0, D, pool_scale + g * 256, pool_w + (size_t)g * 65536 + (size_t)j0 * 256, 256, WPB + (size_t)i0 * D + g * 256 + j0, D, F.lane); }
                }
            } else {
                for (int it = gw; it < I_IN + 2 * I_SQ; it += NGW) {
                    int r = it;
                    if (r < I_IN) { p0_transpose_item<true>(w_in, D, NIN, WIN, scr, r, F.lane, g_mix); continue; } r -= I_IN;
                    if (r < I_SQ) { p0_transpose_item<false>(w_conv_out, D, D, WC, scr, r, F.lane); continue; } r -= I_SQ;
                    p0_transpose_item<false>(w_out, D, D, WOUT, scr, r, F.lane);
                }
                for (int m = gw * 4; m < T; m += NGW * 4) rms_rows4_to_bf16(F.lane, x + (size_t)m * D, XN + (size_t)m * D, RS1 + m);
            }
        }
        }
        DELAY_END(0);
        if (BOTH(0)) GRID_BAR();
    }
    if (PROBE_DUP & 1024) { for (int xb = 0; xb < 10; ++xb) GRID_BAR(); }
    if (IN(1)) { DELAY_T0(1); for (int rep = 0; rep < REPS(1); ++rep) {
        pg8::Gemm g{XN, WIN, 0l, 0l, T, NIN, D}; pg8::StaticOrder S; S.init(T, NIN, F.G, (int)blockIdx.x);
        pg8::EpiProj E{RS1, PB, (long)(WS_PG - WS_PB)};
        pg8::gemm_phase<pg8::EpiProj, pg8::StaticOrder, true, true>(F.lds + RING_OFF, g, S, E);
        }
        DELAY_END(1);
        if (BOTH(1)) GRID_BAR();
    }
    if (IN(2)) { DELAY_T0(2); for (int rep = 0; rep < REPS(2); ++rep) {
        p2_conv_pool(F, PB, conv_w, AIN, POOLED);
        }
        DELAY_END(2);
        if (BOTH(2)) GRID_BAR();
    }
    if (IN(3)) { DELAY_T0(3); for (int rep = 0; rep < REPS(3); ++rep) {
        pg8::Gemm g{AIN, WC, (long)T * D * 2, (long)(WS_WPB - WS_WC), T, D, D}; pg8::MergeOrder S; S.base.init(T, D, F.G, (int)blockIdx.x);
        pg8::EpiMerge E{(const unsigned char*)PG, MG};
        pg8::gemm_phase<pg8::EpiMerge, pg8::MergeOrder, true, true>(F.lds + RING_OFF, g, S, E);
        }
        DELAY_END(3);
        if (BOTH(3)) GRID_BAR();
    }
    if (IN(4)) { DELAY_T0(4); for (int rep = 0; rep < REPS(4); ++rep) {
        if (F.G == 256) {
            pg8::Gemm g{MG, WOUT, 0l, 0l, T, D, D}; pg8::StaticOrder S; S.init(T, D, F.G, (int)blockIdx.x);
            pg8::EpiResRms E{(const pg8::bf16_t*)XN, H16, X8, SSQ, SXQ};
            pg8::gemm_phase<pg8::EpiResRms, pg8::StaticOrder, false, true>(F.lds + RING_OFF, g, S, E);
            if (PROBE_DUP & 4096) { __syncthreads(); pg8::gemm_phase<pg8::EpiResRms, pg8::StaticOrder, false, true>(F.lds + RING_OFF, g, S, E); }
        } else {
            pg8::Gemm g{MG, WOUT, 0l, 0l, T, D, D}; pg8::StaticOrder S; S.init(T, D, F.G, (int)blockIdx.x);
            pg8::EpiRes E{x, H};
            pg8::gemm_phase<pg8::EpiRes, pg8::StaticOrder, true, true>(F.lds + RING_OFF, g, S, E);
            GRID_BAR();
            for (int m = gw; m < T; m += NGW) p4_row_defer(F.lane, H + (size_t)m * D, X8 + (size_t)m * D, SSQ + (size_t)m * 4, SXQ + (size_t)m * 4, H16 + (size_t)m * D);
        }
        }
        DELAY_END(4);
        if (BOTH(4)) GRID_BAR();
    }
    if (IN(5)) { DELAY_T0(5); for (int rep = 0; rep < REPS(5); ++rep) {
        pg8::Gemm g{(const pg8::bf16_t*)H16, WSC, 0l, 0l, T, NSC, D}; pg8::StaticOrder S; S.init(T, NSC, F.G, (int)blockIdx.x);
        pg8::EpiF16 E{(unsigned short*)SC, NSC};
        pg8::gemm_phase<pg8::EpiF16, pg8::StaticOrder, true, true>(F.lds + RING_OFF, g, S, E);
        }
        DELAY_END(5);
        if (BOTH(5)) GRID_BAR();
    }
    if (IN(6)) { DELAY_T0(6); for (int rep = 0; rep < REPS(6); ++rep) {
        const bool handoff = (F.G * NWAVES == T / 8);
        if (F.wave < 4) { if (handoff) p7_topk(F, (const unsigned short*)SC, SSQ, IDX, GATE, F.vcu * 8 + F.wave, F.vcu * 8 + 8, 4, true); else p7_topk(F, (const unsigned short*)SC, SSQ, IDX, GATE, F.vcu * 4 + F.wave, T / 8, F.G * 4, false); }
        else { cvt_fp8_rows<true>(F, expert_u, U8, SU, F.vcu * 4 + F.wave - 4, F.G * 4, g_ffn); cvt_fp8_rows<false>(F, expert_v, V8, SV, F.vcu * 4 + F.wave - 4, F.G * 4, nullptr); }
        }
        DELAY_END(6);
        if (BOTH(6)) GRID_BAR();
    }
    if (IN(7)) { DELAY_T0(7);
        for (int rep = 0; rep < REPS(7); ++rep)
        p8_peer(F, X8, SSQ, SXQ, U8, V8, SU, SV, IDX, GATE, H16, args.out, (bf16*)(ws + WS_PO), g_fin, F.G * NWAVES == T / 8);
        DELAY_END(7);
    }
#undef IN
#undef BOTH
}

extern "C" void kernel_launch(void* const* d_in, const int* in_sizes, int n_in, void* d_out, int out_size, void* d_ws, size_t ws_size, hipStream_t stream) {
    static int grid = 0;
    if (grid == 0) {
        if (n_in != 15 || in_sizes[0] != T * D || out_size != T * D || ws_size < WS_END) { fprintf(stderr, "kernel_launch: shape/workspace mismatch (n_in %d, in0 %d, out %d, ws %zu)\n", n_in, n_in > 0 ? in_sizes[0] : -1, out_size, ws_size); grid = -1; return; }
        int dev = 0, cus = 0, per_cu = 0;
        if (hipGetDevice(&dev) != hipSuccess || hipDeviceGetAttribute(&cus, hipDeviceAttributeMultiprocessorCount, dev) != hipSuccess) { grid = -1; return; }
        if (hipFuncSetAttribute((const void*)hyb_fwd, hipFuncAttributeMaxDynamicSharedMemorySize, LDS_BYTES) != hipSuccess) { fprintf(stderr, "kernel_launch: hipFuncSetAttribute failed\n"); grid = -1; return; }
        if (hipOccupancyMaxActiveBlocksPerMultiprocessor(&per_cu, (const void*)hyb_fwd, NWAVES * 64, LDS_BYTES) != hipSuccess || per_cu < 1)
            fprintf(stderr, "kernel_launch: note: occupancy query reports %d workgroups per CU\n", per_cu);
        (void)hipGetLastError();
        grid = cus;
    }
    if (grid < 0) return;
    if (hipMemsetAsync((char*)d_ws + WS_CTL, 0, CTL_ZERO_BYTES, stream) != hipSuccess) { fprintf(stderr, "kernel_launch: hipMemsetAsync failed\n"); return; }
    Args a{};
    for (int i = 0; i < 15; ++i) a.in[i] = (const float*)d_in[i];
    a.out = (float*)d_out; a.ws = (unsigned char*)d_ws;
    for (int li = 0; li < N_LAUNCHES; ++li) {
        a.ph_lo = (N_LAUNCHES == 1) ? 0 : li; a.ph_hi = (N_LAUNCHES == 1) ? NPHASE : li + 1;
        hipLaunchKernelGGL(hyb_fwd, dim3(grid), dim3(NWAVES * 64), LDS_BYTES, stream, a);
        const hipError_t le = hipPeekAtLastError();
        if (le != hipSuccess) { fprintf(stderr, "kernel_launch: launch %d failed: %s\n", li, hipGetErrorName(le)); break; }
    }
}
```

```cpp
#include <hip/hip_runtime.h>
#include <cstdio>
#include <cstdint>
namespace pg8 {
#define PG8_LAS __attribute__((address_space(3)))
typedef unsigned short bf16_t;
typedef short bf16x8 __attribute__((ext_vector_type(8)));
typedef float f32x4 __attribute__((ext_vector_type(4)));
typedef unsigned u32x4 __attribute__((ext_vector_type(4)));
constexpr int BM = 256, BK = 64, HALF = 128, HTB = HALF * BK * 2  , STAGE_BYTES = 8 * HTB, NXCD = 8, WGM = 8;

__host__ __device__ __forceinline__ int lds_byte(int r, int c) { const int st = (r >> 4) * 2 + (c >> 5), rr = r & 15, cc = c & 31, ob = rr * 64 + cc * 2; return st * 1024 + (ob ^ (((ob >> 9) & 1) << 5)); }
__host__ __device__ __forceinline__ void stage_rc(int b, int& R, int& C) { const int st = b / 1024, sb = b % 1024, swz = sb ^ (((sb >> 9) & 1) << 5); R = (st >> 1) * 16 + swz / 64; C = (st & 1) * 32 + (swz % 64) / 2; }
__host__ __device__ __forceinline__ int perm32(int rho) { const int n = rho >> 4, i = rho & 15; return 8 * (i >> 2) + 4 * n + (i & 3); }

struct Unit { int pm, pn, sel; };
struct Gemm { const bf16_t* A; const bf16_t* Bt; long offA1, offB1; int M, N, K; };

struct StaticOrder {
    int nM, nN, nwg, G, c;
    __host__ __device__ void init(int M, int N, int G_, int c_) { nM = M / BM; nN = N / BM; nwg = nM * nN; G = G_; c = c_; }
    __host__ __device__ __forceinline__ bool next(int i, Unit& u) const {
        const long L = (long)i * G + c; if (L >= nwg) return false;
        int wgid = (int)L; { const int q = nwg / NXCD, r = nwg % NXCD, xcd = wgid % NXCD, off = wgid / NXCD; wgid = (xcd < r ? xcd * (q + 1) : r * (q + 1) + (xcd - r) * q) + off; }
        const int nig = WGM * nN, gid = wgid / nig, fm = gid * WGM, gsz = (nM - fm) < WGM ? (nM - fm) : WGM;
        u.pm = fm + ((wgid % nig) % gsz); u.pn = (wgid % nig) / gsz; u.sel = 0; return true;
    }
    __device__ __forceinline__ void a_ready(const Unit&) const {}
    __device__ __forceinline__ void done(const Unit&) const {}
};


__device__ __forceinline__ unsigned cvt_pk_bf16(float lo, float hi) { unsigned r; asm volatile("v_cvt_pk_bf16_f32 %0, %1, %2" : "=v"(r) : "v"(lo), "v"(hi)); return r; }
template <int K> __device__ __forceinline__ float ror16(float v) { return __int_as_float(__builtin_amdgcn_update_dpp(0, __float_as_int(v), 0x120 + K, 0xf, 0xf, false)); }
__device__ __forceinline__ float sigm(float x) { return __builtin_amdgcn_rcpf(1.0f + __expf(-x)); }
__device__ __forceinline__ float sig255(float x) { return fmaxf(255.0f * __builtin_amdgcn_rcpf(1.0f + __expf(-x)), 1.0f); }
__device__ __forceinline__ unsigned q8(float a, float b, float c, float d) {
    unsigned w = __builtin_amdgcn_cvt_pk_u8_f32(sig255(a), 0u, 0u); w = __builtin_amdgcn_cvt_pk_u8_f32(sig255(b), 1u, w); w = __builtin_amdgcn_cvt_pk_u8_f32(sig255(c), 2u, w); return __builtin_amdgcn_cvt_pk_u8_f32(sig255(d), 3u, w); }
__device__ __forceinline__ float ub0(unsigned w) { return (float)(w & 0xffu); }
__device__ __forceinline__ float ub1(unsigned w) { return (float)((w >> 8) & 0xffu); }
__device__ __forceinline__ float ub2(unsigned w) { return (float)((w >> 16) & 0xffu); }
__device__ __forceinline__ float ub3(unsigned w) { return (float)(w >> 24); }
__device__ __forceinline__ float bflo(unsigned w) { return __uint_as_float(w << 16); }
__device__ __forceinline__ float bfhi(unsigned w) { return __uint_as_float(w & 0xffff0000u); }

struct EpiProj {
    static constexpr bool PERM = true, AFTER_DRAIN = false, CHAIN = false;
    static constexpr bool ROWSCALE = true;
    const float* RS; bf16_t* PB; long pg_off; bf16_t* AIN; const float* CW; bf16_t* RAWU; bf16_t* RAWB; bf16_t* POOLED;
    __device__ __forceinline__ void unit_begin(const Unit& u, int ui, int tid, PG8_LAS unsigned char* buf) const {
        if (tid < 256) __builtin_amdgcn_global_load_lds((const unsigned*)(RS + u.pm * BM + tid), (PG8_LAS unsigned*)(buf + (ui & 1) * 2048 + (tid >> 6) * 256), 4, 0, 0);
        if (u.pn < 16 && tid < 192) __builtin_amdgcn_global_load_lds((const unsigned*)(CW + (tid >> 6) * 1024 + u.pn * 64 + (tid & 63)), (PG8_LAS unsigned*)(buf + (ui & 1) * 2048 + 1024 + (tid >> 6) * 256), 4, 0, 0);
    }
    typedef unsigned u32x2g __attribute__((ext_vector_type(2)));
    __device__ __forceinline__ u32x2g pk4(const f32x4 v) const { u32x2g w; w.x = cvt_pk_bf16(v[0], v[1]); w.y = cvt_pk_bf16(v[2], v[3]); return w; }
    __device__ __forceinline__ void operator()(const f32x4 (&acc)[2][2][4][2], const Unit& u, int wr, int wc, int fr, int fq, const PG8_LAS float* rsl) const {
        const int row0 = u.pm * BM + wr * 64 + fr, lc = wc * 32 + 8 * fq;
        float rs[2][4];
#pragma unroll
        for (int ai = 0; ai < 2; ++ai)
#pragma unroll
            for (int m = 0; m < 4; ++m) rs[ai][m] = rsl[wr * 64 + fr + ai * HALF + m * 16];
        if (u.pn >= 16) {
            unsigned char* base = (unsigned char*)PB + pg_off + (u.pn - 16) * BM + lc;
#pragma unroll
            for (int ai = 0; ai < 2; ++ai)
#pragma unroll
                for (int m = 0; m < 4; ++m) { unsigned char* rowp = base + (size_t)(row0 + ai * HALF + m * 16) * 2048;
#pragma unroll
                    for (int bj = 0; bj < 2; ++bj) { const f32x4 v0 = acc[ai][bj][m][0] * rs[ai][m], v1 = acc[ai][bj][m][1] * rs[ai][m];
                        u32x2g w;
                        w.x = q8(v0[0], v0[1], v0[2], v0[3]); w.y = q8(v1[0], v1[1], v1[2], v1[3]);
                        *(u32x2g*)(rowp + bj * HALF) = w; } }
            return;
        }
        const int ch0 = u.pn * 64 + wc * 16 + fq * 4;
        const PG8_LAS float* wl = rsl + 256 + wc * 16 + fq * 4;
        const f32x4 w0 = *(const PG8_LAS f32x4*)wl, w1 = *(const PG8_LAS f32x4*)(wl + 64), w2 = *(const PG8_LAS f32x4*)(wl + 128);
#pragma unroll
        for (int ai = 0; ai < 2; ++ai) {
            const int blk = u.pm * 4 + ai * 2 + wr;
            f32x4 up = (f32x4){0.f, 0.f, 0.f, 0.f};
            f32x4 pv[4];
#pragma unroll
            for (int m = 0; m < 4; ++m) { const float r = rs[ai][m];
                const f32x4 b = acc[ai][0][m][0] * r, uu = (acc[ai][0][m][1] * r) * (acc[ai][1][m][0] * r), p = acc[ai][1][m][1] * r;
                f32x4 um1, um2;
#pragma unroll
                for (int e = 0; e < 4; ++e) { const float a1 = ror16<1>(uu[e]), a1p = ror16<1>(up[e]), a2 = ror16<2>(uu[e]), a2p = ror16<2>(up[e]);
                    um1[e] = (fr >= 1) ? a1 : a1p; um2[e] = (fr >= 2) ? a2 : a2p; }
                const f32x4 o = b * (w0 * um2 + w1 * um1 + w2 * uu);
                const size_t row = (size_t)(row0 + ai * HALF + m * 16);
                *(u32x2g*)(AIN + row * 1024 + ch0) = pk4(o);
                pv[m] = p;
                if (m == 0 && fr < 2) { *(u32x2g*)(RAWU + (size_t)(blk * 4 + fr) * 1024 + ch0) = pk4(uu); *(u32x2g*)(RAWB + (size_t)(blk * 2 + fr) * 1024 + ch0) = pk4(b); }
                if (m == 3 && fr >= 14) *(u32x2g*)(RAWU + (size_t)(blk * 4 + 2 + (fr - 14)) * 1024 + ch0) = pk4(uu);
                up = uu; }
            const int g = u.pn >> 2;
            f32x4 sv[4];
#pragma unroll
            for (int m = 0; m < 4; ++m) sv[m] = pv[m];
#define PG8_POOLSTEP(DD) do { f32x4 nv[4]; _Pragma("unroll") for (int m = 0; m < 4; ++m) _Pragma("unroll") for (int e = 0; e < 4; ++e) { \
                const float a = ror16<DD>(sv[m][e]), ap = ror16<DD>(m ? sv[m ? m - 1 : 0][e] : 0.f); nv[m][e] = sv[m][e] + ((fr >= DD) ? a : ap); } \
                _Pragma("unroll") for (int m = 0; m < 4; ++m) sv[m] = nv[m]; } while (0)
            PG8_POOLSTEP(1);
            if (g >= 1) PG8_POOLSTEP(2);
            if (g >= 2) PG8_POOLSTEP(4);
            if (g >= 3) PG8_POOLSTEP(8);
#undef PG8_POOLSTEP
            const float invw = (g == 0) ? 0.5f : (g == 1) ? 0.25f : (g == 2) ? 0.125f : 0.0625f; const int w1 = (2 << g) - 1;
#pragma unroll
            for (int m = 0; m < 4; ++m) { const size_t row = (size_t)(row0 + ai * HALF + m * 16);
                *(u32x2g*)(POOLED + row * 1024 + ch0) = pk4(sv[m] * invw - pv[m]);
                if ((m == 0 && fr < w1) || (m == 3 && fr >= 16 - w1)) *(u32x2g*)(PB + row * 3072 + 2048 + ch0) = pk4(pv[m]); }
        }
    }
};
struct EpiMerge {
    static constexpr bool PERM = true, AFTER_DRAIN = false, CHAIN = true;
    static constexpr bool ROWSCALE = false;
    const unsigned char* PG; bf16_t* MG;
    typedef unsigned u32x2g __attribute__((ext_vector_type(2)));
    __device__ __forceinline__ void operator()(f32x4 (&acc)[2][2][4][2], const Unit& u, int wr, int wc, int fr, int fq) const {
        const int row0 = u.pm * BM + wr * 64 + fr, col0 = u.pn * BM + wc * 32 + 8 * fq;
        const unsigned char* pg = PG + (size_t)row0 * 2048 + col0;
        if (u.sel == 0) {
            u32x2g ga[2][4][2], gb[2][4][2];
#pragma unroll
            for (int ai = 0; ai < 2; ++ai)
#pragma unroll
                for (int m = 0; m < 4; ++m)
#pragma unroll
                    for (int bj = 0; bj < 2; ++bj) { const unsigned char* p = pg + (size_t)(ai * HALF + m * 16) * 2048 + bj * HALF; ga[ai][m][bj] = *(const u32x2g*)p; gb[ai][m][bj] = *(const u32x2g*)(p + 1024); }
#pragma unroll
            for (int ai = 0; ai < 2; ++ai)
#pragma unroll
                for (int m = 0; m < 4; ++m)
#pragma unroll
                    for (int bj = 0; bj < 2; ++bj) { const unsigned a0 = ga[ai][m][bj].x, a1 = ga[ai][m][bj].y, b0 = gb[ai][m][bj].x, b1 = gb[ai][m][bj].y; f32x4 v0 = acc[ai][bj][m][0], v1 = acc[ai][bj][m][1];
                        v0[0] *= ub0(a0) * __builtin_amdgcn_rcpf(ub0(b0)); v0[1] *= ub1(a0) * __builtin_amdgcn_rcpf(ub1(b0)); v0[2] *= ub2(a0) * __builtin_amdgcn_rcpf(ub2(b0)); v0[3] *= ub3(a0) * __builtin_amdgcn_rcpf(ub3(b0));
                        v1[0] *= ub0(a1) * __builtin_amdgcn_rcpf(ub0(b1)); v1[1] *= ub1(a1) * __builtin_amdgcn_rcpf(ub1(b1)); v1[2] *= ub2(a1) * __builtin_amdgcn_rcpf(ub2(b1)); v1[3] *= ub3(a1) * __builtin_amdgcn_rcpf(ub3(b1));
                        acc[ai][bj][m][0] = v0; acc[ai][bj][m][1] = v1; }
            asm volatile("" ::: "memory");
        } else {
            u32x2g gb[2][4][2];
#pragma unroll
            for (int ai = 0; ai < 2; ++ai)
#pragma unroll
                for (int m = 0; m < 4; ++m)
#pragma unroll
                    for (int bj = 0; bj < 2; ++bj) gb[ai][m][bj] = *(const u32x2g*)(pg + (size_t)(ai * HALF + m * 16) * 2048 + bj * HALF + 1024);
            const float k = 1.0f / 255.0f;
#pragma unroll
            for (int ai = 0; ai < 2; ++ai)
#pragma unroll
                for (int m = 0; m < 4; ++m)
#pragma unroll
                    for (int bj = 0; bj < 2; ++bj) { const unsigned b0 = gb[ai][m][bj].x, b1 = gb[ai][m][bj].y; const f32x4 v0 = acc[ai][bj][m][0], v1 = acc[ai][bj][m][1];
                        u32x4 w; w.x = cvt_pk_bf16(v0[0] * (ub0(b0) * k), v0[1] * (ub1(b0) * k)); w.y = cvt_pk_bf16(v0[2] * (ub2(b0) * k), v0[3] * (ub3(b0) * k));
                        w.z = cvt_pk_bf16(v1[0] * (ub0(b1) * k), v1[1] * (ub1(b1) * k)); w.w = cvt_pk_bf16(v1[2] * (ub2(b1) * k), v1[3] * (ub3(b1) * k));
                        *(u32x4*)(MG + (size_t)(row0 + ai * HALF + m * 16) * 1024 + col0 + bj * HALF) = w; }
            asm volatile("" ::: "memory");
        }
    }
};
struct EpiRes {
    static constexpr bool PERM = false, AFTER_DRAIN = false, CHAIN = false;
    static constexpr bool ROWSCALE = false;
    const float* X; float* H;
    __device__ __forceinline__ void operator()(const f32x4 (&acc)[2][2][4][2], const Unit& u, int wr, int wc, int fr, int fq) const {
        const int row0 = u.pm * BM + wr * 64 + fr, col0 = u.pn * BM + wc * 32 + 4 * fq;
#pragma unroll
        for (int ai = 0; ai < 2; ++ai)
#pragma unroll
            for (int m = 0; m < 4; ++m) { const size_t off = (size_t)(row0 + ai * HALF + m * 16) * 1024 + col0;
#pragma unroll
                for (int bj = 0; bj < 2; ++bj)
#pragma unroll
                    for (int n = 0; n < 2; ++n) { const f32x4 xv = *(const f32x4*)(X + off + bj * HALF + n * 16); *(f32x4*)(H + off + bj * HALF + n * 16) = xv + acc[ai][bj][m][n]; } }
    }
};
struct EpiF16 {
    static constexpr bool PERM = true, AFTER_DRAIN = false, CHAIN = false;
    static constexpr bool ROWSCALE = false;
    unsigned short* C; int ldc;
    __device__ __forceinline__ unsigned pkh(float a, float b) const { typedef _Float16 h2 __attribute__((ext_vector_type(2))); h2 v; v.x = (_Float16)a; v.y = (_Float16)b; return __builtin_bit_cast(unsigned, v); }
    __device__ __forceinline__ void operator()(const f32x4 (&acc)[2][2][4][2], const Unit& u, int wr, int wc, int fr, int fq) const {
        const int row0 = u.pm * BM + wr * 64 + fr, col0 = u.pn * BM + wc * 32 + 8 * fq;
#pragma unroll
        for (int ai = 0; ai < 2; ++ai)
#pragma unroll
            for (int m = 0; m < 4; ++m) { unsigned short* rowp = C + (size_t)(row0 + ai * HALF + m * 16) * ldc + col0;
#pragma unroll
                for (int bj = 0; bj < 2; ++bj) { const f32x4 v0 = acc[ai][bj][m][0], v1 = acc[ai][bj][m][1];
                    u32x4 w; w.x = pkh(v0[0], v0[1]); w.y = pkh(v0[2], v0[3]); w.z = pkh(v1[0], v1[1]); w.w = pkh(v1[2], v1[3]);
                    *(u32x4*)(rowp + bj * HALF) = w; } }
    }
};
struct EpiResRms {
    static constexpr bool PERM = true, AFTER_DRAIN = true, CHAIN = false;
    static constexpr bool ROWSCALE = false;
    const bf16_t* X; bf16_t* H16; unsigned char* X8; float* SSQ; float* SXQ;
    __device__ __forceinline__ void fused(f32x4 (&acc)[2][2][4][2], const Unit& u, int wr, int wc, int fr, int fq, PG8_LAS unsigned char* lds, int wid, int lane) const {
        typedef float f32x2v __attribute__((ext_vector_type(2))); typedef unsigned u32x2v __attribute__((ext_vector_type(2)));
        PG8_LAS f32x2v* P = (PG8_LAS f32x2v*)lds;
        PG8_LAS f32x2v* S = (PG8_LAS f32x2v*)(lds + 8192);
        int col0 = u.pn * BM + wc * 32 + 8 * fq; asm volatile("" : "+v"(col0));
        const bf16_t* xb = X + (size_t)(u.pm * BM + wr * 64 + fr) * 1024 + col0;
        u32x4 xq[2][4][2];
#pragma unroll
        for (int ai = 0; ai < 2; ++ai)
#pragma unroll
            for (int m = 0; m < 4; ++m)
#pragma unroll
                for (int bj = 0; bj < 2; ++bj) xq[ai][m][bj] = *(const u32x4*)(xb + (size_t)(ai * HALF + m * 16) * 1024 + bj * HALF);
#pragma unroll
        for (int am = 0; am < 8; ++am) { const int ai = am >> 2, m = am & 3, r = ai * HALF + wr * 64 + m * 16 + fr;
            asm volatile("" ::: "memory");
            float s = 0.f, a = 0.f;
#pragma unroll
            for (int bj = 0; bj < 2; ++bj)
#pragma unroll
                for (int n = 0; n < 2; ++n) { const u32x4 xw = xq[ai][m][bj]; const unsigned w0 = n ? xw.z : xw.x, w1 = n ? xw.w : xw.y;
                    const f32x4 h = (f32x4){bflo(w0), bfhi(w0), bflo(w1), bfhi(w1)} + acc[ai][bj][m][n]; acc[ai][bj][m][n] = h;
                    s += (h[0] * h[0] + h[1] * h[1]) + (h[2] * h[2] + h[3] * h[3]);
                    a = fmaxf(a, fmaxf(fmaxf(fabsf(h[0]), fabsf(h[1])), fmaxf(fabsf(h[2]), fabsf(h[3])))); }
            s += __shfl_xor(s, 16); s += __shfl_xor(s, 32); a = fmaxf(a, __shfl_xor(a, 16)); a = fmaxf(a, __shfl_xor(a, 32));
            if (fq == 0) P[r * 4 + wc] = (f32x2v){s, a};
            asm volatile("" ::: "memory"); }
        asm volatile("s_waitcnt lgkmcnt(0)" ::: "memory"); __builtin_amdgcn_s_barrier(); asm volatile("" ::: "memory");
        const int row = wid * 32 + (lane & 31);
        if (lane < 32) {
            const f32x2v a = P[row * 4 + 0], b = P[row * 4 + 1], c = P[row * 4 + 2], d = P[row * 4 + 3];
            const float st = (a.x + b.x) + (c.x + d.x), am = fmaxf(fmaxf(a.y, b.y), fmaxf(c.y, d.y));
            const float sc = (am > 0.f) ? am * (1.0f / 448.0f) : 1.0f;
            S[row] = (f32x2v){st, 1.0f / sc};
            SSQ[(size_t)(u.pm * BM + row) * 4 + u.pn] = st; SXQ[(size_t)(u.pm * BM + row) * 4 + u.pn] = sc;
        }
        asm volatile("s_waitcnt lgkmcnt(0)" ::: "memory"); __builtin_amdgcn_s_barrier(); asm volatile("" ::: "memory");
        asm volatile("" : "+v"(col0), "+v"(fr));
#pragma unroll
        for (int ai = 0; ai < 2; ++ai)
#pragma unroll
            for (int m = 0; m < 4; ++m) { const int r = ai * HALF + wr * 64 + m * 16 + fr; const f32x2v sr = S[r]; const size_t off = (size_t)(u.pm * BM + r) * 1024 + col0;
#pragma unroll
                for (int bj = 0; bj < 2; ++bj) { const f32x4 h0 = acc[ai][bj][m][0], h1 = acc[ai][bj][m][1];
                    u32x4 hw; hw.x = cvt_pk_bf16(h0[0], h0[1]); hw.y = cvt_pk_bf16(h0[2], h0[3]); hw.z = cvt_pk_bf16(h1[0], h1[1]); hw.w = cvt_pk_bf16(h1[2], h1[3]);
                    *(u32x4*)(H16 + off + bj * HALF) = hw;
                    { const f32x4 q0 = h0 * sr.y, q1 = h1 * sr.y; u32x2v w8;
                        w8.x = (unsigned)__builtin_amdgcn_cvt_pk_fp8_f32(q0[2], q0[3], __builtin_amdgcn_cvt_pk_fp8_f32(q0[0], q0[1], 0, false), true);
                        w8.y = (unsigned)__builtin_amdgcn_cvt_pk_fp8_f32(q1[2], q1[3], __builtin_amdgcn_cvt_pk_fp8_f32(q1[0], q1[1], 0, false), true);
                        *(u32x2v*)(X8 + off + bj * HALF) = w8; } }
                asm volatile("" ::: "memory"); }
    }
};
struct MergeOrder {
    StaticOrder base;
    __device__ __forceinline__ bool next(int i, Unit& u) const { if (!base.next(i >> 1, u)) return false; u.sel = i & 1; return true; }
    __device__ __forceinline__ void a_ready(const Unit&) const {}
    __device__ __forceinline__ void done(const Unit&) const {}
};

template <class Epi, class Sched, bool ALIGN_EPI = false, bool SP2 = false>
__device__ __forceinline__ void gemm_phase(PG8_LAS unsigned char* lds, const Gemm g, const Sched& S, const Epi& E) {
    const int tid = threadIdx.x, wid = __builtin_amdgcn_readfirstlane(tid >> 6), lane = tid & 63, wr = wid >> 2, wc = wid & 3, fr = lane & 15, fq = lane >> 4;
    const int K = g.K, nt = K / BK;
    unsigned voffA[2], voffB[2];
#pragma unroll
    for (int i = 0; i < 2; ++i) { int R, C; stage_rc(tid * 16 + i * 8192, R, C); const int Rb = Epi::PERM ? ((R & ~31) + perm32(R & 31)) : R;
        voffA[i] = (unsigned)(R * K + C) * 2u; voffB[i] = (unsigned)(Rb * K + C) * 2u; }
    const size_t kstep = (size_t)(BK * 2);
    const size_t hstep = (size_t)HALF * K * 2;
    const size_t tstep = 2 * hstep;
    const unsigned ldsw = (unsigned)wid * 1024u;
    const int aoff = lds_byte(wr * 64 + fr, fq * 8), boff = lds_byte(wc * 32 + fr, fq * 8);
#define PG8_SA(b, h) (((b) * 2 + (h)) * HTB)
#define PG8_SB(b, h) ((4 + (b) * 2 + (h)) * HTB)
#define PG8_STAGE(bufoff, gbase, voff) do { _Pragma("unroll") for (int _i = 0; _i < 2; ++_i) \
        __builtin_amdgcn_global_load_lds((const unsigned*)((const char*)(gbase) + (voff)[_i]), (PG8_LAS unsigned*)(lds + (bufoff) + ldsw + _i * 8192), 16, 0, 0); } while (0)
#define PG8_LDA(dst, b, h) do { _Pragma("unroll") for (int m = 0; m < 4; ++m) _Pragma("unroll") for (int k = 0; k < 2; ++k) dst[m][k] = *(const PG8_LAS bf16x8*)(lds + PG8_SA(b, h) + aoff + m * 2048 + k * 1024); } while (0)
#define PG8_LDB(dst, b, h) do { _Pragma("unroll") for (int n = 0; n < 2; ++n) _Pragma("unroll") for (int k = 0; k < 2; ++k) dst[n][k] = *(const PG8_LAS bf16x8*)(lds + PG8_SB(b, h) + boff + n * 2048 + k * 1024); } while (0)
#define PG8_MMA(ai, bj, At, Bt) do { __builtin_amdgcn_s_setprio(1); _Pragma("unroll") for (int m = 0; m < 4; ++m) _Pragma("unroll") for (int n = 0; n < 2; ++n) _Pragma("unroll") for (int k = 0; k < 2; ++k) \
        acc[ai][bj][m][n] = __builtin_amdgcn_mfma_f32_16x16x32_bf16(Bt[n][k], At[m][k], acc[ai][bj][m][n], 0, 0, 0); __builtin_amdgcn_s_setprio(0); } while (0)
#define PG8_WAIT_V(n) asm volatile("s_waitcnt vmcnt(" #n ")" ::: "memory")
#define PG8_WAIT_L(n) asm volatile("s_waitcnt lgkmcnt(" #n ")" ::: "memory")
#define PG8_BAR __builtin_amdgcn_s_barrier()
#define PG8_SCHED __builtin_amdgcn_sched_barrier(0)
    Unit cur, nxt; int ui = 0;
    if (!S.next(0, cur)) return;
    f32x4 acc[2][2][4][2];
#pragma unroll
    for (int a = 0; a < 2; ++a)
#pragma unroll
        for (int b = 0; b < 2; ++b)
#pragma unroll
            for (int m = 0; m < 4; ++m)
#pragma unroll
                for (int n = 0; n < 2; ++n) acc[a][b][m][n] = (f32x4){0.f, 0.f, 0.f, 0.f};
    bf16x8 At[4][2], B0[2][2], B1[2][2];
    const char* cA = (const char*)g.A + (cur.sel ? g.offA1 : 0l) + (size_t)cur.pm * tstep; const char* cB = (const char*)g.Bt + (cur.sel ? g.offB1 : 0l) + (size_t)cur.pn * tstep;
    S.a_ready(cur);
    if constexpr (Epi::ROWSCALE) E.unit_begin(cur, 0, tid, lds + STAGE_BYTES);
    if constexpr (SP2) {
        PG8_STAGE(PG8_SB(0, 0), cB, voffB); PG8_STAGE(PG8_SB(0, 1), cB + hstep, voffB); PG8_STAGE(PG8_SA(0, 0), cA, voffA); PG8_STAGE(PG8_SA(0, 1), cA + hstep, voffA);
        if (wr == 1) PG8_BAR;
        PG8_WAIT_V(2); PG8_BAR;
        PG8_STAGE(PG8_SB(1, 0), cB + kstep, voffB); PG8_STAGE(PG8_SA(1, 0), cA + kstep, voffA); PG8_STAGE(PG8_SB(1, 1), cB + hstep + kstep, voffB);
        PG8_WAIT_V(6); PG8_BAR;
    } else {
        PG8_STAGE(PG8_SB(0, 0), cB, voffB); PG8_STAGE(PG8_SA(0, 0), cA, voffA); PG8_STAGE(PG8_SB(0, 1), cB + hstep, voffB); PG8_STAGE(PG8_SA(0, 1), cA + hstep, voffA);
        if (wr == 1) PG8_BAR;
        PG8_WAIT_V(4); PG8_BAR;
        PG8_STAGE(PG8_SB(1, 0), cB + kstep, voffB); PG8_STAGE(PG8_SA(1, 0), cA + kstep, voffA); PG8_STAGE(PG8_SB(1, 1), cB + hstep + kstep, voffB);
        PG8_WAIT_V(6); PG8_BAR;
    }
    for (;;) {
        const bool has_next = S.next(ui + 1, nxt);
        const char* nA = has_next ? (const char*)g.A + (nxt.sel ? g.offA1 : 0l) + (size_t)nxt.pm * tstep : cA; const char* nB = has_next ? (const char*)g.Bt + (nxt.sel ? g.offB1 : 0l) + (size_t)nxt.pn * tstep : cB;
        for (int t = 0; t < nt; t += 2) {
            const bool last = (t == nt - 2);
            const char* a1 = cA + (size_t)(t + 1) * kstep;
            const char* a2 = last ? nA : cA + (size_t)(t + 2) * kstep; const char* b2 = last ? nB : cB + (size_t)(t + 2) * kstep;
            const char* a3 = a2 + kstep; const char* b3 = b2 + kstep;
            if (last && has_next) S.a_ready(nxt);
            if constexpr (SP2) {
            PG8_LDB(B0, 0, 0); PG8_LDB(B1, 0, 1); PG8_SCHED; PG8_LDA(At, 0, 0); PG8_STAGE(PG8_SA(1, 1), a1 + hstep, voffA);
            PG8_WAIT_V(8); PG8_WAIT_L(0); PG8_BAR; PG8_MMA(0, 0, At, B0); PG8_MMA(0, 1, At, B1); PG8_BAR; PG8_SCHED;
            PG8_LDA(At, 0, 1); PG8_STAGE(PG8_SB(0, 0), b2, voffB); PG8_STAGE(PG8_SB(0, 1), b2 + hstep, voffB); PG8_STAGE(PG8_SA(0, 0), a2, voffA);
            PG8_WAIT_V(8); PG8_WAIT_L(0); PG8_BAR; PG8_MMA(1, 0, At, B0); PG8_MMA(1, 1, At, B1); PG8_BAR; PG8_SCHED;
            PG8_LDB(B0, 1, 0); PG8_LDB(B1, 1, 1); PG8_SCHED; PG8_LDA(At, 1, 0); PG8_STAGE(PG8_SA(0, 1), a2 + hstep, voffA);
            PG8_WAIT_V(8); PG8_WAIT_L(0); PG8_BAR; PG8_MMA(0, 0, At, B0); PG8_MMA(0, 1, At, B1); PG8_BAR; PG8_SCHED;
            PG8_LDA(At, 1, 1); PG8_STAGE(PG8_SB(1, 0), b3, voffB); PG8_STAGE(PG8_SB(1, 1), b3 + hstep, voffB); PG8_STAGE(PG8_SA(1, 0), a3, voffA);
            PG8_WAIT_V(8); PG8_WAIT_L(0); PG8_BAR; PG8_MMA(1, 0, At, B0); PG8_MMA(1, 1, At, B1); PG8_BAR; PG8_SCHED;
            } else {
            PG8_LDB(B0, 0, 0); PG8_SCHED; PG8_LDA(At, 0, 0); PG8_STAGE(PG8_SA(1, 1), a1 + hstep, voffA);
            PG8_WAIT_L(8); PG8_BAR; PG8_WAIT_L(0); PG8_MMA(0, 0, At, B0); PG8_BAR; PG8_SCHED;
            PG8_LDB(B1, 0, 1); PG8_STAGE(PG8_SB(0, 0), b2, voffB);
            PG8_BAR; PG8_WAIT_L(0); PG8_MMA(0, 1, At, B1); PG8_BAR;
            PG8_LDA(At, 0, 1); PG8_STAGE(PG8_SA(0, 0), a2, voffA);
            PG8_BAR; PG8_WAIT_L(0); PG8_MMA(1, 0, At, B0); PG8_BAR; PG8_SCHED;
            PG8_STAGE(PG8_SB(0, 1), b2 + hstep, voffB);
            PG8_WAIT_V(6); PG8_BAR; PG8_MMA(1, 1, At, B1); PG8_BAR;
            PG8_LDB(B0, 1, 0); PG8_SCHED; PG8_LDA(At, 1, 0); PG8_STAGE(PG8_SA(0, 1), a2 + hstep, voffA);
            PG8_WAIT_L(8); PG8_BAR; PG8_WAIT_L(0); PG8_MMA(0, 0, At, B0); PG8_BAR; PG8_SCHED;
            PG8_LDB(B1, 1, 1); PG8_STAGE(PG8_SB(1, 0), b3, voffB);
            PG8_BAR; PG8_WAIT_L(0); PG8_MMA(0, 1, At, B1); PG8_BAR;
            PG8_LDA(At, 1, 1); PG8_STAGE(PG8_SA(1, 0), a3, voffA);
            PG8_BAR; PG8_WAIT_L(0); PG8_MMA(1, 0, At, B0); PG8_BAR; PG8_SCHED;
            PG8_STAGE(PG8_SB(1, 1), b3 + hstep, voffB);
            PG8_WAIT_V(6); PG8_BAR; PG8_MMA(1, 1, At, B1); PG8_BAR;
            }
        }
        if constexpr (ALIGN_EPI) { if (wr == 0) PG8_BAR; }
        if constexpr (Epi::ROWSCALE) { E(acc, cur, wr, wc, fr, fq, (const PG8_LAS float*)(lds + STAGE_BYTES + (ui & 1) * 2048)); S.done(cur); }
        else if constexpr (!Epi::AFTER_DRAIN) { E(acc, cur, wr, wc, fr, fq); S.done(cur); }
        if (!has_next) break;
        if (!Epi::CHAIN || nxt.sel == 0) {
#pragma unroll
        for (int a = 0; a < 2; ++a)
#pragma unroll
            for (int b = 0; b < 2; ++b)
#pragma unroll
                for (int m = 0; m < 4; ++m)
#pragma unroll
                    for (int n = 0; n < 2; ++n) acc[a][b][m][n] = (f32x4){0.f, 0.f, 0.f, 0.f};
        }
        cur = nxt; cA = nA; cB = nB; ++ui;
        if constexpr (Epi::ROWSCALE) E.unit_begin(cur, ui, tid, lds + STAGE_BYTES);
        if constexpr (ALIGN_EPI) { if (wr == 1) PG8_BAR; }
    }
    PG8_WAIT_V(0);
    if constexpr (!ALIGN_EPI) { if (wr == 0) PG8_BAR; }
    PG8_BAR;
    if constexpr (Epi::AFTER_DRAIN) { E.fused(acc, cur, wr, wc, fr, fq, lds, wid, lane); S.done(cur); }
#undef PG8_SA
#undef PG8_SB
#undef PG8_STAGE
#undef PG8_LDA
#undef PG8_LDB
#undef PG8_MMA
#undef PG8_WAIT_V
#undef PG8_WAIT_L
#undef PG8_BAR
#undef PG8_SCHED
}
}
constexpr int NWAVES = 8;
#ifndef MK_N_LAUNCHES
#define MK_N_LAUNCHES 1
#endif
constexpr int NPHASE = 8;
#ifndef PROBE_DUP
#define PROBE_DUP 0
#endif
#ifndef PROBE_DELAY
#define PROBE_DELAY (-1)
#endif
#define DELAY_T0(k) const unsigned long long _t0_##k = (PROBE_DELAY == (k)) ? __builtin_amdgcn_s_memrealtime() : 0ull
#define DELAY_END(k) do { if (PROBE_DELAY == (k)) { const unsigned long long _t1 = __builtin_amdgcn_s_memrealtime(), _dt = _t1 - _t0_##k; while (__builtin_amdgcn_s_memrealtime() - _t1 < _dt) __builtin_amdgcn_s_sleep(8); } } while (0)
#define REPS(k) (1 + ((PROBE_DUP >> (k)) & 1))
constexpr int N_LAUNCHES = MK_N_LAUNCHES;
static_assert(N_LAUNCHES == 1 || N_LAUNCHES == NPHASE, "MK_N_LAUNCHES is 1 or NPHASE");

constexpr int T = 16384, SEQ = 2048, D = 1024, NIN = 6144, NSC = 2048, NEXP = 16384, NSEL = 128;
constexpr float EPS = 1e-6f;

constexpr size_t MiB = 1u << 20;
constexpr size_t WS_CTL = 0, CTL_ZERO_BYTES = 64 * 1024;
constexpr size_t WS_WIN = 1 * MiB, WS_WC = 13 * MiB, WS_WPB = 15 * MiB, WS_WOUT = 17 * MiB, WS_WS = 19 * MiB;
constexpr size_t WS_IDX = 1 * MiB, WS_GATE = 9 * MiB;
constexpr size_t WS_XN = 32 * MiB;
constexpr size_t WS_PB = 64 * MiB;
constexpr size_t WS_TMP = 64 * MiB, WS_MG = 96 * MiB;
constexpr size_t WS_X8 = 128 * MiB, WS_SX = 144 * MiB;
constexpr size_t WS_PO = 64 * MiB;
constexpr size_t WS_SC = 64 * MiB;
constexpr size_t WS_PG = 192 * MiB;
constexpr size_t WS_U8 = 192 * MiB, WS_V8 = 208 * MiB, WS_H16 = 224 * MiB, WS_SU = 31 * MiB + 512 * 1024, WS_SV = 31 * MiB + 576 * 1024;
constexpr size_t WS_END = 256 * MiB;
constexpr int CW_TMO = 0;
constexpr int CW_BAR = 1024;
constexpr int CW_SEAM = 8192;
constexpr size_t WS_RAWU = 160 * MiB, WS_RAWB = 164 * MiB;
constexpr size_t WS_RS1 = 31 * MiB + 640 * 1024;
constexpr size_t WS_XBUF = 31 * MiB;

constexpr int RING_OFF = 0, RING_BYTES = 131072;
constexpr int P7_WAVE_BYTES = 18432;
constexpr int P7_IDX_OFF = 0, P7_OUT_OFF = 4096, P7_STAGE_OFF = 6144, P7_ZA_OFF = 14336;
constexpr int LDSCTL_OFF = 8 * P7_WAVE_BYTES, MISC_OFF = LDSCTL_OFF + 320;
constexpr int P7_AUX_OFF = LDSCTL_OFF + 1024;
constexpr int LDS_BYTES = 150528;
#define GAS __attribute__((address_space(1)))
#define LAS __attribute__((address_space(3)))
typedef unsigned short bf16;
typedef unsigned v4u __attribute__((ext_vector_type(4)));
typedef float f32x4 __attribute__((ext_vector_type(4)));
typedef short bf16x8 __attribute__((ext_vector_type(8)));
typedef GAS unsigned gu32;
typedef GAS unsigned long long gu64;
#define RLX_AGENT __ATOMIC_RELAXED, __HIP_MEMORY_SCOPE_AGENT
#define LDS_WAIT() asm volatile("s_waitcnt lgkmcnt(0)" ::: "memory")
#define VM_WAIT() asm volatile("s_waitcnt vmcnt(0)" ::: "memory")
__device__ __forceinline__ unsigned long long rt() { return __builtin_amdgcn_s_memrealtime(); }
__device__ __forceinline__ unsigned f2bf(float f) { unsigned u = __builtin_bit_cast(unsigned, f); return (u + 0x7fffu + ((u >> 16) & 1u)) >> 16; }
__device__ __forceinline__ unsigned pk2(float lo, float hi) { return f2bf(lo) | (f2bf(hi) << 16); }

#define XB_TMO      128
#define XB_XCNT(j)  (256  + 64 * (j))
#define XB_XSUB(j)  (1280 + 64 * (j))
#define XB_XGEN(j)  (2304 + 64 * (j))
#define XB_TOP      3328
#define XB_TOPGEN   3392
#define XCD_BAR_WORDS 3456
#define XB_SPIN_CAP (1u << 18)

__device__ __forceinline__ unsigned xb_ld(unsigned* p)              { return __hip_atomic_load(p, __ATOMIC_RELAXED, __HIP_MEMORY_SCOPE_AGENT); }
__device__ __forceinline__ unsigned xb_add(unsigned* p, unsigned v) { return __hip_atomic_fetch_add(p, v, __ATOMIC_RELAXED, __HIP_MEMORY_SCOPE_AGENT); }
__device__ __forceinline__ unsigned xb_xcc_id() { return (unsigned)__builtin_amdgcn_s_getreg((3 << 11) | 20) & 0xFu; }
#define XB_SPIN(cond, bar) do { unsigned _sp = 0; while (cond) { __builtin_amdgcn_s_sleep(1); \
    if ((++_sp & 255u) == 0u) { if (xb_ld(&(bar)[XB_TMO])) break; if (_sp > XB_SPIN_CAP) { atomicAdd(&(bar)[XB_TMO], 1u); break; } } } } while (0)

struct XcdBarrier {
    unsigned* bar; unsigned x;
    volatile LAS unsigned* st;
};

__device__ __forceinline__ XcdBarrier xcd_barrier_post(unsigned* bar, volatile LAS unsigned* st) {
    XcdBarrier b; b.bar = bar; b.x = xb_xcc_id(); b.st = st;
    if (threadIdx.x == 0) (void)xb_add(&bar[XB_XCNT(b.x)], 1u);
    return b;
}
__device__ __forceinline__ void xcd_barrier_complete(unsigned* bar, unsigned x, unsigned& nloc, unsigned& nx) {
    const unsigned G = gridDim.x * gridDim.y * gridDim.z;
    unsigned sum, cnt, mine, sp = 0u;
    for (;;) {
        sum = 0u; cnt = 0u; mine = 0u;
#pragma unroll
        for (unsigned j = 0; j < 16; ++j) { const unsigned c = xb_ld(&bar[XB_XCNT(j)]); sum += c; cnt += (c > 0u) ? 1u : 0u; mine = (j == x) ? c : mine; }
        if (sum == G) break;
        __builtin_amdgcn_s_sleep(1);
        if ((++sp & 255u) == 0u) { if (xb_ld(&bar[XB_TMO])) break; if (sp > XB_SPIN_CAP) { atomicAdd(&bar[XB_TMO], 1u); break; } }
    }
    nloc = mine > 0u ? mine : 1u; nx = cnt > 0u ? cnt : 1u;
}

__device__ __forceinline__ void xcd_barrier(const XcdBarrier& b) {
    asm volatile("s_waitcnt vmcnt(0)" ::: "memory");
    __syncthreads();
    if (threadIdx.x == 0) {
        unsigned* bar = b.bar;
        __builtin_amdgcn_s_waitcnt(0);
        unsigned nloc = b.st[0], nx = b.st[1];
        if (nloc == 0u) { xcd_barrier_complete(bar, b.x, nloc, nx); b.st[0] = nloc; b.st[1] = nx; }
        const unsigned old = xb_add(&bar[XB_XSUB(b.x)], 1u);
        const unsigned gen = old / nloc;
        if (old + 1u == (gen + 1u) * nloc) {
            __builtin_amdgcn_fence(__ATOMIC_RELEASE, "agent");
            asm volatile("s_waitcnt vmcnt(0)" ::: "memory");
            const unsigned og = xb_add(&bar[XB_TOP], 1u);
            const unsigned tg = og / nx;
            if (og + 1u == (tg + 1u) * nx) xb_add(&bar[XB_TOPGEN], 1u);
            else XB_SPIN(xb_ld(&bar[XB_TOPGEN]) == tg, bar);
            __builtin_amdgcn_fence(__ATOMIC_ACQUIRE, "agent");
            xb_add(&bar[XB_XGEN(b.x)], 1u);
            asm volatile("s_waitcnt vmcnt(0)" ::: "memory");
        } else {
            XB_SPIN(xb_ld(&bar[XB_XGEN(b.x)]) == gen, bar);
            __builtin_amdgcn_fence(__ATOMIC_ACQUIRE, "agent");
            asm volatile("s_waitcnt vmcnt(0)" ::: "memory");
        }
    }
    __syncthreads();
}

struct Frame {
    LAS unsigned char* lds;
    volatile LAS unsigned* MISC;
    int tid, lane, wave;
    int vcu, G;
};
__device__ __forceinline__ float wave_sum(float v) {
#pragma unroll
    for (int o = 1; o < 64; o <<= 1) v += __shfl_xor(v, o);
    return v;
}
__device__ __forceinline__ float bflo(unsigned w) { return __uint_as_float(w << 16); }
__device__ __forceinline__ float bfhi(unsigned w) { return __uint_as_float(w & 0xffff0000u); }
__device__ __forceinline__ void unpack8(const v4u w, float (&f)[8]) { f[0] = bflo(w.x); f[1] = bfhi(w.x); f[2] = bflo(w.y); f[3] = bfhi(w.y); f[4] = bflo(w.z); f[5] = bfhi(w.z); f[6] = bflo(w.w); f[7] = bfhi(w.w); }
__device__ __forceinline__ v4u pack8(const float (&f)[8]) { v4u o; o.x = pk2(f[0], f[1]); o.y = pk2(f[2], f[3]); o.z = pk2(f[4], f[5]); o.w = pk2(f[6], f[7]); return o; }

__device__ __forceinline__ void rms_row_to_fp8(int lane, const float* xrow, const float* g, unsigned char* orow, float* sc_out) {
    const GAS f32x4* xr = (const GAS f32x4*)xrow + 4 * lane; const GAS f32x4* gr = (const GAS f32x4*)g + 4 * lane;
    f32x4 v[4]; float s = 0.f, am = 0.f;
#pragma unroll
    for (int jj = 0; jj < 4; ++jj) { v[jj] = xr[jj]; s += (v[jj].x * v[jj].x + v[jj].y * v[jj].y) + (v[jj].z * v[jj].z + v[jj].w * v[jj].w); v[jj] = v[jj] * gr[jj];
        am = fmaxf(am, fmaxf(fmaxf(fabsf(v[jj].x), fabsf(v[jj].y)), fmaxf(fabsf(v[jj].z), fabsf(v[jj].w)))); }
#pragma unroll
    for (int o = 1; o < 64; o <<= 1) am = fmaxf(am, __shfl_xor(am, o));
    const float rstd = 1.f / sqrtf(wave_sum(s) * (1.f / D) + EPS), xm = am * rstd, sc = (xm > 0.f) ? xm * (1.0f / 448.0f) : 1.0f, mul = rstd / sc;
    v4u o;
    o.x = (unsigned)__builtin_amdgcn_cvt_pk_fp8_f32(v[0].z * mul, v[0].w * mul, __builtin_amdgcn_cvt_pk_fp8_f32(v[0].x * mul, v[0].y * mul, 0, false), true);
    o.y = (unsigned)__builtin_amdgcn_cvt_pk_fp8_f32(v[1].z * mul, v[1].w * mul, __builtin_amdgcn_cvt_pk_fp8_f32(v[1].x * mul, v[1].y * mul, 0, false), true);
    o.z = (unsigned)__builtin_amdgcn_cvt_pk_fp8_f32(v[2].z * mul, v[2].w * mul, __builtin_amdgcn_cvt_pk_fp8_f32(v[2].x * mul, v[2].y * mul, 0, false), true);
    o.w = (unsigned)__builtin_amdgcn_cvt_pk_fp8_f32(v[3].z * mul, v[3].w * mul, __builtin_amdgcn_cvt_pk_fp8_f32(v[3].x * mul, v[3].y * mul, 0, false), true);
    *(GAS v4u*)(orow + 16 * lane) = o;
    if (lane == 0) *sc_out = sc;
}
__device__ __forceinline__ void p4_row_defer(int lane, const float* hrow, unsigned char* x8, float* ssq, float* sxq, bf16* h16) {
    const GAS f32x4* xr = (const GAS f32x4*)hrow + 4 * lane;
    f32x4 h[4]; float s = 0.f, am = 0.f;
#pragma unroll
    for (int jj = 0; jj < 4; ++jj) { h[jj] = xr[jj]; s += (h[jj].x * h[jj].x + h[jj].y * h[jj].y) + (h[jj].z * h[jj].z + h[jj].w * h[jj].w);
        am = fmaxf(am, fmaxf(fmaxf(fabsf(h[jj].x), fabsf(h[jj].y)), fmaxf(fabsf(h[jj].z), fabsf(h[jj].w)))); }
#pragma unroll
    for (int o = 1; o < 64; o <<= 1) am = fmaxf(am, __shfl_xor(am, o));
    s = wave_sum(s);
    const float sc = (am > 0.f) ? am * (1.0f / 448.0f) : 1.0f, mul = 1.0f / sc;
    v4u o;
    o.x = (unsigned)__builtin_amdgcn_cvt_pk_fp8_f32(h[0].z * mul, h[0].w * mul, __builtin_amdgcn_cvt_pk_fp8_f32(h[0].x * mul, h[0].y * mul, 0, false), true);
    o.y = (unsigned)__builtin_amdgcn_cvt_pk_fp8_f32(h[1].z * mul, h[1].w * mul, __builtin_amdgcn_cvt_pk_fp8_f32(h[1].x * mul, h[1].y * mul, 0, false), true);
    o.z = (unsigned)__builtin_amdgcn_cvt_pk_fp8_f32(h[2].z * mul, h[2].w * mul, __builtin_amdgcn_cvt_pk_fp8_f32(h[2].x * mul, h[2].y * mul, 0, false), true);
    o.w = (unsigned)__builtin_amdgcn_cvt_pk_fp8_f32(h[3].z * mul, h[3].w * mul, __builtin_amdgcn_cvt_pk_fp8_f32(h[3].x * mul, h[3].y * mul, 0, false), true);
    *(GAS v4u*)(x8 + 16 * lane) = o;
    v4u b0, b1;
    b0.x = pk2(h[0].x, h[0].y); b0.y = pk2(h[0].z, h[0].w); b0.z = pk2(h[1].x, h[1].y); b0.w = pk2(h[1].z, h[1].w); b1.x = pk2(h[2].x, h[2].y); b1.y = pk2(h[2].z, h[2].w); b1.z = pk2(h[3].x, h[3].y); b1.w = pk2(h[3].z, h[3].w);
    *(GAS v4u*)(h16 + 16 * lane) = b0; *(GAS v4u*)(h16 + 16 * lane + 8) = b1;
    if (lane == 0) { ssq[0] = s; ssq[1] = 0.f; ssq[2] = 0.f; ssq[3] = 0.f; sxq[0] = sc; sxq[1] = sc; sxq[2] = sc; sxq[3] = sc; }
}
__device__ __forceinline__ void rms_rows4_to_bf16(int lane, const float* xrow, bf16* orow, float* rs) {
    asm volatile("" : "+v"(lane));
    f32x4 v[4][4]; float s[4];
#pragma unroll
    for (int rr = 0; rr < 4; ++rr) { const GAS f32x4* xr = (const GAS f32x4*)(xrow + (size_t)rr * D) + lane;
#pragma unroll
        for (int jj = 0; jj < 4; ++jj) v[rr][jj] = xr[64 * jj]; }
#pragma unroll
    for (int rr = 0; rr < 4; ++rr) { float a = 0.f;
#pragma unroll
        for (int jj = 0; jj < 4; ++jj) a += (v[rr][jj].x * v[rr][jj].x + v[rr][jj].y * v[rr][jj].y) + (v[rr][jj].z * v[rr][jj].z + v[rr][jj].w * v[rr][jj].w);
        s[rr] = a; }
#pragma unroll
    for (int rr = 0; rr < 4; ++rr) { GAS unsigned long long* o8 = (GAS unsigned long long*)(orow + (size_t)rr * D) + lane;
#pragma unroll
        for (int jj = 0; jj < 4; ++jj) o8[64 * jj] = (unsigned long long)pk2(v[rr][jj].x, v[rr][jj].y) | ((unsigned long long)pk2(v[rr][jj].z, v[rr][jj].w) << 32); }
#pragma unroll
    for (int o = 1; o < 64; o <<= 1) {
#pragma unroll
        for (int rr = 0; rr < 4; ++rr) s[rr] += __shfl_xor(s[rr], o); }
    if (lane < 4) { const float sv = (lane == 0) ? s[0] : (lane == 1) ? s[1] : (lane == 2) ? s[2] : s[3]; rs[lane] = 1.f / sqrtf(sv * (1.f / D) + EPS); }
}
template <bool PERM_IN>
__device__ __forceinline__ void p0_transpose_item(const float* W, int K, int N, bf16* WT, LAS float* scr, int item, int lane, const float* ks = nullptr  ) {
    const int nblk = N / 32, kb = item / nblk, nb = item % nblk, k0 = 64 * kb, n0 = 32 * nb;
    int nsl = n0 + (lane & 31);
    if (PERM_IN && n0 < 4096) { const int l = lane & 31, q = n0 & 255;
        nsl = (2 * (q >> 7) + ((l >> 2) & 1)) * 1024 + 64 * (n0 >> 8) + 16 * ((q >> 5) & 3) + 4 * (l >> 3) + (l & 3); }
    float tv[32];
#pragma unroll
    for (int i = 0; i < 32; ++i) tv[i] = W[(size_t)(k0 + 2 * i + (lane >> 5)) * N + nsl];
    if (ks) {
#pragma unroll
        for (int i = 0; i < 32; ++i) tv[i] *= ks[k0 + 2 * i + (lane >> 5)]; }
#pragma unroll
    for (int i = 0; i < 32; ++i) scr[(2 * i + (lane >> 5)) * 33 + (lane & 31)] = tv[i];
    LDS_WAIT(); asm volatile("" ::: "memory");
    const int c = lane & 7;
#pragma unroll
    for (int j = 0; j < 4; ++j) { const int n = (lane >> 3) + 8 * j; const LAS float* s = scr + (8 * c) * 33 + n;
        v4u o; o.x = pk2(s[0 * 33], s[1 * 33]); o.y = pk2(s[2 * 33], s[3 * 33]); o.z = pk2(s[4 * 33], s[5 * 33]); o.w = pk2(s[6 * 33], s[7 * 33]);
        *(GAS v4u*)(WT + (size_t)(n0 + n) * K + k0 + 8 * c) = o; }
    LDS_WAIT(); asm volatile("" ::: "memory");
}
template <int NS>
__device__ __forceinline__ void fold_tile(LAS float* sm, const float* Ap, int sAi, int sAk, const float* As, const float* Bp, int sBj, bf16* Cp, int ldc, int tid) {
    LAS float* sA = sm; LAS float* sB = sm + 32 * 68;
    float ra[NS][4], rb[NS][4];
#pragma unroll
    for (int sl = 0; sl < NS; ++sl)
#pragma unroll
        for (int r = 0; r < 4; ++r) { const int e = tid + 512 * r; int i, kq;
            if (sAk == 1) { kq = e & 31; i = e >> 5; } else { i = e & 63; kq = e >> 6; }
            float a = Ap[(size_t)i * sAi + (size_t)(sl * 32 + kq) * sAk]; if (As) a *= As[sl * 32 + kq]; ra[sl][r] = a;
            rb[sl][r] = Bp[(size_t)(e >> 5) * sBj + sl * 32 + (e & 31)]; }
    float acc[2][4];
#pragma unroll
    for (int q = 0; q < 2; ++q)
#pragma unroll
        for (int p = 0; p < 4; ++p) acc[q][p] = 0.f;
    const int tj4 = (tid & 15) * 4, ti2 = (tid >> 4) * 2;
#pragma unroll
    for (int sl = 0; sl < NS; ++sl) {
#pragma unroll
        for (int r = 0; r < 4; ++r) { const int e = tid + 512 * r; int i, kq;
            if (sAk == 1) { kq = e & 31; i = e >> 5; } else { i = e & 63; kq = e >> 6; }
            sA[kq * 68 + i] = ra[sl][r]; sB[(e & 31) * 68 + (e >> 5)] = rb[sl][r]; }
        __syncthreads();
#pragma unroll 8
        for (int kk = 0; kk < 32; ++kk) { const f32x4 bq = *(const LAS f32x4*)(sB + kk * 68 + tj4); const float a0 = sA[kk * 68 + ti2], a1 = sA[kk * 68 + ti2 + 1];
            acc[0][0] += a0 * bq.x; acc[0][1] += a0 * bq.y; acc[0][2] += a0 * bq.z; acc[0][3] += a0 * bq.w;
            acc[1][0] += a1 * bq.x; acc[1][1] += a1 * bq.y; acc[1][2] += a1 * bq.z; acc[1][3] += a1 * bq.w; }
        __syncthreads();
    }
#pragma unroll
    for (int q = 0; q < 2; ++q) *(GAS unsigned long long*)(Cp + (size_t)(ti2 + q) * ldc + tj4) = (unsigned long long)pk2(acc[q][0], acc[q][1]) | ((unsigned long long)pk2(acc[q][2], acc[q][3]) << 32);
}
template <int NS, int TJ, bool A_ICONTIG>
__device__ __forceinline__ void fold_wave(LAS float* sm, const float* Ap, int sA, const float* As, const float* Bp, int sBj, bf16* Cp, int ldc, int lane, const float* Cs = nullptr  ) {
    constexpr int NB = TJ / 8, RB = TJ / 8;
    LAS float* sAl = sm; LAS float* sBl = sm + 32 * 36;
    const int l8 = lane >> 3, l7 = lane & 7;
    f32x4 ra[4], rb[RB];
#define FW_LOAD(sl_) do { _Pragma("unroll") for (int r = 0; r < 4; ++r) { \
            if (A_ICONTIG) { const int kq = l8 + 8 * r; f32x4 a = *(const GAS f32x4*)(Ap + (size_t)((sl_) * 32 + kq) * sA + l7 * 4); const float sc = As[(sl_) * 32 + kq]; ra[r] = a * sc; } \
            else ra[r] = *(const GAS f32x4*)(Ap + (size_t)(l8 + 8 * r) * sA + (sl_) * 32 + l7 * 4); } \
        _Pragma("unroll") for (int r = 0; r < RB; ++r) rb[r] = *(const GAS f32x4*)(Bp + (size_t)(l8 + 8 * r) * sBj + (sl_) * 32 + l7 * 4); } while (0)
    FW_LOAD(0);
    float acc[4][NB];
#pragma unroll
    for (int p = 0; p < 4; ++p)
#pragma unroll
        for (int q = 0; q < NB; ++q) acc[p][q] = 0.f;
#pragma unroll
    for (int sl = 0; sl < NS; ++sl) {
#pragma unroll
        for (int r = 0; r < 4; ++r) {
            if (A_ICONTIG) *(LAS f32x4*)(sAl + (l8 + 8 * r) * 36 + l7 * 4) = ra[r];
            else { const int i = l8 + 8 * r, kq = l7 * 4; sAl[kq * 36 + i] = ra[r].x; sAl[(kq + 1) * 36 + i] = ra[r].y; sAl[(kq + 2) * 36 + i] = ra[r].z; sAl[(kq + 3) * 36 + i] = ra[r].w; } }
#pragma unroll
        for (int r = 0; r < RB; ++r) { const int jj = l8 + 8 * r, kq = l7 * 4; sBl[kq * 36 + jj] = rb[r].x; sBl[(kq + 1) * 36 + jj] = rb[r].y; sBl[(kq + 2) * 36 + jj] = rb[r].z; sBl[(kq + 3) * 36 + jj] = rb[r].w; }
        LDS_WAIT(); asm volatile("" ::: "memory");
        if (sl + 1 < NS) FW_LOAD(sl + 1);
#pragma unroll 8
        for (int kk = 0; kk < 32; ++kk) { const f32x4 a4 = *(const LAS f32x4*)(sAl + kk * 36 + 4 * l8);
            float bq[NB];
            if (NB == 4) { const f32x4 b4 = *(const LAS f32x4*)(sBl + kk * 36 + 4 * l7); bq[0] = b4.x; bq[1] = b4.y; bq[2] = b4.z; bq[NB - 1] = b4.w; }
            else { bq[0] = sBl[kk * 36 + 2 * l7]; bq[NB - 1] = sBl[kk * 36 + 2 * l7 + 1]; }
#pragma unroll
            for (int q = 0; q < NB; ++q) { acc[0][q] += a4.x * bq[q]; acc[1][q] += a4.y * bq[q]; acc[2][q] += a4.z * bq[q]; acc[3][q] += a4.w * bq[q]; } }
        LDS_WAIT(); asm volatile("" ::: "memory");
    }
#undef FW_LOAD
    if (Cs) {
#pragma unroll
        for (int q = 0; q < NB; ++q) { const float cs = Cs[NB * l7 + q];
#pragma unroll
            for (int p = 0; p < 4; ++p) acc[p][q] *= cs; } }
#pragma unroll
    for (int p = 0; p < 4; ++p) { bf16* cp = Cp + (size_t)(4 * l8 + p) * ldc + NB * l7;
        if (NB == 4) *(GAS unsigned long long*)cp = (unsigned long long)pk2(acc[p][0], acc[p][1]) | ((unsigned long long)pk2(acc[p][2], acc[p][NB - 1]) << 32);
        else *(GAS unsigned*)cp = pk2(acc[p][0], acc[p][NB - 1]); }
}
__device__ __forceinline__ void rms_row_to_bf16(int lane, const float* xrow, const float* g, bf16* orow) {
    const GAS f32x4* xr = (const GAS f32x4*)xrow + lane; const GAS f32x4* gr = (const GAS f32x4*)g + lane;
    f32x4 v[4]; float s = 0.f;
#pragma unroll
    for (int j = 0; j < 4; ++j) { v[j] = xr[64 * j]; s += (v[j].x * v[j].x + v[j].y * v[j].y) + (v[j].z * v[j].z + v[j].w * v[j].w); }
    const float rstd = 1.f / sqrtf(wave_sum(s) * (1.f / D) + EPS);
    GAS unsigned long long* o8 = (GAS unsigned long long*)orow + lane;
#pragma unroll
    for (int j = 0; j < 4; ++j) { const f32x4 gg = gr[64 * j];
        o8[64 * j] = (unsigned long long)pk2(v[j].x * rstd * gg.x, v[j].y * rstd * gg.y) | ((unsigned long long)pk2(v[j].z * rstd * gg.z, v[j].w * rstd * gg.w) << 32); }
}
__device__ __forceinline__ v4u ldv(const bf16* p) { return *(const GAS v4u*)p; }
template <int WIN> __device__ __forceinline__ void p2_pool(const bf16* pcol  , bf16* ocol  , int t0, bool first) {
    for (int hf = 0; hf < ((WIN - 1 > 8) ? 2 : 1); ++hf) {
        const int base = t0 + 8 * hf;
        v4u raw[WIN + 7];
#pragma unroll
        for (int q = 0; q < WIN + 7; ++q) { const int rel = 8 * hf + q - (WIN - 1);
            raw[q] = (rel >= 0 || !first) ? ldv(pcol + (size_t)(base + q - (WIN - 1)) * 3072) : (v4u){0u, 0u, 0u, 0u}; }
        float S[8];
#pragma unroll
        for (int e = 0; e < 8; ++e) S[e] = 0.f;
#pragma unroll
        for (int q = 0; q < WIN - 1; ++q) { float f[8]; unpack8(raw[q], f);
#pragma unroll
            for (int e = 0; e < 8; ++e) S[e] += f[e]; }
#pragma unroll
        for (int r = 0; r < 8; ++r) {
            float pn[8], o[8]; unpack8(raw[r + WIN - 1], pn);
#pragma unroll
            for (int e = 0; e < 8; ++e) S[e] += pn[e];
            const int sr = 8 * hf + r;
            const float inv = (first && sr < WIN - 1) ? 1.0f / (float)(sr + 1) : 1.0f / (float)WIN;
#pragma unroll
            for (int e = 0; e < 8; ++e) o[e] = S[e] * inv - pn[e];
            if (8 * hf + r < WIN - 1) *(GAS v4u*)(ocol + (size_t)(base + r) * D) = pack8(o);
            float po[8]; unpack8(raw[r], po);
#pragma unroll
            for (int e = 0; e < 8; ++e) S[e] -= po[e];
        }
        asm volatile("" ::: "memory");
    }
}
__device__ __forceinline__ void p2_conv_pool(Frame& F, const bf16* PB, const float* conv_w, bf16* AIN, bf16* POOLED, const bf16* RAWU, const bf16* RAWB) {
    const int gw = F.vcu * NWAVES + F.wave, NGW = F.G * NWAVES, lane = F.lane;
    for (int it = gw; it < 4 * (T / 32); it += NGW) {
        const int g = it & 3, rc = (it >> 2) * 2 + (lane >> 5), col = g * 256 + (lane & 31) * 8, t0 = rc * 16; const bool first = (t0 & (SEQ - 1)) == 0;
        if ((t0 & 63) == 0) {
            const int blk = t0 >> 6;
            float w0[8], w1[8], w2[8];
            { const f32x4 a = *(const GAS f32x4*)(conv_w + col), b = *(const GAS f32x4*)(conv_w + col + 4); w0[0] = a.x; w0[1] = a.y; w0[2] = a.z; w0[3] = a.w; w0[4] = b.x; w0[5] = b.y; w0[6] = b.z; w0[7] = b.w; }
            { const f32x4 a = *(const GAS f32x4*)(conv_w + D + col), b = *(const GAS f32x4*)(conv_w + D + col + 4); w1[0] = a.x; w1[1] = a.y; w1[2] = a.z; w1[3] = a.w; w1[4] = b.x; w1[5] = b.y; w1[6] = b.z; w1[7] = b.w; }
            { const f32x4 a = *(const GAS f32x4*)(conv_w + 2 * D + col), b = *(const GAS f32x4*)(conv_w + 2 * D + col + 4); w2[0] = a.x; w2[1] = a.y; w2[2] = a.z; w2[3] = a.w; w2[4] = b.x; w2[5] = b.y; w2[6] = b.z; w2[7] = b.w; }
            const v4u z4 = (v4u){0u, 0u, 0u, 0u};
            const v4u ru0 = ldv(RAWU + (size_t)(blk * 4 + 0) * D + col), ru1 = ldv(RAWU + (size_t)(blk * 4 + 1) * D + col), rb0 = ldv(RAWB + (size_t)(blk * 2 + 0) * D + col), rb1 = ldv(RAWB + (size_t)(blk * 2 + 1) * D + col);
            const v4u rp2 = first ? z4 : ldv(RAWU + (size_t)((blk - 1) * 4 + 2) * D + col), rp3 = first ? z4 : ldv(RAWU + (size_t)((blk - 1) * 4 + 3) * D + col);
            float u0[8], u1[8], p2[8], p3[8], b0[8], b1[8], o0[8], o1[8];
            unpack8(ru0, u0); unpack8(ru1, u1); unpack8(rp2, p2); unpack8(rp3, p3); unpack8(rb0, b0); unpack8(rb1, b1);
#pragma unroll
            for (int e = 0; e < 8; ++e) { o0[e] = b0[e] * (w0[e] * p2[e] + w1[e] * p3[e] + w2[e] * u0[e]); o1[e] = b1[e] * (w0[e] * p3[e] + w1[e] * u0[e] + w2[e] * u1[e]); }
            *(GAS v4u*)(AIN + (size_t)t0 * D + col) = pack8(o0); *(GAS v4u*)(AIN + (size_t)(t0 + 1) * D + col) = pack8(o1);
        }
        asm volatile("" ::: "memory");
        const bf16* pcol = PB + 2048 + col; bf16* ocol = POOLED + col;
        if ((t0 & 63) == 0) { if (g == 0) p2_pool<2>(pcol, ocol, t0, first); else if (g == 1) p2_pool<4>(pcol, ocol, t0, first); else if (g == 2) p2_pool<8>(pcol, ocol, t0, first); else p2_pool<16>(pcol, ocol, t0, first); }
    }
}

typedef int v4i __attribute__((ext_vector_type(4)));
__device__ __forceinline__ unsigned fkey(float f) { const unsigned u = __float_as_uint(f); return (u & 0x80000000u) ? ~u : (u | 0x80000000u); }
__device__ __forceinline__ float fkey_inv(unsigned k) { return __uint_as_float((k & 0x80000000u) ? (k & 0x7fffffffu) : ~k); }
__device__ __forceinline__ void ce_desc(unsigned& a, unsigned& b) { const unsigned hi = a > b ? a : b, lo = a > b ? b : a; a = hi; b = lo; }
template <int K, int J> __device__ __forceinline__ void bitonic_stage(unsigned (&a)[16]) {
#pragma unroll
    for (int i = 0; i < 16; ++i) { const int l = i ^ J; if (l > i) { if ((i & K) == 0) ce_desc(a[i], a[l]); else ce_desc(a[l], a[i]); } }
}
__device__ __forceinline__ void bitonic_merge16(unsigned (&a)[16]) { bitonic_stage<16, 8>(a); bitonic_stage<16, 4>(a); bitonic_stage<16, 2>(a); bitonic_stage<16, 1>(a); }
__device__ __forceinline__ void bitonic_sort16(unsigned (&a)[16]) {
    bitonic_stage<2, 1>(a); bitonic_stage<4, 2>(a); bitonic_stage<4, 1>(a); bitonic_stage<8, 4>(a); bitonic_stage<8, 2>(a); bitonic_stage<8, 1>(a); bitonic_merge16(a);
}
__device__ __forceinline__ void top16_merge(unsigned (&top)[16], unsigned (&ch)[16]) {
#pragma unroll
    for (int i = 0; i < 16; ++i) top[i] = top[i] > ch[15 - i] ? top[i] : ch[15 - i];
    bitonic_merge16(top);
}
__device__ __forceinline__ unsigned hkey(unsigned h) { return (h & 0x8000u) ? (~h & 0xffffu) : (h | 0x8000u); }
__device__ __forceinline__ float hkey_inv(unsigned k16) { const unsigned h = (k16 & 0x8000u) ? (k16 & 0x7fffu) : (~k16 & 0xffffu); return (float)__builtin_bit_cast(_Float16, (unsigned short)h); }
__device__ __forceinline__ unsigned pkh2(float a, float b) { return __builtin_bit_cast(unsigned, __builtin_amdgcn_cvt_pkrtz(a, b)); }
__device__ __forceinline__ void p7_topk(Frame& F, const unsigned short* SC, const float* SSQ, int* IDX, float* GATE, int b_lo, int b_hi, int b_step, bool handoff) {
    constexpr int RS = 36;
    LAS unsigned* stg = (LAS unsigned*)(F.lds + RING_OFF + F.wave * P7_WAVE_BYTES + P7_STAGE_OFF);
    const int lane = F.lane, r8 = lane >> 3, c = lane & 7;
    for (int batch = b_lo; batch < b_hi; batch += b_step) {
        const unsigned short* base = SC + (size_t)batch * (8 * NSC);
        unsigned top[16], top1[16];
#pragma unroll
        for (int i = 0; i < 16; ++i) { top[i] = 0u; top1[i] = 0u; }
        v4u ld[8];
#pragma unroll
        for (int q = 0; q < 8; ++q) ld[q] = *(const GAS v4u*)(base + (size_t)(8 * q + r8) * 256 + c * 8);
        for (int ch = 0; ch < 4; ++ch) {
#pragma unroll
            for (int q = 0; q < 8; ++q) *(LAS v4u*)(stg + (8 * q + r8) * RS + c * 4) = ld[q];
            if (ch < 3) {
#pragma unroll
                for (int q = 0; q < 8; ++q) ld[q] = *(const GAS v4u*)(base + (size_t)(8 * q + r8) * 256 + (ch + 1) * 64 + c * 8);
            }
            LDS_WAIT(); asm volatile("" ::: "memory");
#pragma unroll
            for (int hf = 0; hf < 4; ++hf) {
                unsigned k[16];
                const unsigned pb = 127u - (unsigned)((ch & 1) * 64 + hf * 16);
#pragma unroll
                for (int q = 0; q < 2; ++q) { const v4u v = *(const LAS v4u*)(stg + lane * RS + hf * 8 + q * 4);
                    const unsigned w0 = v.x, w1 = v.y, w2 = v.z, w3 = v.w;
                    k[8 * q] = (hkey(w0 & 0xffffu) << 16) | (pb - (unsigned)(8 * q)); k[8 * q + 1] = (hkey(w0 >> 16) << 16) | (pb - (unsigned)(8 * q + 1));
                    k[8 * q + 2] = (hkey(w1 & 0xffffu) << 16) | (pb - (unsigned)(8 * q + 2)); k[8 * q + 3] = (hkey(w1 >> 16) << 16) | (pb - (unsigned)(8 * q + 3));
                    k[8 * q + 4] = (hkey(w2 & 0xffffu) << 16) | (pb - (unsigned)(8 * q + 4)); k[8 * q + 5] = (hkey(w2 >> 16) << 16) | (pb - (unsigned)(8 * q + 5));
                    k[8 * q + 6] = (hkey(w3 & 0xffffu) << 16) | (pb - (unsigned)(8 * q + 6)); k[8 * q + 7] = (hkey(w3 >> 16) << 16) | (pb - (unsigned)(8 * q + 7)); }
                bitonic_sort16(k);
                top16_merge(top, k);
            }
            LDS_WAIT(); asm volatile("" ::: "memory");
            if (ch == 1) {
#pragma unroll
                for (int i = 0; i < 16; ++i) { top1[i] = top[i]; top[i] = 0u; }
            }
        }
        LAS int* tab = (LAS int*)stg + lane * 33;
        float v1[16], v2[16];
#pragma unroll
        for (int i = 0; i < 16; ++i) { tab[i] = 127 - (int)(top1[i] & 0x7fu); tab[16 + i] = 127 - (int)(top[i] & 0x7fu); v1[i] = hkey_inv(top1[i] >> 16); v2[i] = hkey_inv(top[i] >> 16); }
#define P7_KEY(i, j) ((fkey(v1[i] + v2[j]) & ~0xffu) | (unsigned)((i) * 16 + (j)))
        unsigned best[16], cb[16];
#pragma unroll
        for (int jj = 0; jj < 16; ++jj) best[jj] = P7_KEY(0, jj);
#pragma unroll
        for (int jj = 0; jj < 8; ++jj) { cb[jj] = P7_KEY(1, jj); cb[8 + jj] = 0u; }
        top16_merge(best, cb);
        cb[0] = P7_KEY(2, 0); cb[1] = P7_KEY(2, 1); cb[2] = P7_KEY(2, 2); cb[3] = P7_KEY(2, 3); cb[4] = P7_KEY(2, 4); cb[5] = P7_KEY(3, 0); cb[6] = P7_KEY(3, 1); cb[7] = P7_KEY(3, 2);
        cb[8] = P7_KEY(3, 3); cb[9] = P7_KEY(4, 0); cb[10] = P7_KEY(4, 1); cb[11] = P7_KEY(4, 2); cb[12] = 0u; cb[13] = 0u; cb[14] = 0u; cb[15] = 0u;
        bitonic_sort16(cb); top16_merge(best, cb);
        cb[0] = P7_KEY(5, 0); cb[1] = P7_KEY(5, 1); cb[2] = P7_KEY(6, 0); cb[3] = P7_KEY(6, 1); cb[4] = P7_KEY(7, 0); cb[5] = P7_KEY(7, 1); cb[6] = P7_KEY(8, 0); cb[7] = P7_KEY(9, 0);
        cb[8] = P7_KEY(10, 0); cb[9] = P7_KEY(11, 0); cb[10] = P7_KEY(12, 0); cb[11] = P7_KEY(13, 0); cb[12] = P7_KEY(14, 0); cb[13] = P7_KEY(15, 0); cb[14] = 0u; cb[15] = 0u;
        bitonic_sort16(cb); top16_merge(best, cb);
#undef P7_KEY
        LDS_WAIT(); asm volatile("" ::: "memory");
        int eo[16]; float go[16]; float sm = 0.f;
        const float bmax = fkey_inv(best[0] & ~0xffu);
        const f32x4 ssq = *(const GAS f32x4*)(SSQ + (size_t)(batch * 8 + (lane >> 3)) * 4);
        const float rstd = 1.0f / sqrtf(((ssq.x + ssq.y) + (ssq.z + ssq.w)) * (1.0f / D) + EPS);
#pragma unroll
        for (int r = 0; r < 16; ++r) { const int ij = (int)(best[r] & 0xffu); eo[r] = tab[ij >> 4] * 128 + tab[16 + (ij & 15)]; go[r] = __expf((fkey_inv(best[r] & ~0xffu) - bmax) * rstd); sm += go[r]; }
        const float inv = 1.0f / sm;
        if (handoff) {
            LAS unsigned char* reg = F.lds + RING_OFF + (batch - 8 * F.vcu) * P7_WAVE_BYTES;
            LAS int* li = (LAS int*)(reg + P7_IDX_OFF) + lane * 16; LAS unsigned* lg = (LAS unsigned*)(reg + P7_OUT_OFF) + lane * 8;
#pragma unroll
            for (int q = 0; q < 4; ++q) *(LAS v4i*)(li + 4 * q) = (v4i){eo[4 * q], eo[4 * q + 1], eo[4 * q + 2], eo[4 * q + 3]};
#pragma unroll
            for (int q = 0; q < 2; ++q) *(LAS v4u*)(lg + 4 * q) = (v4u){pkh2(go[8 * q] * inv, go[8 * q + 1] * inv), pkh2(go[8 * q + 2] * inv, go[8 * q + 3] * inv), pkh2(go[8 * q + 4] * inv, go[8 * q + 5] * inv), pkh2(go[8 * q + 6] * inv, go[8 * q + 7] * inv)};
        } else {
        int* ip = IDX + (size_t)batch * 1024 + lane * 16; float* gp = GATE + (size_t)batch * 1024 + lane * 16;
#pragma unroll
        for (int q = 0; q < 4; ++q) { *(GAS v4i*)(ip + 4 * q) = (v4i){eo[4 * q], eo[4 * q + 1], eo[4 * q + 2], eo[4 * q + 3]};
            *(GAS f32x4*)(gp + 4 * q) = (f32x4){go[4 * q] * inv, go[4 * q + 1] * inv, go[4 * q + 2] * inv, go[4 * q + 3] * inv}; }
        }
        LDS_WAIT(); asm volatile("" ::: "memory");
    }
}
typedef __bf16 bf16x2_t __attribute__((ext_vector_type(2)));
__device__ __forceinline__ float dpp_f(float v, const int ctrl_sel) {
    const int x = __builtin_bit_cast(int, v);
    int r;
    if (ctrl_sel == 0) r = __builtin_amdgcn_update_dpp(0, x, 0xB1, 0xF, 0xF, true);
    else if (ctrl_sel == 1) r = __builtin_amdgcn_update_dpp(0, x, 0x4E, 0xF, 0xF, true);
    else if (ctrl_sel == 2) r = __builtin_amdgcn_update_dpp(0, x, 0x141, 0xF, 0xF, true);
    else r = __builtin_amdgcn_update_dpp(0, x, 0x128, 0xF, 0xF, true);
    return __builtin_bit_cast(float, r);
}
__device__ __forceinline__ float sum8(float v) { v += dpp_f(v, 0); v += dpp_f(v, 1); v += dpp_f(v, 2); return v; }
__device__ __forceinline__ float dot2bf(unsigned a, unsigned b, float acc) { return __builtin_amdgcn_fdot2_f32_bf16(__builtin_bit_cast(bf16x2_t, a), __builtin_bit_cast(bf16x2_t, b), acc, false); }
__device__ __forceinline__ float dot8(const v4u d, const v4u x, float acc) {
    acc = dot2bf(d.x, x.x, acc); acc = dot2bf(d.y, x.y, acc); acc = dot2bf(d.z, x.z, acc); acc = dot2bf(d.w, x.w, acc);
    return acc;
}
__device__ __forceinline__ float gelu_erf(float v) {
    const float t = __builtin_amdgcn_rcpf(fabsf(v) * 0.2316418882f + 1.0f);
    float q = t * 0.5307027145f + (-0.7265760135f); q = q * t + 0.7107068705f; q = q * t + (-0.142248368f); q = q * t + 0.127414796f; q = q * t;
    const float m = v * (q * __builtin_amdgcn_exp2f((v * v) * (-0.72134752044f)));
    return v < 0.f ? m : v - m;
}
__device__ __forceinline__ void p8_issue(v4u (&d)[8], const LAS int* li8, __amdgpu_buffer_rsrc_t rs, int soff, int c16) {
    const v4i e0 = *(const LAS v4i*)li8, e1 = *(const LAS v4i*)(li8 + 4);
    d[0] = __builtin_amdgcn_raw_buffer_load_b128(rs, e0.x * 128 + c16, soff, 0); d[1] = __builtin_amdgcn_raw_buffer_load_b128(rs, e0.y * 128 + c16, soff, 0);
    d[2] = __builtin_amdgcn_raw_buffer_load_b128(rs, e0.z * 128 + c16, soff, 0); d[3] = __builtin_amdgcn_raw_buffer_load_b128(rs, e0.w * 128 + c16, soff, 0);
    d[4] = __builtin_amdgcn_raw_buffer_load_b128(rs, e1.x * 128 + c16, soff, 0); d[5] = __builtin_amdgcn_raw_buffer_load_b128(rs, e1.y * 128 + c16, soff, 0);
    d[6] = __builtin_amdgcn_raw_buffer_load_b128(rs, e1.z * 128 + c16, soff, 0); d[7] = __builtin_amdgcn_raw_buffer_load_b128(rs, e1.w * 128 + c16, soff, 0);
}
typedef float f32x2 __attribute__((ext_vector_type(2)));
__device__ __forceinline__ f32x2 fp8lo(unsigned w) { return __builtin_amdgcn_cvt_pk_f32_fp8((int)w, false); }
__device__ __forceinline__ f32x2 fp8hi(unsigned w) { return __builtin_amdgcn_cvt_pk_f32_fp8((int)w, true); }
__device__ __forceinline__ float dot16q(const v4u d, const f32x2 (&xx)[8]) {
    f32x2 acc = fp8lo(d.x) * xx[0];
    acc += fp8hi(d.x) * xx[1]; acc += fp8lo(d.y) * xx[2]; acc += fp8hi(d.y) * xx[3]; acc += fp8lo(d.z) * xx[4]; acc += fp8hi(d.z) * xx[5]; acc += fp8lo(d.w) * xx[6]; acc += fp8hi(d.w) * xx[7];
    return acc.x + acc.y;
}
__device__ __forceinline__ void p8_compute_u(const v4u (&d)[8], const f32x2 (&xx)[8], LAS float* lz8, int c) {
    float p[8];
#pragma unroll
    for (int g = 0; g < 8; ++g) p[g] = sum8(dot16q(d[g], xx));
    if (c == 0) {
#pragma unroll
        for (int q = 0; q < 2; ++q) { f32x4 z = *(LAS f32x4*)(lz8 + 4 * q); z.x += p[4 * q]; z.y += p[4 * q + 1]; z.z += p[4 * q + 2]; z.w += p[4 * q + 3]; *(LAS f32x4*)(lz8 + 4 * q) = z; }
    }
}
__device__ __forceinline__ void p8_compute_v(const v4u (&d)[8], const LAS float* la8, f32x2 (&y)[8]) {
    const f32x4 a0 = *(const LAS f32x4*)la8, a1 = *(const LAS f32x4*)(la8 + 4);
    const float a[8] = {a0.x, a0.y, a0.z, a0.w, a1.x, a1.y, a1.z, a1.w};
#pragma unroll
    for (int g = 0; g < 8; ++g) { const f32x2 ag = {a[g], a[g]};
        y[0] += ag * fp8lo(d[g].x); y[1] += ag * fp8hi(d[g].x); y[2] += ag * fp8lo(d[g].y); y[3] += ag * fp8hi(d[g].y);
        y[4] += ag * fp8lo(d[g].z); y[5] += ag * fp8hi(d[g].z); y[6] += ag * fp8lo(d[g].w); y[7] += ag * fp8hi(d[g].w); }
}
__device__ __forceinline__ void p8_unpack_x(f32x2 (&xx)[8], const v4u a, const v4u b) {
    xx[0] = (f32x2){bflo(a.x), bfhi(a.x)}; xx[1] = (f32x2){bflo(a.y), bfhi(a.y)}; xx[2] = (f32x2){bflo(a.z), bfhi(a.z)}; xx[3] = (f32x2){bflo(a.w), bfhi(a.w)};
    xx[4] = (f32x2){bflo(b.x), bfhi(b.x)}; xx[5] = (f32x2){bflo(b.y), bfhi(b.y)}; xx[6] = (f32x2){bflo(b.z), bfhi(b.z)}; xx[7] = (f32x2){bflo(b.w), bfhi(b.w)};
}
typedef unsigned u32x2s __attribute__((ext_vector_type(2)));
__device__ __forceinline__ float u2f(unsigned u) { return __builtin_bit_cast(float, u); }
__device__ __forceinline__ float swap32_add(float a, float b) { const u32x2s r = __builtin_amdgcn_permlane32_swap(__builtin_bit_cast(unsigned, a), __builtin_bit_cast(unsigned, b), false, false); return u2f(r.x) + u2f(r.y); }
__device__ __forceinline__ float swap16_add(float a, float b) { const u32x2s r = __builtin_amdgcn_permlane16_swap(__builtin_bit_cast(unsigned, a), __builtin_bit_cast(unsigned, b), false, false); return u2f(r.x) + u2f(r.y); }
__device__ __forceinline__ void p8_reduce_heads(const f32x2 (&y)[8], int j, float& r0, float& r1) {
    float v[8], w[4];
#pragma unroll
    for (int q = 0; q < 4; ++q) { v[2 * q] = swap32_add(y[q].x, y[4 + q].x); v[2 * q + 1] = swap32_add(y[q].y, y[4 + q].y); }
#pragma unroll
    for (int q = 0; q < 4; ++q) w[q] = swap16_add(v[q], v[4 + q]);
    const bool odd = (j & 1) != 0;
    const float s0 = odd ? w[0] : w[2], s1 = odd ? w[1] : w[3], k0 = odd ? w[2] : w[0], k1 = odd ? w[3] : w[1];
    r0 = k0 + dpp_f(s0, 3); r1 = k1 + dpp_f(s1, 3);
}
typedef _Float16 h16x2 __attribute__((ext_vector_type(2)));
__device__ __forceinline__ h16x2 q2h_lo(unsigned w) { return __builtin_amdgcn_cvt_scalef32_pk_f16_fp8(w, 1.0f, false); }
__device__ __forceinline__ h16x2 q2h_hi(unsigned w) { return __builtin_amdgcn_cvt_scalef32_pk_f16_fp8(w, 1.0f, true); }
__device__ __forceinline__ h16x2 f2h(float a, float b) { h16x2 r; r.x = (_Float16)a; r.y = (_Float16)b; return r; }
__device__ __forceinline__ float dot16h(const v4u d, const h16x2 (&xh)[8]) {
    float acc = 0.f;
    acc = __builtin_amdgcn_fdot2(q2h_lo(d.x), xh[0], acc, false); acc = __builtin_amdgcn_fdot2(q2h_hi(d.x), xh[1], acc, false);
    acc = __builtin_amdgcn_fdot2(q2h_lo(d.y), xh[2], acc, false); acc = __builtin_amdgcn_fdot2(q2h_hi(d.y), xh[3], acc, false);
    acc = __builtin_amdgcn_fdot2(q2h_lo(d.z), xh[4], acc, false); acc = __builtin_amdgcn_fdot2(q2h_hi(d.z), xh[5], acc, false);
    acc = __builtin_amdgcn_fdot2(q2h_lo(d.w), xh[6], acc, false); acc = __builtin_amdgcn_fdot2(q2h_hi(d.w), xh[7], acc, false);
    return acc;
}
__device__ __forceinline__ void p8h_compute_u(const v4u (&d)[8], const h16x2 (&xh)[8], LAS float* lz8, int c) {
    float p[8];
#pragma unroll
    for (int g = 0; g < 8; ++g) p[g] = sum8(dot16h(d[g], xh));
    if (c == 0) {
#pragma unroll
        for (int q = 0; q < 2; ++q) { f32x4 z = *(LAS f32x4*)(lz8 + 4 * q); z.x += p[4 * q]; z.y += p[4 * q + 1]; z.z += p[4 * q + 2]; z.w += p[4 * q + 3]; *(LAS f32x4*)(lz8 + 4 * q) = z; }
    }
}
__device__ __forceinline__ void p8h_unpack_x(h16x2 (&xh)[8], const v4u a, const v4u b) {
    xh[0] = f2h(bflo(a.x), bfhi(a.x)); xh[1] = f2h(bflo(a.y), bfhi(a.y)); xh[2] = f2h(bflo(a.z), bfhi(a.z)); xh[3] = f2h(bflo(a.w), bfhi(a.w));
    xh[4] = f2h(bflo(b.x), bfhi(b.x)); xh[5] = f2h(bflo(b.y), bfhi(b.y)); xh[6] = f2h(bflo(b.z), bfhi(b.z)); xh[7] = f2h(bflo(b.w), bfhi(b.w));
}
__device__ __forceinline__ void p8h_compute_v(const v4u (&d)[8], const LAS float* la8, h16x2 (&y)[8]) {
    const f32x4 a0 = *(const LAS f32x4*)la8, a1 = *(const LAS f32x4*)(la8 + 4);
    const float a[8] = {a0.x, a0.y, a0.z, a0.w, a1.x, a1.y, a1.z, a1.w};
#pragma unroll
    for (int g = 0; g < 8; ++g) { const _Float16 ah = (_Float16)a[g]; const h16x2 ag = {ah, ah};
        y[0] += ag * q2h_lo(d[g].x); y[1] += ag * q2h_hi(d[g].x); y[2] += ag * q2h_lo(d[g].y); y[3] += ag * q2h_hi(d[g].y);
        y[4] += ag * q2h_lo(d[g].z); y[5] += ag * q2h_hi(d[g].z); y[6] += ag * q2h_lo(d[g].w); y[7] += ag * q2h_hi(d[g].w); }
}
__device__ __forceinline__ long pk64(unsigned lo, unsigned hi) { return (long)(((unsigned long long)hi << 32) | lo); }
__device__ __forceinline__ void p8m_issue(v4u (&d)[8], const LAS int* lig, __amdgpu_buffer_rsrc_t rs, int soff, int q16) {
    const int e0 = lig[0], e1 = lig[16], e2 = lig[32], e3 = lig[48];
    d[0] = __builtin_amdgcn_raw_buffer_load_b128(rs, e0 * D + q16, soff, 0); d[1] = __builtin_amdgcn_raw_buffer_load_b128(rs, e0 * D + q16 + 64, soff, 0);
    d[2] = __builtin_amdgcn_raw_buffer_load_b128(rs, e1 * D + q16, soff, 0); d[3] = __builtin_amdgcn_raw_buffer_load_b128(rs, e1 * D + q16 + 64, soff, 0);
    d[4] = __builtin_amdgcn_raw_buffer_load_b128(rs, e2 * D + q16, soff, 0); d[5] = __builtin_amdgcn_raw_buffer_load_b128(rs, e2 * D + q16 + 64, soff, 0);
    d[6] = __builtin_amdgcn_raw_buffer_load_b128(rs, e3 * D + q16, soff, 0); d[7] = __builtin_amdgcn_raw_buffer_load_b128(rs, e3 * D + q16 + 64, soff, 0);
}
__device__ __forceinline__ float p8m_dot(const v4u xa, const v4u xb, const v4u d0, const v4u d1) {
    f32x4 acc = {0.f, 0.f, 0.f, 0.f};
    acc = __builtin_amdgcn_mfma_f32_16x16x32_fp8_fp8(pk64(xa.x, xa.y), pk64(d0.x, d0.y), acc, 0, 0, 0);
    acc = __builtin_amdgcn_mfma_f32_16x16x32_fp8_fp8(pk64(xa.z, xa.w), pk64(d0.z, d0.w), acc, 0, 0, 0);
    acc = __builtin_amdgcn_mfma_f32_16x16x32_fp8_fp8(pk64(xb.x, xb.y), pk64(d1.x, d1.y), acc, 0, 0, 0);
    acc = __builtin_amdgcn_mfma_f32_16x16x32_fp8_fp8(pk64(xb.z, xb.w), pk64(d1.z, d1.w), acc, 0, 0, 0);
    return acc[0];
}
__device__ __forceinline__ void p8m_compute_u(const v4u (&d)[8], const v4u xa, const v4u xb, LAS float* lzq, int q) {
    const float z0 = p8m_dot(xa, xb, d[0], d[1]), z1 = p8m_dot(xa, xb, d[2], d[3]), z2 = p8m_dot(xa, xb, d[4], d[5]), z3 = p8m_dot(xa, xb, d[6], d[7]);
    const float z = (q == 0) ? z0 : (q == 1) ? z1 : (q == 2) ? z2 : z3;
    *lzq += z;
}
__device__ __forceinline__ void p8s_compute_u(const v4u (&d)[8], const v4u xa, const v4u xb, LAS unsigned char* stage, LAS float* lz  , int lane, const float sxq  ) {
    const int j8 = lane >> 3, c = lane & 7, n = lane & 15, q = lane >> 4;
#pragma unroll
    for (int r = 0; r < 8; ++r) { const int row = j8 * 8 + r; *(LAS v4u*)(stage + row * 128 + ((c ^ (row >> 1)) & 7) * 16) = d[r]; }
    LDS_WAIT(); asm volatile("" ::: "memory");
    float z[4];
#pragma unroll
    for (int t = 0; t < 4; ++t) { const int row = 16 * t + n, sw = (row >> 1) & 7;
        const v4u d0 = *(const LAS v4u*)(stage + row * 128 + ((q ^ sw) & 7) * 16), d1 = *(const LAS v4u*)(stage + row * 128 + (((q + 4) ^ sw) & 7) * 16);
        z[t] = p8m_dot(xa, xb, d0, d1); }
    asm volatile("" ::: "memory");
    const float zq = (q == 0) ? z[0] : (q == 1) ? z[1] : (q == 2) ? z[2] : z[3];
    LAS float* p = lz + (2 * q + (n >> 3)) * 16 + (n & 7);
    *p += zq * sxq;
}
__device__ __forceinline__ void p8_peer(Frame& F, const unsigned char* X8, const float* SSQ, const float* SXQ, const unsigned char* U8, const unsigned char* V8, const float* SU, const float* SV, const int* IDX, const float* GATE, const bf16* H16, float* YOUT, bf16* OUT, const float* gfin, bool handoff) {
    LAS unsigned char* lstage = F.lds + RING_OFF + F.wave * P7_WAVE_BYTES + P7_STAGE_OFF;
    LAS int* lidx = (LAS int*)(F.lds + RING_OFF + F.wave * P7_WAVE_BYTES + P7_IDX_OFF);
    LAS float* lza = (LAS float*)(F.lds + RING_OFF + F.wave * P7_WAVE_BYTES + P7_ZA_OFF);
    LAS unsigned* lout = (LAS unsigned*)(F.lds + RING_OFF + F.wave * P7_WAVE_BYTES + P7_OUT_OFF);
    const int gw = F.vcu * NWAVES + F.wave, NGW = F.G * NWAVES, lane = F.lane, j = lane >> 3, c = lane & 7, c16 = c * 16;
    const __amdgpu_buffer_rsrc_t rsU = __builtin_amdgcn_make_buffer_rsrc((void*)U8, (short)0, NEXP * D, 0x00020000);
    const __amdgpu_buffer_rsrc_t rsV = __builtin_amdgcn_make_buffer_rsrc((void*)V8, (short)0, NEXP * D, 0x00020000);
    const int pfrank = ((int)blockIdx.x >> 3) * NWAVES + F.wave; const int pfoff = (pfrank < 256) ? pfrank * 8192 + lane * 128 : 0; unsigned pf = 0u;
    for (int grp = gw; grp < T / 8; grp += NGW) {
        const int tb = grp * 8;
        for (int prep = 0; prep < REPS(13); ++prep) {
        LAS float* lsx = (LAS float*)(F.lds + P7_AUX_OFF + F.wave * 256); LAS float* lrs = lsx + 32;
        if (lane < 32) lsx[lane] = SXQ[(size_t)tb * 4 + lane];
        if (lane < 8) { const f32x4 q4 = *(const GAS f32x4*)(SSQ + (size_t)(tb + lane) * 4); lrs[lane] = 1.0f / sqrtf(((q4.x + q4.y) + (q4.z + q4.w)) * (1.0f / D) + EPS); }
        LAS _Float16* lgate = (LAS _Float16*)lout;
        if (!handoff) {
#pragma unroll
            for (int i = 0; i < 8; ++i) { lidx[i * 128 + lane] = IDX[(size_t)(tb + i) * NSEL + lane]; lidx[i * 128 + 64 + lane] = IDX[(size_t)(tb + i) * NSEL + 64 + lane];
                lgate[i * 128 + lane] = (_Float16)GATE[(size_t)(tb + i) * NSEL + lane]; lgate[i * 128 + 64 + lane] = (_Float16)GATE[(size_t)(tb + i) * NSEL + 64 + lane]; }
        }
#pragma unroll
        for (int i = 0; i < 8; ++i) { lza[i * 128 + lane] = 0.f; lza[i * 128 + 64 + lane] = 0.f; }
        LDS_WAIT(); asm volatile("" ::: "memory");
        for (int urep = 0; urep < REPS(8); ++urep) {
            if (urep) {
#pragma unroll
                for (int i = 0; i < 8; ++i) { lza[i * 128 + lane] = 0.f; lza[i * 128 + 64 + lane] = 0.f; }
                LDS_WAIT(); asm volatile("" ::: "memory"); }
            v4u b0[8], b1[8], b2[8], b3[8], xa0, xb0, xa1, xb1, xa2, xb2, xa3, xb3;
            const unsigned char* xbase = X8 + (size_t)tb * D + (lane >> 4) * 16;
            xa0 = *(const GAS v4u*)xbase; xb0 = *(const GAS v4u*)(xbase + 64); xa1 = *(const GAS v4u*)(xbase + D); xb1 = *(const GAS v4u*)(xbase + D + 64);
            p8_issue(b0, lidx + j * 16, rsU, 0, c16); p8_issue(b1, lidx + j * 16 + 8, rsU, 0, c16); p8_issue(b2, lidx + 128 + j * 16, rsU, 0, c16); p8_issue(b3, lidx + 128 + j * 16 + 8, rsU, 0, c16);
            for (int n = 0; n < 64; n += 2) {
                const int i = n & 7, n2 = (n + 2) & 63, s2 = n2 >> 3, i2 = n2 & 7;
                { const unsigned char* xp = xbase + (size_t)i2 * D + s2 * 128; xa2 = *(const GAS v4u*)xp; xb2 = *(const GAS v4u*)(xp + 64); xa3 = *(const GAS v4u*)(xp + D); xb3 = *(const GAS v4u*)(xp + D + 64); }
                if ((n & 7) == 6) {
                    asm volatile("" :: "v"(pf));
                    pf = (s2 != 0) ? __builtin_amdgcn_raw_buffer_load_b32(rsU, pfoff, s2 * (NEXP * 128), 0) : __builtin_amdgcn_raw_buffer_load_b32(rsV, pfoff, 0, 0); }
                const float sxa = lsx[i * 4 + (n >> 4)], sxb = lsx[(i + 1) * 4 + (n >> 4)];
                p8s_compute_u(b0, xa0, xb0, lstage, lza + i * 128, lane, sxa);           p8_issue(b0, lidx + i2 * 128 + j * 16, rsU, s2 * (NEXP * 128), c16);
                p8s_compute_u(b1, xa0, xb0, lstage, lza + i * 128 + 8, lane, sxa);       p8_issue(b1, lidx + i2 * 128 + j * 16 + 8, rsU, s2 * (NEXP * 128), c16);
                p8s_compute_u(b2, xa1, xb1, lstage, lza + (i + 1) * 128, lane, sxb);     p8_issue(b2, lidx + (i2 + 1) * 128 + j * 16, rsU, s2 * (NEXP * 128), c16);
                p8s_compute_u(b3, xa1, xb1, lstage, lza + (i + 1) * 128 + 8, lane, sxb); p8_issue(b3, lidx + (i2 + 1) * 128 + j * 16 + 8, rsU, s2 * (NEXP * 128), c16);
                xa0 = xa2; xb0 = xb2; xa1 = xa3; xb1 = xb3;
            }
        }
        LDS_WAIT(); asm volatile("" ::: "memory");
#pragma unroll
        for (int i = 0; i < 8; ++i) {
            const int e0 = lidx[i * 128 + lane], e1 = lidx[i * 128 + 64 + lane];
            const float sx = lrs[i];
            const float z0 = lza[i * 128 + lane] * SU[e0] * sx, z1 = lza[i * 128 + 64 + lane] * SU[e1] * sx;
            const float g0 = (float)lgate[i * 128 + lane] * SV[e0], g1 = (float)lgate[i * 128 + 64 + lane] * SV[e1];
            lza[i * 128 + lane] = gelu_erf(z0) * g0 * 1024.0f; lza[i * 128 + 64 + lane] = gelu_erf(z1) * g1 * 1024.0f;
        }
        LDS_WAIT(); asm volatile("" ::: "memory");
        for (int vrep = 0; vrep < REPS(9); ++vrep) {
            v4u b0[8], b1[8], b2[8], b3[8];
            LAS unsigned* lkeep = (LAS unsigned*)lstage;
            p8_issue(b0, lidx + j * 16, rsV, 0, c16); p8_issue(b1, lidx + j * 16 + 8, rsV, 0, c16); p8_issue(b2, lidx + 128 + j * 16, rsV, 0, c16); p8_issue(b3, lidx + 128 + j * 16 + 8, rsV, 0, c16);
            for (int n = 0; n < 64; n += 2) {
                const int s = n >> 3, i = n & 7, n2 = (n + 2) & 63, s2 = n2 >> 3, i2 = n2 & 7;
                if ((n & 7) == 6 && s2 != 0) { asm volatile("" :: "v"(pf)); pf = __builtin_amdgcn_raw_buffer_load_b32(rsV, pfoff, s2 * (NEXP * 128), 0); }
                LAS unsigned* lo = ((s < 4) ? lkeep + s * 512 : lout) + c * 8 + j;
                h16x2 yh[8]; f32x2 y[8]; float r0, r1;
#pragma unroll
                for (int q = 0; q < 8; ++q) yh[q] = (h16x2){(_Float16)0.f, (_Float16)0.f};
                p8h_compute_v(b0, lza + i * 128 + j * 16, yh);           p8_issue(b0, lidx + i2 * 128 + j * 16, rsV, s2 * (NEXP * 128), c16);
                p8h_compute_v(b1, lza + i * 128 + j * 16 + 8, yh);       p8_issue(b1, lidx + i2 * 128 + j * 16 + 8, rsV, s2 * (NEXP * 128), c16);
#pragma unroll
                for (int q = 0; q < 8; ++q) y[q] = (f32x2){(float)yh[q].x * (1.0f / 1024.0f), (float)yh[q].y * (1.0f / 1024.0f)};
                p8_reduce_heads(y, j, r0, r1);
                lo[i * 64] = pk2(r0, r1);
#pragma unroll
                for (int q = 0; q < 8; ++q) yh[q] = (h16x2){(_Float16)0.f, (_Float16)0.f};
                p8h_compute_v(b2, lza + (i + 1) * 128 + j * 16, yh);     p8_issue(b2, lidx + (i2 + 1) * 128 + j * 16, rsV, s2 * (NEXP * 128), c16);
                p8h_compute_v(b3, lza + (i + 1) * 128 + j * 16 + 8, yh); p8_issue(b3, lidx + (i2 + 1) * 128 + j * 16 + 8, rsV, s2 * (NEXP * 128), c16);
#pragma unroll
                for (int q = 0; q < 8; ++q) y[q] = (f32x2){(float)yh[q].x * (1.0f / 1024.0f), (float)yh[q].y * (1.0f / 1024.0f)};
                p8_reduce_heads(y, j, r0, r1);
                lo[(i + 1) * 64] = pk2(r0, r1);
                if (i == 6 && s >= 4) {
                    LDS_WAIT(); asm volatile("" ::: "memory");
                    const v4u w0 = *(const LAS v4u*)(lout + (lane >> 4) * 64 + (lane & 15) * 4), w1 = *(const LAS v4u*)(lout + (4 + (lane >> 4)) * 64 + (lane & 15) * 4);
                    bf16* op = OUT + (size_t)(tb + (lane >> 4)) * D + s * 128 + (lane & 15) * 8;
                    *(GAS v4u*)op = w0; *(GAS v4u*)(op + 4 * D) = w1;
                }
            }
        }
        }
        asm volatile("" :: "v"(pf));
        VM_WAIT(); __builtin_amdgcn_fence(__ATOMIC_ACQUIRE, "agent"); VM_WAIT(); LDS_WAIT(); asm volatile("" ::: "memory");
        for (int frep = 0; frep < REPS(14); ++frep)
        for (int i0 = 0; i0 < 8; i0 += 4) {
            u32x2s hv[4][4], ov[4][4]; float ss[4];
#pragma unroll
            for (int rr = 0; rr < 4; ++rr) { const bf16* hrow = H16 + (size_t)(tb + i0 + rr) * D + 4 * lane; const bf16* orow = OUT + (size_t)(tb + i0 + rr) * D + 4 * lane;
                const LAS unsigned* krow = (const LAS unsigned*)lstage + (lane >> 5) * 512 + (i0 + rr) * 64 + ((2 * lane) & 63);
#pragma unroll
                for (int q = 0; q < 4; ++q) { hv[rr][q] = *(const GAS u32x2s*)(hrow + 256 * q);
                    if (q < 2) ov[rr][q] = *(const LAS u32x2s*)(krow + q * 1024); else ov[rr][q] = *(const GAS u32x2s*)(orow + 256 * q); } }
            f32x4 gg[4];
#pragma unroll
            for (int q = 0; q < 4; ++q) gg[q] = *(const GAS f32x4*)(gfin + 256 * q + 4 * lane);
            f32x4 yv[4][4];
#pragma unroll
            for (int rr = 0; rr < 4; ++rr) { float a = 0.f;
#pragma unroll
                for (int q = 0; q < 4; ++q) { const unsigned h0 = hv[rr][q].x, h1 = hv[rr][q].y, o0 = ov[rr][q].x, o1 = ov[rr][q].y;
                    yv[rr][q] = (f32x4){bflo(h0) + bflo(o0), bfhi(h0) + bfhi(o0), bflo(h1) + bflo(o1), bfhi(h1) + bfhi(o1)};
                    a += (yv[rr][q].x * yv[rr][q].x + yv[rr][q].y * yv[rr][q].y) + (yv[rr][q].z * yv[rr][q].z + yv[rr][q].w * yv[rr][q].w); }
                ss[rr] = a; }
#pragma unroll
            for (int o = 1; o < 64; o <<= 1) {
#pragma unroll
                for (int rr = 0; rr < 4; ++rr) ss[rr] += __shfl_xor(ss[rr], o); }
#pragma unroll
            for (int rr = 0; rr < 4; ++rr) { const float rstd = 1.f / sqrtf(ss[rr] * (1.f / D) + EPS); float* yr = YOUT + (size_t)(tb + i0 + rr) * D + 4 * lane;
#pragma unroll
                for (int q = 0; q < 4; ++q) *(GAS f32x4*)(yr + 256 * q) = (f32x4){yv[rr][q].x * rstd * gg[q].x, yv[rr][q].y * rstd * gg[q].y, yv[rr][q].z * rstd * gg[q].z, yv[rr][q].w * rstd * gg[q].w}; }
        }
    }
}
template <bool GAIN>
__device__ __forceinline__ void cvt_fp8_rows(Frame& F, const float* src, unsigned char* dst, float* scale, int gw, int NGW, const float* gain) {
    const int lane = F.lane;
    f32x4 gq[4];
    if (GAIN) {
#pragma unroll
        for (int q = 0; q < 4; ++q) gq[q] = ((const GAS f32x4*)gain)[4 * lane + q]; }
    for (int r0 = gw * 4; r0 < NEXP; r0 += NGW * 4) {
        f32x4 v[4][4];
#pragma unroll
        for (int rr = 0; rr < 4; ++rr) { const GAS f32x4* sp = (const GAS f32x4*)(src + (size_t)(r0 + rr) * D) + 4 * lane;
#pragma unroll
            for (int q = 0; q < 4; ++q) v[rr][q] = sp[q]; }
        if (GAIN) {
#pragma unroll
            for (int rr = 0; rr < 4; ++rr)
#pragma unroll
                for (int q = 0; q < 4; ++q) v[rr][q] = v[rr][q] * gq[q]; }
        float m[4];
#pragma unroll
        for (int rr = 0; rr < 4; ++rr) { float mm = 0.f;
#pragma unroll
            for (int q = 0; q < 4; ++q) mm = fmaxf(mm, fmaxf(fmaxf(fabsf(v[rr][q].x), fabsf(v[rr][q].y)), fmaxf(fabsf(v[rr][q].z), fabsf(v[rr][q].w))));
            m[rr] = mm; }
#pragma unroll
        for (int o = 1; o < 64; o <<= 1) {
#pragma unroll
            for (int rr = 0; rr < 4; ++rr) m[rr] = fmaxf(m[rr], __shfl_xor(m[rr], o)); }
#pragma unroll
        for (int rr = 0; rr < 4; ++rr) {
            const float sc = (m[rr] > 0.f) ? m[rr] * (1.0f / 448.0f) : 1.0f, inv = 1.0f / sc;
            unsigned o[4];
#pragma unroll
            for (int q = 0; q < 4; ++q) o[q] = (unsigned)__builtin_amdgcn_cvt_pk_fp8_f32(v[rr][q].z * inv, v[rr][q].w * inv, __builtin_amdgcn_cvt_pk_fp8_f32(v[rr][q].x * inv, v[rr][q].y * inv, 0, false), true);
            *(GAS v4u*)(dst + (size_t)(lane >> 3) * (NEXP * 128) + (size_t)(r0 + rr) * 128 + 16 * (lane & 7)) = (v4u){o[0], o[1], o[2], o[3]};
            if (lane == 0) scale[r0 + rr] = sc;
        }
    }
}
struct Args { const float* in[15]; float* out; unsigned char* ws; int ph_lo, ph_hi; };
__global__ void __launch_bounds__(NWAVES * 64, 2) hyb_fwd(Args args) {
    extern __shared__ __attribute__((aligned(16))) unsigned char lds[];
    Frame F;
    F.lds = (LAS unsigned char*)lds;
    F.MISC = (volatile LAS unsigned*)(F.lds + MISC_OFF);
    F.tid = threadIdx.x; F.lane = F.tid & 63; F.wave = __builtin_amdgcn_readfirstlane(F.tid >> 6);
    F.G = gridDim.x; { const int bx = blockIdx.x; F.vcu = (F.G % 8 == 0) ? (bx % 8) * (F.G / 8) + bx / 8 : bx; }
    unsigned char* ws = args.ws;
    gu32* ctl = (gu32*)(ws + WS_CTL);
    const float* x = args.in[0]; const float* g_mix = args.in[1]; const float* w_in = args.in[2]; const float* conv_w = args.in[3]; const float* w_conv_out = args.in[4];
    const float* pool_w = args.in[5]; const float* pool_scale = args.in[6]; const float* w_pool_out = args.in[7]; const float* w_out = args.in[8]; const float* g_ffn = args.in[9];
    const float* w_query = args.in[10]; const float* sub_keys = args.in[11]; const float* expert_u = args.in[12]; const float* expert_v = args.in[13]; const float* g_fin = args.in[14];
    bf16* WIN = (bf16*)(ws + WS_WIN); bf16* WC = (bf16*)(ws + WS_WC); bf16* WPB = (bf16*)(ws + WS_WPB); bf16* WOUT = (bf16*)(ws + WS_WOUT); bf16* WSC = (bf16*)(ws + WS_WS);
    bf16* XN = (bf16*)(ws + WS_XN); bf16* PB = (bf16*)(ws + WS_PB); bf16* PG = (bf16*)(ws + WS_PG); bf16* TMP = (bf16*)(ws + WS_TMP); bf16* MG = (bf16*)(ws + WS_MG);
    float* SC = (float*)(ws + WS_SC); int* IDX = (int*)(ws + WS_IDX); float* GATE = (float*)(ws + WS_GATE); unsigned char* U8 = ws + WS_U8; unsigned char* V8 = ws + WS_V8; float* SU = (float*)(ws + WS_SU); float* SV = (float*)(ws + WS_SV); bf16* H16 = (bf16*)(ws + WS_H16); unsigned char* X8 = ws + WS_X8; float* SX = (float*)(ws + WS_SX);
    float* RS1 = (float*)(ws + WS_RS1);
    float* SSQ = (float*)(ws + WS_XBUF); float* SXQ = (float*)(ws + WS_XBUF + 256 * 1024);
    bf16* AIN = (bf16*)args.out; bf16* POOLED = (bf16*)args.out + (size_t)T * D; float* H = args.out;

    for (int u = F.tid; u < (LDS_BYTES - LDSCTL_OFF) / 4; u += NWAVES * 64) ((LAS unsigned*)(F.lds + LDSCTL_OFF))[u] = 0u;
    __syncthreads();
    XcdBarrier bar; bar.bar = (unsigned*)(ctl + CW_BAR); bar.x = 0; bar.st = nullptr;
    if (N_LAUNCHES == 1) bar = xcd_barrier_post((unsigned*)(ctl + CW_BAR), F.MISC + 8);
#define GRID_BAR() do { if (N_LAUNCHES == 1) xcd_barrier(bar); } while (0)
    const int lo = args.ph_lo, hi = args.ph_hi;
#define IN(k) (lo <= (k) && (k) < hi)
#define BOTH(k) (IN(k) && IN((k) + 1))
    const int gw = F.vcu * NWAVES + F.wave, NGW = F.G * NWAVES;

    if (IN(0)) { DELAY_T0(0); for (int rep = 0; rep < REPS(0); ++rep) {
        LAS float* scr = (LAS float*)(F.lds + RING_OFF + F.wave * 16384);
        constexpr int I_IN = (D / 64) * (NIN / 32), I_SQ = (D / 64) * (D / 32);
#pragma unroll 1
        for (int stage = 0; stage < 2; ++stage) {
            if ((stage == 0) == ((F.wave & 1) == 0)) {
                for (int it = gw; it < 2048; it += NGW) {
                    { const int hp = it >> 7, i0 = ((it >> 5) & 3) * 32, j0 = (it & 31) * 32;
                      fold_wave<4, 32, false>(scr, sub_keys + (size_t)hp * 16384 + (size_t)i0 * 128, 128, nullptr, w_query + (size_t)j0 * NSC + hp * 128, NSC, WSC + (size_t)(hp * 128 + i0) * D + j0, D, F.lane, g_ffn + j0); }
                    { const int g = it >> 9, i0 = ((it >> 4) & 31) * 32, j0 = (it & 15) * 16;
                      fold_wave<8, 16, true>(scr, w_pool_out + (size_t)g * 256 * D + i0, D, pool_scale + g * 256, pool_w + (size_t)g * 65536 + (size_t)j0 * 256, 256, WPB + (size_t)i0 * D + g * 256 + j0, D, F.lane); }
                }
            } else {
                for (int it = gw; it < I_IN + 2 * I_SQ; it += NGW) {
                    int r = it;
                    if (r < I_IN) { p0_transpose_item<true>(w_in, D, NIN, WIN, scr, r, F.lane, g_mix); continue; } r -= I_IN;
                    if (r < I_SQ) { p0_transpose_item<false>(w_conv_out, D, D, WC, scr, r, F.lane); continue; } r -= I_SQ;
                    p0_transpose_item<false>(w_out, D, D, WOUT, scr, r, F.lane);
                }
                for (int m = gw * 4; m < T; m += NGW * 4) rms_rows4_to_bf16(F.lane, x + (size_t)m * D, XN + (size_t)m * D, RS1 + m);
            }
        }
        }
        DELAY_END(0);
        if (BOTH(0)) GRID_BAR();
    }
    if (PROBE_DUP & 1024) { for (int xb = 0; xb < 10; ++xb) GRID_BAR(); }
    if (IN(1)) { DELAY_T0(1); for (int rep = 0; rep < REPS(1); ++rep) {
        pg8::Gemm g{XN, WIN, 0l, 0l, T, NIN, D}; pg8::StaticOrder S; S.init(T, NIN, F.G, (int)blockIdx.x);
        pg8::EpiProj E{RS1, PB, (long)(WS_PG - WS_PB), (pg8::bf16_t*)AIN, conv_w, (pg8::bf16_t*)(ws + WS_RAWU), (pg8::bf16_t*)(ws + WS_RAWB), (pg8::bf16_t*)POOLED};
        pg8::gemm_phase<pg8::EpiProj, pg8::StaticOrder, true, true>(F.lds + RING_OFF, g, S, E);
        }
        DELAY_END(1);
        if (BOTH(1)) GRID_BAR();
    }
    if (IN(2)) { DELAY_T0(2); for (int rep = 0; rep < REPS(2); ++rep) {
        p2_conv_pool(F, PB, conv_w, AIN, POOLED, (const bf16*)(ws + WS_RAWU), (const bf16*)(ws + WS_RAWB));
        }
        DELAY_END(2);
        if (BOTH(2)) GRID_BAR();
    }
    if (IN(3)) { DELAY_T0(3); for (int rep = 0; rep < REPS(3); ++rep) {
        pg8::Gemm g{AIN, WC, (long)T * D * 2, (long)(WS_WPB - WS_WC), T, D, D}; pg8::MergeOrder S; S.base.init(T, D, F.G, (int)blockIdx.x);
        pg8::EpiMerge E{(const unsigned char*)PG, MG};
        pg8::gemm_phase<pg8::EpiMerge, pg8::MergeOrder, true, true>(F.lds + RING_OFF, g, S, E);
        }
        DELAY_END(3);
        if (BOTH(3)) GRID_BAR();
    }
    if (IN(4)) { DELAY_T0(4); for (int rep = 0; rep < REPS(4); ++rep) {
        if (F.G == 256) {
            pg8::Gemm g{MG, WOUT, 0l, 0l, T, D, D}; pg8::StaticOrder S; S.init(T, D, F.G, (int)blockIdx.x);
            pg8::EpiResRms E{(const pg8::bf16_t*)XN, H16, X8, SSQ, SXQ};
            pg8::gemm_phase<pg8::EpiResRms, pg8::StaticOrder, false, true>(F.lds + RING_OFF, g, S, E);
            if (PROBE_DUP & 4096) { __syncthreads(); pg8::gemm_phase<pg8::EpiResRms, pg8::StaticOrder, false, true>(F.lds + RING_OFF, g, S, E); }
        } else {
            pg8::Gemm g{MG, WOUT, 0l, 0l, T, D, D}; pg8::StaticOrder S; S.init(T, D, F.G, (int)blockIdx.x);
            pg8::EpiRes E{x, H};
            pg8::gemm_phase<pg8::EpiRes, pg8::StaticOrder, true, true>(F.lds + RING_OFF, g, S, E);
            GRID_BAR();
            for (int m = gw; m < T; m += NGW) p4_row_defer(F.lane, H + (size_t)m * D, X8 + (size_t)m * D, SSQ + (size_t)m * 4, SXQ + (size_t)m * 4, H16 + (size_t)m * D);
        }
        }
        DELAY_END(4);
        if (BOTH(4)) GRID_BAR();
    }
    if (IN(5)) { DELAY_T0(5); for (int rep = 0; rep < REPS(5); ++rep) {
        pg8::Gemm g{(const pg8::bf16_t*)H16, WSC, 0l, 0l, T, NSC, D}; pg8::StaticOrder S; S.init(T, NSC, F.G, (int)blockIdx.x);
        pg8::EpiF16 E{(unsigned short*)SC, NSC};
        pg8::gemm_phase<pg8::EpiF16, pg8::StaticOrder, true, true>(F.lds + RING_OFF, g, S, E);
        }
        DELAY_END(5);
        if (BOTH(5)) GRID_BAR();
    }
    if (IN(6)) { DELAY_T0(6); for (int rep = 0; rep < REPS(6); ++rep) {
        const bool handoff = (F.G * NWAVES == T / 8);
        if (F.wave < 4) { if (handoff) p7_topk(F, (const unsigned short*)SC, SSQ, IDX, GATE, F.vcu * 8 + F.wave, F.vcu * 8 + 8, 4, true); else p7_topk(F, (const unsigned short*)SC, SSQ, IDX, GATE, F.vcu * 4 + F.wave, T / 8, F.G * 4, false); }
        else { cvt_fp8_rows<true>(F, expert_u, U8, SU, F.vcu * 4 + F.wave - 4, F.G * 4, g_ffn); cvt_fp8_rows<false>(F, expert_v, V8, SV, F.vcu * 4 + F.wave - 4, F.G * 4, nullptr); }
        }
        DELAY_END(6);
        if (BOTH(6)) GRID_BAR();
    }
    if (IN(7)) { DELAY_T0(7);
        for (int rep = 0; rep < REPS(7); ++rep)
        p8_peer(F, X8, SSQ, SXQ, U8, V8, SU, SV, IDX, GATE, H16, args.out, (bf16*)(ws + WS_PO), g_fin, F.G * NWAVES == T / 8);
        DELAY_END(7);
    }
#undef IN
#undef BOTH
}

extern "C" void kernel_launch(void* const* d_in, const int* in_sizes, int n_in, void* d_out, int out_size, void* d_ws, size_t ws_size, hipStream_t stream) {
    static int grid = 0;
    if (grid == 0) {
        if (n_in != 15 || in_sizes[0] != T * D || out_size != T * D || ws_size < WS_END) { fprintf(stderr, "kernel_launch: shape/workspace mismatch (n_in %d, in0 %d, out %d, ws %zu)\n", n_in, n_in > 0 ? in_sizes[0] : -1, out_size, ws_size); grid = -1; return; }
        int dev = 0, cus = 0, per_cu = 0;
        if (hipGetDevice(&dev) != hipSuccess || hipDeviceGetAttribute(&cus, hipDeviceAttributeMultiprocessorCount, dev) != hipSuccess) { grid = -1; return; }
        if (hipFuncSetAttribute((const void*)hyb_fwd, hipFuncAttributeMaxDynamicSharedMemorySize, LDS_BYTES) != hipSuccess) { fprintf(stderr, "kernel_launch: hipFuncSetAttribute failed\n"); grid = -1; return; }
        if (hipOccupancyMaxActiveBlocksPerMultiprocessor(&per_cu, (const void*)hyb_fwd, NWAVES * 64, LDS_BYTES) != hipSuccess || per_cu < 1)
            fprintf(stderr, "kernel_launch: note: occupancy query reports %d workgroups per CU\n", per_cu);
        (void)hipGetLastError();
        grid = cus;
    }
    if (grid < 0) return;
    if (hipMemsetAsync((char*)d_ws + WS_CTL, 0, CTL_ZERO_BYTES, stream) != hipSuccess) { fprintf(stderr, "kernel_launch: hipMemsetAsync failed\n"); return; }
    Args a{};
    for (int i = 0; i < 15; ++i) a.in[i] = (const float*)d_in[i];
    a.out = (float*)d_out; a.ws = (unsigned char*)d_ws;
    for (int li = 0; li < N_LAUNCHES; ++li) {
        a.ph_lo = (N_LAUNCHES == 1) ? 0 : li; a.ph_hi = (N_LAUNCHES == 1) ? NPHASE : li + 1;
        hipLaunchKernelGGL(hyb_fwd, dim3(grid), dim3(NWAVES * 64), LDS_BYTES, stream, a);
        const hipError_t le = hipPeekAtLastError();
        if (le != hipSuccess) { fprintf(stderr, "kernel_launch: launch %d failed: %s\n", li, hipGetErrorName(le)); break; }
    }
}
```

```cpp
#include <hip/hip_runtime.h>
#include <cstdio>
#include <cstdint>
namespace pg8 {
#define PG8_LAS __attribute__((address_space(3)))
typedef unsigned short bf16_t;
typedef short bf16x8 __attribute__((ext_vector_type(8)));
typedef float f32x4 __attribute__((ext_vector_type(4)));
typedef unsigned u32x4 __attribute__((ext_vector_type(4)));
__device__ __forceinline__ __amdgpu_buffer_rsrc_t wt_rsrc(const void* base) { return __builtin_amdgcn_make_buffer_rsrc((void*)base, (short)0, 0x7ffffff0, 0x00020000); }
__device__ __forceinline__ void wt_store16(__amdgpu_buffer_rsrc_t r, size_t byte_off, u32x4 v) { __builtin_amdgcn_raw_buffer_store_b128(v, r, (int)byte_off, 0, 16); }
constexpr int BM = 256, BK = 64, HALF = 128, HTB = HALF * BK * 2  , STAGE_BYTES = 8 * HTB, NXCD = 8, WGM = 4;

__host__ __device__ __forceinline__ int lds_byte(int r, int c) { const int st = (r >> 4) * 2 + (c >> 5), rr = r & 15, cc = c & 31, ob = rr * 64 + cc * 2; return st * 1024 + (ob ^ (((ob >> 9) & 1) << 5)); }
__host__ __device__ __forceinline__ void stage_rc(int b, int& R, int& C) { const int st = b / 1024, sb = b % 1024, swz = sb ^ (((sb >> 9) & 1) << 5); R = (st >> 1) * 16 + swz / 64; C = (st & 1) * 32 + (swz % 64) / 2; }
__host__ __device__ __forceinline__ int perm32(int rho) { const int n = rho >> 4, i = rho & 15; return 8 * (i >> 2) + 4 * n + (i & 3); }

struct Unit { int pm, pn, sel; };
struct Gemm { const bf16_t* A; const bf16_t* Bt; long offA1, offB1; int M, N, K; };

struct StaticOrder {
    int nM, nN, nwg, G, c;
    __host__ __device__ void init(int M, int N, int G_, int c_) { nM = M / BM; nN = N / BM; nwg = nM * nN; G = G_; c = c_; }
    __host__ __device__ __forceinline__ bool next(int i, Unit& u) const {
        const long L = (long)i * G + c; if (L >= nwg) return false;
        int wgid = (int)L; { const int q = nwg / NXCD, r = nwg % NXCD, xcd = wgid % NXCD, off = wgid / NXCD; wgid = (xcd < r ? xcd * (q + 1) : r * (q + 1) + (xcd - r) * q) + off; }
        const int nig = WGM * nN, gid = wgid / nig, fm = gid * WGM, gsz = (nM - fm) < WGM ? (nM - fm) : WGM;
        u.pm = fm + ((wgid % nig) % gsz); u.pn = (wgid % nig) / gsz; u.sel = 0; return true;
    }
    __device__ __forceinline__ void a_ready(const Unit&) const {}
    __device__ __forceinline__ void done(const Unit&) const {}
};


__device__ __forceinline__ unsigned cvt_pk_bf16(float lo, float hi) { unsigned r; asm volatile("v_cvt_pk_bf16_f32 %0, %1, %2" : "=v"(r) : "v"(lo), "v"(hi)); return r; }
template <int K> __device__ __forceinline__ float ror16(float v) { return __int_as_float(__builtin_amdgcn_update_dpp(0, __float_as_int(v), 0x120 + K, 0xf, 0xf, false)); }
__device__ __forceinline__ float sigm(float x) { return __builtin_amdgcn_rcpf(1.0f + __expf(-x)); }
__device__ __forceinline__ float sig255(float x) { return fmaxf(255.0f * __builtin_amdgcn_rcpf(1.0f + __expf(-x)), 1.0f); }
__device__ __forceinline__ unsigned q8(float a, float b, float c, float d) {
    unsigned w = __builtin_amdgcn_cvt_pk_u8_f32(sig255(a), 0u, 0u); w = __builtin_amdgcn_cvt_pk_u8_f32(sig255(b), 1u, w); w = __builtin_amdgcn_cvt_pk_u8_f32(sig255(c), 2u, w); return __builtin_amdgcn_cvt_pk_u8_f32(sig255(d), 3u, w); }
__device__ __forceinline__ float ub0(unsigned w) { return (float)(w & 0xffu); }
__device__ __forceinline__ float ub1(unsigned w) { return (float)((w >> 8) & 0xffu); }
__device__ __forceinline__ float ub2(unsigned w) { return (float)((w >> 16) & 0xffu); }
__device__ __forceinline__ float ub3(unsigned w) { return (float)(w >> 24); }
__device__ __forceinline__ float bflo(unsigned w) { return __uint_as_float(w << 16); }
__device__ __forceinline__ float bfhi(unsigned w) { return __uint_as_float(w & 0xffff0000u); }

struct EpiProj {
    static constexpr bool PERM = true, AFTER_DRAIN = false, CHAIN = false;
    static constexpr bool ROWSCALE = true;
    const float* RS; bf16_t* PB; long pg_off; bf16_t* AIN; const float* CW; bf16_t* RAWU; bf16_t* RAWB; bf16_t* POOLED;
    __device__ __forceinline__ void unit_begin(const Unit& u, int ui, int tid, PG8_LAS unsigned char* buf) const {
        if (tid < 256) __builtin_amdgcn_global_load_lds((const unsigned*)(RS + u.pm * BM + tid), (PG8_LAS unsigned*)(buf + (ui & 1) * 2048 + (tid >> 6) * 256), 4, 0, 0);
        if (u.pn < 16 && tid < 192) __builtin_amdgcn_global_load_lds((const unsigned*)(CW + (tid >> 6) * 1024 + u.pn * 64 + (tid & 63)), (PG8_LAS unsigned*)(buf + (ui & 1) * 2048 + 1024 + (tid >> 6) * 256), 4, 0, 0);
    }
    typedef unsigned u32x2g __attribute__((ext_vector_type(2)));
    __device__ __forceinline__ u32x2g pk4(const f32x4 v) const { u32x2g w; w.x = cvt_pk_bf16(v[0], v[1]); w.y = cvt_pk_bf16(v[2], v[3]); return w; }
    __device__ __forceinline__ void operator()(const f32x4 (&acc)[2][2][4][2], const Unit& u, int wr, int wc, int fr, int fq, const PG8_LAS float* rsl) const {
        const int row0 = u.pm * BM + wr * 64 + fr, lc = wc * 32 + 8 * fq;
        float rs[2][4];
#pragma unroll
        for (int ai = 0; ai < 2; ++ai)
#pragma unroll
            for (int m = 0; m < 4; ++m) rs[ai][m] = rsl[wr * 64 + fr + ai * HALF + m * 16];
        if (u.pn >= 16) {
            unsigned char* pgb = (unsigned char*)PB + pg_off; const __amdgpu_buffer_rsrc_t rpg = wt_rsrc(pgb);
            unsigned char* base = pgb + (u.pn - 16) * BM + wc * 64 + fq * 16;
#pragma unroll
            for (int ai = 0; ai < 2; ++ai)
#pragma unroll
                for (int m = 0; m < 4; ++m) { const float r = rs[ai][m]; const f32x4 v0 = acc[ai][0][m][0] * r, v1 = acc[ai][0][m][1] * r, v2 = acc[ai][1][m][0] * r, v3 = acc[ai][1][m][1] * r;
                    u32x4 w; w.x = q8(v0[0], v0[1], v0[2], v0[3]); w.y = q8(v1[0], v1[1], v1[2], v1[3]); w.z = q8(v2[0], v2[1], v2[2], v2[3]); w.w = q8(v3[0], v3[1], v3[2], v3[3]);
                    wt_store16(rpg, (size_t)(base - pgb) + (size_t)(row0 + ai * HALF + m * 16) * 2048, w); }
            return;
        }
        const int ch0 = u.pn * 64 + wc * 16 + fq * 4;
        const PG8_LAS float* wl = rsl + 256 + wc * 16 + fq * 4;
        const f32x4 w0 = *(const PG8_LAS f32x4*)wl, w1 = *(const PG8_LAS f32x4*)(wl + 64), w2 = *(const PG8_LAS f32x4*)(wl + 128);
#pragma unroll
        for (int ai = 0; ai < 2; ++ai) {
            const int blk = u.pm * 4 + ai * 2 + wr;
            f32x4 up = (f32x4){0.f, 0.f, 0.f, 0.f};
            f32x4 pv[4]; u32x2g ao[4];
#pragma unroll
            for (int m = 0; m < 4; ++m) { const float r = rs[ai][m];
                const f32x4 b = acc[ai][0][m][0] * r, uu = (acc[ai][0][m][1] * r) * (acc[ai][1][m][0] * r), p = acc[ai][1][m][1] * r;
                f32x4 um1, um2;
#pragma unroll
                for (int e = 0; e < 4; ++e) { const float a1 = ror16<1>(uu[e]), a1p = ror16<1>(up[e]), a2 = ror16<2>(uu[e]), a2p = ror16<2>(up[e]);
                    um1[e] = (fr >= 1) ? a1 : a1p; um2[e] = (fr >= 2) ? a2 : a2p; }
                const f32x4 o = b * (w0 * um2 + w1 * um1 + w2 * uu);
                const size_t row = (size_t)(row0 + ai * HALF + m * 16);
                ao[m] = pk4(o);
                pv[m] = p;
                if (m == 0 && fr < 2) { *(u32x2g*)(RAWU + (size_t)(blk * 4 + fr) * 1024 + ch0) = pk4(uu); *(u32x2g*)(RAWB + (size_t)(blk * 2 + fr) * 1024 + ch0) = pk4(b); }
                if (m == 3 && fr >= 14) *(u32x2g*)(RAWU + (size_t)(blk * 4 + 2 + (fr - 14)) * 1024 + ch0) = pk4(uu);
                up = uu; }
            const int prow = row0 + ai * HALF + (fq & 1) * 16, pch = u.pn * 64 + wc * 16 + (fq >> 1) * 8;
#pragma unroll
            for (int m = 0; m < 4; m += 2) { const u32x2g s0 = __builtin_amdgcn_permlane16_swap(ao[m].x, ao[m + 1].x, false, false), s1 = __builtin_amdgcn_permlane16_swap(ao[m].y, ao[m + 1].y, false, false);
                *(u32x4*)(AIN + (size_t)(prow + m * 16) * 1024 + pch) = (u32x4){s0.x, s1.x, s0.y, s1.y}; }
            const int g = u.pn >> 2;
            f32x4 sv[4];
#pragma unroll
            for (int m = 0; m < 4; ++m) sv[m] = pv[m];
#define PG8_POOLSTEP(DD) do { f32x4 nv[4]; _Pragma("unroll") for (int m = 0; m < 4; ++m) _Pragma("unroll") for (int e = 0; e < 4; ++e) { \
                const float a = ror16<DD>(sv[m][e]), ap = ror16<DD>(m ? sv[m ? m - 1 : 0][e] : 0.f); nv[m][e] = sv[m][e] + ((fr >= DD) ? a : ap); } \
                _Pragma("unroll") for (int m = 0; m < 4; ++m) sv[m] = nv[m]; } while (0)
            PG8_POOLSTEP(1);
            if (g >= 1) PG8_POOLSTEP(2);
            if (g >= 2) PG8_POOLSTEP(4);
            if (g >= 3) PG8_POOLSTEP(8);
#undef PG8_POOLSTEP
            const float invw = (g == 0) ? 0.5f : (g == 1) ? 0.25f : (g == 2) ? 0.125f : 0.0625f; const int w1 = (2 << g) - 1;
#pragma unroll
            for (int m = 0; m < 4; ++m) { const size_t row = (size_t)(row0 + ai * HALF + m * 16);
                ao[m] = pk4(sv[m] * invw - pv[m]);
                if ((m == 0 && fr < w1) || (m == 3 && fr >= 16 - w1)) *(u32x2g*)(PB + row * 1024 + ch0) = pk4(pv[m]); }
#pragma unroll
            for (int m = 0; m < 4; m += 2) { const u32x2g s0 = __builtin_amdgcn_permlane16_swap(ao[m].x, ao[m + 1].x, false, false), s1 = __builtin_amdgcn_permlane16_swap(ao[m].y, ao[m + 1].y, false, false);
                *(u32x4*)(POOLED + (size_t)(prow + m * 16) * 1024 + pch) = (u32x4){s0.x, s1.x, s0.y, s1.y}; }
        }
    }
};
struct EpiMerge {
    static constexpr bool PERM = true, AFTER_DRAIN = false, CHAIN = true;
    static constexpr bool ROWSCALE = false;
    const unsigned char* PG; bf16_t* MG;
    typedef unsigned u32x2g __attribute__((ext_vector_type(2)));
    __device__ __forceinline__ void operator()(f32x4 (&acc)[2][2][4][2], const Unit& u, int wr, int wc, int fr, int fq) const {
        const int row0 = u.pm * BM + wr * 64 + fr, col0 = u.pn * BM + wc * 32 + 8 * fq;
        const unsigned char* pg = PG + (size_t)row0 * 2048 + col0;
        if (u.sel == 0) {
            u32x2g ga[2][4][2], gb[2][4][2];
#pragma unroll
            for (int ai = 0; ai < 2; ++ai)
#pragma unroll
                for (int m = 0; m < 4; ++m)
#pragma unroll
                    for (int bj = 0; bj < 2; ++bj) { const unsigned char* p = pg + (size_t)(ai * HALF + m * 16) * 2048 + bj * HALF; ga[ai][m][bj] = *(const u32x2g*)p; gb[ai][m][bj] = *(const u32x2g*)(p + 1024); }
#pragma unroll
            for (int ai = 0; ai < 2; ++ai)
#pragma unroll
                for (int m = 0; m < 4; ++m)
#pragma unroll
                    for (int bj = 0; bj < 2; ++bj) { const unsigned a0 = ga[ai][m][bj].x, a1 = ga[ai][m][bj].y, b0 = gb[ai][m][bj].x, b1 = gb[ai][m][bj].y; f32x4 v0 = acc[ai][bj][m][0], v1 = acc[ai][bj][m][1];
                        v0[0] *= ub0(a0) * __builtin_amdgcn_rcpf(ub0(b0)); v0[1] *= ub1(a0) * __builtin_amdgcn_rcpf(ub1(b0)); v0[2] *= ub2(a0) * __builtin_amdgcn_rcpf(ub2(b0)); v0[3] *= ub3(a0) * __builtin_amdgcn_rcpf(ub3(b0));
                        v1[0] *= ub0(a1) * __builtin_amdgcn_rcpf(ub0(b1)); v1[1] *= ub1(a1) * __builtin_amdgcn_rcpf(ub1(b1)); v1[2] *= ub2(a1) * __builtin_amdgcn_rcpf(ub2(b1)); v1[3] *= ub3(a1) * __builtin_amdgcn_rcpf(ub3(b1));
                        acc[ai][bj][m][0] = v0; acc[ai][bj][m][1] = v1; }
            asm volatile("" ::: "memory");
        } else {
            const __amdgpu_buffer_rsrc_t rmg = wt_rsrc(MG);
            u32x2g gb[2][4][2];
#pragma unroll
            for (int ai = 0; ai < 2; ++ai)
#pragma unroll
                for (int m = 0; m < 4; ++m)
#pragma unroll
                    for (int bj = 0; bj < 2; ++bj) gb[ai][m][bj] = *(const u32x2g*)(pg + (size_t)(ai * HALF + m * 16) * 2048 + bj * HALF + 1024);
            const float k = 1.0f / 255.0f;
#pragma unroll
            for (int ai = 0; ai < 2; ++ai)
#pragma unroll
                for (int m = 0; m < 4; ++m)
#pragma unroll
                    for (int bj = 0; bj < 2; ++bj) { const unsigned b0 = gb[ai][m][bj].x, b1 = gb[ai][m][bj].y; const f32x4 v0 = acc[ai][bj][m][0], v1 = acc[ai][bj][m][1];
                        u32x4 w; w.x = cvt_pk_bf16(v0[0] * (ub0(b0) * k), v0[1] * (ub1(b0) * k)); w.y = cvt_pk_bf16(v0[2] * (ub2(b0) * k), v0[3] * (ub3(b0) * k));
                        w.z = cvt_pk_bf16(v1[0] * (ub0(b1) * k), v1[1] * (ub1(b1) * k)); w.w = cvt_pk_bf16(v1[2] * (ub2(b1) * k), v1[3] * (ub3(b1) * k));
                        wt_store16(rmg, ((size_t)(row0 + ai * HALF + m * 16) * 1024 + col0 + bj * HALF) * 2, w); }
            asm volatile("" ::: "memory");
        }
    }
};
struct EpiRes {
    static constexpr bool PERM = false, AFTER_DRAIN = false, CHAIN = false;
    static constexpr bool ROWSCALE = false;
    const float* X; float* H;
    __device__ __forceinline__ void operator()(const f32x4 (&acc)[2][2][4][2], const Unit& u, int wr, int wc, int fr, int fq) const {
        const int row0 = u.pm * BM + wr * 64 + fr, col0 = u.pn * BM + wc * 32 + 4 * fq;
#pragma unroll
        for (int ai = 0; ai < 2; ++ai)
#pragma unroll
            for (int m = 0; m < 4; ++m) { const size_t off = (size_t)(row0 + ai * HALF + m * 16) * 1024 + col0;
#pragma unroll
                for (int bj = 0; bj < 2; ++bj)
#pragma unroll
                    for (int n = 0; n < 2; ++n) { const f32x4 xv = *(const f32x4*)(X + off + bj * HALF + n * 16); *(f32x4*)(H + off + bj * HALF + n * 16) = xv + acc[ai][bj][m][n]; } }
    }
};
struct EpiF16 {
    static constexpr bool PERM = true, AFTER_DRAIN = false, CHAIN = false;
    static constexpr bool ROWSCALE = false;
    unsigned short* C; int ldc;
    __device__ __forceinline__ unsigned pkh(float a, float b) const { typedef _Float16 h2 __attribute__((ext_vector_type(2))); h2 v; v.x = (_Float16)a; v.y = (_Float16)b; return __builtin_bit_cast(unsigned, v); }
    __device__ __forceinline__ void operator()(const f32x4 (&acc)[2][2][4][2], const Unit& u, int wr, int wc, int fr, int fq) const {
        const __amdgpu_buffer_rsrc_t rc = wt_rsrc(C);
        const int row0 = u.pm * BM + wr * 64 + fr, col0 = u.pn * BM + wc * 32 + 8 * fq;
#pragma unroll
        for (int ai = 0; ai < 2; ++ai)
#pragma unroll
            for (int m = 0; m < 4; ++m) { unsigned short* rowp = C + (size_t)(row0 + ai * HALF + m * 16) * ldc + col0;
#pragma unroll
                for (int bj = 0; bj < 2; ++bj) { const f32x4 v0 = acc[ai][bj][m][0], v1 = acc[ai][bj][m][1];
                    u32x4 w; w.x = pkh(v0[0], v0[1]); w.y = pkh(v0[2], v0[3]); w.z = pkh(v1[0], v1[1]); w.w = pkh(v1[2], v1[3]);
                    wt_store16(rc, (size_t)((rowp + bj * HALF) - C) * 2, w); } }
    }
};
struct EpiResRms {
    static constexpr bool PERM = true, AFTER_DRAIN = true, CHAIN = false;
    static constexpr bool ROWSCALE = false;
    const bf16_t* X; bf16_t* H16; unsigned char* X8; float* SSQ; float* SXQ;
    __device__ __forceinline__ void fused(f32x4 (&acc)[2][2][4][2], const Unit& u, int wr, int wc, int fr, int fq, PG8_LAS unsigned char* lds, int wid, int lane) const {
        typedef float f32x2v __attribute__((ext_vector_type(2))); typedef unsigned u32x2v __attribute__((ext_vector_type(2)));
        PG8_LAS f32x2v* P = (PG8_LAS f32x2v*)lds;
        PG8_LAS f32x2v* S = (PG8_LAS f32x2v*)(lds + 8192);
        int col0 = u.pn * BM + wc * 32 + 8 * fq; asm volatile("" : "+v"(col0));
        const bf16_t* xb = X + (size_t)(u.pm * BM + wr * 64 + fr) * 1024 + col0;
        u32x4 xq[2][4][2];
#pragma unroll
        for (int ai = 0; ai < 2; ++ai)
#pragma unroll
            for (int m = 0; m < 4; ++m)
#pragma unroll
                for (int bj = 0; bj < 2; ++bj) xq[ai][m][bj] = __builtin_nontemporal_load((const u32x4*)(xb + (size_t)(ai * HALF + m * 16) * 1024 + bj * HALF));
#pragma unroll
        for (int am = 0; am < 8; ++am) { const int ai = am >> 2, m = am & 3, r = ai * HALF + wr * 64 + m * 16 + fr;
            asm volatile("" ::: "memory");
            float s = 0.f, a = 0.f;
#pragma unroll
            for (int bj = 0; bj < 2; ++bj)
#pragma unroll
                for (int n = 0; n < 2; ++n) { const u32x4 xw = xq[ai][m][bj]; const unsigned w0 = n ? xw.z : xw.x, w1 = n ? xw.w : xw.y;
                    const f32x4 h = (f32x4){bflo(w0), bfhi(w0), bflo(w1), bfhi(w1)} + acc[ai][bj][m][n]; acc[ai][bj][m][n] = h;
                    s += (h[0] * h[0] + h[1] * h[1]) + (h[2] * h[2] + h[3] * h[3]);
                    a = fmaxf(a, fmaxf(fmaxf(fabsf(h[0]), fabsf(h[1])), fmaxf(fabsf(h[2]), fabsf(h[3])))); }
            s += __shfl_xor(s, 16); s += __shfl_xor(s, 32); a = fmaxf(a, __shfl_xor(a, 16)); a = fmaxf(a, __shfl_xor(a, 32));
            if (fq == 0) P[r * 4 + wc] = (f32x2v){s, a};
            asm volatile("" ::: "memory"); }
        asm volatile("s_waitcnt lgkmcnt(0)" ::: "memory"); __builtin_amdgcn_s_barrier(); asm volatile("" ::: "memory");
        const int row = wid * 32 + (lane & 31);
        if (lane < 32) {
            const f32x2v a = P[row * 4 + 0], b = P[row * 4 + 1], c = P[row * 4 + 2], d = P[row * 4 + 3];
            const float st = (a.x + b.x) + (c.x + d.x), am = fmaxf(fmaxf(a.y, b.y), fmaxf(c.y, d.y));
            const float sc = (am > 0.f) ? am * (1.0f / 448.0f) : 1.0f;
            S[row] = (f32x2v){st, 1.0f / sc};
            SSQ[(size_t)(u.pm * BM + row) * 4 + u.pn] = st; SXQ[(size_t)(u.pm * BM + row) * 4 + u.pn] = sc;
        }
        asm volatile("s_waitcnt lgkmcnt(0)" ::: "memory"); __builtin_amdgcn_s_barrier(); asm volatile("" ::: "memory");
        asm volatile("" : "+v"(col0), "+v"(fr));
        const __amdgpu_buffer_rsrc_t rh = wt_rsrc(H16);
#pragma unroll
        for (int ai = 0; ai < 2; ++ai)
#pragma unroll
            for (int m = 0; m < 4; ++m) { const int r = ai * HALF + wr * 64 + m * 16 + fr; const f32x2v sr = S[r]; const size_t off = (size_t)(u.pm * BM + r) * 1024 + col0;
#pragma unroll
                for (int bj = 0; bj < 2; ++bj) { const f32x4 h0 = acc[ai][bj][m][0], h1 = acc[ai][bj][m][1];
                    u32x4 hw; hw.x = cvt_pk_bf16(h0[0], h0[1]); hw.y = cvt_pk_bf16(h0[2], h0[3]); hw.z = cvt_pk_bf16(h1[0], h1[1]); hw.w = cvt_pk_bf16(h1[2], h1[3]);
                    wt_store16(rh, (off + bj * HALF) * 2, hw);
                    { const f32x4 q0 = h0 * sr.y, q1 = h1 * sr.y; u32x2v w8;
                        w8.x = (unsigned)__builtin_amdgcn_cvt_pk_fp8_f32(q0[2], q0[3], __builtin_amdgcn_cvt_pk_fp8_f32(q0[0], q0[1], 0, false), true);
                        w8.y = (unsigned)__builtin_amdgcn_cvt_pk_fp8_f32(q1[2], q1[3], __builtin_amdgcn_cvt_pk_fp8_f32(q1[0], q1[1], 0, false), true);
                        *(u32x2v*)(X8 + off + bj * HALF) = w8; } }
                asm volatile("" ::: "memory"); }
    }
};
struct MergeOrder {
    StaticOrder base;
    __device__ __forceinline__ bool next(int i, Unit& u) const { if (!base.next(i >> 1, u)) return false; u.sel = i & 1; return true; }
    __device__ __forceinline__ void a_ready(const Unit&) const {}
    __device__ __forceinline__ void done(const Unit&) const {}
};

template <class Epi, class Sched, bool ALIGN_EPI = false, bool SP2 = false>
__device__ __forceinline__ void gemm_phase(PG8_LAS unsigned char* lds, const Gemm g, const Sched& S, const Epi& E) {
    const int tid = threadIdx.x, wid = __builtin_amdgcn_readfirstlane(tid >> 6), lane = tid & 63, wr = wid >> 2, wc = wid & 3, fr = lane & 15, fq = lane >> 4;
    const int K = g.K, nt = K / BK;
    unsigned voffA[2], voffB[2];
#pragma unroll
    for (int i = 0; i < 2; ++i) { int R, C; stage_rc(tid * 16 + i * 8192, R, C); const int Rb = Epi::PERM ? ((R & ~31) + perm32(R & 31)) : R;
        voffA[i] = (unsigned)(R * K + C) * 2u; voffB[i] = (unsigned)(Rb * K + C) * 2u; }
    const size_t kstep = (size_t)(BK * 2);
    const size_t hstep = (size_t)HALF * K * 2;
    const size_t tstep = 2 * hstep;
    const unsigned ldsw = (unsigned)wid * 1024u;
    const int aoff = lds_byte(wr * 64 + fr, fq * 8), boff = lds_byte(wc * 32 + fr, fq * 8);
#define PG8_SA(b, h) (((b) * 2 + (h)) * HTB)
#define PG8_SB(b, h) ((4 + (b) * 2 + (h)) * HTB)
#define PG8_STAGE(bufoff, gbase, voff) do { _Pragma("unroll") for (int _i = 0; _i < 2; ++_i) \
        __builtin_amdgcn_global_load_lds((const unsigned*)((const char*)(gbase) + (voff)[_i]), (PG8_LAS unsigned*)(lds + (bufoff) + ldsw + _i * 8192), 16, 0, 0); } while (0)
#define PG8_STAGEM(bufoff, gbase, voff) do { _Pragma("unroll") for (int _i = 0; _i < 2; ++_i) \
        __builtin_amdgcn_global_load_lds((const unsigned*)((const char*)(gbase) + (dummy ? 0u : (voff)[_i])), (PG8_LAS unsigned*)(lds + (bufoff) + ldsw + _i * 8192), 16, 0, 0); } while (0)
#define PG8_LDA(dst, b, h) do { _Pragma("unroll") for (int m = 0; m < 4; ++m) _Pragma("unroll") for (int k = 0; k < 2; ++k) dst[m][k] = *(const PG8_LAS bf16x8*)(lds + PG8_SA(b, h) + aoff + m * 2048 + k * 1024); } while (0)
#define PG8_LDB(dst, b, h) do { _Pragma("unroll") for (int n = 0; n < 2; ++n) _Pragma("unroll") for (int k = 0; k < 2; ++k) dst[n][k] = *(const PG8_LAS bf16x8*)(lds + PG8_SB(b, h) + boff + n * 2048 + k * 1024); } while (0)
#define PG8_MMA(ai, bj, At, Bt) do { __builtin_amdgcn_s_setprio(1); _Pragma("unroll") for (int m = 0; m < 4; ++m) _Pragma("unroll") for (int n = 0; n < 2; ++n) _Pragma("unroll") for (int k = 0; k < 2; ++k) \
        acc[ai][bj][m][n] = __builtin_amdgcn_mfma_f32_16x16x32_bf16(Bt[n][k], At[m][k], acc[ai][bj][m][n], 0, 0, 0); __builtin_amdgcn_s_setprio(0); } while (0)
#define PG8_WAIT_V(n) asm volatile("s_waitcnt vmcnt(" #n ")" ::: "memory")
#define PG8_WAIT_L(n) asm volatile("s_waitcnt lgkmcnt(" #n ")" ::: "memory")
#define PG8_BAR __builtin_amdgcn_s_barrier()
#define PG8_SCHED __builtin_amdgcn_sched_barrier(0)
    Unit cur, nxt; int ui = 0;
    if (!S.next(0, cur)) return;
    f32x4 acc[2][2][4][2];
#pragma unroll
    for (int a = 0; a < 2; ++a)
#pragma unroll
        for (int b = 0; b < 2; ++b)
#pragma unroll
            for (int m = 0; m < 4; ++m)
#pragma unroll
                for (int n = 0; n < 2; ++n) acc[a][b][m][n] = (f32x4){0.f, 0.f, 0.f, 0.f};
    bf16x8 At[4][2], B0[2][2], B1[2][2];
    const char* cA = (const char*)g.A + (cur.sel ? g.offA1 : 0l) + (size_t)cur.pm * tstep; const char* cB = (const char*)g.Bt + (cur.sel ? g.offB1 : 0l) + (size_t)cur.pn * tstep;
    S.a_ready(cur);
    if constexpr (Epi::ROWSCALE) E.unit_begin(cur, 0, tid, lds + STAGE_BYTES);
    if constexpr (SP2) {
        PG8_STAGE(PG8_SB(0, 0), cB, voffB); PG8_STAGE(PG8_SB(0, 1), cB + hstep, voffB); PG8_STAGE(PG8_SA(0, 0), cA, voffA); PG8_STAGE(PG8_SA(0, 1), cA + hstep, voffA);
        if (wr == 1) PG8_BAR;
        PG8_WAIT_V(2); PG8_BAR;
        PG8_STAGE(PG8_SB(1, 0), cB + kstep, voffB); PG8_STAGE(PG8_SA(1, 0), cA + kstep, voffA); PG8_STAGE(PG8_SB(1, 1), cB + hstep + kstep, voffB);
        PG8_WAIT_V(6); PG8_BAR;
    } else {
        PG8_STAGE(PG8_SB(0, 0), cB, voffB); PG8_STAGE(PG8_SA(0, 0), cA, voffA); PG8_STAGE(PG8_SB(0, 1), cB + hstep, voffB); PG8_STAGE(PG8_SA(0, 1), cA + hstep, voffA);
        if (wr == 1) PG8_BAR;
        PG8_WAIT_V(4); PG8_BAR;
        PG8_STAGE(PG8_SB(1, 0), cB + kstep, voffB); PG8_STAGE(PG8_SA(1, 0), cA + kstep, voffA); PG8_STAGE(PG8_SB(1, 1), cB + hstep + kstep, voffB);
        PG8_WAIT_V(6); PG8_BAR;
    }
    for (;;) {
        const bool has_next = S.next(ui + 1, nxt);
        const char* nA = has_next ? (const char*)g.A + (nxt.sel ? g.offA1 : 0l) + (size_t)nxt.pm * tstep : cA; const char* nB = has_next ? (const char*)g.Bt + (nxt.sel ? g.offB1 : 0l) + (size_t)nxt.pn * tstep : cB;
        for (int t = 0; t < nt; t += 2) {
            const bool last = (t == nt - 2); const bool dummy = last && !has_next;
            const char* a1 = cA + (size_t)(t + 1) * kstep;
            const char* a2 = last ? nA : cA + (size_t)(t + 2) * kstep; const char* b2 = last ? nB : cB + (size_t)(t + 2) * kstep;
            const char* a3 = a2 + kstep; const char* b3 = b2 + kstep;
            if (last && has_next) S.a_ready(nxt);
            if constexpr (SP2) {
            PG8_LDB(B0, 0, 0); PG8_LDB(B1, 0, 1); PG8_SCHED; PG8_LDA(At, 0, 0); PG8_STAGE(PG8_SA(1, 1), a1 + hstep, voffA);
            PG8_WAIT_V(8); PG8_WAIT_L(0); PG8_BAR; PG8_MMA(0, 0, At, B0); PG8_MMA(0, 1, At, B1); PG8_BAR; PG8_SCHED;
            PG8_LDA(At, 0, 1); PG8_STAGEM(PG8_SB(0, 0), b2, voffB); PG8_STAGEM(PG8_SB(0, 1), b2 + hstep, voffB); PG8_STAGEM(PG8_SA(0, 0), a2, voffA);
            PG8_WAIT_V(8); PG8_WAIT_L(0); PG8_BAR; PG8_MMA(1, 0, At, B0); PG8_MMA(1, 1, At, B1); PG8_BAR; PG8_SCHED;
            PG8_LDB(B0, 1, 0); PG8_LDB(B1, 1, 1); PG8_SCHED; PG8_LDA(At, 1, 0); PG8_STAGEM(PG8_SA(0, 1), a2 + hstep, voffA);
            PG8_WAIT_V(8); PG8_WAIT_L(0); PG8_BAR; PG8_MMA(0, 0, At, B0); PG8_MMA(0, 1, At, B1); PG8_BAR; PG8_SCHED;
            PG8_LDA(At, 1, 1); PG8_STAGEM(PG8_SB(1, 0), b3, voffB); PG8_STAGEM(PG8_SB(1, 1), b3 + hstep, voffB); PG8_STAGEM(PG8_SA(1, 0), a3, voffA);
            PG8_WAIT_V(8); PG8_WAIT_L(0); PG8_BAR; PG8_MMA(1, 0, At, B0); PG8_MMA(1, 1, At, B1); PG8_BAR; PG8_SCHED;
            } else {
            PG8_LDB(B0, 0, 0); PG8_SCHED; PG8_LDA(At, 0, 0); PG8_STAGE(PG8_SA(1, 1), a1 + hstep, voffA);
            PG8_WAIT_L(8); PG8_BAR; PG8_WAIT_L(0); PG8_MMA(0, 0, At, B0); PG8_BAR; PG8_SCHED;
            PG8_LDB(B1, 0, 1); PG8_STAGEM(PG8_SB(0, 0), b2, voffB);
            PG8_BAR; PG8_WAIT_L(0); PG8_MMA(0, 1, At, B1); PG8_BAR;
            PG8_LDA(At, 0, 1); PG8_STAGEM(PG8_SA(0, 0), a2, voffA);
            PG8_BAR; PG8_WAIT_L(0); PG8_MMA(1, 0, At, B0); PG8_BAR; PG8_SCHED;
            PG8_STAGEM(PG8_SB(0, 1), b2 + hstep, voffB);
            PG8_WAIT_V(6); PG8_BAR; PG8_MMA(1, 1, At, B1); PG8_BAR;
            PG8_LDB(B0, 1, 0); PG8_SCHED; PG8_LDA(At, 1, 0); PG8_STAGEM(PG8_SA(0, 1), a2 + hstep, voffA);
            PG8_WAIT_L(8); PG8_BAR; PG8_WAIT_L(0); PG8_MMA(0, 0, At, B0); PG8_BAR; PG8_SCHED;
            PG8_LDB(B1, 1, 1); PG8_STAGEM(PG8_SB(1, 0), b3, voffB);
            PG8_BAR; PG8_WAIT_L(0); PG8_MMA(0, 1, At, B1); PG8_BAR;
            PG8_LDA(At, 1, 1); PG8_STAGEM(PG8_SA(1, 0), a3, voffA);
            PG8_BAR; PG8_WAIT_L(0); PG8_MMA(1, 0, At, B0); PG8_BAR; PG8_SCHED;
            PG8_STAGEM(PG8_SB(1, 1), b3 + hstep, voffB);
            PG8_WAIT_V(6); PG8_BAR; PG8_MMA(1, 1, At, B1); PG8_BAR;
            }
        }
        if constexpr (ALIGN_EPI) { if (wr == 0) PG8_BAR; }
        if constexpr (Epi::ROWSCALE) { E(acc, cur, wr, wc, fr, fq, (const PG8_LAS float*)(lds + STAGE_BYTES + (ui & 1) * 2048)); S.done(cur); }
        else if constexpr (!Epi::AFTER_DRAIN) { E(acc, cur, wr, wc, fr, fq); S.done(cur); }
        if (!has_next) break;
        if (!Epi::CHAIN || nxt.sel == 0) {
#pragma unroll
        for (int a = 0; a < 2; ++a)
#pragma unroll
            for (int b = 0; b < 2; ++b)
#pragma unroll
                for (int m = 0; m < 4; ++m)
#pragma unroll
                    for (int n = 0; n < 2; ++n) acc[a][b][m][n] = (f32x4){0.f, 0.f, 0.f, 0.f};
        }
        cur = nxt; cA = nA; cB = nB; ++ui;
        if constexpr (Epi::ROWSCALE) E.unit_begin(cur, ui, tid, lds + STAGE_BYTES);
        if constexpr (ALIGN_EPI) { if (wr == 1) PG8_BAR; }
    }
    PG8_WAIT_V(0);
    if constexpr (!ALIGN_EPI) { if (wr == 0) PG8_BAR; }
    PG8_BAR;
    if constexpr (Epi::AFTER_DRAIN) { E.fused(acc, cur, wr, wc, fr, fq, lds, wid, lane); S.done(cur); }
#undef PG8_SA
#undef PG8_SB
#undef PG8_STAGE
#undef PG8_LDA
#undef PG8_LDB
#undef PG8_MMA
#undef PG8_WAIT_V
#undef PG8_WAIT_L
#undef PG8_BAR
#undef PG8_SCHED
}
}
constexpr int NWAVES = 8;
#ifndef MK_N_LAUNCHES
#define MK_N_LAUNCHES 1
#endif
constexpr int NPHASE = 8;
#ifndef PROBE_DUP
#define PROBE_DUP 0
#endif
#ifndef PROBE_DELAY
#define PROBE_DELAY (-1)
#endif
#define DELAY_T0(k) const unsigned long long _t0_##k = (PROBE_DELAY == (k)) ? __builtin_amdgcn_s_memrealtime() : 0ull
#define DELAY_END(k) do { if (PROBE_DELAY == (k)) { const unsigned long long _t1 = __builtin_amdgcn_s_memrealtime(), _dt = _t1 - _t0_##k; while (__builtin_amdgcn_s_memrealtime() - _t1 < _dt) __builtin_amdgcn_s_sleep(8); } } while (0)
#define REPS(k) (1 + ((PROBE_DUP >> (k)) & 1))
constexpr int N_LAUNCHES = MK_N_LAUNCHES;
static_assert(N_LAUNCHES == 1 || N_LAUNCHES == NPHASE, "MK_N_LAUNCHES is 1 or NPHASE");

constexpr int T = 16384, SEQ = 2048, D = 1024, NIN = 6144, NSC = 2048, NEXP = 16384, NSEL = 128;
constexpr float EPS = 1e-6f;

constexpr size_t MiB = 1u << 20;
constexpr size_t WS_CTL = 0, CTL_ZERO_BYTES = 64 * 1024;
constexpr size_t WS_WIN = 1 * MiB, WS_WC = 13 * MiB, WS_WPB = 15 * MiB, WS_WOUT = 17 * MiB, WS_WS = 19 * MiB;
constexpr size_t WS_IDX = 1 * MiB, WS_GATE = 9 * MiB;
constexpr size_t WS_XN = 32 * MiB;
constexpr size_t WS_PB = 64 * MiB;
constexpr size_t WS_TMP = 64 * MiB, WS_MG = 64 * MiB, WS_AIN = 96 * MiB;
constexpr size_t WS_X8 = 128 * MiB, WS_SX = 144 * MiB;
constexpr size_t WS_PO = 64 * MiB;
constexpr size_t WS_SC = 64 * MiB;
constexpr size_t WS_PG = 192 * MiB;
constexpr size_t WS_U8 = 192 * MiB, WS_V8 = 208 * MiB, WS_H16 = 224 * MiB, WS_SU = 31 * MiB + 512 * 1024, WS_SV = 31 * MiB + 576 * 1024;
constexpr size_t WS_END = 256 * MiB;
constexpr int CW_TMO = 0;
constexpr int CW_BAR = 1024;
constexpr int CW_SEAM = 8192;
constexpr size_t WS_RAWU = 160 * MiB, WS_RAWB = 164 * MiB;
constexpr size_t WS_RS1 = 31 * MiB + 640 * 1024;
constexpr size_t WS_XBUF = 31 * MiB;

constexpr int RING_OFF = 0, RING_BYTES = 131072;
constexpr int P7_WAVE_BYTES = 18432;
constexpr int P7_IDX_OFF = 0, P7_OUT_OFF = 4096, P7_STAGE_OFF = 6144, P7_ZA_OFF = 14336;
constexpr int LDSCTL_OFF = 8 * P7_WAVE_BYTES, MISC_OFF = LDSCTL_OFF + 320;
constexpr int P7_AUX_OFF = LDSCTL_OFF + 1024;
constexpr int LDS_BYTES = 150528;
#define GAS __attribute__((address_space(1)))
#define LAS __attribute__((address_space(3)))
typedef unsigned short bf16;
typedef unsigned v4u __attribute__((ext_vector_type(4)));
typedef float f32x4 __attribute__((ext_vector_type(4)));
typedef short bf16x8 __attribute__((ext_vector_type(8)));
typedef GAS unsigned gu32;
typedef GAS unsigned long long gu64;
#define RLX_AGENT __ATOMIC_RELAXED, __HIP_MEMORY_SCOPE_AGENT
#define LDS_WAIT() asm volatile("s_waitcnt lgkmcnt(0)" ::: "memory")
#define VM_WAIT() asm volatile("s_waitcnt vmcnt(0)" ::: "memory")
__device__ __forceinline__ unsigned long long rt() { return __builtin_amdgcn_s_memrealtime(); }
__device__ __forceinline__ unsigned f2bf(float f) { unsigned u = __builtin_bit_cast(unsigned, f); return (u + 0x7fffu + ((u >> 16) & 1u)) >> 16; }
__device__ __forceinline__ unsigned pk2(float lo, float hi) { return f2bf(lo) | (f2bf(hi) << 16); }

#define XB_TMO      128
#define XB_XCNT(j)  (256  + 64 * (j))
#define XB_XSUB(j)  (1280 + 64 * (j))
#define XB_XGEN(j)  (2304 + 64 * (j))
#define XB_TOP      3328
#define XB_TOPGEN   3392
#define XCD_BAR_WORDS 3456
#define XB_SPIN_CAP (1u << 18)

__device__ __forceinline__ unsigned xb_ld(unsigned* p)              { return __hip_atomic_load(p, __ATOMIC_RELAXED, __HIP_MEMORY_SCOPE_AGENT); }
__device__ __forceinline__ unsigned xb_add(unsigned* p, unsigned v) { return __hip_atomic_fetch_add(p, v, __ATOMIC_RELAXED, __HIP_MEMORY_SCOPE_AGENT); }
__device__ __forceinline__ unsigned xb_xcc_id() { return (unsigned)__builtin_amdgcn_s_getreg((3 << 11) | 20) & 0xFu; }
#define XB_SPIN(cond, bar) do { unsigned _sp = 0; while (cond) { __builtin_amdgcn_s_sleep(1); \
    if ((++_sp & 255u) == 0u) { if (xb_ld(&(bar)[XB_TMO])) break; if (_sp > XB_SPIN_CAP) { atomicAdd(&(bar)[XB_TMO], 1u); break; } } } } while (0)

struct XcdBarrier {
    unsigned* bar; unsigned x;
    volatile LAS unsigned* st;
};

__device__ __forceinline__ XcdBarrier xcd_barrier_post(unsigned* bar, volatile LAS unsigned* st) {
    XcdBarrier b; b.bar = bar; b.x = xb_xcc_id(); b.st = st;
    if (threadIdx.x == 0) (void)xb_add(&bar[XB_XCNT(b.x)], 1u);
    return b;
}
__device__ __forceinline__ void xcd_barrier_complete(unsigned* bar, unsigned x, unsigned& nloc, unsigned& nx) {
    const unsigned G = gridDim.x * gridDim.y * gridDim.z;
    unsigned sum, cnt, mine, sp = 0u;
    for (;;) {
        sum = 0u; cnt = 0u; mine = 0u;
#pragma unroll
        for (unsigned j = 0; j < 16; ++j) { const unsigned c = xb_ld(&bar[XB_XCNT(j)]); sum += c; cnt += (c > 0u) ? 1u : 0u; mine = (j == x) ? c : mine; }
        if (sum == G) break;
        __builtin_amdgcn_s_sleep(1);
        if ((++sp & 255u) == 0u) { if (xb_ld(&bar[XB_TMO])) break; if (sp > XB_SPIN_CAP) { atomicAdd(&bar[XB_TMO], 1u); break; } }
    }
    nloc = mine > 0u ? mine : 1u; nx = cnt > 0u ? cnt : 1u;
}

__device__ __forceinline__ void xcd_barrier(const XcdBarrier& b) {
    asm volatile("s_waitcnt vmcnt(0)" ::: "memory");
    __syncthreads();
    if (threadIdx.x == 0) {
        unsigned* bar = b.bar;
        __builtin_amdgcn_s_waitcnt(0);
        unsigned nloc = b.st[0], nx = b.st[1];
        if (nloc == 0u) { xcd_barrier_complete(bar, b.x, nloc, nx); b.st[0] = nloc; b.st[1] = nx; }
        const unsigned old = xb_add(&bar[XB_XSUB(b.x)], 1u);
        const unsigned gen = old / nloc;
        if (old + 1u == (gen + 1u) * nloc) {
            __builtin_amdgcn_fence(__ATOMIC_RELEASE, "agent");
            asm volatile("s_waitcnt vmcnt(0)" ::: "memory");
            const unsigned og = xb_add(&bar[XB_TOP], 1u);
            const unsigned tg = og / nx;
            if (og + 1u == (tg + 1u) * nx) xb_add(&bar[XB_TOPGEN], 1u);
            else XB_SPIN(xb_ld(&bar[XB_TOPGEN]) == tg, bar);
            __builtin_amdgcn_fence(__ATOMIC_ACQUIRE, "agent");
            xb_add(&bar[XB_XGEN(b.x)], 1u);
            asm volatile("s_waitcnt vmcnt(0)" ::: "memory");
        } else {
            XB_SPIN(xb_ld(&bar[XB_XGEN(b.x)]) == gen, bar);
            __builtin_amdgcn_fence(__ATOMIC_ACQUIRE, "agent");
            asm volatile("s_waitcnt vmcnt(0)" ::: "memory");
        }
    }
    __syncthreads();
}

struct Frame {
    LAS unsigned char* lds;
    volatile LAS unsigned* MISC;
    int tid, lane, wave;
    int vcu, G;
};
template <int CTRL, int ROWMASK> __device__ __forceinline__ float dpp_max_step(float v) { return fmaxf(v, __int_as_float(__builtin_amdgcn_update_dpp(__float_as_int(v), __float_as_int(v), CTRL, ROWMASK, 0xf, false))); }
__device__ __forceinline__ float wave_max_dpp(float v) {
    v = dpp_max_step<0xB1, 0xf>(v); v = dpp_max_step<0x4E, 0xf>(v); v = dpp_max_step<0x141, 0xf>(v); v = dpp_max_step<0x140, 0xf>(v);
    v = dpp_max_step<0x142, 0xA>(v); v = dpp_max_step<0x143, 0xC>(v);
    return __int_as_float(__builtin_amdgcn_readlane(__float_as_int(v), 63));
}
__device__ __forceinline__ float wave_sum(float v) {
#pragma unroll
    for (int o = 1; o < 64; o <<= 1) v += __shfl_xor(v, o);
    return v;
}
__device__ __forceinline__ float bflo(unsigned w) { return __uint_as_float(w << 16); }
__device__ __forceinline__ float bfhi(unsigned w) { return __uint_as_float(w & 0xffff0000u); }
__device__ __forceinline__ void unpack8(const v4u w, float (&f)[8]) { f[0] = bflo(w.x); f[1] = bfhi(w.x); f[2] = bflo(w.y); f[3] = bfhi(w.y); f[4] = bflo(w.z); f[5] = bfhi(w.z); f[6] = bflo(w.w); f[7] = bfhi(w.w); }
__device__ __forceinline__ v4u pack8(const float (&f)[8]) { v4u o; o.x = pk2(f[0], f[1]); o.y = pk2(f[2], f[3]); o.z = pk2(f[4], f[5]); o.w = pk2(f[6], f[7]); return o; }

__device__ __forceinline__ void rms_row_to_fp8(int lane, const float* xrow, const float* g, unsigned char* orow, float* sc_out) {
    const GAS f32x4* xr = (const GAS f32x4*)xrow + 4 * lane; const GAS f32x4* gr = (const GAS f32x4*)g + 4 * lane;
    f32x4 v[4]; float s = 0.f, am = 0.f;
#pragma unroll
    for (int jj = 0; jj < 4; ++jj) { v[jj] = xr[jj]; s += (v[jj].x * v[jj].x + v[jj].y * v[jj].y) + (v[jj].z * v[jj].z + v[jj].w * v[jj].w); v[jj] = v[jj] * gr[jj];
        am = fmaxf(am, fmaxf(fmaxf(fabsf(v[jj].x), fabsf(v[jj].y)), fmaxf(fabsf(v[jj].z), fabsf(v[jj].w)))); }
#pragma unroll
    for (int o = 1; o < 64; o <<= 1) am = fmaxf(am, __shfl_xor(am, o));
    const float rstd = 1.f / sqrtf(wave_sum(s) * (1.f / D) + EPS), xm = am * rstd, sc = (xm > 0.f) ? xm * (1.0f / 448.0f) : 1.0f, mul = rstd / sc;
    v4u o;
    o.x = (unsigned)__builtin_amdgcn_cvt_pk_fp8_f32(v[0].z * mul, v[0].w * mul, __builtin_amdgcn_cvt_pk_fp8_f32(v[0].x * mul, v[0].y * mul, 0, false), true);
    o.y = (unsigned)__builtin_amdgcn_cvt_pk_fp8_f32(v[1].z * mul, v[1].w * mul, __builtin_amdgcn_cvt_pk_fp8_f32(v[1].x * mul, v[1].y * mul, 0, false), true);
    o.z = (unsigned)__builtin_amdgcn_cvt_pk_fp8_f32(v[2].z * mul, v[2].w * mul, __builtin_amdgcn_cvt_pk_fp8_f32(v[2].x * mul, v[2].y * mul, 0, false), true);
    o.w = (unsigned)__builtin_amdgcn_cvt_pk_fp8_f32(v[3].z * mul, v[3].w * mul, __builtin_amdgcn_cvt_pk_fp8_f32(v[3].x * mul, v[3].y * mul, 0, false), true);
    *(GAS v4u*)(orow + 16 * lane) = o;
    if (lane == 0) *sc_out = sc;
}
__device__ __forceinline__ void p4_row_defer(int lane, const float* hrow, unsigned char* x8, float* ssq, float* sxq, bf16* h16) {
    const GAS f32x4* xr = (const GAS f32x4*)hrow + 4 * lane;
    f32x4 h[4]; float s = 0.f, am = 0.f;
#pragma unroll
    for (int jj = 0; jj < 4; ++jj) { h[jj] = xr[jj]; s += (h[jj].x * h[jj].x + h[jj].y * h[jj].y) + (h[jj].z * h[jj].z + h[jj].w * h[jj].w);
        am = fmaxf(am, fmaxf(fmaxf(fabsf(h[jj].x), fabsf(h[jj].y)), fmaxf(fabsf(h[jj].z), fabsf(h[jj].w)))); }
#pragma unroll
    for (int o = 1; o < 64; o <<= 1) am = fmaxf(am, __shfl_xor(am, o));
    s = wave_sum(s);
    const float sc = (am > 0.f) ? am * (1.0f / 448.0f) : 1.0f, mul = 1.0f / sc;
    v4u o;
    o.x = (unsigned)__builtin_amdgcn_cvt_pk_fp8_f32(h[0].z * mul, h[0].w * mul, __builtin_amdgcn_cvt_pk_fp8_f32(h[0].x * mul, h[0].y * mul, 0, false), true);
    o.y = (unsigned)__builtin_amdgcn_cvt_pk_fp8_f32(h[1].z * mul, h[1].w * mul, __builtin_amdgcn_cvt_pk_fp8_f32(h[1].x * mul, h[1].y * mul, 0, false), true);
    o.z = (unsigned)__builtin_amdgcn_cvt_pk_fp8_f32(h[2].z * mul, h[2].w * mul, __builtin_amdgcn_cvt_pk_fp8_f32(h[2].x * mul, h[2].y * mul, 0, false), true);
    o.w = (unsigned)__builtin_amdgcn_cvt_pk_fp8_f32(h[3].z * mul, h[3].w * mul, __builtin_amdgcn_cvt_pk_fp8_f32(h[3].x * mul, h[3].y * mul, 0, false), true);
    *(GAS v4u*)(x8 + 16 * lane) = o;
    v4u b0, b1;
    b0.x = pk2(h[0].x, h[0].y); b0.y = pk2(h[0].z, h[0].w); b0.z = pk2(h[1].x, h[1].y); b0.w = pk2(h[1].z, h[1].w); b1.x = pk2(h[2].x, h[2].y); b1.y = pk2(h[2].z, h[2].w); b1.z = pk2(h[3].x, h[3].y); b1.w = pk2(h[3].z, h[3].w);
    *(GAS v4u*)(h16 + 16 * lane) = b0; *(GAS v4u*)(h16 + 16 * lane + 8) = b1;
    if (lane == 0) { ssq[0] = s; ssq[1] = 0.f; ssq[2] = 0.f; ssq[3] = 0.f; sxq[0] = sc; sxq[1] = sc; sxq[2] = sc; sxq[3] = sc; }
}
__device__ __forceinline__ void rms_rows4_to_bf16(int lane, const float* xrow, bf16* orow, float* rs) {
    asm volatile("" : "+v"(lane));
    f32x4 v[4][4]; float s[4];
#pragma unroll
    for (int rr = 0; rr < 4; ++rr) { const GAS f32x4* xr = (const GAS f32x4*)(xrow + (size_t)rr * D) + lane;
#pragma unroll
        for (int jj = 0; jj < 4; ++jj) v[rr][jj] = __builtin_nontemporal_load(xr + 64 * jj); }
#pragma unroll
    for (int rr = 0; rr < 4; ++rr) { float a = 0.f;
#pragma unroll
        for (int jj = 0; jj < 4; ++jj) a += (v[rr][jj].x * v[rr][jj].x + v[rr][jj].y * v[rr][jj].y) + (v[rr][jj].z * v[rr][jj].z + v[rr][jj].w * v[rr][jj].w);
        s[rr] = a; }
#pragma unroll
    for (int rr = 0; rr < 4; ++rr) { GAS unsigned long long* o8 = (GAS unsigned long long*)(orow + (size_t)rr * D) + lane;
#pragma unroll
        for (int jj = 0; jj < 4; ++jj) o8[64 * jj] = (unsigned long long)pk2(v[rr][jj].x, v[rr][jj].y) | ((unsigned long long)pk2(v[rr][jj].z, v[rr][jj].w) << 32); }
#pragma unroll
    for (int o = 1; o < 64; o <<= 1) {
#pragma unroll
        for (int rr = 0; rr < 4; ++rr) s[rr] += __shfl_xor(s[rr], o); }
    if (lane < 4) { const float sv = (lane == 0) ? s[0] : (lane == 1) ? s[1] : (lane == 2) ? s[2] : s[3]; rs[lane] = 1.f / sqrtf(sv * (1.f / D) + EPS); }
}
template <bool PERM_IN>
__device__ __forceinline__ void p0_transpose_item(const float* W, int K, int N, bf16* WT, LAS float* scr, int item, int lane, const float* ks = nullptr  ) {
    const int nblk = N / 32, kb = item / nblk, nb = item % nblk, k0 = 64 * kb, n0 = 32 * nb;
    int nsl = n0 + (lane & 31);
    if (PERM_IN && n0 < 4096) { const int l = lane & 31, q = n0 & 255;
        nsl = (2 * (q >> 7) + ((l >> 2) & 1)) * 1024 + 64 * (n0 >> 8) + 16 * ((q >> 5) & 3) + 4 * (l >> 3) + (l & 3); }
    if (PERM_IN && n0 >= 4096) { const int l = lane & 31, q = n0 & 255;
        nsl = (n0 & ~255) + 64 * ((q >> 5) & 3) + 8 * (q >> 7) + 16 * (l >> 3) + (l & 7); }
    float tv[32];
#pragma unroll
    for (int i = 0; i < 32; ++i) tv[i] = __builtin_nontemporal_load(W + (size_t)(k0 + 2 * i + (lane >> 5)) * N + nsl);
    if (ks) {
#pragma unroll
        for (int i = 0; i < 32; ++i) tv[i] *= ks[k0 + 2 * i + (lane >> 5)]; }
#pragma unroll
    for (int i = 0; i < 32; ++i) scr[(2 * i + (lane >> 5)) * 33 + (lane & 31)] = tv[i];
    LDS_WAIT(); asm volatile("" ::: "memory");
    const int c = lane & 7;
#pragma unroll
    for (int j = 0; j < 4; ++j) { const int n = (lane >> 3) + 8 * j; const LAS float* s = scr + (8 * c) * 33 + n;
        v4u o; o.x = pk2(s[0 * 33], s[1 * 33]); o.y = pk2(s[2 * 33], s[3 * 33]); o.z = pk2(s[4 * 33], s[5 * 33]); o.w = pk2(s[6 * 33], s[7 * 33]);
        *(GAS v4u*)(WT + (size_t)(n0 + n) * K + k0 + 8 * c) = o; }
    LDS_WAIT(); asm volatile("" ::: "memory");
}
template <int NS>
__device__ __forceinline__ void fold_tile(LAS float* sm, const float* Ap, int sAi, int sAk, const float* As, const float* Bp, int sBj, bf16* Cp, int ldc, int tid) {
    LAS float* sA = sm; LAS float* sB = sm + 32 * 68;
    float ra[NS][4], rb[NS][4];
#pragma unroll
    for (int sl = 0; sl < NS; ++sl)
#pragma unroll
        for (int r = 0; r < 4; ++r) { const int e = tid + 512 * r; int i, kq;
            if (sAk == 1) { kq = e & 31; i = e >> 5; } else { i = e & 63; kq = e >> 6; }
            float a = Ap[(size_t)i * sAi + (size_t)(sl * 32 + kq) * sAk]; if (As) a *= As[sl * 32 + kq]; ra[sl][r] = a;
            rb[sl][r] = Bp[(size_t)(e >> 5) * sBj + sl * 32 + (e & 31)]; }
    float acc[2][4];
#pragma unroll
    for (int q = 0; q < 2; ++q)
#pragma unroll
        for (int p = 0; p < 4; ++p) acc[q][p] = 0.f;
    const int tj4 = (tid & 15) * 4, ti2 = (tid >> 4) * 2;
#pragma unroll
    for (int sl = 0; sl < NS; ++sl) {
#pragma unroll
        for (int r = 0; r < 4; ++r) { const int e = tid + 512 * r; int i, kq;
            if (sAk == 1) { kq = e & 31; i = e >> 5; } else { i = e & 63; kq = e >> 6; }
            sA[kq * 68 + i] = ra[sl][r]; sB[(e & 31) * 68 + (e >> 5)] = rb[sl][r]; }
        __syncthreads();
#pragma unroll 8
        for (int kk = 0; kk < 32; ++kk) { const f32x4 bq = *(const LAS f32x4*)(sB + kk * 68 + tj4); const float a0 = sA[kk * 68 + ti2], a1 = sA[kk * 68 + ti2 + 1];
            acc[0][0] += a0 * bq.x; acc[0][1] += a0 * bq.y; acc[0][2] += a0 * bq.z; acc[0][3] += a0 * bq.w;
            acc[1][0] += a1 * bq.x; acc[1][1] += a1 * bq.y; acc[1][2] += a1 * bq.z; acc[1][3] += a1 * bq.w; }
        __syncthreads();
    }
#pragma unroll
    for (int q = 0; q < 2; ++q) *(GAS unsigned long long*)(Cp + (size_t)(ti2 + q) * ldc + tj4) = (unsigned long long)pk2(acc[q][0], acc[q][1]) | ((unsigned long long)pk2(acc[q][2], acc[q][3]) << 32);
}
typedef float f32x2f __attribute__((ext_vector_type(2)));
template <int NS, int TJ, bool A_ICONTIG>
__device__ __forceinline__ void fold_wave(LAS float* sm, const float* Ap, int sA, const float* As, const float* Bp, int sBj, bf16* Cp, int ldc, int lane, const float* Cs = nullptr  ) {
    constexpr int NB = TJ / 8, RB = TJ / 8;
    LAS float* sAl = sm; LAS float* sBl = sm + 32 * 36;
    const int l8 = lane >> 3, l7 = lane & 7;
    f32x4 ra[4], rb[RB];
#define FW_LOAD(sl_) do { _Pragma("unroll") for (int r = 0; r < 4; ++r) { \
            if (A_ICONTIG) { const int kq = l8 + 8 * r; f32x4 a = *(const GAS f32x4*)(Ap + (size_t)((sl_) * 32 + kq) * sA + l7 * 4); const float sc = As[(sl_) * 32 + kq]; ra[r] = a * sc; } \
            else ra[r] = *(const GAS f32x4*)(Ap + (size_t)(l8 + 8 * r) * sA + (sl_) * 32 + l7 * 4); } \
        _Pragma("unroll") for (int r = 0; r < RB; ++r) rb[r] = *(const GAS f32x4*)(Bp + (size_t)(l8 + 8 * r) * sBj + (sl_) * 32 + l7 * 4); } while (0)
    FW_LOAD(0);
    f32x2f acc2[4][NB / 2];
#pragma unroll
    for (int p = 0; p < 4; ++p)
#pragma unroll
        for (int q = 0; q < NB / 2; ++q) acc2[p][q] = (f32x2f){0.f, 0.f};
#pragma unroll
    for (int sl = 0; sl < NS; ++sl) {
#pragma unroll
        for (int r = 0; r < 4; ++r) {
            if (A_ICONTIG) *(LAS f32x4*)(sAl + (l8 + 8 * r) * 36 + l7 * 4) = ra[r];
            else { const int i = l8 + 8 * r, kq = l7 * 4; sAl[kq * 36 + i] = ra[r].x; sAl[(kq + 1) * 36 + i] = ra[r].y; sAl[(kq + 2) * 36 + i] = ra[r].z; sAl[(kq + 3) * 36 + i] = ra[r].w; } }
#pragma unroll
        for (int r = 0; r < RB; ++r) { const int jj = l8 + 8 * r, kq = l7 * 4; sBl[kq * 36 + jj] = rb[r].x; sBl[(kq + 1) * 36 + jj] = rb[r].y; sBl[(kq + 2) * 36 + jj] = rb[r].z; sBl[(kq + 3) * 36 + jj] = rb[r].w; }
        LDS_WAIT(); asm volatile("" ::: "memory");
        if (sl + 1 < NS) FW_LOAD(sl + 1);
#pragma unroll 8
        for (int kk = 0; kk < 32; ++kk) { const f32x4 a4 = *(const LAS f32x4*)(sAl + kk * 36 + 4 * l8);
            f32x2f bq2[NB / 2];
            if (NB == 4) { const f32x4 b4 = *(const LAS f32x4*)(sBl + kk * 36 + 4 * l7); bq2[0] = (f32x2f){b4.x, b4.y}; bq2[NB / 2 - 1] = (f32x2f){b4.z, b4.w}; }
            else bq2[0] = *(const LAS f32x2f*)(sBl + kk * 36 + 2 * l7);
#pragma unroll
            for (int q = 0; q < NB / 2; ++q) {
                acc2[0][q] = __builtin_elementwise_fma((f32x2f){a4.x, a4.x}, bq2[q], acc2[0][q]); acc2[1][q] = __builtin_elementwise_fma((f32x2f){a4.y, a4.y}, bq2[q], acc2[1][q]);
                acc2[2][q] = __builtin_elementwise_fma((f32x2f){a4.z, a4.z}, bq2[q], acc2[2][q]); acc2[3][q] = __builtin_elementwise_fma((f32x2f){a4.w, a4.w}, bq2[q], acc2[3][q]); } }
        LDS_WAIT(); asm volatile("" ::: "memory");
    }
#undef FW_LOAD
    float acc[4][NB];
#pragma unroll
    for (int p = 0; p < 4; ++p)
#pragma unroll
        for (int q = 0; q < NB / 2; ++q) { acc[p][2 * q] = acc2[p][q].x; acc[p][2 * q + 1] = acc2[p][q].y; }
    if (Cs) {
#pragma unroll
        for (int q = 0; q < NB; ++q) { const float cs = Cs[NB * l7 + q];
#pragma unroll
            for (int p = 0; p < 4; ++p) acc[p][q] *= cs; } }
#pragma unroll
    for (int p = 0; p < 4; ++p) { bf16* cp = Cp + (size_t)(4 * l8 + p) * ldc + NB * l7;
        if (NB == 4) *(GAS unsigned long long*)cp = (unsigned long long)pk2(acc[p][0], acc[p][1]) | ((unsigned long long)pk2(acc[p][2], acc[p][NB - 1]) << 32);
        else *(GAS unsigned*)cp = pk2(acc[p][0], acc[p][NB - 1]); }
}
__device__ __forceinline__ void rms_row_to_bf16(int lane, const float* xrow, const float* g, bf16* orow) {
    const GAS f32x4* xr = (const GAS f32x4*)xrow + lane; const GAS f32x4* gr = (const GAS f32x4*)g + lane;
    f32x4 v[4]; float s = 0.f;
#pragma unroll
    for (int j = 0; j < 4; ++j) { v[j] = xr[64 * j]; s += (v[j].x * v[j].x + v[j].y * v[j].y) + (v[j].z * v[j].z + v[j].w * v[j].w); }
    const float rstd = 1.f / sqrtf(wave_sum(s) * (1.f / D) + EPS);
    GAS unsigned long long* o8 = (GAS unsigned long long*)orow + lane;
#pragma unroll
    for (int j = 0; j < 4; ++j) { const f32x4 gg = gr[64 * j];
        o8[64 * j] = (unsigned long long)pk2(v[j].x * rstd * gg.x, v[j].y * rstd * gg.y) | ((unsigned long long)pk2(v[j].z * rstd * gg.z, v[j].w * rstd * gg.w) << 32); }
}
__device__ __forceinline__ v4u ldv(const bf16* p) { return *(const GAS v4u*)p; }
template <int WIN> __device__ __forceinline__ void p2_pool(const bf16* pcol  , bf16* ocol  , int t0, bool first) {
    for (int hf = 0; hf < ((WIN - 1 > 8) ? 2 : 1); ++hf) {
        const int base = t0 + 8 * hf;
        v4u raw[WIN + 7];
#pragma unroll
        for (int q = 0; q < WIN + 7; ++q) { const int rel = 8 * hf + q - (WIN - 1);
            raw[q] = (rel >= 0 || !first) ? ldv(pcol + (size_t)(base + q - (WIN - 1)) * D) : (v4u){0u, 0u, 0u, 0u}; }
        float S[8];
#pragma unroll
        for (int e = 0; e < 8; ++e) S[e] = 0.f;
#pragma unroll
        for (int q = 0; q < WIN - 1; ++q) { float f[8]; unpack8(raw[q], f);
#pragma unroll
            for (int e = 0; e < 8; ++e) S[e] += f[e]; }
#pragma unroll
        for (int r = 0; r < 8; ++r) {
            float pn[8], o[8]; unpack8(raw[r + WIN - 1], pn);
#pragma unroll
            for (int e = 0; e < 8; ++e) S[e] += pn[e];
            const int sr = 8 * hf + r;
            const float inv = (first && sr < WIN - 1) ? 1.0f / (float)(sr + 1) : 1.0f / (float)WIN;
#pragma unroll
            for (int e = 0; e < 8; ++e) o[e] = S[e] * inv - pn[e];
            if (8 * hf + r < WIN - 1) *(GAS v4u*)(ocol + (size_t)(base + r) * D) = pack8(o);
            float po[8]; unpack8(raw[r], po);
#pragma unroll
            for (int e = 0; e < 8; ++e) S[e] -= po[e];
        }
        asm volatile("" ::: "memory");
    }
}
__device__ __forceinline__ void p2_conv_pool(Frame& F, const bf16* PB, const float* conv_w, bf16* AIN, bf16* POOLED, const bf16* RAWU, const bf16* RAWB) {
    const int gw = F.vcu * NWAVES + F.wave, NGW = F.G * NWAVES, lane = F.lane;
    for (int it = gw; it < 4 * (T / 32); it += NGW) {
        const int g = it & 3, rc = (it >> 2) * 2 + (lane >> 5), col = g * 256 + (lane & 31) * 8, t0 = rc * 16; const bool first = (t0 & (SEQ - 1)) == 0;
        if ((t0 & 63) == 0) {
            const int blk = t0 >> 6;
            float w0[8], w1[8], w2[8];
            { const f32x4 a = *(const GAS f32x4*)(conv_w + col), b = *(const GAS f32x4*)(conv_w + col + 4); w0[0] = a.x; w0[1] = a.y; w0[2] = a.z; w0[3] = a.w; w0[4] = b.x; w0[5] = b.y; w0[6] = b.z; w0[7] = b.w; }
            { const f32x4 a = *(const GAS f32x4*)(conv_w + D + col), b = *(const GAS f32x4*)(conv_w + D + col + 4); w1[0] = a.x; w1[1] = a.y; w1[2] = a.z; w1[3] = a.w; w1[4] = b.x; w1[5] = b.y; w1[6] = b.z; w1[7] = b.w; }
            { const f32x4 a = *(const GAS f32x4*)(conv_w + 2 * D + col), b = *(const GAS f32x4*)(conv_w + 2 * D + col + 4); w2[0] = a.x; w2[1] = a.y; w2[2] = a.z; w2[3] = a.w; w2[4] = b.x; w2[5] = b.y; w2[6] = b.z; w2[7] = b.w; }
            const v4u z4 = (v4u){0u, 0u, 0u, 0u};
            const v4u ru0 = ldv(RAWU + (size_t)(blk * 4 + 0) * D + col), ru1 = ldv(RAWU + (size_t)(blk * 4 + 1) * D + col), rb0 = ldv(RAWB + (size_t)(blk * 2 + 0) * D + col), rb1 = ldv(RAWB + (size_t)(blk * 2 + 1) * D + col);
            const v4u rp2 = first ? z4 : ldv(RAWU + (size_t)((blk - 1) * 4 + 2) * D + col), rp3 = first ? z4 : ldv(RAWU + (size_t)((blk - 1) * 4 + 3) * D + col);
            float u0[8], u1[8], p2[8], p3[8], b0[8], b1[8], o0[8], o1[8];
            unpack8(ru0, u0); unpack8(ru1, u1); unpack8(rp2, p2); unpack8(rp3, p3); unpack8(rb0, b0); unpack8(rb1, b1);
#pragma unroll
            for (int e = 0; e < 8; ++e) { o0[e] = b0[e] * (w0[e] * p2[e] + w1[e] * p3[e] + w2[e] * u0[e]); o1[e] = b1[e] * (w0[e] * p3[e] + w1[e] * u0[e] + w2[e] * u1[e]); }
            *(GAS v4u*)(AIN + (size_t)t0 * D + col) = pack8(o0); *(GAS v4u*)(AIN + (size_t)(t0 + 1) * D + col) = pack8(o1);
        }
        const bf16* pcol = PB + col; bf16* ocol = POOLED + col;
        if ((t0 & 63) == 0) { if (g == 0) p2_pool<2>(pcol, ocol, t0, first); else if (g == 1) p2_pool<4>(pcol, ocol, t0, first); else if (g == 2) p2_pool<8>(pcol, ocol, t0, first); else p2_pool<16>(pcol, ocol, t0, first); }
    }
}

typedef int v4i __attribute__((ext_vector_type(4)));
__device__ __forceinline__ unsigned fkey(float f) { const unsigned u = __float_as_uint(f); return (u & 0x80000000u) ? ~u : (u | 0x80000000u); }
__device__ __forceinline__ float fkey_inv(unsigned k) { return __uint_as_float((k & 0x80000000u) ? (k & 0x7fffffffu) : ~k); }
__device__ __forceinline__ void ce_desc(unsigned& a, unsigned& b) { const unsigned hi = a > b ? a : b, lo = a > b ? b : a; a = hi; b = lo; }
template <int K, int J> __device__ __forceinline__ void bitonic_stage(unsigned (&a)[16]) {
#pragma unroll
    for (int i = 0; i < 16; ++i) { const int l = i ^ J; if (l > i) { if ((i & K) == 0) ce_desc(a[i], a[l]); else ce_desc(a[l], a[i]); } }
}
__device__ __forceinline__ void bitonic_merge16(unsigned (&a)[16]) { bitonic_stage<16, 8>(a); bitonic_stage<16, 4>(a); bitonic_stage<16, 2>(a); bitonic_stage<16, 1>(a); }
__device__ __forceinline__ void bitonic_sort16(unsigned (&a)[16]) {
#define S16_CE(i, j) { const unsigned hi_ = a[i] > a[j] ? a[i] : a[j], lo_ = a[i] > a[j] ? a[j] : a[i]; a[i] = hi_; a[j] = lo_; }
    S16_CE(0, 13) S16_CE(1, 12) S16_CE(2, 15) S16_CE(3, 14) S16_CE(4, 8) S16_CE(5, 6) S16_CE(7, 11) S16_CE(9, 10)
    S16_CE(0, 5) S16_CE(1, 7) S16_CE(2, 9) S16_CE(3, 4) S16_CE(6, 13) S16_CE(8, 14) S16_CE(10, 15) S16_CE(11, 12)
    S16_CE(0, 1) S16_CE(2, 3) S16_CE(4, 5) S16_CE(6, 8) S16_CE(7, 9) S16_CE(10, 11) S16_CE(12, 13) S16_CE(14, 15)
    S16_CE(0, 2) S16_CE(1, 3) S16_CE(4, 10) S16_CE(5, 11) S16_CE(6, 7) S16_CE(8, 9) S16_CE(12, 14) S16_CE(13, 15)
    S16_CE(1, 2) S16_CE(3, 12) S16_CE(4, 6) S16_CE(5, 7) S16_CE(8, 10) S16_CE(9, 11) S16_CE(13, 14)
    S16_CE(1, 4) S16_CE(2, 6) S16_CE(5, 8) S16_CE(7, 10) S16_CE(9, 13) S16_CE(11, 14)
    S16_CE(2, 4) S16_CE(3, 6) S16_CE(9, 12) S16_CE(11, 13)
    S16_CE(3, 5) S16_CE(6, 8) S16_CE(7, 9) S16_CE(10, 12)
    S16_CE(3, 4) S16_CE(5, 6) S16_CE(7, 8) S16_CE(9, 10) S16_CE(11, 12)
    S16_CE(6, 7) S16_CE(8, 9)
#undef S16_CE
}
__device__ __forceinline__ void top16_merge(unsigned (&top)[16], unsigned (&ch)[16]) {
#pragma unroll
    for (int i = 0; i < 16; ++i) top[i] = top[i] > ch[15 - i] ? top[i] : ch[15 - i];
    bitonic_merge16(top);
}
__device__ __forceinline__ unsigned hkey(unsigned h) { return (h & 0x8000u) ? (~h & 0xffffu) : (h | 0x8000u); }
typedef short s16x2k __attribute__((ext_vector_type(2)));
__device__ __forceinline__ unsigned hkey2(unsigned w) { const s16x2k m = __builtin_bit_cast(s16x2k, w) >> (short)15; return w ^ (__builtin_bit_cast(unsigned, m) | 0x80008000u); }
__device__ __forceinline__ float hkey_inv(unsigned k16) { const unsigned h = (k16 & 0x8000u) ? (k16 & 0x7fffu) : (~k16 & 0xffffu); return (float)__builtin_bit_cast(_Float16, (unsigned short)h); }
__device__ __forceinline__ unsigned pkh2(float a, float b) { return __builtin_bit_cast(unsigned, __builtin_amdgcn_cvt_pkrtz(a, b)); }
__device__ __forceinline__ void p7_topk(Frame& F, const unsigned short* SC, const float* SSQ, int* IDX, float* GATE, int b_lo, int b_hi, int b_step, bool handoff) {
    constexpr int RS = 36;
    LAS unsigned* stg = (LAS unsigned*)(F.lds + RING_OFF + F.wave * P7_WAVE_BYTES + P7_STAGE_OFF);
    const int lane = F.lane, r8 = lane >> 3, c = lane & 7;
    for (int batch = b_lo; batch < b_hi; batch += b_step) {
        const unsigned short* base = SC + (size_t)batch * (8 * NSC);
        unsigned top[16], top1[16];
#pragma unroll
        for (int i = 0; i < 16; ++i) { top[i] = 0u; top1[i] = 0u; }
        v4u ld[8];
#pragma unroll
        for (int q = 0; q < 8; ++q) ld[q] = __builtin_nontemporal_load((const GAS v4u*)(base + (size_t)(8 * q + r8) * 256 + c * 8));
        for (int ch = 0; ch < 4; ++ch) {
#pragma unroll
            for (int q = 0; q < 8; ++q) *(LAS v4u*)(stg + (8 * q + r8) * RS + c * 4) = ld[q];
            if (ch < 3) {
#pragma unroll
                for (int q = 0; q < 8; ++q) ld[q] = __builtin_nontemporal_load((const GAS v4u*)(base + (size_t)(8 * q + r8) * 256 + (ch + 1) * 64 + c * 8));
            }
            LDS_WAIT(); asm volatile("" ::: "memory");
#pragma unroll
            for (int hf = 0; hf < 4; ++hf) {
                unsigned k[16];
                const unsigned pb = 127u - (unsigned)((ch & 1) * 64 + hf * 16);
#pragma unroll
                for (int q = 0; q < 2; ++q) { const v4u v = *(const LAS v4u*)(stg + lane * RS + hf * 8 + q * 4);
                    const unsigned w0 = hkey2(v.x), w1 = hkey2(v.y), w2 = hkey2(v.z), w3 = hkey2(v.w);
                    k[8 * q] = (w0 << 16) | (pb - (unsigned)(8 * q)); k[8 * q + 1] = (w0 & 0xffff0000u) | (pb - (unsigned)(8 * q + 1));
                    k[8 * q + 2] = (w1 << 16) | (pb - (unsigned)(8 * q + 2)); k[8 * q + 3] = (w1 & 0xffff0000u) | (pb - (unsigned)(8 * q + 3));
                    k[8 * q + 4] = (w2 << 16) | (pb - (unsigned)(8 * q + 4)); k[8 * q + 5] = (w2 & 0xffff0000u) | (pb - (unsigned)(8 * q + 5));
                    k[8 * q + 6] = (w3 << 16) | (pb - (unsigned)(8 * q + 6)); k[8 * q + 7] = (w3 & 0xffff0000u) | (pb - (unsigned)(8 * q + 7)); }
                bitonic_sort16(k);
                top16_merge(top, k);
            }
            LDS_WAIT(); asm volatile("" ::: "memory");
            if (ch == 1) {
#pragma unroll
                for (int i = 0; i < 16; ++i) { top1[i] = top[i]; top[i] = 0u; }
            }
        }
        LAS int* tab = (LAS int*)stg + lane * 33;
        float v1[16], v2[16];
#pragma unroll
        for (int i = 0; i < 16; ++i) { tab[i] = 127 - (int)(top1[i] & 0x7fu); tab[16 + i] = 127 - (int)(top[i] & 0x7fu); v1[i] = hkey_inv(top1[i] >> 16); v2[i] = hkey_inv(top[i] >> 16); }
#define P7_KEY(i, j) ((fkey(v1[i] + v2[j]) & ~0xffu) | (unsigned)((i) * 16 + (j)))
        unsigned best[16], cb[16];
#pragma unroll
        for (int jj = 0; jj < 16; ++jj) best[jj] = P7_KEY(0, jj);
#pragma unroll
        for (int jj = 0; jj < 8; ++jj) { cb[jj] = P7_KEY(1, jj); cb[8 + jj] = 0u; }
        top16_merge(best, cb);
        cb[0] = P7_KEY(2, 0); cb[1] = P7_KEY(2, 1); cb[2] = P7_KEY(2, 2); cb[3] = P7_KEY(2, 3); cb[4] = P7_KEY(2, 4); cb[5] = P7_KEY(3, 0); cb[6] = P7_KEY(3, 1); cb[7] = P7_KEY(3, 2);
        cb[8] = P7_KEY(3, 3); cb[9] = P7_KEY(4, 0); cb[10] = P7_KEY(4, 1); cb[11] = P7_KEY(4, 2); cb[12] = 0u; cb[13] = 0u; cb[14] = 0u; cb[15] = 0u;
        bitonic_sort16(cb); top16_merge(best, cb);
        cb[0] = P7_KEY(5, 0); cb[1] = P7_KEY(5, 1); cb[2] = P7_KEY(6, 0); cb[3] = P7_KEY(6, 1); cb[4] = P7_KEY(7, 0); cb[5] = P7_KEY(7, 1); cb[6] = P7_KEY(8, 0); cb[7] = P7_KEY(9, 0);
        cb[8] = P7_KEY(10, 0); cb[9] = P7_KEY(11, 0); cb[10] = P7_KEY(12, 0); cb[11] = P7_KEY(13, 0); cb[12] = P7_KEY(14, 0); cb[13] = P7_KEY(15, 0); cb[14] = 0u; cb[15] = 0u;
        bitonic_sort16(cb); top16_merge(best, cb);
#undef P7_KEY
        LDS_WAIT(); asm volatile("" ::: "memory");
        int eo[16]; float go[16]; float sm = 0.f;
        const float bmax = fkey_inv(best[0] & ~0xffu);
        const f32x4 ssq = *(const GAS f32x4*)(SSQ + (size_t)(batch * 8 + (lane >> 3)) * 4);
        const float rstd = 1.0f / sqrtf(((ssq.x + ssq.y) + (ssq.z + ssq.w)) * (1.0f / D) + EPS);
#pragma unroll
        for (int r = 0; r < 16; ++r) { const int ij = (int)(best[r] & 0xffu); eo[r] = tab[ij >> 4] * 128 + tab[16 + (ij & 15)]; go[r] = __expf((fkey_inv(best[r] & ~0xffu) - bmax) * rstd); sm += go[r]; }
        const float inv = 1.0f / sm;
        if (handoff) {
            LAS unsigned char* reg = F.lds + RING_OFF + (batch - 8 * F.vcu) * P7_WAVE_BYTES;
            LAS int* li = (LAS int*)(reg + P7_IDX_OFF) + lane * 16; LAS unsigned* lg = (LAS unsigned*)(reg + P7_OUT_OFF) + lane * 8;
#pragma unroll
            for (int q = 0; q < 4; ++q) *(LAS v4i*)(li + 4 * q) = (v4i){eo[4 * q], eo[4 * q + 1], eo[4 * q + 2], eo[4 * q + 3]};
#pragma unroll
            for (int q = 0; q < 2; ++q) *(LAS v4u*)(lg + 4 * q) = (v4u){pkh2(go[8 * q] * inv, go[8 * q + 1] * inv), pkh2(go[8 * q + 2] * inv, go[8 * q + 3] * inv), pkh2(go[8 * q + 4] * inv, go[8 * q + 5] * inv), pkh2(go[8 * q + 6] * inv, go[8 * q + 7] * inv)};
        } else {
        int* ip = IDX + (size_t)batch * 1024 + lane * 16; float* gp = GATE + (size_t)batch * 1024 + lane * 16;
#pragma unroll
        for (int q = 0; q < 4; ++q) { *(GAS v4i*)(ip + 4 * q) = (v4i){eo[4 * q], eo[4 * q + 1], eo[4 * q + 2], eo[4 * q + 3]};
            *(GAS f32x4*)(gp + 4 * q) = (f32x4){go[4 * q] * inv, go[4 * q + 1] * inv, go[4 * q + 2] * inv, go[4 * q + 3] * inv}; }
        }
        LDS_WAIT(); asm volatile("" ::: "memory");
    }
}
typedef __bf16 bf16x2_t __attribute__((ext_vector_type(2)));
__device__ __forceinline__ float dpp_f(float v, const int ctrl_sel) {
    const int x = __builtin_bit_cast(int, v);
    int r;
    if (ctrl_sel == 0) r = __builtin_amdgcn_update_dpp(0, x, 0xB1, 0xF, 0xF, true);
    else if (ctrl_sel == 1) r = __builtin_amdgcn_update_dpp(0, x, 0x4E, 0xF, 0xF, true);
    else if (ctrl_sel == 2) r = __builtin_amdgcn_update_dpp(0, x, 0x141, 0xF, 0xF, true);
    else r = __builtin_amdgcn_update_dpp(0, x, 0x128, 0xF, 0xF, true);
    return __builtin_bit_cast(float, r);
}
__device__ __forceinline__ float sum8(float v) { v += dpp_f(v, 0); v += dpp_f(v, 1); v += dpp_f(v, 2); return v; }
__device__ __forceinline__ float dot2bf(unsigned a, unsigned b, float acc) { return __builtin_amdgcn_fdot2_f32_bf16(__builtin_bit_cast(bf16x2_t, a), __builtin_bit_cast(bf16x2_t, b), acc, false); }
__device__ __forceinline__ float dot8(const v4u d, const v4u x, float acc) {
    acc = dot2bf(d.x, x.x, acc); acc = dot2bf(d.y, x.y, acc); acc = dot2bf(d.z, x.z, acc); acc = dot2bf(d.w, x.w, acc);
    return acc;
}
__device__ __forceinline__ float gelu_erf(float v) {
    const float t = __builtin_amdgcn_rcpf(fabsf(v) * 0.2316418882f + 1.0f);
    float q = t * 0.5307027145f + (-0.7265760135f); q = q * t + 0.7107068705f; q = q * t + (-0.142248368f); q = q * t + 0.127414796f; q = q * t;
    const float m = v * (q * __builtin_amdgcn_exp2f((v * v) * (-0.72134752044f)));
    return v < 0.f ? m : v - m;
}
__device__ __forceinline__ void p8_issue(v4u (&d)[8], const LAS int* li8, __amdgpu_buffer_rsrc_t rs, int soff, int c16) {
    const v4i e0 = *(const LAS v4i*)li8, e1 = *(const LAS v4i*)(li8 + 4);
    d[0] = __builtin_amdgcn_raw_buffer_load_b128(rs, e0.x * 128 + c16, soff, 0); d[1] = __builtin_amdgcn_raw_buffer_load_b128(rs, e0.y * 128 + c16, soff, 0);
    d[2] = __builtin_amdgcn_raw_buffer_load_b128(rs, e0.z * 128 + c16, soff, 0); d[3] = __builtin_amdgcn_raw_buffer_load_b128(rs, e0.w * 128 + c16, soff, 0);
    d[4] = __builtin_amdgcn_raw_buffer_load_b128(rs, e1.x * 128 + c16, soff, 0); d[5] = __builtin_amdgcn_raw_buffer_load_b128(rs, e1.y * 128 + c16, soff, 0);
    d[6] = __builtin_amdgcn_raw_buffer_load_b128(rs, e1.z * 128 + c16, soff, 0); d[7] = __builtin_amdgcn_raw_buffer_load_b128(rs, e1.w * 128 + c16, soff, 0);
}
typedef float f32x2 __attribute__((ext_vector_type(2)));
__device__ __forceinline__ f32x2 fp8lo(unsigned w) { return __builtin_amdgcn_cvt_pk_f32_fp8((int)w, false); }
__device__ __forceinline__ f32x2 fp8hi(unsigned w) { return __builtin_amdgcn_cvt_pk_f32_fp8((int)w, true); }
__device__ __forceinline__ float dot16q(const v4u d, const f32x2 (&xx)[8]) {
    f32x2 acc = fp8lo(d.x) * xx[0];
    acc += fp8hi(d.x) * xx[1]; acc += fp8lo(d.y) * xx[2]; acc += fp8hi(d.y) * xx[3]; acc += fp8lo(d.z) * xx[4]; acc += fp8hi(d.z) * xx[5]; acc += fp8lo(d.w) * xx[6]; acc += fp8hi(d.w) * xx[7];
    return acc.x + acc.y;
}
__device__ __forceinline__ void p8_compute_u(const v4u (&d)[8], const f32x2 (&xx)[8], LAS float* lz8, int c) {
    float p[8];
#pragma unroll
    for (int g = 0; g < 8; ++g) p[g] = sum8(dot16q(d[g], xx));
    if (c == 0) {
#pragma unroll
        for (int q = 0; q < 2; ++q) { f32x4 z = *(LAS f32x4*)(lz8 + 4 * q); z.x += p[4 * q]; z.y += p[4 * q + 1]; z.z += p[4 * q + 2]; z.w += p[4 * q + 3]; *(LAS f32x4*)(lz8 + 4 * q) = z; }
    }
}
__device__ __forceinline__ void p8_compute_v(const v4u (&d)[8], const LAS float* la8, f32x2 (&y)[8]) {
    const f32x4 a0 = *(const LAS f32x4*)la8, a1 = *(const LAS f32x4*)(la8 + 4);
    const float a[8] = {a0.x, a0.y, a0.z, a0.w, a1.x, a1.y, a1.z, a1.w};
#pragma unroll
    for (int g = 0; g < 8; ++g) { const f32x2 ag = {a[g], a[g]};
        y[0] += ag * fp8lo(d[g].x); y[1] += ag * fp8hi(d[g].x); y[2] += ag * fp8lo(d[g].y); y[3] += ag * fp8hi(d[g].y);
        y[4] += ag * fp8lo(d[g].z); y[5] += ag * fp8hi(d[g].z); y[6] += ag * fp8lo(d[g].w); y[7] += ag * fp8hi(d[g].w); }
}
__device__ __forceinline__ void p8_unpack_x(f32x2 (&xx)[8], const v4u a, const v4u b) {
    xx[0] = (f32x2){bflo(a.x), bfhi(a.x)}; xx[1] = (f32x2){bflo(a.y), bfhi(a.y)}; xx[2] = (f32x2){bflo(a.z), bfhi(a.z)}; xx[3] = (f32x2){bflo(a.w), bfhi(a.w)};
    xx[4] = (f32x2){bflo(b.x), bfhi(b.x)}; xx[5] = (f32x2){bflo(b.y), bfhi(b.y)}; xx[6] = (f32x2){bflo(b.z), bfhi(b.z)}; xx[7] = (f32x2){bflo(b.w), bfhi(b.w)};
}
typedef unsigned u32x2s __attribute__((ext_vector_type(2)));
__device__ __forceinline__ float u2f(unsigned u) { return __builtin_bit_cast(float, u); }
__device__ __forceinline__ float swap32_add(float a, float b) { const u32x2s r = __builtin_amdgcn_permlane32_swap(__builtin_bit_cast(unsigned, a), __builtin_bit_cast(unsigned, b), false, false); return u2f(r.x) + u2f(r.y); }
__device__ __forceinline__ float swap16_add(float a, float b) { const u32x2s r = __builtin_amdgcn_permlane16_swap(__builtin_bit_cast(unsigned, a), __builtin_bit_cast(unsigned, b), false, false); return u2f(r.x) + u2f(r.y); }
__device__ __forceinline__ void p8_reduce_heads(const f32x2 (&y)[8], int j, float& r0, float& r1) {
    float v[8], w[4];
#pragma unroll
    for (int q = 0; q < 4; ++q) { v[2 * q] = swap32_add(y[q].x, y[4 + q].x); v[2 * q + 1] = swap32_add(y[q].y, y[4 + q].y); }
#pragma unroll
    for (int q = 0; q < 4; ++q) w[q] = swap16_add(v[q], v[4 + q]);
    const bool odd = (j & 1) != 0;
    const float s0 = odd ? w[0] : w[2], s1 = odd ? w[1] : w[3], k0 = odd ? w[2] : w[0], k1 = odd ? w[3] : w[1];
    r0 = k0 + dpp_f(s0, 3); r1 = k1 + dpp_f(s1, 3);
}
typedef _Float16 h16x2 __attribute__((ext_vector_type(2)));
__device__ __forceinline__ h16x2 q2h_lo(unsigned w) { return __builtin_amdgcn_cvt_scalef32_pk_f16_fp8(w, 1.0f, false); }
__device__ __forceinline__ h16x2 q2h_hi(unsigned w) { return __builtin_amdgcn_cvt_scalef32_pk_f16_fp8(w, 1.0f, true); }
__device__ __forceinline__ h16x2 f2h(float a, float b) { h16x2 r; r.x = (_Float16)a; r.y = (_Float16)b; return r; }
__device__ __forceinline__ float dot16h(const v4u d, const h16x2 (&xh)[8]) {
    float acc = 0.f;
    acc = __builtin_amdgcn_fdot2(q2h_lo(d.x), xh[0], acc, false); acc = __builtin_amdgcn_fdot2(q2h_hi(d.x), xh[1], acc, false);
    acc = __builtin_amdgcn_fdot2(q2h_lo(d.y), xh[2], acc, false); acc = __builtin_amdgcn_fdot2(q2h_hi(d.y), xh[3], acc, false);
    acc = __builtin_amdgcn_fdot2(q2h_lo(d.z), xh[4], acc, false); acc = __builtin_amdgcn_fdot2(q2h_hi(d.z), xh[5], acc, false);
    acc = __builtin_amdgcn_fdot2(q2h_lo(d.w), xh[6], acc, false); acc = __builtin_amdgcn_fdot2(q2h_hi(d.w), xh[7], acc, false);
    return acc;
}
__device__ __forceinline__ void p8h_compute_u(const v4u (&d)[8], const h16x2 (&xh)[8], LAS float* lz8, int c) {
    float p[8];
#pragma unroll
    for (int g = 0; g < 8; ++g) p[g] = sum8(dot16h(d[g], xh));
    if (c == 0) {
#pragma unroll
        for (int q = 0; q < 2; ++q) { f32x4 z = *(LAS f32x4*)(lz8 + 4 * q); z.x += p[4 * q]; z.y += p[4 * q + 1]; z.z += p[4 * q + 2]; z.w += p[4 * q + 3]; *(LAS f32x4*)(lz8 + 4 * q) = z; }
    }
}
__device__ __forceinline__ void p8h_unpack_x(h16x2 (&xh)[8], const v4u a, const v4u b) {
    xh[0] = f2h(bflo(a.x), bfhi(a.x)); xh[1] = f2h(bflo(a.y), bfhi(a.y)); xh[2] = f2h(bflo(a.z), bfhi(a.z)); xh[3] = f2h(bflo(a.w), bfhi(a.w));
    xh[4] = f2h(bflo(b.x), bfhi(b.x)); xh[5] = f2h(bflo(b.y), bfhi(b.y)); xh[6] = f2h(bflo(b.z), bfhi(b.z)); xh[7] = f2h(bflo(b.w), bfhi(b.w));
}
__device__ __forceinline__ void p8h_compute_v(const v4u (&d)[8], const LAS float* la8, h16x2 (&y)[8]) {
    const f32x4 a0 = *(const LAS f32x4*)la8, a1 = *(const LAS f32x4*)(la8 + 4);
    const float a[8] = {a0.x, a0.y, a0.z, a0.w, a1.x, a1.y, a1.z, a1.w};
#pragma unroll
    for (int g = 0; g < 8; ++g) { const _Float16 ah = (_Float16)a[g]; const h16x2 ag = {ah, ah};
        y[0] += ag * q2h_lo(d[g].x); y[1] += ag * q2h_hi(d[g].x); y[2] += ag * q2h_lo(d[g].y); y[3] += ag * q2h_hi(d[g].y);
        y[4] += ag * q2h_lo(d[g].z); y[5] += ag * q2h_hi(d[g].z); y[6] += ag * q2h_lo(d[g].w); y[7] += ag * q2h_hi(d[g].w); }
}
__device__ __forceinline__ long pk64(unsigned lo, unsigned hi) { return (long)(((unsigned long long)hi << 32) | lo); }
__device__ __forceinline__ void p8m_issue(v4u (&d)[8], const LAS int* lig, __amdgpu_buffer_rsrc_t rs, int soff, int q16) {
    const int e0 = lig[0], e1 = lig[16], e2 = lig[32], e3 = lig[48];
    d[0] = __builtin_amdgcn_raw_buffer_load_b128(rs, e0 * D + q16, soff, 0); d[1] = __builtin_amdgcn_raw_buffer_load_b128(rs, e0 * D + q16 + 64, soff, 0);
    d[2] = __builtin_amdgcn_raw_buffer_load_b128(rs, e1 * D + q16, soff, 0); d[3] = __builtin_amdgcn_raw_buffer_load_b128(rs, e1 * D + q16 + 64, soff, 0);
    d[4] = __builtin_amdgcn_raw_buffer_load_b128(rs, e2 * D + q16, soff, 0); d[5] = __builtin_amdgcn_raw_buffer_load_b128(rs, e2 * D + q16 + 64, soff, 0);
    d[6] = __builtin_amdgcn_raw_buffer_load_b128(rs, e3 * D + q16, soff, 0); d[7] = __builtin_amdgcn_raw_buffer_load_b128(rs, e3 * D + q16 + 64, soff, 0);
}
__device__ __forceinline__ float p8m_dot(const v4u xa, const v4u xb, const v4u d0, const v4u d1) {
    f32x4 acc = {0.f, 0.f, 0.f, 0.f};
    acc = __builtin_amdgcn_mfma_f32_16x16x32_fp8_fp8(pk64(xa.x, xa.y), pk64(d0.x, d0.y), acc, 0, 0, 0);
    acc = __builtin_amdgcn_mfma_f32_16x16x32_fp8_fp8(pk64(xa.z, xa.w), pk64(d0.z, d0.w), acc, 0, 0, 0);
    acc = __builtin_amdgcn_mfma_f32_16x16x32_fp8_fp8(pk64(xb.x, xb.y), pk64(d1.x, d1.y), acc, 0, 0, 0);
    acc = __builtin_amdgcn_mfma_f32_16x16x32_fp8_fp8(pk64(xb.z, xb.w), pk64(d1.z, d1.w), acc, 0, 0, 0);
    return acc[0];
}
__device__ __forceinline__ void p8m_compute_u(const v4u (&d)[8], const v4u xa, const v4u xb, LAS float* lzq, int q) {
    const float z0 = p8m_dot(xa, xb, d[0], d[1]), z1 = p8m_dot(xa, xb, d[2], d[3]), z2 = p8m_dot(xa, xb, d[4], d[5]), z3 = p8m_dot(xa, xb, d[6], d[7]);
    const float z = (q == 0) ? z0 : (q == 1) ? z1 : (q == 2) ? z2 : z3;
    *lzq += z;
}
__device__ __forceinline__ void p8s_compute_u(const v4u (&d)[8], const v4u xa, const v4u xb, LAS unsigned char* stage, LAS float* lz  , int lane, const float sxq  ) {
    const int j8 = lane >> 3, c = lane & 7, n = lane & 15, q = lane >> 4;
#pragma unroll
    for (int r = 0; r < 8; ++r) { const int row = j8 * 8 + r; *(LAS v4u*)(stage + row * 128 + ((c ^ (row >> 1)) & 7) * 16) = d[r]; }
    LDS_WAIT(); asm volatile("" ::: "memory");
    float z[4];
#pragma unroll
    for (int t = 0; t < 4; ++t) { const int row = 16 * t + n, sw = (row >> 1) & 7;
        const v4u d0 = *(const LAS v4u*)(stage + row * 128 + ((q ^ sw) & 7) * 16), d1 = *(const LAS v4u*)(stage + row * 128 + (((q + 4) ^ sw) & 7) * 16);
        z[t] = p8m_dot(xa, xb, d0, d1); }
    asm volatile("" ::: "memory");
    const float zq = (q == 0) ? z[0] : (q == 1) ? z[1] : (q == 2) ? z[2] : z[3];
    LAS float* p = lz + (2 * q + (n >> 3)) * 16 + (n & 7);
    *p += zq * sxq;
}
__device__ __forceinline__ void p8_peer(Frame& F, const unsigned char* X8, const float* SSQ, const float* SXQ, const unsigned char* U8, const unsigned char* V8, const float* SU, const float* SV, const int* IDX, const float* GATE, const bf16* H16, float* YOUT, bf16* OUT, const float* gfin, bool handoff) {
    LAS unsigned char* lstage = F.lds + RING_OFF + F.wave * P7_WAVE_BYTES + P7_STAGE_OFF;
    LAS int* lidx = (LAS int*)(F.lds + RING_OFF + F.wave * P7_WAVE_BYTES + P7_IDX_OFF);
    LAS float* lza = (LAS float*)(F.lds + RING_OFF + F.wave * P7_WAVE_BYTES + P7_ZA_OFF);
    LAS unsigned* lout = (LAS unsigned*)(F.lds + RING_OFF + F.wave * P7_WAVE_BYTES + P7_OUT_OFF);
    const int gw = F.vcu * NWAVES + F.wave, NGW = F.G * NWAVES, lane = F.lane, j = lane >> 3, c = lane & 7, c16 = c * 16;
    const __amdgpu_buffer_rsrc_t rsU = __builtin_amdgcn_make_buffer_rsrc((void*)U8, (short)0, NEXP * D, 0x00020000);
    const __amdgpu_buffer_rsrc_t rsV = __builtin_amdgcn_make_buffer_rsrc((void*)V8, (short)0, NEXP * D, 0x00020000);
    const int pfrank = ((int)blockIdx.x >> 3) * NWAVES + F.wave; const int pfoff = (pfrank < 256) ? pfrank * 8192 + lane * 128 : 0; unsigned pf = 0u;
    for (int grp = gw; grp < T / 8; grp += NGW) {
        const int tb = grp * 8;
        for (int prep = 0; prep < REPS(13); ++prep) {
        LAS float* lsx = (LAS float*)(F.lds + P7_AUX_OFF + F.wave * 256); LAS float* lrs = lsx + 32;
        const float sxv = SXQ[(size_t)tb * 4 + (lane & 31)];
        const f32x4 q4 = *(const GAS f32x4*)(SSQ + (size_t)(tb + (lane & 7)) * 4);
        pf = __builtin_amdgcn_raw_buffer_load_b32(rsU, pfoff, 0, 0);
        if (lane < 32) lsx[lane] = sxv;
        if (lane < 8) lrs[lane] = 1.0f / sqrtf(((q4.x + q4.y) + (q4.z + q4.w)) * (1.0f / D) + EPS);
        LAS _Float16* lgate = (LAS _Float16*)lout;
        if (!handoff) {
#pragma unroll
            for (int i = 0; i < 8; ++i) { lidx[i * 128 + lane] = IDX[(size_t)(tb + i) * NSEL + lane]; lidx[i * 128 + 64 + lane] = IDX[(size_t)(tb + i) * NSEL + 64 + lane];
                lgate[i * 128 + lane] = (_Float16)GATE[(size_t)(tb + i) * NSEL + lane]; lgate[i * 128 + 64 + lane] = (_Float16)GATE[(size_t)(tb + i) * NSEL + 64 + lane]; }
        }
#pragma unroll
        for (int i = 0; i < 8; ++i) { lza[i * 128 + lane] = 0.f; lza[i * 128 + 64 + lane] = 0.f; }
        LDS_WAIT(); asm volatile("" ::: "memory");
        for (int urep = 0; urep < REPS(8); ++urep) {
            if (urep) {
#pragma unroll
                for (int i = 0; i < 8; ++i) { lza[i * 128 + lane] = 0.f; lza[i * 128 + 64 + lane] = 0.f; }
                LDS_WAIT(); asm volatile("" ::: "memory"); }
            v4u b0[8], b1[8], b2[8], b3[8], xa0, xb0, xa1, xb1, xa2, xb2, xa3, xb3;
            const unsigned char* xbase = X8 + (size_t)tb * D + (lane >> 4) * 16;
            xa0 = __builtin_nontemporal_load((const GAS v4u*)xbase); xb0 = __builtin_nontemporal_load((const GAS v4u*)(xbase + 64)); xa1 = __builtin_nontemporal_load((const GAS v4u*)(xbase + D)); xb1 = __builtin_nontemporal_load((const GAS v4u*)(xbase + D + 64));
            p8_issue(b0, lidx + j * 16, rsU, 0, c16); p8_issue(b1, lidx + j * 16 + 8, rsU, 0, c16); p8_issue(b2, lidx + 128 + j * 16, rsU, 0, c16); p8_issue(b3, lidx + 128 + j * 16 + 8, rsU, 0, c16);
            for (int n = 0; n < 62; n += 2) {
                const int i = n & 7, n2 = n + 2, s2 = n2 >> 3, i2 = n2 & 7;
                { const unsigned char* xp = xbase + (size_t)i2 * D + s2 * 128; xa2 = __builtin_nontemporal_load((const GAS v4u*)xp); xb2 = __builtin_nontemporal_load((const GAS v4u*)(xp + 64)); xa3 = __builtin_nontemporal_load((const GAS v4u*)(xp + D)); xb3 = __builtin_nontemporal_load((const GAS v4u*)(xp + D + 64)); }
                if ((n & 7) == 6) {
                    asm volatile("" :: "v"(pf));
                    pf = __builtin_amdgcn_raw_buffer_load_b32(rsU, pfoff, s2 * (NEXP * 128), 0); }
                const float sxa = lsx[i * 4 + (n >> 4)], sxb = lsx[(i + 1) * 4 + (n >> 4)];
                p8s_compute_u(b0, xa0, xb0, lstage, lza + i * 128, lane, sxa);           p8_issue(b0, lidx + i2 * 128 + j * 16, rsU, s2 * (NEXP * 128), c16);
                p8s_compute_u(b1, xa0, xb0, lstage, lza + i * 128 + 8, lane, sxa);       p8_issue(b1, lidx + i2 * 128 + j * 16 + 8, rsU, s2 * (NEXP * 128), c16);
                p8s_compute_u(b2, xa1, xb1, lstage, lza + (i + 1) * 128, lane, sxb);     p8_issue(b2, lidx + (i2 + 1) * 128 + j * 16, rsU, s2 * (NEXP * 128), c16);
                p8s_compute_u(b3, xa1, xb1, lstage, lza + (i + 1) * 128 + 8, lane, sxb); p8_issue(b3, lidx + (i2 + 1) * 128 + j * 16 + 8, rsU, s2 * (NEXP * 128), c16);
                xa0 = xa2; xb0 = xb2; xa1 = xa3; xb1 = xb3;
            }
            {
                asm volatile("" :: "v"(pf));
                pf = __builtin_amdgcn_raw_buffer_load_b32(rsV, pfoff, 0, 0);
                const float sxa = lsx[6 * 4 + 3], sxb = lsx[7 * 4 + 3];
                p8s_compute_u(b0, xa0, xb0, lstage, lza + 6 * 128, lane, sxa);
                p8s_compute_u(b1, xa0, xb0, lstage, lza + 6 * 128 + 8, lane, sxa);
                p8s_compute_u(b2, xa1, xb1, lstage, lza + 7 * 128, lane, sxb);
                p8s_compute_u(b3, xa1, xb1, lstage, lza + 7 * 128 + 8, lane, sxb);
            }
        }
        LDS_WAIT(); asm volatile("" ::: "memory");
#pragma unroll
        for (int i = 0; i < 8; ++i) {
            const int e0 = lidx[i * 128 + lane], e1 = lidx[i * 128 + 64 + lane];
            const float sx = lrs[i];
            const f32x2 s0 = *(const GAS f32x2*)(SU + 2 * e0), s1 = *(const GAS f32x2*)(SU + 2 * e1);
            const float z0 = lza[i * 128 + lane] * s0.x * sx, z1 = lza[i * 128 + 64 + lane] * s1.x * sx;
            const float g0 = (float)lgate[i * 128 + lane] * s0.y, g1 = (float)lgate[i * 128 + 64 + lane] * s1.y;
            lza[i * 128 + lane] = gelu_erf(z0) * g0 * 1024.0f; lza[i * 128 + 64 + lane] = gelu_erf(z1) * g1 * 1024.0f;
        }
        LDS_WAIT(); asm volatile("" ::: "memory");
        for (int vrep = 0; vrep < REPS(9); ++vrep) {
            v4u b0[8], b1[8], b2[8], b3[8];
            const __amdgpu_buffer_rsrc_t rout = pg8::wt_rsrc(OUT);
            LAS unsigned* lkeep = (LAS unsigned*)lstage;
            p8_issue(b0, lidx + j * 16, rsV, 0, c16); p8_issue(b1, lidx + j * 16 + 8, rsV, 0, c16); p8_issue(b2, lidx + 128 + j * 16, rsV, 0, c16); p8_issue(b3, lidx + 128 + j * 16 + 8, rsV, 0, c16);
            for (int n = 0; n < 62; n += 2) {
                const int s = n >> 3, i = n & 7, n2 = n + 2, s2 = n2 >> 3, i2 = n2 & 7;
                if ((n & 7) == 6) { asm volatile("" :: "v"(pf)); pf = __builtin_amdgcn_raw_buffer_load_b32(rsV, pfoff, s2 * (NEXP * 128), 0); }
                LAS unsigned* lo = ((s < 4) ? lkeep + s * 512 : lout) + c * 8 + j;
                h16x2 yh[8]; f32x2 y[8]; float r0, r1;
#pragma unroll
                for (int q = 0; q < 8; ++q) yh[q] = (h16x2){(_Float16)0.f, (_Float16)0.f};
                p8h_compute_v(b0, lza + i * 128 + j * 16, yh);           p8_issue(b0, lidx + i2 * 128 + j * 16, rsV, s2 * (NEXP * 128), c16);
                p8h_compute_v(b1, lza + i * 128 + j * 16 + 8, yh);       p8_issue(b1, lidx + i2 * 128 + j * 16 + 8, rsV, s2 * (NEXP * 128), c16);
#pragma unroll
                for (int q = 0; q < 8; ++q) y[q] = (f32x2){(float)yh[q].x * (1.0f / 1024.0f), (float)yh[q].y * (1.0f / 1024.0f)};
                p8_reduce_heads(y, j, r0, r1);
                lo[i * 64] = pk2(r0, r1);
#pragma unroll
                for (int q = 0; q < 8; ++q) yh[q] = (h16x2){(_Float16)0.f, (_Float16)0.f};
                p8h_compute_v(b2, lza + (i + 1) * 128 + j * 16, yh);     p8_issue(b2, lidx + (i2 + 1) * 128 + j * 16, rsV, s2 * (NEXP * 128), c16);
                p8h_compute_v(b3, lza + (i + 1) * 128 + j * 16 + 8, yh); p8_issue(b3, lidx + (i2 + 1) * 128 + j * 16 + 8, rsV, s2 * (NEXP * 128), c16);
#pragma unroll
                for (int q = 0; q < 8; ++q) y[q] = (f32x2){(float)yh[q].x * (1.0f / 1024.0f), (float)yh[q].y * (1.0f / 1024.0f)};
                p8_reduce_heads(y, j, r0, r1);
                lo[(i + 1) * 64] = pk2(r0, r1);
                if (i == 6 && s >= 4) {
                    LDS_WAIT(); asm volatile("" ::: "memory");
                    const v4u w0 = *(const LAS v4u*)(lout + (lane >> 4) * 64 + (lane & 15) * 4), w1 = *(const LAS v4u*)(lout + (4 + (lane >> 4)) * 64 + (lane & 15) * 4);
                    bf16* op = OUT + (size_t)(tb + (lane >> 4)) * D + s * 128 + (lane & 15) * 8;
                    pg8::wt_store16(rout, (size_t)(op - OUT) * 2, w0); pg8::wt_store16(rout, (size_t)(op + 4 * D - OUT) * 2, w1);
                }
            }
            {
                LAS unsigned* lo = lout + c * 8 + j;
                h16x2 yh[8]; f32x2 y[8]; float r0, r1;
#pragma unroll
                for (int q = 0; q < 8; ++q) yh[q] = (h16x2){(_Float16)0.f, (_Float16)0.f};
                p8h_compute_v(b0, lza + 6 * 128 + j * 16, yh);
                p8h_compute_v(b1, lza + 6 * 128 + j * 16 + 8, yh);
#pragma unroll
                for (int q = 0; q < 8; ++q) y[q] = (f32x2){(float)yh[q].x * (1.0f / 1024.0f), (float)yh[q].y * (1.0f / 1024.0f)};
                p8_reduce_heads(y, j, r0, r1);
                lo[6 * 64] = pk2(r0, r1);
#pragma unroll
                for (int q = 0; q < 8; ++q) yh[q] = (h16x2){(_Float16)0.f, (_Float16)0.f};
                p8h_compute_v(b2, lza + 7 * 128 + j * 16, yh);
                p8h_compute_v(b3, lza + 7 * 128 + j * 16 + 8, yh);
#pragma unroll
                for (int q = 0; q < 8; ++q) y[q] = (f32x2){(float)yh[q].x * (1.0f / 1024.0f), (float)yh[q].y * (1.0f / 1024.0f)};
                p8_reduce_heads(y, j, r0, r1);
                lo[7 * 64] = pk2(r0, r1);
                LDS_WAIT(); asm volatile("" ::: "memory");
                const v4u w0 = *(const LAS v4u*)(lout + (lane >> 4) * 64 + (lane & 15) * 4), w1 = *(const LAS v4u*)(lout + (4 + (lane >> 4)) * 64 + (lane & 15) * 4);
                bf16* op = OUT + (size_t)(tb + (lane >> 4)) * D + 7 * 128 + (lane & 15) * 8;
                pg8::wt_store16(rout, (size_t)(op - OUT) * 2, w0); pg8::wt_store16(rout, (size_t)(op + 4 * D - OUT) * 2, w1);
            }
        }
        }
        asm volatile("" :: "v"(pf));
        VM_WAIT(); __builtin_amdgcn_fence(__ATOMIC_ACQUIRE, "agent"); VM_WAIT(); LDS_WAIT(); asm volatile("" ::: "memory");
        const __amdgpu_buffer_rsrc_t ryo = pg8::wt_rsrc(YOUT);
        for (int frep = 0; frep < REPS(14); ++frep)
        for (int i0 = 0; i0 < 8; i0 += 4) {
            u32x2s hv[4][4], ov[4][4]; float ss[4];
#pragma unroll
            for (int rr = 0; rr < 4; ++rr) { const bf16* hrow = H16 + (size_t)(tb + i0 + rr) * D + 4 * lane; const bf16* orow = OUT + (size_t)(tb + i0 + rr) * D + 4 * lane;
                const LAS unsigned* krow = (const LAS unsigned*)lstage + (lane >> 5) * 512 + (i0 + rr) * 64 + ((2 * lane) & 63);
#pragma unroll
                for (int q = 0; q < 4; ++q) { hv[rr][q] = __builtin_nontemporal_load((const GAS u32x2s*)(hrow + 256 * q));
                    if (q < 2) ov[rr][q] = *(const LAS u32x2s*)(krow + q * 1024); else ov[rr][q] = __builtin_nontemporal_load((const GAS u32x2s*)(orow + 256 * q)); } }
            f32x4 gg[4];
#pragma unroll
            for (int q = 0; q < 4; ++q) gg[q] = *(const GAS f32x4*)(gfin + 256 * q + 4 * lane);
            f32x4 yv[4][4];
#pragma unroll
            for (int rr = 0; rr < 4; ++rr) { float a = 0.f;
#pragma unroll
                for (int q = 0; q < 4; ++q) { const unsigned h0 = hv[rr][q].x, h1 = hv[rr][q].y, o0 = ov[rr][q].x, o1 = ov[rr][q].y;
                    yv[rr][q] = (f32x4){bflo(h0) + bflo(o0), bfhi(h0) + bfhi(o0), bflo(h1) + bflo(o1), bfhi(h1) + bfhi(o1)};
                    a += (yv[rr][q].x * yv[rr][q].x + yv[rr][q].y * yv[rr][q].y) + (yv[rr][q].z * yv[rr][q].z + yv[rr][q].w * yv[rr][q].w); }
                ss[rr] = a; }
#pragma unroll
            for (int o = 1; o < 64; o <<= 1) {
#pragma unroll
                for (int rr = 0; rr < 4; ++rr) ss[rr] += __shfl_xor(ss[rr], o); }
#pragma unroll
            for (int rr = 0; rr < 4; ++rr) { const float rstd = 1.f / sqrtf(ss[rr] * (1.f / D) + EPS); float* yr = YOUT + (size_t)(tb + i0 + rr) * D + 4 * lane;
#pragma unroll
                for (int q = 0; q < 4; ++q) pg8::wt_store16(ryo, (size_t)((yr + 256 * q) - YOUT) * 4, __builtin_bit_cast(v4u, (f32x4){yv[rr][q].x * rstd * gg[q].x, yv[rr][q].y * rstd * gg[q].y, yv[rr][q].z * rstd * gg[q].z, yv[rr][q].w * rstd * gg[q].w})); }
        }
    }
}
template <bool GAIN>
__device__ __forceinline__ void cvt_fp8_rows(Frame& F, const float* src, unsigned char* dst, float* scale, int gw, int NGW, const float* gain) {
    const int lane = F.lane;
    const __amdgpu_buffer_rsrc_t rdst = pg8::wt_rsrc(dst);
    f32x4 gq[4];
    if (GAIN) {
#pragma unroll
        for (int q = 0; q < 4; ++q) gq[q] = ((const GAS f32x4*)gain)[4 * lane + q]; }
    const int step = NGW * 4, rlast = gw * 4 + ((NEXP - gw * 4 - 1) / step) * step;
    f32x4 va[4][4], vb[4][4];
#define CV_LOAD(V, r_) CV_LOADM(V, r_, true)
#define CV_LOADM(V, r_, ok_) do { const int lo_ = (ok_) ? 4 * lane : 0;     \
        _Pragma("unroll") for (int rr = 0; rr < 4; ++rr) { const GAS f32x4* sp = (const GAS f32x4*)(src + (size_t)((r_) + rr) * D) + lo_; \
        _Pragma("unroll") for (int q = 0; q < 4; ++q) V[rr][q] = sp[q]; } } while (0)
#define CV_FINISH(V, r_) do { \
        if (GAIN) { _Pragma("unroll") for (int rr = 0; rr < 4; ++rr) _Pragma("unroll") for (int q = 0; q < 4; ++q) V[rr][q] = V[rr][q] * gq[q]; } \
        float m[4]; \
        _Pragma("unroll") for (int rr = 0; rr < 4; ++rr) { float mm = 0.f; \
            _Pragma("unroll") for (int q = 0; q < 4; ++q) mm = fmaxf(mm, fmaxf(fmaxf(fabsf(V[rr][q].x), fabsf(V[rr][q].y)), fmaxf(fabsf(V[rr][q].z), fabsf(V[rr][q].w)))); \
            m[rr] = mm; } \
        _Pragma("unroll") for (int rr = 0; rr < 4; ++rr) m[rr] = wave_max_dpp(m[rr]); \
        _Pragma("unroll") for (int rr = 0; rr < 4; ++rr) { \
            const float sc = (m[rr] > 0.f) ? m[rr] * (1.0f / 448.0f) : 1.0f, inv = 1.0f / sc; \
            unsigned o[4]; \
            _Pragma("unroll") for (int q = 0; q < 4; ++q) o[q] = (unsigned)__builtin_amdgcn_cvt_pk_fp8_f32(V[rr][q].z * inv, V[rr][q].w * inv, __builtin_amdgcn_cvt_pk_fp8_f32(V[rr][q].x * inv, V[rr][q].y * inv, 0, false), true); \
            pg8::wt_store16(rdst, (size_t)(lane >> 3) * (NEXP * 128) + (size_t)((r_) + rr) * 128 + 16 * (lane & 7), (v4u){o[0], o[1], o[2], o[3]});     \
            if (lane == 0) scale[2 * ((r_) + rr)] = sc; } } while (0)
    if (gw * 4 < NEXP) {
        CV_LOAD(va, gw * 4);
        for (int r0 = gw * 4; r0 < NEXP; r0 += 2 * step) {
            const int r1 = (r0 + step < NEXP) ? r0 + step : rlast, r2 = (r0 + 2 * step < NEXP) ? r0 + 2 * step : rlast;
            CV_LOAD(vb, r1);
            CV_FINISH(va, r0);
            CV_LOADM(va, r2, r0 + 2 * step < NEXP);
            if (r0 + step < NEXP) CV_FINISH(vb, r1);
        }
    }
#undef CV_LOAD
#undef CV_LOADM
#undef CV_FINISH
}
struct Args { const float* in[15]; float* out; unsigned char* ws; int ph_lo, ph_hi; };
__global__ void __launch_bounds__(NWAVES * 64, 2) hyb_fwd(Args args) {
    extern __shared__ __attribute__((aligned(16))) unsigned char lds[];
    Frame F;
    F.lds = (LAS unsigned char*)lds;
    F.MISC = (volatile LAS unsigned*)(F.lds + MISC_OFF);
    F.tid = threadIdx.x; F.lane = F.tid & 63; F.wave = __builtin_amdgcn_readfirstlane(F.tid >> 6);
    F.G = gridDim.x; { const int bx = blockIdx.x; F.vcu = (F.G % 8 == 0) ? (bx % 8) * (F.G / 8) + bx / 8 : bx; }
    unsigned char* ws = args.ws;
    gu32* ctl = (gu32*)(ws + WS_CTL);
    const float* x = args.in[0]; const float* g_mix = args.in[1]; const float* w_in = args.in[2]; const float* conv_w = args.in[3]; const float* w_conv_out = args.in[4];
    const float* pool_w = args.in[5]; const float* pool_scale = args.in[6]; const float* w_pool_out = args.in[7]; const float* w_out = args.in[8]; const float* g_ffn = args.in[9];
    const float* w_query = args.in[10]; const float* sub_keys = args.in[11]; const float* expert_u = args.in[12]; const float* expert_v = args.in[13]; const float* g_fin = args.in[14];
    bf16* WIN = (bf16*)(ws + WS_WIN); bf16* WC = (bf16*)(ws + WS_WC); bf16* WPB = (bf16*)(ws + WS_WPB); bf16* WOUT = (bf16*)(ws + WS_WOUT); bf16* WSC = (bf16*)(ws + WS_WS);
    bf16* XN = (bf16*)(ws + WS_XN); bf16* PB = (bf16*)(ws + WS_PB); bf16* PG = (bf16*)(ws + WS_PG); bf16* TMP = (bf16*)(ws + WS_TMP); bf16* MG = (bf16*)(ws + WS_MG);
    float* SC = (float*)(ws + WS_SC); int* IDX = (int*)(ws + WS_IDX); float* GATE = (float*)(ws + WS_GATE); unsigned char* U8 = ws + WS_U8; unsigned char* V8 = ws + WS_V8; float* SU = (float*)(ws + WS_SU); float* SV = SU + 1;     bf16* H16 = (bf16*)(ws + WS_H16); unsigned char* X8 = ws + WS_X8; float* SX = (float*)(ws + WS_SX);
    float* RS1 = (float*)(ws + WS_RS1);
    float* SSQ = (float*)(ws + WS_XBUF); float* SXQ = (float*)(ws + WS_XBUF + 256 * 1024);
    bf16* AIN = (bf16*)(ws + WS_AIN); bf16* POOLED = AIN + (size_t)T * D; float* H = args.out;

    for (int u = F.tid; u < (LDS_BYTES - LDSCTL_OFF) / 4; u += NWAVES * 64) ((LAS unsigned*)(F.lds + LDSCTL_OFF))[u] = 0u;
    __syncthreads();
    XcdBarrier bar; bar.bar = (unsigned*)(ctl + CW_BAR); bar.x = 0; bar.st = nullptr;
    if (N_LAUNCHES == 1) bar = xcd_barrier_post((unsigned*)(ctl + CW_BAR), F.MISC + 8);
#define GRID_BAR() do { if (N_LAUNCHES == 1) xcd_barrier(bar); } while (0)
    const int lo = args.ph_lo, hi = args.ph_hi;
#define IN(k) (lo <= (k) && (k) < hi)
#define BOTH(k) (IN(k) && IN((k) + 1))
    const int gw = F.vcu * NWAVES + F.wave, NGW = F.G * NWAVES;

    if (IN(0)) { DELAY_T0(0); for (int rep = 0; rep < REPS(0); ++rep) {
        LAS float* scr = (LAS float*)(F.lds + RING_OFF + F.wave * 16384);
        constexpr int I_IN = (D / 64) * (NIN / 32), I_SQ = (D / 64) * (D / 32);
#pragma unroll 1
        for (int stage = 0; stage < 2; ++stage) {
            if ((stage == 0) == ((F.wave & 1) == 0)) {
                for (int it = gw; it < 2048; it += NGW) {
                    { const int hp = it >> 7, i0 = ((it >> 5) & 3) * 32, j0 = (it & 31) * 32;
                      fold_wave<4, 32, false>(scr, sub_keys + (size_t)hp * 16384 + (size_t)i0 * 128, 128, nullptr, w_query + (size_t)j0 * NSC + hp * 128, NSC, WSC + (size_t)(hp * 128 + i0) * D + j0, D, F.lane, g_ffn + j0); }
                    { const int g = it >> 9, i0 = ((it >> 4) & 31) * 32, j0 = (it & 15) * 16;
                      fold_wave<8, 16, true>(scr, w_pool_out + (size_t)g * 256 * D + i0, D, pool_scale + g * 256, pool_w + (size_t)g * 65536 + (size_t)j0 * 256, 256, WPB + (size_t)i0 * D + g * 256 + j0, D, F.lane); }
                }
            } else {
                for (int it = gw; it < I_IN + 2 * I_SQ; it += NGW) {
                    int r = it;
                    if (r < I_IN) { p0_transpose_item<true>(w_in, D, NIN, WIN, scr, r, F.lane, g_mix); continue; } r -= I_IN;
                    if (r < I_SQ) { p0_transpose_item<false>(w_conv_out, D, D, WC, scr, r, F.lane); continue; } r -= I_SQ;
                    p0_transpose_item<false>(w_out, D, D, WOUT, scr, r, F.lane);
                }
                for (int m = gw * 4; m < T; m += NGW * 4) rms_rows4_to_bf16(F.lane, x + (size_t)m * D, XN + (size_t)m * D, RS1 + m);
            }
        }
        }
        DELAY_END(0);
        if (BOTH(0)) GRID_BAR();
    }
    if (PROBE_DUP & 1024) { for (int xb = 0; xb < 10; ++xb) GRID_BAR(); }
    if (IN(1)) { DELAY_T0(1); for (int rep = 0; rep < REPS(1); ++rep) {
        pg8::Gemm g{XN, WIN, 0l, 0l, T, NIN, D}; pg8::StaticOrder S; S.init(T, NIN, F.G, (int)blockIdx.x);
        pg8::EpiProj E{RS1, PB, (long)(WS_PG - WS_PB), (pg8::bf16_t*)AIN, conv_w, (pg8::bf16_t*)(ws + WS_RAWU), (pg8::bf16_t*)(ws + WS_RAWB), (pg8::bf16_t*)POOLED};
        pg8::gemm_phase<pg8::EpiProj, pg8::StaticOrder, true, true>(F.lds + RING_OFF, g, S, E);
        }
        DELAY_END(1);
        if (BOTH(1)) GRID_BAR();
    }
    if (IN(2)) { DELAY_T0(2); for (int rep = 0; rep < REPS(2); ++rep) {
        p2_conv_pool(F, PB, conv_w, AIN, POOLED, (const bf16*)(ws + WS_RAWU), (const bf16*)(ws + WS_RAWB));
        }
        DELAY_END(2);
        if (BOTH(2)) GRID_BAR();
    }
    if (IN(3)) { DELAY_T0(3); for (int rep = 0; rep < REPS(3); ++rep) {
        pg8::Gemm g{AIN, WC, (long)T * D * 2, (long)(WS_WPB - WS_WC), T, D, D}; pg8::MergeOrder S; S.base.init(T, D, F.G, (int)blockIdx.x);
        pg8::EpiMerge E{(const unsigned char*)PG, MG};
        pg8::gemm_phase<pg8::EpiMerge, pg8::MergeOrder, true, true>(F.lds + RING_OFF, g, S, E);
        }
        DELAY_END(3);
        if (BOTH(3)) GRID_BAR();
    }
    if (IN(4)) { DELAY_T0(4); for (int rep = 0; rep < REPS(4); ++rep) {
        if (F.G == 256) {
            pg8::Gemm g{MG, WOUT, 0l, 0l, T, D, D}; pg8::StaticOrder S; S.init(T, D, F.G, (int)blockIdx.x);
            pg8::EpiResRms E{(const pg8::bf16_t*)XN, H16, X8, SSQ, SXQ};
            pg8::gemm_phase<pg8::EpiResRms, pg8::StaticOrder, false, true>(F.lds + RING_OFF, g, S, E);
            if (PROBE_DUP & 4096) { __syncthreads(); pg8::gemm_phase<pg8::EpiResRms, pg8::StaticOrder, false, true>(F.lds + RING_OFF, g, S, E); }
        } else {
            pg8::Gemm g{MG, WOUT, 0l, 0l, T, D, D}; pg8::StaticOrder S; S.init(T, D, F.G, (int)blockIdx.x);
            pg8::EpiRes E{x, H};
            pg8::gemm_phase<pg8::EpiRes, pg8::StaticOrder, true, true>(F.lds + RING_OFF, g, S, E);
            GRID_BAR();
            for (int m = gw; m < T; m += NGW) p4_row_defer(F.lane, H + (size_t)m * D, X8 + (size_t)m * D, SSQ + (size_t)m * 4, SXQ + (size_t)m * 4, H16 + (size_t)m * D);
        }
        }
        DELAY_END(4);
        if (BOTH(4)) GRID_BAR();
    }
    if (IN(5)) { DELAY_T0(5); for (int rep = 0; rep < REPS(5); ++rep) {
        pg8::Gemm g{(const pg8::bf16_t*)H16, WSC, 0l, 0l, T, NSC, D}; pg8::StaticOrder S; S.init(T, NSC, F.G, (int)blockIdx.x);
        pg8::EpiF16 E{(unsigned short*)SC, NSC};
        pg8::gemm_phase<pg8::EpiF16, pg8::StaticOrder, true, true>(F.lds + RING_OFF, g, S, E);
        }
        DELAY_END(5);
        if (BOTH(5)) GRID_BAR();
    }
    if (IN(6)) { DELAY_T0(6); for (int rep = 0; rep < REPS(6); ++rep) {
        const bool handoff = (F.G * NWAVES == T / 8);
        if (F.wave < 4) { __builtin_amdgcn_s_setprio(1);
            if (handoff) p7_topk(F, (const unsigned short*)SC, SSQ, IDX, GATE, F.vcu * 8 + F.wave, F.vcu * 8 + 8, 4, true); else p7_topk(F, (const unsigned short*)SC, SSQ, IDX, GATE, F.vcu * 4 + F.wave, T / 8, F.G * 4, false);
            __builtin_amdgcn_s_setprio(0); }
        else { cvt_fp8_rows<true>(F, expert_u, U8, SU, F.vcu * 4 + F.wave - 4, F.G * 4, g_ffn); cvt_fp8_rows<false>(F, expert_v, V8, SV, F.vcu * 4 + F.wave - 4, F.G * 4, nullptr); }
        }
        DELAY_END(6);
        if (BOTH(6)) GRID_BAR();
    }
    if (IN(7)) { DELAY_T0(7);
        for (int rep = 0; rep < REPS(7); ++rep)
        p8_peer(F, X8, SSQ, SXQ, U8, V8, SU, SV, IDX, GATE, H16, args.out, (bf16*)(ws + WS_PO), g_fin, F.G * NWAVES == T / 8);
        DELAY_END(7);
    }
#undef IN
#undef BOTH
}

extern "C" void kernel_launch(void* const* d_in, const int* in_sizes, int n_in, void* d_out, int out_size, void* d_ws, size_t ws_size, hipStream_t stream) {
    static int grid = 0;
    if (grid == 0) {
        if (n_in != 15 || in_sizes[0] != T * D || out_size != T * D || ws_size < WS_END) { fprintf(stderr, "kernel_launch: shape/workspace mismatch (n_in %d, in0 %d, out %d, ws %zu)\n", n_in, n_in > 0 ? in_sizes[0] : -1, out_size, ws_size); grid = -1; return; }
        int dev = 0, cus = 0, per_cu = 0;
        if (hipGetDevice(&dev) != hipSuccess || hipDeviceGetAttribute(&cus, hipDeviceAttributeMultiprocessorCount, dev) != hipSuccess) { grid = -1; return; }
        if (hipFuncSetAttribute((const void*)hyb_fwd, hipFuncAttributeMaxDynamicSharedMemorySize, LDS_BYTES) != hipSuccess) { fprintf(stderr, "kernel_launch: hipFuncSetAttribute failed\n"); grid = -1; return; }
        if (hipOccupancyMaxActiveBlocksPerMultiprocessor(&per_cu, (const void*)hyb_fwd, NWAVES * 64, LDS_BYTES) != hipSuccess || per_cu < 1)
            fprintf(stderr, "kernel_launch: note: occupancy query reports %d workgroups per CU\n", per_cu);
        (void)hipGetLastError();
        grid = cus;
    }
    if (grid < 0) return;
    if (hipMemsetAsync((char*)d_ws + WS_CTL, 0, CTL_ZERO_BYTES, stream) != hipSuccess) { fprintf(stderr, "kernel_launch: hipMemsetAsync failed\n"); return; }
    Args a{};
    for (int i = 0; i < 15; ++i) a.in[i] = (const float*)d_in[i];
    a.out = (float*)d_out; a.ws = (unsigned char*)d_ws;
    for (int li = 0; li < N_LAUNCHES; ++li) {
        a.ph_lo = (N_LAUNCHES == 1) ? 0 : li; a.ph_hi = (N_LAUNCHES == 1) ? NPHASE : li + 1;
        hipLaunchKernelGGL(hyb_fwd, dim3(grid), dim3(NWAVES * 64), LDS_BYTES, stream, a);
        const hipError_t le = hipPeekAtLastError();
        if (le != hipSuccess) { fprintf(stderr, "kernel_launch: launch %d failed: %s\n", li, hipGetErrorName(le)); break; }
    }
}
```
